# Optimizing an MI355X kernel written in HIP

```python
import jax, jax.numpy as jnp
from jax import lax
import numpy as np

D_MODEL = 1024
BATCH = 2
SEQ = 8192
DEPTH = 1

N_GROUPS = 3
HEADS_PER_GROUP = 4
HEAD_DIM = 128
DILATED_CONFIGS = ((128, 1), (512, 4), (2048, 16))
ATTN_WIDTH = N_GROUPS * HEADS_PER_GROUP * HEAD_DIM
ATTN_OUT = HEADS_PER_GROUP * HEAD_DIM
CONV_WIDTH = D_MODEL
CONV_K = 3
D_FF = 2816
EPS = 1e-6
N_MOD = 9
IN_SIZES = (ATTN_WIDTH, ATTN_WIDTH, ATTN_WIDTH, CONV_WIDTH, CONV_WIDTH, CONV_WIDTH, D_MODEL, D_MODEL)
IN_WIDTH = sum(IN_SIZES)
IN_SPLITS = tuple(int(s) for s in np.cumsum(IN_SIZES)[:-1])

kernel_name = "hybrid_dilated_attn_shortconv_macaron_adaln"


def rms_norm(x, g):
    x32 = x.astype(jnp.float32)
    y = x32 * lax.rsqrt(jnp.mean(x32 * x32, axis=-1, keepdims=True) + EPS)
    return (y * g.astype(jnp.float32)).astype(x.dtype)


def modulate(h, shift, scale):
    return h * (1.0 + scale[:, None, :]) + shift[:, None, :]


def swiglu(h, w_gate, w_up, w_down):
    return (jax.nn.silu(h @ w_gate) * (h @ w_up)) @ w_down


def dilated_band_attention(q, k, v, window, dilation):
    B, S, H, E = q.shape
    nw = window // dilation
    L = S // dilation
    nb = -(-L // nw)
    Lp = nb * nw

    def to_blocks(t):
        t = t.reshape(B, L, dilation, H, E).transpose(0, 2, 3, 1, 4)
        t = jnp.pad(t, ((0, 0), (0, 0), (0, 0), (0, Lp - L), (0, 0)))
        return t.reshape(B, dilation, H, nb, nw, E)

    def with_prev(t):
        prev = jnp.pad(t[:, :, :, :-1], ((0, 0), (0, 0), (0, 0), (1, 0), (0, 0), (0, 0)))
        return jnp.concatenate([prev, t], axis=4)

    qb = to_blocks(q)
    kc = with_prev(to_blocks(k))
    vc = with_prev(to_blocks(v))
    s = jnp.einsum('brhnqe,brhnke->brhnqk', qb, kc) * (E ** -0.5)
    qi = jnp.arange(nw)
    kj = jnp.arange(2 * nw)
    rel = nw + qi[:, None] - kj[None, :]
    band = (rel >= 0) & (rel <= nw)
    key_pos = jnp.arange(nb)[:, None] * nw - nw + kj[None, :]
    mask = band[None, :, :] & (key_pos >= 0)[:, None, :]
    s = jnp.where(mask, s, -jnp.inf)
    m = jnp.max(s, axis=-1, keepdims=True)
    p = jnp.exp(s - m)
    denom = jnp.sum(p, axis=-1, keepdims=True)
    o = jnp.einsum('brhnqk,brhnke->brhnqe', p, vc) / denom
    lse = (m + jnp.log(denom))[..., 0]
    o = o.reshape(B, dilation, H, Lp, E)[:, :, :, :L].transpose(0, 3, 1, 2, 4).reshape(B, S, H, E)
    lse = lse.reshape(B, dilation, H, Lp)[:, :, :, :L].transpose(0, 3, 1, 2).reshape(B, S, H)
    return o, lse


def hybrid_mixer(h, w_in, q_norm, k_norm, conv_w, w_attn_branch, w_conv_branch, w_out):
    B, S, _ = h.shape
    proj = h @ w_in
    q, k, v, u, b_gate, c_gate, g_attn, g_conv = jnp.split(proj, IN_SPLITS, axis=-1)
    q = rms_norm(q.reshape(B, S, N_GROUPS, HEADS_PER_GROUP, HEAD_DIM), q_norm).astype(jnp.float32)
    k = rms_norm(k.reshape(B, S, N_GROUPS, HEADS_PER_GROUP, HEAD_DIM), k_norm).astype(jnp.float32)
    v = v.reshape(B, S, N_GROUPS, HEADS_PER_GROUP, HEAD_DIM).astype(jnp.float32)
    outs, lses = [], []
    for g, (window, dilation) in enumerate(DILATED_CONFIGS):
        o_g, lse_g = dilated_band_attention(q[:, :, g], k[:, :, g], v[:, :, g], window, dilation)
        outs.append(o_g)
        lses.append(lse_g)
    weights = jax.nn.softmax(jnp.stack(lses, axis=0), axis=0)
    o = jnp.einsum('gbsh,gbshe->bshe', weights, jnp.stack(outs, axis=0))
    y_attn = o.reshape(B, S, ATTN_OUT).astype(h.dtype) @ w_attn_branch
    xc = c_gate * u
    xp = jnp.pad(xc, ((0, 0), (CONV_K - 1, 0), (0, 0)))
    conv = xp[:, 0:S] * conv_w[0]
    for j in range(1, CONV_K):
        conv = conv + xp[:, j:j + S] * conv_w[j]
    y_conv = (b_gate * conv) @ w_conv_branch
    merged = jax.nn.sigmoid(g_attn) * y_attn + jax.nn.sigmoid(g_conv) * y_conv
    return merged @ w_out


def setup_inputs(seed: int = 0) -> dict:
    key = jax.random.key(seed)
    ks = jax.random.split(key, 24)
    f32 = jnp.float32
    L, D = DEPTH, D_MODEL

    def nrm(k, shape, scale):
        return jax.random.normal(k, shape, f32) * scale

    return {
        'x': nrm(ks[0], (BATCH, SEQ, D), 1.0),
        'c': nrm(ks[1], (BATCH, D), 1.0),
        'w_ada': nrm(ks[2], (L, D, N_MOD * D), 0.5 * D ** -0.5),
        'b_ada': nrm(ks[3], (L, N_MOD * D), 0.01),
        'norm_ffn1': 1.0 + nrm(ks[4], (L, D), 0.01),
        'ffn1_w_gate': nrm(ks[5], (L, D, D_FF), D ** -0.5),
        'ffn1_w_up': nrm(ks[6], (L, D, D_FF), D ** -0.5),
        'ffn1_w_down': nrm(ks[7], (L, D_FF, D), D_FF ** -0.5),
        'norm_mix': 1.0 + nrm(ks[8], (L, D), 0.01),
        'w_in': nrm(ks[9], (L, D, IN_WIDTH), D ** -0.5),
        'q_norm': 1.0 + nrm(ks[10], (L, HEAD_DIM), 0.01),
        'k_norm': 1.0 + nrm(ks[11], (L, HEAD_DIM), 0.01),
        'conv_w': nrm(ks[12], (L, CONV_K, CONV_WIDTH), CONV_K ** -0.5),
        'w_attn_branch': nrm(ks[13], (L, ATTN_OUT, D), ATTN_OUT ** -0.5),
        'w_conv_branch': nrm(ks[14], (L, CONV_WIDTH, D), CONV_WIDTH ** -0.5),
        'w_out': nrm(ks[15], (L, D, D), D ** -0.5),
        'norm_ffn2': 1.0 + nrm(ks[16], (L, D), 0.01),
        'ffn2_w_gate': nrm(ks[17], (L, D, D_FF), D ** -0.5),
        'ffn2_w_up': nrm(ks[18], (L, D, D_FF), D ** -0.5),
        'ffn2_w_down': nrm(ks[19], (L, D_FF, D), D_FF ** -0.5),
    }


def reference(x, c, w_ada, b_ada, norm_ffn1, ffn1_w_gate, ffn1_w_up, ffn1_w_down,
              norm_mix, w_in, q_norm, k_norm, conv_w, w_attn_branch, w_conv_branch, w_out,
              norm_ffn2, ffn2_w_gate, ffn2_w_up, ffn2_w_down):
    c_act = jax.nn.silu(c)
    for l in range(DEPTH):
        mod = c_act @ w_ada[l] + b_ada[l]
        sh1, sc1, gt1, sh2, sc2, gt2, sh3, sc3, gt3 = jnp.split(mod, N_MOD, axis=-1)
        h = modulate(rms_norm(x, norm_ffn1[l]), sh1, sc1)
        x = x + 0.5 * gt1[:, None, :] * swiglu(h, ffn1_w_gate[l], ffn1_w_up[l], ffn1_w_down[l])
        h = modulate(rms_norm(x, norm_mix[l]), sh2, sc2)
        x = x + gt2[:, None, :] * hybrid_mixer(h, w_in[l], q_norm[l], k_norm[l], conv_w[l],
                                               w_attn_branch[l], w_conv_branch[l], w_out[l])
        h = modulate(rms_norm(x, norm_ffn2[l]), sh3, sc3)
        x = x + 0.5 * gt3[:, None, :] * swiglu(h, ffn2_w_gate[l], ffn2_w_up[l], ffn2_w_down[l])
    return x
```

```cpp
#include <hip/hip_runtime.h>
#include <hip/hip_bf16.h>
#include <cstdio>
#include <cstdint>

constexpr int DM = 1024, BATCH = 2, SEQ = 8192, M = BATCH * SEQ;
constexpr int DFF = 2816, NMOD = 9 * DM;
constexpr int AW = 1536;
constexpr int INW = 9728;
constexpr int COL_Q = 0, COL_K = 1536, COL_V = 3072, COL_U = 4608, COL_B = 5632, COL_C = 6656, COL_GA = 7680, COL_GC = 8704;
constexpr float EPS = 1e-6f;

namespace pg8 {
#define PG8_LAS __attribute__((address_space(3)))
typedef unsigned short bf16_t;
typedef short bf16x8 __attribute__((ext_vector_type(8)));
typedef float f32x4 __attribute__((ext_vector_type(4)));
typedef unsigned u32x4 __attribute__((ext_vector_type(4)));
constexpr int BM = 256, BK = 64, HALF = 128, HTB = HALF * BK * 2  , STAGE_BYTES = 8 * HTB, NXCD = 8, WGM = 8;

__host__ __device__ __forceinline__ int lds_byte(int r, int c) { const int st = (r >> 4) * 2 + (c >> 5), rr = r & 15, cc = c & 31, ob = rr * 64 + cc * 2; return st * 1024 + (ob ^ (((ob >> 9) & 1) << 5)); }
__host__ __device__ __forceinline__ void stage_rc(int b, int& R, int& C) { const int st = b / 1024, sb = b % 1024, swz = sb ^ (((sb >> 9) & 1) << 5); R = (st >> 1) * 16 + swz / 64; C = (st & 1) * 32 + (swz % 64) / 2; }
__host__ __device__ __forceinline__ int perm32(int rho) { const int n = rho >> 4, i = rho & 15; return 8 * (i >> 2) + 4 * n + (i & 3); }

struct Unit { int pm, pn; };
struct Gemm { const bf16_t* A; const bf16_t* Bt; int M, N, K; };

struct StaticOrder {
    int nM, nN, nwg, G, c;
    __host__ __device__ void init(int M, int N, int G_, int c_) { nM = M / BM; nN = N / BM; nwg = nM * nN; G = G_; c = c_; }
    __host__ __device__ bool next(int i, Unit& u) const {
        const long L = (long)i * G + c; if (L >= nwg) return false;
        int wgid = (int)L; { const int q = nwg / NXCD, r = nwg % NXCD, xcd = wgid % NXCD, off = wgid / NXCD; wgid = (xcd < r ? xcd * (q + 1) : r * (q + 1) + (xcd - r) * q) + off; }
        const int nig = WGM * nN, gid = wgid / nig, fm = gid * WGM, gsz = (nM - fm) < WGM ? (nM - fm) : WGM;
        u.pm = fm + ((wgid % nig) % gsz); u.pn = (wgid % nig) / gsz; return true;
    }
    __device__ __forceinline__ void a_ready(const Unit&) const {}
    __device__ __forceinline__ void done(const Unit&) const {}
};

typedef float f32x2_t __attribute__((ext_vector_type(2))); typedef __bf16 bf16x2_t __attribute__((ext_vector_type(2)));
__device__ __forceinline__ unsigned cvt_pk_bf16(float lo, float hi) { f32x2_t v = {lo, hi}; bf16x2_t b = __builtin_convertvector(v, bf16x2_t); return __builtin_bit_cast(unsigned, b); }
__device__ __forceinline__ float bf_lo(unsigned w) { return __uint_as_float(w << 16); }
__device__ __forceinline__ float bf_hi(unsigned w) { return __uint_as_float(w & 0xffff0000u); }
__device__ __forceinline__ float sigmoidf_(float x) { return __builtin_amdgcn_rcpf(1.0f + __builtin_amdgcn_exp2f(-1.4426950408889634f * x)); }
__device__ __forceinline__ void unpack8(const u32x4 w, f32x4& a, f32x4& b) { a = (f32x4){bf_lo(w.x), bf_hi(w.x), bf_lo(w.y), bf_hi(w.y)}; b = (f32x4){bf_lo(w.z), bf_hi(w.z), bf_lo(w.w), bf_hi(w.w)}; }
__device__ __forceinline__ u32x4 pack8(const f32x4 a, const f32x4 b) { u32x4 w; w.x = cvt_pk_bf16(a[0], a[1]); w.y = cvt_pk_bf16(a[2], a[3]); w.z = cvt_pk_bf16(b[0], b[1]); w.w = cvt_pk_bf16(b[2], b[3]); return w; }

enum { EB_PLAIN = 0, EB_SWIGLU = 1, EB_SIGMOID = 2, EB_GATEMUL = 3, EB_MERGE = 4 };
template <int mode> struct EpiB {
    static constexpr bool PERM = true, AFTER_DRAIN = false;
    bf16_t* O; int ldc; int split_cols; size_t split_stride; const bf16_t* In1; const bf16_t* In2;
    __device__ __forceinline__ void operator()(const f32x4 (&acc)[2][2][4][2], const Unit& u, int wr, int wc, int fr, int fq) const {
        const int row0 = u.pm * BM + wr * 64 + fr;
        if (mode == EB_SWIGLU) {
            const int col0 = u.pn * HALF + wc * 32 + 8 * fq;
#pragma unroll
            for (int ai = 0; ai < 2; ++ai)
#pragma unroll
                for (int m = 0; m < 4; ++m) { bf16_t* rowp = O + (size_t)(row0 + ai * HALF + m * 16) * ldc + col0;
                    f32x4 v0, v1;
#pragma unroll
                    for (int i = 0; i < 4; ++i) { const float g0 = acc[ai][0][m][0][i], g1 = acc[ai][0][m][1][i];
                        v0[i] = g0 * sigmoidf_(g0) * acc[ai][1][m][0][i]; v1[i] = g1 * sigmoidf_(g1) * acc[ai][1][m][1][i]; }
                    *(u32x4*)rowp = pack8(v0, v1); }
            return;
        }
        int colt = u.pn * BM; size_t boff = 0;
        if (split_cols) { const int t = colt / split_cols; boff = (size_t)t * split_stride; colt -= t * split_cols; }
        const int col0 = colt + wc * 32 + 8 * fq;
#pragma unroll
        for (int ai = 0; ai < 2; ++ai)
#pragma unroll
            for (int m = 0; m < 4; ++m) { const size_t roff = boff + (size_t)(row0 + ai * HALF + m * 16) * ldc + col0;
#pragma unroll
                for (int bj = 0; bj < 2; ++bj) { const size_t off = roff + bj * HALF; f32x4 v0 = acc[ai][bj][m][0], v1 = acc[ai][bj][m][1];
                    if (mode == EB_SIGMOID) {
#pragma unroll
                        for (int i = 0; i < 4; ++i) { v0[i] = sigmoidf_(v0[i]); v1[i] = sigmoidf_(v1[i]); }
                    } else if (mode == EB_GATEMUL) { f32x4 a0, a1; unpack8(*(const u32x4*)(In1 + off), a0, a1); v0 = v0 * a0; v1 = v1 * a1; }
                    else if (mode == EB_MERGE) { f32x4 a0, a1, g0, g1; unpack8(*(const u32x4*)(In1 + off), a0, a1); unpack8(*(const u32x4*)(In2 + off), g0, g1); v0 = a0 + g0 * v0; v1 = a1 + g1 * v1; }
                    *(u32x4*)(O + off) = pack8(v0, v1); } }
    }
};
struct EpiF {
    static constexpr bool PERM = false, AFTER_DRAIN = false;
    const float* base; float* out; const float* coef; float scale;
    __device__ __forceinline__ void operator()(const f32x4 (&acc)[2][2][4][2], const Unit& u, int wr, int wc, int fr, int fq) const {
        const int row0 = u.pm * BM + wr * 64 + fr, col0 = u.pn * BM + wc * 32 + 4 * fq;
        const float* cf = coef + (size_t)((u.pm * BM) / SEQ) * NMOD + col0;
        f32x4 cv[2][2];
#pragma unroll
        for (int bj = 0; bj < 2; ++bj)
#pragma unroll
            for (int n = 0; n < 2; ++n) cv[bj][n] = *(const f32x4*)(cf + bj * HALF + n * 16) * scale;
#pragma unroll
        for (int ai = 0; ai < 2; ++ai)
#pragma unroll
            for (int m = 0; m < 4; ++m) { const size_t off = (size_t)(row0 + ai * HALF + m * 16) * DM + col0;
#pragma unroll
                for (int bj = 0; bj < 2; ++bj)
#pragma unroll
                    for (int n = 0; n < 2; ++n) { const f32x4 bs = *(const f32x4*)(base + off + bj * HALF + n * 16); *(f32x4*)(out + off + bj * HALF + n * 16) = bs + cv[bj][n] * acc[ai][bj][m][n]; } }
    }
};

template <class Epi, class Sched, bool ALIGN_EPI = false, bool SP2 = false>
__device__ __forceinline__ void gemm_phase(PG8_LAS unsigned char* lds, const Gemm g, const Sched& S, const Epi& E) {
    const int tid = threadIdx.x, wid = __builtin_amdgcn_readfirstlane(tid >> 6), lane = tid & 63, wr = wid >> 2, wc = wid & 3, fr = lane & 15, fq = lane >> 4;
    const int K = g.K, nt = K / BK;
    unsigned voffA[2], voffB[2];
#pragma unroll
    for (int i = 0; i < 2; ++i) { int R, C; stage_rc(tid * 16 + i * 8192, R, C); const int Rb = Epi::PERM ? ((R & ~31) + perm32(R & 31)) : R;
        voffA[i] = (unsigned)(R * K + C) * 2u; voffB[i] = (unsigned)(Rb * K + C) * 2u; }
    const size_t kstep = (size_t)(BK * 2);
    const size_t hstep = (size_t)HALF * K * 2;
    const size_t tstep = 2 * hstep;
    const unsigned ldsw = (unsigned)wid * 1024u;
    const int aoff = lds_byte(wr * 64 + fr, fq * 8), boff = lds_byte(wc * 32 + fr, fq * 8);
#define PG8_SA(b, h) (((b) * 2 + (h)) * HTB)
#define PG8_SB(b, h) ((4 + (b) * 2 + (h)) * HTB)
#define PG8_STAGE(bufoff, gbase, voff) do { _Pragma("unroll") for (int _i = 0; _i < 2; ++_i) \
        __builtin_amdgcn_global_load_lds((const unsigned*)((const char*)(gbase) + (voff)[_i]), (PG8_LAS unsigned*)(lds + (bufoff) + ldsw + _i * 8192), 16, 0, 0); } while (0)
#define PG8_LDA(dst, b, h) do { _Pragma("unroll") for (int m = 0; m < 4; ++m) _Pragma("unroll") for (int k = 0; k < 2; ++k) dst[m][k] = *(const PG8_LAS bf16x8*)(lds + PG8_SA(b, h) + aoff + m * 2048 + k * 1024); } while (0)
#define PG8_LDB(dst, b, h) do { _Pragma("unroll") for (int n = 0; n < 2; ++n) _Pragma("unroll") for (int k = 0; k < 2; ++k) dst[n][k] = *(const PG8_LAS bf16x8*)(lds + PG8_SB(b, h) + boff + n * 2048 + k * 1024); } while (0)
#define PG8_MMA(ai, bj, At, Bt) do { __builtin_amdgcn_s_setprio(1); _Pragma("unroll") for (int m = 0; m < 4; ++m) _Pragma("unroll") for (int n = 0; n < 2; ++n) _Pragma("unroll") for (int k = 0; k < 2; ++k) \
        acc[ai][bj][m][n] = __builtin_amdgcn_mfma_f32_16x16x32_bf16(Bt[n][k], At[m][k], acc[ai][bj][m][n], 0, 0, 0); __builtin_amdgcn_s_setprio(0); } while (0)
#define PG8_WAIT_V(n) asm volatile("s_waitcnt vmcnt(" #n ")" ::: "memory")
#define PG8_WAIT_L(n) asm volatile("s_waitcnt lgkmcnt(" #n ")" ::: "memory")
#define PG8_BAR __builtin_amdgcn_s_barrier()
#define PG8_SCHED __builtin_amdgcn_sched_barrier(0)
    Unit cur, nxt; int ui = 0;
    if (!S.next(0, cur)) return;
    f32x4 acc[2][2][4][2];
#pragma unroll
    for (int a = 0; a < 2; ++a)
#pragma unroll
        for (int b = 0; b < 2; ++b)
#pragma unroll
            for (int m = 0; m < 4; ++m)
#pragma unroll
                for (int n = 0; n < 2; ++n) acc[a][b][m][n] = (f32x4){0.f, 0.f, 0.f, 0.f};
    bf16x8 At[4][2], B0[2][2], B1[2][2];
    const char* cA = (const char*)g.A + (size_t)cur.pm * tstep; const char* cB = (const char*)g.Bt + (size_t)cur.pn * tstep;
    S.a_ready(cur);
    if constexpr (SP2) {
        PG8_STAGE(PG8_SB(0, 0), cB, voffB); PG8_STAGE(PG8_SB(0, 1), cB + hstep, voffB); PG8_STAGE(PG8_SA(0, 0), cA, voffA); PG8_STAGE(PG8_SA(0, 1), cA + hstep, voffA);
        if (wr == 1) PG8_BAR;
        PG8_WAIT_V(2); PG8_BAR;
        PG8_STAGE(PG8_SB(1, 0), cB + kstep, voffB); PG8_STAGE(PG8_SA(1, 0), cA + kstep, voffA); PG8_STAGE(PG8_SB(1, 1), cB + hstep + kstep, voffB);
        PG8_WAIT_V(6); PG8_BAR;
    } else {
        PG8_STAGE(PG8_SB(0, 0), cB, voffB); PG8_STAGE(PG8_SA(0, 0), cA, voffA); PG8_STAGE(PG8_SB(0, 1), cB + hstep, voffB); PG8_STAGE(PG8_SA(0, 1), cA + hstep, voffA);
        if (wr == 1) PG8_BAR;
        PG8_WAIT_V(4); PG8_BAR;
        PG8_STAGE(PG8_SB(1, 0), cB + kstep, voffB); PG8_STAGE(PG8_SA(1, 0), cA + kstep, voffA); PG8_STAGE(PG8_SB(1, 1), cB + hstep + kstep, voffB);
        PG8_WAIT_V(6); PG8_BAR;
    }
    for (;;) {
        const bool has_next = S.next(ui + 1, nxt);
        const char* nA = has_next ? (const char*)g.A + (size_t)nxt.pm * tstep : cA; const char* nB = has_next ? (const char*)g.Bt + (size_t)nxt.pn * tstep : cB;
        for (int t = 0; t < nt; t += 2) {
            const bool last = (t == nt - 2);
            const char* a1 = cA + (size_t)(t + 1) * kstep;
            const char* a2 = last ? nA : cA + (size_t)(t + 2) * kstep; const char* b2 = last ? nB : cB + (size_t)(t + 2) * kstep;
            const char* a3 = a2 + kstep; const char* b3 = b2 + kstep;
            if (last && has_next) S.a_ready(nxt);
            if constexpr (SP2) {
            PG8_LDB(B0, 0, 0); PG8_LDB(B1, 0, 1); PG8_SCHED; PG8_LDA(At, 0, 0); PG8_STAGE(PG8_SA(1, 1), a1 + hstep, voffA);
            PG8_WAIT_V(8); PG8_WAIT_L(0); PG8_BAR; PG8_MMA(0, 0, At, B0); PG8_MMA(0, 1, At, B1); PG8_BAR; PG8_SCHED;
            PG8_LDA(At, 0, 1); PG8_STAGE(PG8_SB(0, 0), b2, voffB); PG8_STAGE(PG8_SB(0, 1), b2 + hstep, voffB); PG8_STAGE(PG8_SA(0, 0), a2, voffA);
            PG8_WAIT_V(8); PG8_WAIT_L(0); PG8_BAR; PG8_MMA(1, 0, At, B0); PG8_MMA(1, 1, At, B1); PG8_BAR; PG8_SCHED;
            PG8_LDB(B0, 1, 0); PG8_LDB(B1, 1, 1); PG8_SCHED; PG8_LDA(At, 1, 0); PG8_STAGE(PG8_SA(0, 1), a2 + hstep, voffA);
            PG8_WAIT_V(8); PG8_WAIT_L(0); PG8_BAR; PG8_MMA(0, 0, At, B0); PG8_MMA(0, 1, At, B1); PG8_BAR; PG8_SCHED;
            PG8_LDA(At, 1, 1); PG8_STAGE(PG8_SB(1, 0), b3, voffB); PG8_STAGE(PG8_SB(1, 1), b3 + hstep, voffB); PG8_STAGE(PG8_SA(1, 0), a3, voffA);
            PG8_WAIT_V(8); PG8_WAIT_L(0); PG8_BAR; PG8_MMA(1, 0, At, B0); PG8_MMA(1, 1, At, B1); PG8_BAR; PG8_SCHED;
            } else {
            PG8_LDB(B0, 0, 0); PG8_SCHED; PG8_LDA(At, 0, 0); PG8_STAGE(PG8_SA(1, 1), a1 + hstep, voffA);
            PG8_WAIT_L(8); PG8_BAR; PG8_WAIT_L(0); PG8_MMA(0, 0, At, B0); PG8_BAR; PG8_SCHED;
            PG8_LDB(B1, 0, 1); PG8_STAGE(PG8_SB(0, 0), b2, voffB);
            PG8_BAR; PG8_WAIT_L(0); PG8_MMA(0, 1, At, B1); PG8_BAR;
            PG8_LDA(At, 0, 1); PG8_STAGE(PG8_SA(0, 0), a2, voffA);
            PG8_BAR; PG8_WAIT_L(0); PG8_MMA(1, 0, At, B0); PG8_BAR; PG8_SCHED;
            PG8_STAGE(PG8_SB(0, 1), b2 + hstep, voffB);
            PG8_WAIT_V(6); PG8_BAR; PG8_MMA(1, 1, At, B1); PG8_BAR;
            PG8_LDB(B0, 1, 0); PG8_SCHED; PG8_LDA(At, 1, 0); PG8_STAGE(PG8_SA(0, 1), a2 + hstep, voffA);
            PG8_WAIT_L(8); PG8_BAR; PG8_WAIT_L(0); PG8_MMA(0, 0, At, B0); PG8_BAR; PG8_SCHED;
            PG8_LDB(B1, 1, 1); PG8_STAGE(PG8_SB(1, 0), b3, voffB);
            PG8_BAR; PG8_WAIT_L(0); PG8_MMA(0, 1, At, B1); PG8_BAR;
            PG8_LDA(At, 1, 1); PG8_STAGE(PG8_SA(1, 0), a3, voffA);
            PG8_BAR; PG8_WAIT_L(0); PG8_MMA(1, 0, At, B0); PG8_BAR; PG8_SCHED;
            PG8_STAGE(PG8_SB(1, 1), b3 + hstep, voffB);
            PG8_WAIT_V(6); PG8_BAR; PG8_MMA(1, 1, At, B1); PG8_BAR;
            }
        }
        if constexpr (ALIGN_EPI) { if (wr == 0) PG8_BAR; }
        if constexpr (!Epi::AFTER_DRAIN) { E(acc, cur, wr, wc, fr, fq); S.done(cur); }
        if (!has_next) break;
#pragma unroll
        for (int a = 0; a < 2; ++a)
#pragma unroll
            for (int b = 0; b < 2; ++b)
#pragma unroll
                for (int m = 0; m < 4; ++m)
#pragma unroll
                    for (int n = 0; n < 2; ++n) acc[a][b][m][n] = (f32x4){0.f, 0.f, 0.f, 0.f};
        cur = nxt; cA = nA; cB = nB; ++ui;
        if constexpr (ALIGN_EPI) { if (wr == 1) PG8_BAR; }
    }
    PG8_WAIT_V(0);
    if constexpr (!ALIGN_EPI) { if (wr == 0) PG8_BAR; }
    PG8_BAR;
    if constexpr (Epi::AFTER_DRAIN) { E.fused(acc, cur, wr, wc, fr, fq, lds, wid, lane); S.done(cur); }
#undef PG8_SA
#undef PG8_SB
#undef PG8_STAGE
#undef PG8_LDA
#undef PG8_LDB
#undef PG8_MMA
#undef PG8_WAIT_V
#undef PG8_WAIT_L
#undef PG8_BAR
#undef PG8_SCHED
}
}

namespace attn {
constexpr int D = 128;
constexpr int WINDOW = 129;
constexpr float THR = 8.f;
constexpr bool WSKIP = true;
constexpr float SCALE = 0.08838834764831845f;
constexpr int NW = 8, QBLK = 32, KVBLK = 64, QB = NW * QBLK;
constexpr int SHM_V = KVBLK * D * 2, SHM_K = KVBLK * D * 2;
constexpr int LDS_BYTES = 2 * SHM_V + 2 * SHM_K + NW * 64 * 4;
using bf16 = __hip_bfloat16;
typedef short bf16x8 __attribute__((ext_vector_type(8)));
typedef short s16x4 __attribute__((ext_vector_type(4)));
typedef float f32x16 __attribute__((ext_vector_type(16)));
typedef float f32x4 __attribute__((ext_vector_type(4)));
typedef unsigned u32x4 __attribute__((ext_vector_type(4)));
template <class A, class Bt> struct same_t { static constexpr bool v = false; };
template <class A> struct same_t<A, A> { static constexpr bool v = true; };

#define KSWZ(row, colB) ((row) * 256 + ((colB) ^ (((row) & 7) << 4)))
#define SBAR() __builtin_amdgcn_sched_barrier(0)
__device__ __forceinline__ int v_st(int k, int c) { const int kk = (k & ~0xC) | ((k & 4) << 1) | ((k & 8) >> 1); return ((kk >> 3) * 4 + (c >> 5)) * 512 + ((kk & 7) * 32 + (c & 31)) * 2; }
__device__ __forceinline__ int v_rd_base(int lane) { return ((lane & 3) << 3) | (((lane >> 2) & 3) << 6) | (((lane >> 4) & 1) << 5) | (((lane >> 5) & 1) << 8); }
constexpr int v_rd_off(int d0, int ks, int half) { return d0 * 512 + ks * 4096 + half * 2048; }
__device__ __forceinline__ int crow(int r, int hi) { return (r & 3) + 8 * (r >> 2) + 4 * hi; }
__device__ __forceinline__ unsigned cvtpk(float lo, float hi) {
    unsigned r; asm volatile("v_cvt_pk_bf16_f32 %0, %1, %2" : "=v"(r) : "v"(lo), "v"(hi)); return r;
}
__device__ __forceinline__ bf16x8 pack8(f32x4 a, f32x4 b) {
    u32x4 w = {cvtpk(a[0], a[1]), cvtpk(a[2], a[3]), cvtpk(b[0], b[1]), cvtpk(b[2], b[3])};
    return *reinterpret_cast<bf16x8*>(&w);
}
template <class T> __device__ __forceinline__ bf16x8 load8(const T* p) {
    if constexpr (same_t<T, float>::v) { return pack8(*(const f32x4*)p, *(const f32x4*)(p + 4)); }
    else { return *reinterpret_cast<const bf16x8*>(p); }
}
__device__ __forceinline__ void mask_tile(f32x16& p0, f32x16& p1, int dq, unsigned W) {
    const float NEG = -__builtin_inff();
#pragma unroll
    for (int r = 0; r < 16; ++r) {
        const int c = (r & 3) + 8 * (r >> 2);
        if ((unsigned)(dq - c) >= W) p0[r] = NEG;
        if ((unsigned)(dq - c - 32) >= W) p1[r] = NEG;
    }
}
__device__ __forceinline__ void partialSM(f32x16& p0, f32x16& p1, float& m_reg, float& mn, float& alpha) {
    float pmax = p0[0]; for (int r = 1; r < 16; ++r) pmax = fmaxf(pmax, p0[r]); for (int r = 0; r < 16; ++r) pmax = fmaxf(pmax, p1[r]);
    { auto rr = __builtin_amdgcn_permlane32_swap(__float_as_uint(pmax), __float_as_uint(pmax), false, false);
      pmax = fmaxf(__uint_as_float(rr[0]), __uint_as_float(rr[1])); }
    constexpr float C2 = 1.4426950408889634f * SCALE;
    if (__builtin_expect(__all((pmax - m_reg) * SCALE <= THR), 1)) { mn = m_reg; alpha = 1.f; }
    else { mn = fmaxf(m_reg, pmax); alpha = __builtin_amdgcn_exp2f((m_reg - mn) * C2); m_reg = mn; }
    const float mnL = -mn * C2;
    for (int r = 0; r < 16; ++r) p0[r] = fmaf(p0[r], C2, mnL); for (int r = 0; r < 16; ++r) p1[r] = fmaf(p1[r], C2, mnL);
    for (int r = 0; r < 16; ++r) p0[r] = __builtin_amdgcn_exp2f(p0[r]);
}
__device__ __forceinline__ void finishSM(f32x16& p0, f32x16& p1, float alpha, float& l_reg, bf16x8& pa0, bf16x8& pa1, bf16x8& pa2, bf16x8& pa3) {
    for (int r = 0; r < 16; ++r) p1[r] = __builtin_amdgcn_exp2f(p1[r]);
    float ps = 0; for (int r = 0; r < 16; ++r) ps += p0[r]; for (int r = 0; r < 16; ++r) ps += p1[r];
    { auto rr = __builtin_amdgcn_permlane32_swap(__float_as_uint(ps), __float_as_uint(ps), false, false);
      ps = __uint_as_float(rr[0]) + __uint_as_float(rr[1]); }
    l_reg = l_reg * alpha + ps;
#define PK4(P, B_, OUT) do { unsigned a0 = cvtpk(P[B_+0], P[B_+1]), a1 = cvtpk(P[B_+2], P[B_+3]);                          \
        unsigned b0 = cvtpk(P[B_+4], P[B_+5]), b1 = cvtpk(P[B_+6], P[B_+7]);                                             \
        auto r0 = __builtin_amdgcn_permlane32_swap(a0, b0, false, false); auto r1 = __builtin_amdgcn_permlane32_swap(a1, b1, false, false); \
        u32x4 w = {r0[0], r1[0], r0[1], r1[1]}; OUT = *reinterpret_cast<bf16x8*>(&w); } while (0)
    PK4(p0, 0, pa0); PK4(p0, 8, pa1); PK4(p1, 0, pa2); PK4(p1, 8, pa3);
#undef PK4
}
template <int KB, bool SK>
__device__ __forceinline__ void qkt(f32x16& p0, f32x16& p1, const char* K_lds, int r32, int hi, const bf16x8* qr, bool act) {
    if (SK && !act) { const float NEG = -__builtin_inff();
#pragma unroll
        for (int r = 0; r < 16; ++r) { p0[r] = NEG; p1[r] = NEG; } return; }
    p0 = f32x16{}; p1 = f32x16{};
    const char* kb[4];
#pragma unroll
    for (int dd = 0; dd < 4; ++dd) kb[dd] = K_lds + KB * SHM_K + KSWZ(r32, (dd * 16 + hi * 8) * 2);
#pragma unroll
    for (int d0 = 0; d0 < 8; ++d0) { const char* a = kb[d0 & 3] + (d0 >> 2) * 128;
        bf16x8 b0 = *reinterpret_cast<const bf16x8*>(a);
        bf16x8 b1 = *reinterpret_cast<const bf16x8*>(a + 32 * 256);
        p0 = __builtin_amdgcn_mfma_f32_32x32x16_bf16(b0, qr[d0], p0, 0, 0, 0);
        p1 = __builtin_amdgcn_mfma_f32_32x32x16_bf16(b1, qr[d0], p1, 0, 0, 0); }
}
template <int VB, bool SK>
__device__ __forceinline__ void pv_tile(f32x16* o, int vb0, bf16x8 pa0, bf16x8 pa1, bf16x8 pa2, bf16x8 pa3, bool act) {
    if (SK && !act) return;
#define TRRD(dst, off) asm volatile("ds_read_b64_tr_b16 %0, %1 offset:%2" : "=&v"(dst) : "v"(vb0), "i"(off) : "memory")
#define PV_D0(d0) do { s16x4 l0, l1, l2, l3, h0, h1, h2, h3; constexpr int b_ = VB * SHM_V + v_rd_off(d0, 0, 0);     \
        TRRD(l0, b_); TRRD(h0, b_ + 2048); TRRD(l1, b_ + 4096); TRRD(h1, b_ + 6144); TRRD(l2, b_ + 8192); TRRD(h2, b_ + 10240); TRRD(l3, b_ + 12288); TRRD(h3, b_ + 14336); \
        asm volatile("s_waitcnt lgkmcnt(0)" ::: "memory"); SBAR();                 \
        o[d0] = __builtin_amdgcn_mfma_f32_32x32x16_bf16(pa0, (bf16x8){l0[0], l0[1], l0[2], l0[3], h0[0], h0[1], h0[2], h0[3]}, o[d0], 0, 0, 0);   \
        o[d0] = __builtin_amdgcn_mfma_f32_32x32x16_bf16(pa1, (bf16x8){l1[0], l1[1], l1[2], l1[3], h1[0], h1[1], h1[2], h1[3]}, o[d0], 0, 0, 0);   \
        o[d0] = __builtin_amdgcn_mfma_f32_32x32x16_bf16(pa2, (bf16x8){l2[0], l2[1], l2[2], l2[3], h2[0], h2[1], h2[2], h2[3]}, o[d0], 0, 0, 0);   \
        o[d0] = __builtin_amdgcn_mfma_f32_32x32x16_bf16(pa3, (bf16x8){l3[0], l3[1], l3[2], l3[3], h3[0], h3[1], h3[2], h3[3]}, o[d0], 0, 0, 0); } while (0)
    PV_D0(0); PV_D0(1); PV_D0(2); PV_D0(3);
#undef PV_D0
#undef TRRD
}

template <class TIn, class TOut> struct BlockRef { const TIn* Q; const TIn* K; const TIn* V; TOut* O; float* LSE; int P0; int rs; int ls; };
template <class TIn> struct Seam {
    bf16x8 qr[8];
    bf16x8 st_v0, st_v1, st_k0, st_k1; f32x4 sf0, sf1, sf2, sf3;
    f32x4 tq[16];
};
__device__ __forceinline__ int swa_jlo(int P0, int W) { const int lowk = P0 - W + 1; return lowk > 0 ? lowk / KVBLK : 0; }
#define ROW(p, k0, rr, rs_) ((p) + (size_t)((k0) + (rr)) * (size_t)(rs_) + sc)
#define VMW() asm volatile("s_waitcnt vmcnt(0)" ::: "memory")
#define VMWN(n) asm volatile("s_waitcnt vmcnt(%0)" :: "i"(n) : "memory")
#define SLOAD_H(Kp, Vp, k0, rs_) do { S.st_v0 = load8<TIn>(ROW(Vp, k0, sr, rs_)); S.st_v1 = load8<TIn>(ROW(Vp, k0, 32 + sr, rs_));              \
                         S.st_k0 = load8<TIn>(ROW(Kp, k0, sr, rs_)); S.st_k1 = load8<TIn>(ROW(Kp, k0, 32 + sr, rs_)); } while (0)
#define SWRITE_HK(bf) do { *(bf16x8*)(K_lds + (bf) * SHM_K + kws) = S.st_k0; *(bf16x8*)(K_lds + (bf) * SHM_K + kws + 32 * 256) = S.st_k1; } while (0)
#define SWRITE_HV(bf) do { *(bf16x8*)(V_lds + (bf) * SHM_V + vst0) = S.st_v0; *(bf16x8*)(V_lds + (bf) * SHM_V + vst1) = S.st_v1; } while (0)
#define SWRITE_H(bf) do { SWRITE_HV(bf); SWRITE_HK(bf); } while (0)
#define SLOAD_F(p, k0) do { } while (0)
#define SWRITE_KF(bf) do { *(bf16x8*)(K_lds + (bf) * SHM_K + kws) = pack8(S.sf0, S.sf1); *(bf16x8*)(K_lds + (bf) * SHM_K + kws + 32 * 256) = pack8(S.sf2, S.sf3); } while (0)
#define SWRITE_VF(bf) do { *(bf16x8*)(V_lds + (bf) * SHM_V + vst0) = pack8(S.sf0, S.sf1); *(bf16x8*)(V_lds + (bf) * SHM_V + vst1) = pack8(S.sf2, S.sf3); } while (0)
template <class TIn, class TOut>
__device__ __forceinline__ void causal_swa_prime(const BlockRef<TIn, TOut>& cur, int W, char* lds, Seam<TIn>& S) {
    constexpr bool F32 = same_t<TIn, float>::v;
    const int tid = threadIdx.x, wid = __builtin_amdgcn_readfirstlane(tid >> 6), lane = tid & 63, r32 = lane & 31, hi = lane >> 5;
    const int sr = tid >> 4, sc = (tid & 15) * 8, kws = KSWZ(sr, sc * 2); char* K_lds = lds + 2 * SHM_V;
    const int kb0 = swa_jlo(cur.P0, W) * KVBLK;
    for (int d0 = 0; d0 < 8; ++d0) S.qr[d0] = load8<TIn>(cur.Q + (size_t)(wid * QBLK + r32) * (size_t)cur.rs + d0 * 16 + hi * 8);
    if constexpr (F32) { SLOAD_F((const float*)cur.K, kb0); VMW(); SWRITE_KF(0); SBAR(); SLOAD_F((const float*)cur.V, kb0); }
    else { SLOAD_H(cur.K, cur.V, kb0, cur.rs); VMW(); SWRITE_HK(0); }
    __syncthreads();
}
template <class TIn, class TOut>
__device__ __forceinline__ void causal_swa_block(const BlockRef<TIn, TOut>& cur, const BlockRef<TIn, TOut>& nxt, int skv, int W, char* lds, Seam<TIn>& S) {
    constexpr bool F32 = same_t<TIn, float>::v;
    const int tid = threadIdx.x, wid = __builtin_amdgcn_readfirstlane(tid >> 6), lane = tid & 63, r32 = lane & 31, hi = lane >> 5;
    const int j_lo = swa_jlo(cur.P0, W);
    int j_hi = (cur.P0 + QB - 1) / KVBLK + 1; if (j_hi > skv / KVBLK) j_hi = skv / KVBLK;
    const int NT = j_hi - j_lo;
    const int kbn = swa_jlo(nxt.P0, W) * KVBLK;
    const int qlo = cur.P0 + wid * QBLK, qm = qlo + r32 - 4 * hi;
    char* V_lds = lds; char* K_lds = lds + 2 * SHM_V;
    float* ws = (float*)(lds + 2 * SHM_V + 2 * SHM_K) + wid * 64; float* li_l = ws, * al_l = ws + 32;
    float m_reg = -1e30f, l_reg = 0; f32x16 o[4] = {};
    const int sr = tid >> 4, sc = (tid & 15) * 8, vst0 = v_st(sr, sc), vst1 = v_st(32 + sr, sc), kws = KSWZ(sr, sc * 2);
    const int vb0 = (int)(uintptr_t)V_lds + v_rd_base(lane);
    const TIn* Kh = cur.K; const TIn* Vh = cur.V;
#define RESC(a) do { if (__any((a) < 1.f)) { if (hi == 0) al_l[r32] = (a); asm volatile("s_waitcnt lgkmcnt(0)" ::: "memory");              \
                     for (int d_ = 0; d_ < 4; ++d_) for (int r = 0; r < 16; ++r) o[d_][r] *= al_l[crow(r, hi)]; } } while (0)
#define KBASE(t) ((j_lo + (t)) * KVBLK)
#define ACT(t) (KBASE(t) <= qlo + QBLK - 1 && KBASE(t) + KVBLK - 1 >= qlo - W + 1)
#define MASKT(P0_, P1_, t) do { const int kb_ = KBASE(t); if ((!SK || ACT(t)) && (kb_ + KVBLK - 1 > qlo || kb_ <= qlo + QBLK - 1 - W)) mask_tile(P0_, P1_, qm - kb_, (unsigned)W); } while (0)
    constexpr int NQL = F32 ? 16 : 8;
    constexpr bool SK = WSKIP && !F32;
#define SEAM_K0() do { VMWN(NQL); if constexpr (F32) { SWRITE_KF(0); SBAR(); SLOAD_F((const float*)nxt.V, kbn); } else { SWRITE_HK(0); } SBAR(); } while (0)
    f32x16 pA0, pA1, pB0, pB1; float mnA, mnB, alA, alB; bf16x8 pa0, pa1, pa2, pa3;
    if constexpr (F32) { VMW(); SWRITE_VF(0); SBAR(); } else { SWRITE_HV(0); SBAR(); }
    if (NT > 1) { if constexpr (F32) SLOAD_F((const float*)Kh, KBASE(1)); else SLOAD_H(Kh, Vh, KBASE(1), cur.rs); }
    SBAR(); qkt<0, SK>(pA0, pA1, K_lds, r32, hi, S.qr, ACT(0));
    if constexpr (F32) { if (NT > 1) { VMW(); SWRITE_KF(1); SBAR(); SLOAD_F((const float*)Vh, KBASE(1)); } }
    MASKT(pA0, pA1, 0); partialSM(pA0, pA1, m_reg, mnA, alA);
    if (NT > 1) { VMW(); if constexpr (F32) { SWRITE_VF(1); SBAR(); if (NT > 2) SLOAD_F((const float*)Kh, KBASE(2)); } else SWRITE_H(1); }
    __syncthreads();
#define HALF_STEP(PX0, PX1, mnX, alX, PY0, PY1, alY, t, KB, VB, SB) do {                                                      \
        SBAR(); qkt<KB, SK>(PX0, PX1, K_lds, r32, hi, S.qr, ACT(t));                                             \
        finishSM(PY0, PY1, alY, l_reg, pa0, pa1, pa2, pa3); SBAR();                                                           \
        if ((t) + 1 < NT) { if constexpr (F32) { VMW(); SWRITE_KF(SB); SBAR(); SLOAD_F((const float*)Vh, KBASE((t) + 1)); }  \
                            else { SLOAD_H(Kh, Vh, KBASE((t) + 1), cur.rs); } SBAR(); }                                               \
        pv_tile<VB, SK>(o, vb0, pa0, pa1, pa2, pa3, ACT((t) - 1)); MASKT(PX0, PX1, (t)); partialSM(PX0, PX1, m_reg, mnX, alX);                                        \
        __syncthreads();                                                                                                      \
        if ((t) + 1 < NT) { VMW(); if constexpr (F32) { SWRITE_VF(SB); SBAR(); if ((t) + 2 < NT) SLOAD_F((const float*)Kh, KBASE((t) + 2)); } \
                            else { SWRITE_H(SB); } }                                                                          \
        RESC(alX); __syncthreads(); } while (0)
    for (int t = 1; t + 1 < NT; t += 2) {
        HALF_STEP(pB0, pB1, mnB, alB, pA0, pA1, alA, t, 1, 0, 0);
        HALF_STEP(pA0, pA1, mnA, alA, pB0, pB1, alB, t + 1, 0, 1, 1);
    }
    const bool even = (NT & 1) == 0;
    if (even) { SBAR(); qkt<1, SK>(pB0, pB1, K_lds, r32, hi, S.qr, ACT(NT - 1)); SBAR(); }
#define QROW(e) (nxt.Q + (size_t)(wid * QBLK + r32) * (size_t)nxt.rs + ((e) >> 1) * 16 + hi * 8 + ((e) & 1) * 4)
    if constexpr (F32) { SLOAD_F((const float*)nxt.K, kbn); SBAR();
#pragma unroll
        for (int e = 0; e < 8; ++e) S.tq[e] = *(const f32x4*)QROW(e); }
    else { SLOAD_H(nxt.K, nxt.V, kbn, nxt.rs); SBAR();
#pragma unroll
        for (int d0 = 0; d0 < 8; ++d0) S.qr[d0] = load8<TIn>(nxt.Q + (size_t)(wid * QBLK + r32) * (size_t)nxt.rs + d0 * 16 + hi * 8); }
    SBAR();
    finishSM(pA0, pA1, alA, l_reg, pa0, pa1, pa2, pa3); SBAR();
    if constexpr (F32) {
#pragma unroll
        for (int e = 8; e < 16; ++e) S.tq[e] = *(const f32x4*)QROW(e); SBAR(); }
#undef QROW
    pv_tile<0, SK>(o, vb0, pa0, pa1, pa2, pa3, ACT(even ? NT - 2 : NT - 1));
    if (even) { MASKT(pB0, pB1, NT - 1); partialSM(pB0, pB1, m_reg, mnB, alB); __syncthreads(); RESC(alB);
        finishSM(pB0, pB1, alB, l_reg, pa0, pa1, pa2, pa3); SBAR(); pv_tile<1, SK>(o, vb0, pa0, pa1, pa2, pa3, ACT(NT - 1)); }
    SBAR(); SEAM_K0();
    if (hi == 0) li_l[r32] = l_reg; asm volatile("s_waitcnt lgkmcnt(0)" ::: "memory");
    float rli[16];
#pragma unroll
    for (int r = 0; r < 16; ++r) rli[r] = __builtin_amdgcn_rcpf(li_l[crow(r, hi)]);
    TOut* Ow = cur.O + (size_t)(wid * QBLK) * (size_t)cur.rs;
    if (hi == 0) cur.LSE[(size_t)(wid * QBLK + r32) * (size_t)cur.ls] = m_reg * SCALE + __logf(l_reg);
#pragma unroll
    for (int r = 0; r < 16; ++r) { const int orow = crow(r, hi);
#pragma unroll
        for (int d0 = 0; d0 < 4; ++d0) { const float v = o[d0][r] * rli[r];
            if constexpr (same_t<TOut, float>::v) { Ow[(size_t)orow * (size_t)cur.rs + d0 * 32 + r32] = v; }
            else { const float vn = __shfl_xor(v, 1);
                   if ((r32 & 1) == 0) *(unsigned*)(Ow + (size_t)orow * (size_t)cur.rs + d0 * 32 + r32) = cvtpk(v, vn); } } }
    if constexpr (F32) {
#pragma unroll
        for (int d0 = 0; d0 < 8; ++d0) S.qr[d0] = pack8(S.tq[2 * d0], S.tq[2 * d0 + 1]); }
    __syncthreads();
#undef RESC
#undef KBASE
#undef ACT
#undef MASKT
#undef SEAM_K0
#undef HALF_STEP
}
#undef ROW
#undef VMW
#undef VMWN
#undef SLOAD_H
#undef SWRITE_HK
#undef SWRITE_HV
#undef SWRITE_H
#undef SLOAD_F
#undef SWRITE_KF
#undef SWRITE_VF

#undef SBAR
}
#define GAS __attribute__((address_space(1)))
#define LAS __attribute__((address_space(3)))
typedef unsigned short bf16;
typedef unsigned v4u __attribute__((ext_vector_type(4)));
typedef float f32x4 __attribute__((ext_vector_type(4)));
typedef short bf16x8 __attribute__((ext_vector_type(8)));
typedef GAS unsigned gu32;
typedef GAS unsigned long long gu64;
#define RLX_AGENT __ATOMIC_RELAXED, __HIP_MEMORY_SCOPE_AGENT
#define LDS_WAIT() asm volatile("s_waitcnt lgkmcnt(0)" ::: "memory")
#define VM_WAIT() asm volatile("s_waitcnt vmcnt(0)" ::: "memory")
__device__ __forceinline__ unsigned long long rt() { return __builtin_amdgcn_s_memrealtime(); }
__device__ __forceinline__ unsigned f2bf(float f) { unsigned u = __builtin_bit_cast(unsigned, f); return (u + 0x7fffu + ((u >> 16) & 1u)) >> 16; }
__device__ __forceinline__ unsigned pk2(float lo, float hi) { return f2bf(lo) | (f2bf(hi) << 16); }

#define XB_TMO      128
#define XB_XCNT(j)  (256  + 64 * (j))
#define XB_XSUB(j)  (1280 + 64 * (j))
#define XB_XGEN(j)  (2304 + 64 * (j))
#define XB_TOP      3328
#define XB_TOPGEN   3392
#define XCD_BAR_WORDS 3456
#define XB_SPIN_CAP (1u << 18)

__device__ __forceinline__ unsigned xb_ld(unsigned* p)              { return __hip_atomic_load(p, __ATOMIC_RELAXED, __HIP_MEMORY_SCOPE_AGENT); }
__device__ __forceinline__ unsigned xb_add(unsigned* p, unsigned v) { return __hip_atomic_fetch_add(p, v, __ATOMIC_RELAXED, __HIP_MEMORY_SCOPE_AGENT); }
__device__ __forceinline__ unsigned xb_xcc_id() { return (unsigned)__builtin_amdgcn_s_getreg((3 << 11) | 20) & 0xFu; }
#define XB_SPIN(cond, bar) do { unsigned _sp = 0; while (cond) { __builtin_amdgcn_s_sleep(1); \
    if ((++_sp & 255u) == 0u) { if (xb_ld(&(bar)[XB_TMO])) break; if (_sp > XB_SPIN_CAP) { atomicAdd(&(bar)[XB_TMO], 1u); break; } } } } while (0)

struct XcdBarrier {
    unsigned* bar; unsigned x;
    volatile LAS unsigned* st;
};

__device__ __forceinline__ XcdBarrier xcd_barrier_post(unsigned* bar, volatile LAS unsigned* st) {
    XcdBarrier b; b.bar = bar; b.x = xb_xcc_id(); b.st = st;
    if (threadIdx.x == 0) (void)xb_add(&bar[XB_XCNT(b.x)], 1u);
    return b;
}
__device__ __forceinline__ void xcd_barrier_complete(unsigned* bar, unsigned x, unsigned& nloc, unsigned& nx) {
    const unsigned G = gridDim.x * gridDim.y * gridDim.z;
    unsigned sum, cnt, mine, sp = 0u;
    for (;;) {
        sum = 0u; cnt = 0u; mine = 0u;
#pragma unroll
        for (unsigned j = 0; j < 16; ++j) { const unsigned c = xb_ld(&bar[XB_XCNT(j)]); sum += c; cnt += (c > 0u) ? 1u : 0u; mine = (j == x) ? c : mine; }
        if (sum == G) break;
        __builtin_amdgcn_s_sleep(1);
        if ((++sp & 255u) == 0u) { if (xb_ld(&bar[XB_TMO])) break; if (sp > XB_SPIN_CAP) { atomicAdd(&bar[XB_TMO], 1u); break; } }
    }
    nloc = mine > 0u ? mine : 1u; nx = cnt > 0u ? cnt : 1u;
}

__device__ __forceinline__ void xcd_barrier(const XcdBarrier& b) {
    asm volatile("s_waitcnt vmcnt(0)" ::: "memory");
    __syncthreads();
    if (threadIdx.x == 0) {
        unsigned* bar = b.bar;
        __builtin_amdgcn_s_waitcnt(0);
        unsigned nloc = b.st[0], nx = b.st[1];
        if (nloc == 0u) { xcd_barrier_complete(bar, b.x, nloc, nx); b.st[0] = nloc; b.st[1] = nx; }
        const unsigned old = xb_add(&bar[XB_XSUB(b.x)], 1u);
        const unsigned gen = old / nloc;
        if (old + 1u == (gen + 1u) * nloc) {
            __builtin_amdgcn_fence(__ATOMIC_RELEASE, "agent");
            asm volatile("s_waitcnt vmcnt(0)" ::: "memory");
            const unsigned og = xb_add(&bar[XB_TOP], 1u);
            const unsigned tg = og / nx;
            if (og + 1u == (tg + 1u) * nx) xb_add(&bar[XB_TOPGEN], 1u);
            else XB_SPIN(xb_ld(&bar[XB_TOPGEN]) == tg, bar);
            __builtin_amdgcn_fence(__ATOMIC_ACQUIRE, "agent");
            xb_add(&bar[XB_XGEN(b.x)], 1u);
            asm volatile("s_waitcnt vmcnt(0)" ::: "memory");
        } else {
            XB_SPIN(xb_ld(&bar[XB_XGEN(b.x)]) == gen, bar);
            __builtin_amdgcn_fence(__ATOMIC_ACQUIRE, "agent");
            asm volatile("s_waitcnt vmcnt(0)" ::: "memory");
        }
    }
    __syncthreads();
}

constexpr int NWAVES = 8;

constexpr size_t MiB = 1u << 20, HMiB = 1u << 19;
constexpr size_t WS_CTL = 0, CTL_ZERO_BYTES = 64 * 1024;
constexpr size_t WS_MOD = 1 * MiB;
constexpr size_t WS_WGU1 = 2 * MiB;
constexpr size_t WS_WD1 = WS_WGU1 + 11 * MiB;
constexpr size_t WS_WIN = WS_WD1 + 11 * HMiB;
constexpr size_t WS_WA = WS_WIN + 19 * MiB;
constexpr size_t WS_WC = WS_WA + 1 * MiB;
constexpr size_t WS_WO = WS_WC + 2 * MiB;
constexpr size_t WS_WGU2 = WS_WO + 2 * MiB;
constexpr size_t WS_WD2 = WS_WGU2 + 11 * MiB;
constexpr size_t WS_XS = WS_WD2 + 11 * HMiB;
constexpr size_t WS_R = WS_XS + 32 * MiB;
constexpr size_t WS_ACT = WS_R;
constexpr size_t WS_Q = WS_R, WS_K = WS_R + 48 * MiB, WS_V = WS_R + 96 * MiB;
constexpr size_t WS_LSE = WS_R + 144 * MiB;
constexpr size_t WS_O = WS_R + 145 * MiB;
constexpr size_t WS_U = WS_R + 48 * MiB, WS_B = WS_R + 80 * MiB, WS_C = WS_R + 112 * MiB;
constexpr size_t WS_SGA = WS_R, WS_SGC = WS_R + 48 * MiB;
constexpr size_t WS_END = WS_O + 16 * MiB;
static_assert(WS_XS == 59 * MiB && WS_END <= 256 * MiB, "d_ws map");
constexpr int CW_BAR = 4096;

constexpr int RING_OFF = 0, RING_BYTES = 131072;
constexpr int LDSCTL_OFF = RING_BYTES, MISC_OFF = LDSCTL_OFF + 320;
constexpr int LDS_BYTES = 147456;


struct Args { const float* in[20]; float* out; unsigned char* ws; int ph_lo, ph_hi; };
struct Frame {
    LAS unsigned char* lds;
    volatile LAS unsigned* MISC;
    gu32* ctl;
    int tid, lane, wave;
    int vcu, G;
    float* out; unsigned char* ws;
};
enum { I_X = 0, I_C, I_WADA, I_BADA, I_NF1, I_F1G, I_F1U, I_F1D, I_NMIX, I_WIN, I_QN, I_KN, I_CONVW, I_WAB, I_WCB, I_WOUT, I_NF2, I_F2G, I_F2U, I_F2D };
enum { MOD_SH1 = 0, MOD_SC1 = 1024, MOD_GT1 = 2048, MOD_SH2 = 3072, MOD_SC2 = 4096, MOD_GT2 = 5120, MOD_SH3 = 6144, MOD_SC3 = 7168, MOD_GT3 = 8192 };

__device__ __forceinline__ float silu_f(float x) { return x * __builtin_amdgcn_rcpf(1.0f + __builtin_amdgcn_exp2f(-1.4426950408889634f * x)); }
__device__ __forceinline__ float wave_sum(float v) {
#pragma unroll
    for (int o = 1; o < 64; o <<= 1) v += __shfl_xor(v, o);
    return v;
}
__device__ __forceinline__ float blo(unsigned w) { return __uint_as_float(w << 16); }
__device__ __forceinline__ float bhi(unsigned w) { return __uint_as_float(w & 0xffff0000u); }

constexpr int ADA_ITEMS = NMOD / 64;
__device__ __forceinline__ void p0_adaln_item(Frame& F, const Args& args, int item) {
    LAS float* sc = (LAS float*)(F.lds + RING_OFF);
    LAS float* red = sc + 2048;
    const float* c = args.in[I_C]; const float* wada = args.in[I_WADA]; const float* bada = args.in[I_BADA];
    for (int i = F.tid; i < 2 * DM; i += NWAVES * 64) sc[i] = silu_f(c[i]);
    __syncthreads();
    const int j0 = item * 64, cg = F.lane & 15, rs = F.lane >> 4;
    f32x4 a0 = {0.f, 0.f, 0.f, 0.f}, a1 = {0.f, 0.f, 0.f, 0.f};
    const GAS f32x4* wp = (const GAS f32x4*)(wada + (size_t)(F.wave * 128 + rs) * NMOD + j0 + 4 * cg);
#pragma unroll 8
    for (int it = 0; it < 32; ++it) { const int k = F.wave * 128 + 4 * it + rs; const f32x4 w = wp[(size_t)it * 4 * (NMOD / 4)];
        a0 = a0 + w * sc[k]; a1 = a1 + w * sc[DM + k]; }
#pragma unroll
    for (int i = 0; i < 4; ++i) { a0[i] += __shfl_xor(a0[i], 16); a0[i] += __shfl_xor(a0[i], 32); a1[i] += __shfl_xor(a1[i], 16); a1[i] += __shfl_xor(a1[i], 32); }
    if (F.lane < 16) {
#pragma unroll
        for (int i = 0; i < 4; ++i) { red[(F.wave * 2 + 0) * 64 + 4 * cg + i] = a0[i]; red[(F.wave * 2 + 1) * 64 + 4 * cg + i] = a1[i]; } }
    __syncthreads();
    if (F.tid < 128) { const int b = F.tid >> 6, j = F.tid & 63; float s = bada[j0 + j];
#pragma unroll
        for (int w = 0; w < NWAVES; ++w) s += red[(w * 2 + b) * 64 + j];
        ((float*)(F.ws + WS_MOD))[b * NMOD + j0 + j] = s; }
    __syncthreads();
}
__device__ __forceinline__ void p0_transpose_item(const float* W, int K, int N, bf16* WT, int rmode, LAS float* scr, int item, int lane) {
    const int nblk = N / 32, kb = item / nblk, nb = item % nblk, k0 = 64 * kb, n0 = 32 * nb;
    const int r0 = rmode == 0 ? n0 : 256 * (n0 >> 7) + 128 * (rmode - 1) + (n0 & 127);
#pragma unroll 8
    for (int i = 0; i < 32; ++i) { const int kk = 2 * i + (lane >> 5); scr[kk * 33 + (lane & 31)] = W[(size_t)(k0 + kk) * N + n0 + (lane & 31)]; }
    LDS_WAIT(); asm volatile("" ::: "memory");
    const int c = lane & 7;
#pragma unroll
    for (int j = 0; j < 4; ++j) { const int n = (lane >> 3) + 8 * j; const LAS float* s = scr + (8 * c) * 33 + n;
        v4u o; o.x = pk2(s[0 * 33], s[1 * 33]); o.y = pk2(s[2 * 33], s[3 * 33]); o.z = pk2(s[4 * 33], s[5 * 33]); o.w = pk2(s[6 * 33], s[7 * 33]);
        *(GAS v4u*)(WT + (size_t)(r0 + n) * K + k0 + 8 * c) = o; }
    LDS_WAIT(); asm volatile("" ::: "memory");
}
__device__ __forceinline__ void p0_transposes(Frame& F, const Args& args) {
    LAS float* scr = (LAS float*)(F.lds + RING_OFF + F.wave * 16384);
    const int gw = F.vcu * NWAVES + F.wave, NGW = F.G * NWAVES;
    int base = 0;
#define TR_JOB(SRC, K_, N_, RMODE, DST) do { const int n_it = ((K_) / 64) * ((N_) / 32); int it = gw - (base % NGW); if (it < 0) it += NGW;     \
        const float* W_ = args.in[SRC]; bf16* WT_ = (bf16*)(F.ws + (DST)); \
        for (; it < n_it; it += NGW) p0_transpose_item(W_, (K_), (N_), WT_, (RMODE), scr, it, F.lane); base += n_it; } while (0)
    TR_JOB(I_F1G, DM, DFF, 1, WS_WGU1); TR_JOB(I_F1U, DM, DFF, 2, WS_WGU1); TR_JOB(I_F1D, DFF, DM, 0, WS_WD1); TR_JOB(I_WIN, DM, INW, 0, WS_WIN);
    TR_JOB(I_WAB, 512, DM, 0, WS_WA); TR_JOB(I_WCB, DM, DM, 0, WS_WC); TR_JOB(I_WOUT, DM, DM, 0, WS_WO);
    TR_JOB(I_F2G, DM, DFF, 1, WS_WGU2); TR_JOB(I_F2U, DM, DFF, 2, WS_WGU2); TR_JOB(I_F2D, DFF, DM, 0, WS_WD2);
#undef TR_JOB
}
__device__ __forceinline__ void norm_pass(Frame& F, const float* X, const float* g, int mod_sh, int mod_sc) {
    const int gw = F.vcu * NWAVES + F.wave, NGW = F.G * NWAVES;
    const float* mod = (const float*)(F.ws + WS_MOD); bf16* XS = (bf16*)(F.ws + WS_XS);
    for (int r0 = gw * 8; r0 < M; r0 += NGW * 8) {
        const int b = r0 / SEQ;
        f32x4 a[4], s[4];
#pragma unroll
        for (int j = 0; j < 4; ++j) { const int c = 4 * F.lane + 256 * j;
            a[j] = *(const f32x4*)(g + c) * (*(const f32x4*)(mod + b * NMOD + mod_sc + c) + 1.0f); s[j] = *(const f32x4*)(mod + b * NMOD + mod_sh + c); }
#pragma unroll 2
        for (int r = 0; r < 8; ++r) {
            const GAS f32x4* xr = (const GAS f32x4*)(X + (size_t)(r0 + r) * DM) + F.lane;
            f32x4 v[4]; float ss = 0.f;
#pragma unroll
            for (int j = 0; j < 4; ++j) { v[j] = xr[64 * j]; ss += (v[j].x * v[j].x + v[j].y * v[j].y) + (v[j].z * v[j].z + v[j].w * v[j].w); }
            const float rstd = 1.0f / sqrtf(wave_sum(ss) * (1.f / DM) + EPS);
            GAS unsigned long long* o8 = (GAS unsigned long long*)(XS + (size_t)(r0 + r) * DM) + F.lane;
#pragma unroll
            for (int j = 0; j < 4; ++j) { const f32x4 y = v[j] * rstd * a[j] + s[j];
                o8[64 * j] = (unsigned long long)pk2(y.x, y.y) | ((unsigned long long)pk2(y.z, y.w) << 32); }
        }
    }
}
__device__ __forceinline__ void qknorm_pass(Frame& F, const Args& args) {
    const int gw = F.vcu * NWAVES + F.wave, NGW = F.G * NWAVES;
    const float* gq_ = args.in[I_QN]; const float* gk_ = args.in[I_KN];
    for (int it = gw; it < 2 * M; it += NGW) {
        const int which = it >= M, row = which ? it - M : it;
        bf16* buf = (bf16*)(F.ws + (which ? WS_K : WS_Q)) + (size_t)row * AW; const float* gm = (which ? gk_ : gq_) + 8 * (F.lane & 15);
        const f32x4 g0 = *(const f32x4*)gm, g1 = *(const f32x4*)(gm + 4);
#pragma unroll
        for (int j = 0; j < 3; ++j) { GAS v4u* p = (GAS v4u*)(buf + 512 * j + 8 * F.lane); const v4u w = *p;
            f32x4 v0 = {blo(w.x), bhi(w.x), blo(w.y), bhi(w.y)}, v1 = {blo(w.z), bhi(w.z), blo(w.w), bhi(w.w)};
            float ss = (v0.x * v0.x + v0.y * v0.y) + (v0.z * v0.z + v0.w * v0.w) + (v1.x * v1.x + v1.y * v1.y) + (v1.z * v1.z + v1.w * v1.w);
            ss += __shfl_xor(ss, 1); ss += __shfl_xor(ss, 2); ss += __shfl_xor(ss, 4); ss += __shfl_xor(ss, 8);
            const float r = 1.0f / sqrtf(ss * (1.f / 128.f) + EPS);
            v0 = v0 * r * g0; v1 = v1 * r * g1;
            v4u o; o.x = pk2(v0.x, v0.y); o.y = pk2(v0.z, v0.w); o.z = pk2(v1.x, v1.y); o.w = pk2(v1.z, v1.w); *p = o; }
    }
}
typedef attn::BlockRef<attn::bf16, attn::bf16> ABlock;
__device__ __forceinline__ ABlock attn_ref(Frame& F, int id, int& skv) {
    const int bgh = id >> 5, x = id & 31, b = bgh / 12, gh = bgh - b * 12, g = gh >> 2, d = 1 << (2 * g), nqb = 32 >> (2 * g), r = x / nqb, qb = x - r * nqb;
    ABlock R; const size_t e0 = (size_t)(b * SEQ + r) * AW + gh * 128;
    R.rs = d * AW; R.ls = d * 12; R.P0 = qb * 256; skv = SEQ / d;
    R.K = (const attn::bf16*)(F.ws + WS_K) + e0; R.V = (const attn::bf16*)(F.ws + WS_V) + e0;
    attn::bf16* q = (attn::bf16*)(F.ws + WS_Q) + e0 + (size_t)(qb * 256) * R.rs; R.Q = q; R.O = q;
    R.LSE = (float*)(F.ws + WS_LSE) + (size_t)(b * SEQ + r + qb * 256 * d) * 12 + gh;
    return R;
}
__device__ __forceinline__ void attn_phase(Frame& F, char* lds) {
    constexpr int NITEMS = 768;
    const int per = (NITEMS + F.G - 1) / F.G; int id = F.vcu * per; const int end = (id + per < NITEMS) ? id + per : NITEMS;
    if (id >= end) return;
    int skv, skvn; ABlock cur = attn_ref(F, id, skv);
    attn::Seam<attn::bf16> S;
    attn::causal_swa_prime<attn::bf16, attn::bf16>(cur, attn::WINDOW, lds, S);
    for (;;) {
        const bool last = id + 1 >= end; skvn = skv;
        const ABlock nxt = last ? cur : attn_ref(F, id + 1, skvn);
        attn::causal_swa_block<attn::bf16, attn::bf16>(cur, nxt, skv, attn::WINDOW, lds, S);
        if (last) break;
        cur = nxt; skv = skvn; ++id;
    }
}
__device__ __forceinline__ void merge_conv_pass(Frame& F, const Args& args) {
    const int gw = F.vcu * NWAVES + F.wave, NGW = F.G * NWAVES;
    { const bf16* OG = (const bf16*)(F.ws + WS_Q); const float* LSE = (const float*)(F.ws + WS_LSE); bf16* O = (bf16*)(F.ws + WS_O);
      const int h = F.lane >> 4, e = 8 * (F.lane & 15);
      for (int t = gw; t < M; t += NGW) {
          const float l0 = LSE[(size_t)t * 12 + h], l1 = LSE[(size_t)t * 12 + 4 + h], l2 = LSE[(size_t)t * 12 + 8 + h];
          const float mx = fmaxf(l0, fmaxf(l1, l2)); const float e0 = __expf(l0 - mx), e1 = __expf(l1 - mx), e2 = __expf(l2 - mx); const float inv = 1.0f / (e0 + e1 + e2);
          const float wg[3] = {e0 * inv, e1 * inv, e2 * inv};
          f32x4 a0 = {0.f, 0.f, 0.f, 0.f}, a1 = {0.f, 0.f, 0.f, 0.f};
#pragma unroll
          for (int g = 0; g < 3; ++g) { const v4u w = *(const GAS v4u*)(OG + (size_t)t * AW + (g * 4 + h) * 128 + e);
              a0 = a0 + (f32x4){blo(w.x), bhi(w.x), blo(w.y), bhi(w.y)} * wg[g]; a1 = a1 + (f32x4){blo(w.z), bhi(w.z), blo(w.w), bhi(w.w)} * wg[g]; }
          v4u o; o.x = pk2(a0.x, a0.y); o.y = pk2(a0.z, a0.w); o.z = pk2(a1.x, a1.y); o.w = pk2(a1.z, a1.w);
          *(GAS v4u*)(O + (size_t)t * 512 + 8 * F.lane) = o; } }
    { const bf16* U = (const bf16*)(F.ws + WS_U); bf16* Bv = (bf16*)(F.ws + WS_B); const bf16* Cg = (const bf16*)(F.ws + WS_C); const float* cw = args.in[I_CONVW];
      for (int it = gw; it < 2 * (M / 16); it += NGW) {
          const int ch = it & 1, t0 = (it >> 1) * 16, c0 = 512 * ch + 8 * F.lane;
          float w0[8], w1[8], w2[8], x1[8], x2[8];
#pragma unroll
          for (int i = 0; i < 8; ++i) { w0[i] = cw[c0 + i]; w1[i] = cw[DM + c0 + i]; w2[i] = cw[2 * DM + c0 + i]; x1[i] = 0.f; x2[i] = 0.f; }
          if ((t0 & (SEQ - 1)) != 0) {
#pragma unroll
              for (int p = 2; p >= 1; --p) { const v4u wu = *(const GAS v4u*)(U + (size_t)(t0 - p) * DM + c0), wc = *(const GAS v4u*)(Cg + (size_t)(t0 - p) * DM + c0);
                  const float xu[8] = {blo(wu.x), bhi(wu.x), blo(wu.y), bhi(wu.y), blo(wu.z), bhi(wu.z), blo(wu.w), bhi(wu.w)}, xc[8] = {blo(wc.x), bhi(wc.x), blo(wc.y), bhi(wc.y), blo(wc.z), bhi(wc.z), blo(wc.w), bhi(wc.w)};
#pragma unroll
                  for (int i = 0; i < 8; ++i) { if (p == 2) x2[i] = xu[i] * xc[i]; else x1[i] = xu[i] * xc[i]; } } }
#pragma unroll 4
          for (int r = 0; r < 16; ++r) { const size_t off = (size_t)(t0 + r) * DM + c0;
              const v4u wu = *(const GAS v4u*)(U + off), wc = *(const GAS v4u*)(Cg + off), wb = *(const GAS v4u*)(Bv + off);
              const float xu[8] = {blo(wu.x), bhi(wu.x), blo(wu.y), bhi(wu.y), blo(wu.z), bhi(wu.z), blo(wu.w), bhi(wu.w)}, xc[8] = {blo(wc.x), bhi(wc.x), blo(wc.y), bhi(wc.y), blo(wc.z), bhi(wc.z), blo(wc.w), bhi(wc.w)};
              const float xb[8] = {blo(wb.x), bhi(wb.x), blo(wb.y), bhi(wb.y), blo(wb.z), bhi(wb.z), blo(wb.w), bhi(wb.w)};
              float y[8];
#pragma unroll
              for (int i = 0; i < 8; ++i) { const float x0 = xu[i] * xc[i]; y[i] = xb[i] * (w0[i] * x2[i] + w1[i] * x1[i] + w2[i] * x0); x2[i] = x1[i]; x1[i] = x0; }
              v4u o; o.x = pk2(y[0], y[1]); o.y = pk2(y[2], y[3]); o.z = pk2(y[4], y[5]); o.w = pk2(y[6], y[7]);
              *(GAS v4u*)(Bv + off) = o; } } }
}


#ifdef NAIVE
template <bool DUAL, class St>
__device__ __forceinline__ void naive_gemm(Frame& F, const bf16* A, int lda, const float* W, const float* W2, int ldw, int M_, int N_, int K_, St store) {
    LAS float* As = (LAS float*)(F.lds + RING_OFF);
    LAS float* Ws = As + 64 * 33;
    LAS float* Ws2 = Ws + 32 * 68;
    const int ty = F.tid >> 4, tx = F.tid & 15, ntn = N_ / 64, ntiles = (M_ / 64) * ntn;
    for (int tile = blockIdx.x; tile < ntiles; tile += F.G) {
        const int tm = tile / ntn, tn = tile - tm * ntn;
        float acc[2][4] = {{0.f, 0.f, 0.f, 0.f}, {0.f, 0.f, 0.f, 0.f}}, acc2[2][4] = {{0.f, 0.f, 0.f, 0.f}, {0.f, 0.f, 0.f, 0.f}};
        for (int k0 = 0; k0 < K_; k0 += 32) {
            __syncthreads();
#pragma unroll
            for (int i = 0; i < 4; ++i) { const int e = F.tid + 512 * i, r = e >> 5, c = e & 31; As[r * 33 + c] = __uint_as_float((unsigned)A[(size_t)(tm * 64 + r) * lda + k0 + c] << 16); }
#pragma unroll
            for (int i = 0; i < 4; ++i) { const int e = F.tid + 512 * i, r = e >> 6, c = e & 63; Ws[r * 68 + c] = W[(size_t)(k0 + r) * ldw + tn * 64 + c]; if (DUAL) Ws2[r * 68 + c] = W2[(size_t)(k0 + r) * ldw + tn * 64 + c]; }
            __syncthreads();
#pragma unroll 8
            for (int kk = 0; kk < 32; ++kk) { const float a0 = As[(ty * 2) * 33 + kk], a1 = As[(ty * 2 + 1) * 33 + kk];
#pragma unroll
                for (int j = 0; j < 4; ++j) { const float w = Ws[kk * 68 + tx * 4 + j]; acc[0][j] += a0 * w; acc[1][j] += a1 * w;
                    if (DUAL) { const float w2 = Ws2[kk * 68 + tx * 4 + j]; acc2[0][j] += a0 * w2; acc2[1][j] += a1 * w2; } } }
        }
#pragma unroll
        for (int i = 0; i < 2; ++i)
#pragma unroll
            for (int j = 0; j < 4; ++j) store(tm * 64 + ty * 2 + i, tn * 64 + tx * 4 + j, acc[i][j], acc2[i][j]);
    }
    __syncthreads();
}
__device__ __forceinline__ bf16 f2b(float v) { return (bf16)f2bf(v); }
__device__ __forceinline__ float b2f(bf16 v) { return __uint_as_float((unsigned)v << 16); }
__device__ __forceinline__ void naive_attn(Frame& F) {
    const int gw = F.vcu * NWAVES + F.wave, NGW = F.G * NWAVES;
    bf16* Qb = (bf16*)(F.ws + WS_Q); const bf16* Kb = (const bf16*)(F.ws + WS_K); const bf16* Vb = (const bf16*)(F.ws + WS_V); float* LSE = (float*)(F.ws + WS_LSE);
    for (int it = gw; it < M * 12; it += NGW) {
        const int t = it / 12, gh = it - t * 12, g = gh >> 2, d = 1 << (2 * g), tl = t & (SEQ - 1);
        const float q0 = b2f(Qb[(size_t)t * AW + gh * 128 + 2 * F.lane]), q1 = b2f(Qb[(size_t)t * AW + gh * 128 + 2 * F.lane + 1]);
        float s0 = -INFINITY, s1 = -INFINITY, s2 = -INFINITY;
        for (int j = 0; j <= 128; ++j) { if (tl - j * d < 0) break; const size_t kr = (size_t)(t - j * d) * AW + gh * 128 + 2 * F.lane;
            const float sc = wave_sum(q0 * b2f(Kb[kr]) + q1 * b2f(Kb[kr + 1])) * 0.08838834764831845f;
            if (j < 64) { if (F.lane == j) s0 = sc; } else if (j < 128) { if (F.lane == j - 64) s1 = sc; } else { if (F.lane == 0) s2 = sc; } }
        float mx = fmaxf(s0, fmaxf(s1, s2));
#pragma unroll
        for (int o = 1; o < 64; o <<= 1) mx = fmaxf(mx, __shfl_xor(mx, o));
        const float p0 = __expf(s0 - mx), p1 = __expf(s1 - mx), p2 = __expf(s2 - mx);
        const float l = wave_sum(p0 + p1 + p2);
        float o0 = 0.f, o1 = 0.f;
        for (int j = 0; j <= 128; ++j) { if (tl - j * d < 0) break; const size_t vr = (size_t)(t - j * d) * AW + gh * 128 + 2 * F.lane;
            const float p = (j < 64) ? __shfl(p0, j) : (j < 128) ? __shfl(p1, j - 64) : __shfl(p2, 0);
            o0 += p * b2f(Vb[vr]); o1 += p * b2f(Vb[vr + 1]); }
        const float inv = 1.0f / l;
        Qb[(size_t)t * AW + gh * 128 + 2 * F.lane] = f2b(o0 * inv); Qb[(size_t)t * AW + gh * 128 + 2 * F.lane + 1] = f2b(o1 * inv);
        if (F.lane == 0) LSE[(size_t)t * 12 + gh] = mx + __logf(l);
    }
}
#endif

constexpr int N_PHASES = 17;
__global__ void __launch_bounds__(NWAVES * 64, 2) mega_fwd(Args args) {
    extern __shared__ __attribute__((aligned(16))) unsigned char lds[];
    Frame F;
    F.lds = (LAS unsigned char*)lds;
    F.MISC = (volatile LAS unsigned*)(F.lds + MISC_OFF);
    F.tid = threadIdx.x; F.lane = F.tid & 63; F.wave = __builtin_amdgcn_readfirstlane(F.tid >> 6);
    F.G = gridDim.x; { const int bx = blockIdx.x; F.vcu = (F.G % 8 == 0) ? (bx % 8) * (F.G / 8) + bx / 8 : bx; }
    unsigned char* ws = args.ws; F.ws = ws; F.out = args.out;
    F.ctl = (gu32*)(ws + WS_CTL);
    for (int u = F.tid; u < (LDS_BYTES - LDSCTL_OFF) / 4; u += NWAVES * 64) ((LAS unsigned*)(F.lds + LDSCTL_OFF))[u] = 0u;
    __syncthreads();
    XcdBarrier bar = xcd_barrier_post((unsigned*)(F.ctl + CW_BAR), F.MISC + 8);
    const int lo = args.ph_lo, hi = args.ph_hi;
    const float* mod = (const float*)(ws + WS_MOD);
    typedef pg8::bf16_t pb;
    const pb* XS = (const pb*)(ws + WS_XS);
#define IN(k) (lo <= (k) && (k) < hi)
#define SEAM(k) do { if (IN(k) && IN((k) + 1)) xcd_barrier(bar); } while (0)
#define GEMM_B(A_, K_, BT, N_, MODE, O_, LDC, SPC, SPS, I1, I2) do { pg8::Gemm g{(const pb*)(A_), (const pb*)(BT), M, (N_), (K_)}; pg8::StaticOrder S; S.init(M, (N_), F.G, (int)blockIdx.x); \
        pg8::EpiB<MODE> E{(pb*)(O_), (LDC), (SPC), (SPS), (const pb*)(I1), (const pb*)(I2)}; pg8::gemm_phase<pg8::EpiB<MODE>, pg8::StaticOrder, true, true>(F.lds + RING_OFF, g, S, E); } while (0)
#define GEMM_F(A_, K_, BT, BASE, COEF, SCALE) do { pg8::Gemm g{(const pb*)(A_), (const pb*)(BT), M, DM, (K_)}; pg8::StaticOrder S; S.init(M, DM, F.G, (int)blockIdx.x); \
        pg8::EpiF E{(BASE), F.out, (COEF), (SCALE)}; pg8::gemm_phase<pg8::EpiF, pg8::StaticOrder, true, true>(F.lds + RING_OFF, g, S, E); } while (0)

    if (IN(0)) { for (int it = blockIdx.x; it < ADA_ITEMS; it += F.G) p0_adaln_item(F, args, it); p0_transposes(F, args); }
    SEAM(0);
    if (IN(1)) norm_pass(F, args.in[I_X], args.in[I_NF1], MOD_SH1, MOD_SC1);
    SEAM(1);
#if defined(NAIVE) && (NAIVE & 1)
    if (IN(2)) { bf16* ACT = (bf16*)(ws + WS_ACT); naive_gemm<true>(F, (const bf16*)XS, DM, args.in[I_F1G], args.in[I_F1U], DFF, M, DFF, DM, [=](int r, int c, float g, float u) { ACT[(size_t)r * DFF + c] = f2b(silu_f(g) * u); }); }
#else
    if (IN(2)) GEMM_B(XS, DM, ws + WS_WGU1, 2 * DFF, pg8::EB_SWIGLU, ws + WS_ACT, DFF, 0, 0, nullptr, nullptr);
#endif
    SEAM(2);
#if defined(NAIVE) && (NAIVE & 2)
    if (IN(3)) { const float* xb = args.in[I_X]; float* ob = F.out; naive_gemm<false>(F, (const bf16*)(ws + WS_ACT), DFF, args.in[I_F1D], nullptr, DM, M, DM, DFF, [=](int r, int c, float v, float) { ob[(size_t)r * DM + c] = xb[(size_t)r * DM + c] + 0.5f * mod[(r / SEQ) * NMOD + MOD_GT1 + c] * v; }); }
#else
    if (IN(3)) GEMM_F(ws + WS_ACT, DFF, ws + WS_WD1, args.in[I_X], mod + MOD_GT1, 0.5f);
#endif
    SEAM(3);
    if (IN(4)) norm_pass(F, F.out, args.in[I_NMIX], MOD_SH2, MOD_SC2);
    SEAM(4);
#if defined(NAIVE) && (NAIVE & 4)
    if (IN(5)) { bf16* Qb = (bf16*)(ws + WS_Q); naive_gemm<false>(F, (const bf16*)XS, DM, args.in[I_WIN] + COL_Q, nullptr, INW, M, 3 * AW, DM, [=](int r, int c, float v, float) { const int t = c / AW; Qb[(size_t)t * M * AW + (size_t)r * AW + (c - t * AW)] = f2b(v); }); }
#else
    if (IN(5)) GEMM_B(XS, DM, ws + WS_WIN + (size_t)COL_Q * DM * 2, 3 * AW, pg8::EB_PLAIN, ws + WS_Q, AW, AW, (size_t)(WS_K - WS_Q) / 2, nullptr, nullptr);
#endif
    SEAM(5);
    if (IN(6)) qknorm_pass(F, args);
    SEAM(6);
#if defined(NAIVE) && (NAIVE & 8)
    if (IN(7)) naive_attn(F);
#else
    if (IN(7)) attn_phase(F, (char*)lds + RING_OFF);
#endif
    SEAM(7);
#if defined(NAIVE) && (NAIVE & 16)
    if (IN(8)) { bf16* Ub = (bf16*)(ws + WS_U); naive_gemm<false>(F, (const bf16*)XS, DM, args.in[I_WIN] + COL_U, nullptr, INW, M, 3 * DM, DM, [=](int r, int c, float v, float) { const int t = c / DM; Ub[(size_t)t * M * DM + (size_t)r * DM + (c - t * DM)] = f2b(v); }); }
#else
    if (IN(8)) GEMM_B(XS, DM, ws + WS_WIN + (size_t)COL_U * DM * 2, 3 * DM, pg8::EB_PLAIN, ws + WS_U, DM, DM, (size_t)(WS_B - WS_U) / 2, nullptr, nullptr);
#endif
    SEAM(8);
    if (IN(9)) merge_conv_pass(F, args);
    SEAM(9);
    { bf16* SGA = (bf16*)(ws + WS_SGA); bf16* SGC = (bf16*)(ws + WS_SGC); (void)SGA; (void)SGC;
#if defined(NAIVE) && (NAIVE & 32)
      if (IN(10)) naive_gemm<false>(F, (const bf16*)XS, DM, args.in[I_WIN] + COL_GA, nullptr, INW, M, DM, DM, [=](int r, int c, float v, float) { SGA[(size_t)r * DM + c] = f2b(1.0f / (1.0f + __expf(-v))); });
      if (IN(11)) naive_gemm<false>(F, (const bf16*)XS, DM, args.in[I_WIN] + COL_GC, nullptr, INW, M, DM, DM, [=](int r, int c, float v, float) { SGC[(size_t)r * DM + c] = f2b(1.0f / (1.0f + __expf(-v))); });
#else
    if (IN(10)) GEMM_B(XS, DM, ws + WS_WIN + (size_t)COL_GA * DM * 2, DM, pg8::EB_SIGMOID, ws + WS_SGA, DM, 0, 0, nullptr, nullptr);
    if (IN(11)) GEMM_B(XS, DM, ws + WS_WIN + (size_t)COL_GC * DM * 2, DM, pg8::EB_SIGMOID, ws + WS_SGC, DM, 0, 0, nullptr, nullptr);
#endif
#ifdef NAIVE
    if (IN(11) && IN(12)) xcd_barrier(bar);
#endif
#if defined(NAIVE) && (NAIVE & 512)
      if (IN(12)) naive_gemm<false>(F, (const bf16*)(ws + WS_O), 512, args.in[I_WAB], nullptr, DM, M, DM, 512, [=](int r, int c, float v, float) { SGA[(size_t)r * DM + c] = f2b(b2f(SGA[(size_t)r * DM + c]) * v); });
#else
    if (IN(12)) GEMM_B(ws + WS_O, 512, ws + WS_WA, DM, pg8::EB_GATEMUL, ws + WS_SGA, DM, 0, 0, ws + WS_SGA, nullptr);
#endif
#ifdef NAIVE
    if (IN(12) && IN(13)) xcd_barrier(bar);
#endif
#if defined(NAIVE) && (NAIVE & 1024)
      if (IN(13)) naive_gemm<false>(F, (const bf16*)(ws + WS_B), DM, args.in[I_WCB], nullptr, DM, M, DM, DM, [=](int r, int c, float v, float) { SGA[(size_t)r * DM + c] = f2b(b2f(SGA[(size_t)r * DM + c]) + b2f(SGC[(size_t)r * DM + c]) * v); });
#else
    if (IN(13)) GEMM_B(ws + WS_B, DM, ws + WS_WC, DM, pg8::EB_MERGE, ws + WS_SGA, DM, 0, 0, ws + WS_SGA, ws + WS_SGC);
#endif
    }
    SEAM(13);
#if defined(NAIVE) && (NAIVE & 64)
    if (IN(14)) { float* ob = F.out; naive_gemm<false>(F, (const bf16*)(ws + WS_SGA), DM, args.in[I_WOUT], nullptr, DM, M, DM, DM, [=](int r, int c, float v, float) { ob[(size_t)r * DM + c] += mod[(r / SEQ) * NMOD + MOD_GT2 + c] * v; }); }
#else
    if (IN(14)) GEMM_F(ws + WS_SGA, DM, ws + WS_WO, F.out, mod + MOD_GT2, 1.0f);
#endif
    SEAM(14);
    if (IN(15)) norm_pass(F, F.out, args.in[I_NF2], MOD_SH3, MOD_SC3);
    SEAM(15);
#if defined(NAIVE) && (NAIVE & 128)
    if (IN(16)) { bf16* ACT = (bf16*)(ws + WS_ACT); naive_gemm<true>(F, (const bf16*)XS, DM, args.in[I_F2G], args.in[I_F2U], DFF, M, DFF, DM, [=](int r, int c, float g, float u) { ACT[(size_t)r * DFF + c] = f2b(silu_f(g) * u); }); }
#else
    if (IN(16)) GEMM_B(XS, DM, ws + WS_WGU2, 2 * DFF, pg8::EB_SWIGLU, ws + WS_ACT, DFF, 0, 0, nullptr, nullptr);
#endif
    SEAM(16);
#if defined(NAIVE) && (NAIVE & 256)
    if (IN(17)) { float* ob = F.out; naive_gemm<false>(F, (const bf16*)(ws + WS_ACT), DFF, args.in[I_F2D], nullptr, DM, M, DM, DFF, [=](int r, int c, float v, float) { ob[(size_t)r * DM + c] += 0.5f * mod[(r / SEQ) * NMOD + MOD_GT3 + c] * v; }); }
#else
    if (IN(17)) GEMM_F(ws + WS_ACT, DFF, ws + WS_WD2, F.out, mod + MOD_GT3, 0.5f);
#endif
#undef IN
#undef SEAM
}

extern "C" void kernel_launch(void* const* d_in, const int* in_sizes, int n_in, void* d_out, int out_size, void* d_ws, size_t ws_size, hipStream_t stream) {
    static int grid = 0;
    if (grid == 0) {
        if (n_in != 20 || in_sizes[0] != M * DM || out_size != M * DM || ws_size < WS_END) { fprintf(stderr, "kernel_launch: shape/workspace mismatch (n_in %d, in0 %d, out %d, ws %zu < %zu)\n", n_in, n_in > 0 ? in_sizes[0] : -1, out_size, ws_size, (size_t)WS_END); grid = -1; return; }
        int dev = 0, cus = 0, per_cu = 0;
        if (hipGetDevice(&dev) != hipSuccess || hipDeviceGetAttribute(&cus, hipDeviceAttributeMultiprocessorCount, dev) != hipSuccess) { grid = -1; return; }
        if (hipFuncSetAttribute((const void*)mega_fwd, hipFuncAttributeMaxDynamicSharedMemorySize, LDS_BYTES) != hipSuccess) { fprintf(stderr, "kernel_launch: hipFuncSetAttribute failed\n"); grid = -1; return; }
        if (hipOccupancyMaxActiveBlocksPerMultiprocessor(&per_cu, (const void*)mega_fwd, NWAVES * 64, LDS_BYTES) != hipSuccess || per_cu < 1) { fprintf(stderr, "kernel_launch: occupancy query reports %d workgroups per CU\n", per_cu); }
        (void)hipGetLastError();
        grid = cus;
    }
    if (grid < 0) return;
    (void)hipMemsetAsync((char*)d_ws + WS_CTL, 0, CTL_ZERO_BYTES, stream);
    Args a{};
    for (int i = 0; i < 20; ++i) a.in[i] = (const float*)d_in[i];
    a.out = (float*)d_out; a.ws = (unsigned char*)d_ws;
#ifndef MK_PER_PHASE
    a.ph_lo = 0; a.ph_hi = N_PHASES + 1;
    hipLaunchKernelGGL(mega_fwd, dim3(grid), dim3(NWAVES * 64), LDS_BYTES, stream, a);
#else
    for (int p = 0; p <= N_PHASES; ++p) { a.ph_lo = p; a.ph_hi = p + 1; hipLaunchKernelGGL(mega_fwd, dim3(grid), dim3(NWAVES * 64), LDS_BYTES, stream, a); }
#endif
}
```

```cpp
#include <hip/hip_runtime.h>
#include <hip/hip_bf16.h>
#include <cstdio>
#include <cstdint>

constexpr int DM = 1024, BATCH = 2, SEQ = 8192, M = BATCH * SEQ;
constexpr int DFF = 2816, NMOD = 9 * DM;
constexpr int AW = 1536;
constexpr int INW = 9728;
constexpr int COL_Q = 0, COL_K = 1536, COL_V = 3072, COL_U = 4608, COL_B = 5632, COL_C = 6656, COL_GA = 7680, COL_GC = 8704;
constexpr float EPS = 1e-6f;

__device__ __forceinline__ int tid_opaque() { int t = (int)threadIdx.x; asm volatile("" : "+v"(t)); return t; }

namespace pg8 {
#define PG8_LAS __attribute__((address_space(3)))
typedef unsigned short bf16_t;
typedef short bf16x8 __attribute__((ext_vector_type(8)));
typedef float f32x4 __attribute__((ext_vector_type(4)));
typedef unsigned u32x4 __attribute__((ext_vector_type(4)));
constexpr int BM = 256, BK = 64, HALF = 128, HTB = HALF * BK * 2  , STAGE_BYTES = 8 * HTB, NXCD = 8, WGM = 8;

__host__ __device__ __forceinline__ int lds_byte(int r, int c) { const int st = (r >> 4) * 2 + (c >> 5), rr = r & 15, cc = c & 31, ob = rr * 64 + cc * 2; return st * 1024 + (ob ^ (((ob >> 9) & 1) << 5)); }
__host__ __device__ __forceinline__ void stage_rc(int b, int& R, int& C) { const int st = b / 1024, sb = b % 1024, swz = sb ^ (((sb >> 9) & 1) << 5); R = (st >> 1) * 16 + swz / 64; C = (st & 1) * 32 + (swz % 64) / 2; }
__host__ __device__ __forceinline__ int perm32(int rho) { const int n = rho >> 4, i = rho & 15; return 8 * (i >> 2) + 4 * n + (i & 3); }

struct Unit { int pm, pn; };
struct Gemm { const bf16_t* A; const bf16_t* Bt; int M, N, K; };

struct StaticOrder {
    int nM, nN, nwg, G, c;
    __host__ __device__ void init(int M, int N, int G_, int c_) { nM = M / BM; nN = N / BM; nwg = nM * nN; G = G_; c = c_; }
    __host__ __device__ bool next(int i, Unit& u) const {
        const long L = (long)i * G + c; if (L >= nwg) return false;
        int wgid = (int)L; { const int q = nwg / NXCD, r = nwg % NXCD, xcd = wgid % NXCD, off = wgid / NXCD; wgid = (xcd < r ? xcd * (q + 1) : r * (q + 1) + (xcd - r) * q) + off; }
        const int nig = WGM * nN, gid = wgid / nig, fm = gid * WGM, gsz = (nM - fm) < WGM ? (nM - fm) : WGM;
        u.pm = fm + ((wgid % nig) % gsz); u.pn = (wgid % nig) / gsz; return true;
    }
    __device__ __forceinline__ void a_ready(const Unit&) const {}
    __device__ __forceinline__ void done(const Unit&) const {}
};

typedef float f32x2_t __attribute__((ext_vector_type(2))); typedef __bf16 bf16x2_t __attribute__((ext_vector_type(2)));
__device__ __forceinline__ unsigned cvt_pk_bf16(float lo, float hi) { f32x2_t v = {lo, hi}; bf16x2_t b = __builtin_convertvector(v, bf16x2_t); return __builtin_bit_cast(unsigned, b); }
__device__ __forceinline__ float bf_lo(unsigned w) { return __uint_as_float(w << 16); }
__device__ __forceinline__ float bf_hi(unsigned w) { return __uint_as_float(w & 0xffff0000u); }
__device__ __forceinline__ float sigmoidf_(float x) { return __builtin_amdgcn_rcpf(1.0f + __builtin_amdgcn_exp2f(-1.4426950408889634f * x)); }
__device__ __forceinline__ void unpack8(const u32x4 w, f32x4& a, f32x4& b) { a = (f32x4){bf_lo(w.x), bf_hi(w.x), bf_lo(w.y), bf_hi(w.y)}; b = (f32x4){bf_lo(w.z), bf_hi(w.z), bf_lo(w.w), bf_hi(w.w)}; }
__device__ __forceinline__ u32x4 pack8(const f32x4 a, const f32x4 b) { u32x4 w; w.x = cvt_pk_bf16(a[0], a[1]); w.y = cvt_pk_bf16(a[2], a[3]); w.z = cvt_pk_bf16(b[0], b[1]); w.w = cvt_pk_bf16(b[2], b[3]); return w; }

enum { EB_PLAIN = 0, EB_SWIGLU = 1, EB_SIGMOID = 2, EB_GATEMUL = 3, EB_MERGE = 4 };
template <int mode, bool NORMED = false, bool QKN = false> struct EpiB {
    static constexpr bool PERM = true, AFTER_DRAIN = false, PREFETCH = NORMED;
    bf16_t* O; int ldc; int split_cols; size_t split_stride; const bf16_t* In1; const bf16_t* In2;
    const float* PS; const float* bias; int bias_bstride; const float* gamma_q; const float* gamma_k; int qk_cols; PG8_LAS float* XL; int par;
    __device__ __forceinline__ void prefetch(const Unit& u, int wid, int buf) const {
        if (NORMED && wid < 4) { const int lane = threadIdx.x & 63; PG8_LAS unsigned char* X2 = (PG8_LAS unsigned char*)(XL + 2048) + buf * 5120;
            __builtin_amdgcn_global_load_lds((const unsigned*)(PS + (size_t)(u.pm * BM + wid * 64 + lane) * 4), (PG8_LAS unsigned*)(X2 + wid * 1024), 16, 0, 0);
            if (wid == 0) __builtin_amdgcn_global_load_lds((const unsigned*)(bias + (size_t)((u.pm * BM) / SEQ) * bias_bstride + u.pn * BM + lane * 4), (PG8_LAS unsigned*)(X2 + 4096), 16, 0, 0); }
    }
    __device__ __forceinline__ void operator()(f32x4 (&acc)[2][2][4][2], const Unit& u, int wr, int wc, int fr, int fq) const {
        const int row0 = u.pm * BM + wr * 64 + fr;
        if (NORMED) {
            const PG8_LAS float* X2 = XL + 2048 + par * 1280;
            f32x4 bv[2][2];
#pragma unroll
            for (int bj = 0; bj < 2; ++bj)
#pragma unroll
                for (int n = 0; n < 2; ++n) bv[bj][n] = *(const PG8_LAS f32x4*)(X2 + 1024 + bj * HALF + wc * 32 + 8 * fq + 4 * n);
#pragma unroll
            for (int ai = 0; ai < 2; ++ai)
#pragma unroll
                for (int m = 0; m < 4; ++m) { const f32x4 p = *(const PG8_LAS f32x4*)(X2 + (ai * HALF + wr * 64 + m * 16 + fr) * 4);
                    const float rstd = __builtin_amdgcn_rsqf(((p[0] + p[1]) + (p[2] + p[3])) * (1.0f / 1024.0f) + 1e-6f);
#pragma unroll
                    for (int bj = 0; bj < 2; ++bj)
#pragma unroll
                        for (int n = 0; n < 2; ++n) acc[ai][bj][m][n] = acc[ai][bj][m][n] * rstd + bv[bj][n]; }
        }
        if (mode == EB_SWIGLU) {
            const int col0 = u.pn * HALF + wc * 32 + 8 * fq;
#pragma unroll
            for (int ai = 0; ai < 2; ++ai)
#pragma unroll
                for (int m = 0; m < 4; ++m) { bf16_t* rowp = O + (size_t)(row0 + ai * HALF + m * 16) * ldc + col0;
                    f32x4 v0, v1;
#pragma unroll
                    for (int i = 0; i < 4; ++i) { const float g0 = acc[ai][0][m][0][i], g1 = acc[ai][0][m][1][i];
                        v0[i] = g0 * sigmoidf_(g0) * acc[ai][1][m][0][i]; v1[i] = g1 * sigmoidf_(g1) * acc[ai][1][m][1][i]; }
                    *(u32x4*)rowp = pack8(v0, v1); }
            return;
        }
        int colt = u.pn * BM; size_t boff = 0;
        if (QKN && colt < qk_cols) {
            PG8_LAS float* P = XL;
#pragma unroll
            for (int ai = 0; ai < 2; ++ai)
#pragma unroll
                for (int m = 0; m < 4; ++m)
#pragma unroll
                    for (int bj = 0; bj < 2; ++bj) { const f32x4 a = acc[ai][bj][m][0], b = acc[ai][bj][m][1];
                        float s = ((a[0] * a[0] + a[1] * a[1]) + (a[2] * a[2] + a[3] * a[3])) + ((b[0] * b[0] + b[1] * b[1]) + (b[2] * b[2] + b[3] * b[3]));
                        s += __shfl_xor(s, 16); s += __shfl_xor(s, 32);
                        if (fq == 0) P[((ai * HALF + wr * 64 + m * 16 + fr) * 2 + bj) * 4 + wc] = s; }
            asm volatile("s_waitcnt lgkmcnt(0)" ::: "memory"); __builtin_amdgcn_s_barrier(); asm volatile("" ::: "memory");
            const float* gm = (colt < (qk_cols >> 1) ? gamma_q : gamma_k) + wc * 32 + 8 * fq;
            const f32x4 g0 = *(const f32x4*)gm, g1 = *(const f32x4*)(gm + 4);
#pragma unroll
            for (int ai = 0; ai < 2; ++ai)
#pragma unroll
                for (int m = 0; m < 4; ++m)
#pragma unroll
                    for (int bj = 0; bj < 2; ++bj) { const f32x4 p = *(const PG8_LAS f32x4*)(P + ((ai * HALF + wr * 64 + m * 16 + fr) * 2 + bj) * 4);
                        const float r = __builtin_amdgcn_rsqf(((p[0] + p[1]) + (p[2] + p[3])) * (1.0f / 128.0f) + 1e-6f);
                        acc[ai][bj][m][0] = acc[ai][bj][m][0] * r * g0; acc[ai][bj][m][1] = acc[ai][bj][m][1] * r * g1; }
        }
        if (split_cols) { const int t = colt / split_cols; boff = (size_t)t * split_stride; colt -= t * split_cols; }
        const int col0 = colt + wc * 32 + 8 * fq;
#pragma unroll
        for (int ai = 0; ai < 2; ++ai)
#pragma unroll
            for (int m = 0; m < 4; ++m) { const size_t roff = boff + (size_t)(row0 + ai * HALF + m * 16) * ldc + col0;
#pragma unroll
                for (int bj = 0; bj < 2; ++bj) { const size_t off = roff + bj * HALF; f32x4 v0 = acc[ai][bj][m][0], v1 = acc[ai][bj][m][1];
                    if (mode == EB_SIGMOID) {
#pragma unroll
                        for (int i = 0; i < 4; ++i) { v0[i] = sigmoidf_(v0[i]); v1[i] = sigmoidf_(v1[i]); }
                    } else if (mode == EB_GATEMUL) { f32x4 a0, a1; unpack8(*(const u32x4*)(In1 + off), a0, a1); v0 = v0 * a0; v1 = v1 * a1; }
                    else if (mode == EB_MERGE) { f32x4 a0, a1, g0, g1; unpack8(*(const u32x4*)(In1 + off), a0, a1); unpack8(*(const u32x4*)(In2 + off), g0, g1); v0 = a0 + g0 * v0; v1 = a1 + g1 * v1; }
                    *(u32x4*)(O + off) = pack8(v0, v1); } }
    }
};
template <bool XSOUT = false> struct EpiF {
    static constexpr bool PERM = false, AFTER_DRAIN = false, PREFETCH = false;
    const float* base; float* out; const float* coef; bf16_t* XS; const float* avec; float* PS; PG8_LAS float* XL; float scale;
    __device__ __forceinline__ void operator()(f32x4 (&acc)[2][2][4][2], const Unit& u, int wr, int wc, int fr, int fq) const {
        const int row0 = u.pm * BM + wr * 64 + fr, col0 = u.pn * BM + wc * 32 + 4 * fq, bt = (u.pm * BM) / SEQ;
        const float* cf = coef + (size_t)bt * NMOD + col0;
        f32x4 cv[2][2], av[2][2];
#pragma unroll
        for (int bj = 0; bj < 2; ++bj)
#pragma unroll
            for (int n = 0; n < 2; ++n) { cv[bj][n] = *(const f32x4*)(cf + bj * HALF + n * 16) * scale; if (XSOUT) av[bj][n] = *(const f32x4*)(avec + bt * DM + col0 + bj * HALF + n * 16); }
        PG8_LAS float* P = XL;
        f32x4 pre[2][2][2];
#define EPIF_LOAD(slot, q) do { const size_t off_ = (size_t)(row0 + ((q) >> 2) * HALF + ((q) & 3) * 16) * DM + col0; \
            _Pragma("unroll") for (int bj = 0; bj < 2; ++bj) _Pragma("unroll") for (int n = 0; n < 2; ++n) pre[slot][bj][n] = *(const f32x4*)(base + off_ + bj * HALF + n * 16); } while (0)
#define EPIF_DO(slot, q) do { const int ai = (q) >> 2, m = (q) & 3; const size_t off = (size_t)(row0 + ai * HALF + m * 16) * DM + col0; float ss = 0.f; \
            _Pragma("unroll") for (int bj = 0; bj < 2; ++bj) _Pragma("unroll") for (int n = 0; n < 2; ++n) { const f32x4 o = pre[slot][bj][n] + cv[bj][n] * acc[ai][bj][m][n]; \
                *(f32x4*)(out + off + bj * HALF + n * 16) = o; \
                if (XSOUT) { ss += (o[0] * o[0] + o[1] * o[1]) + (o[2] * o[2] + o[3] * o[3]); const f32x4 x = o * av[bj][n]; \
                    unsigned long long w = (unsigned long long)cvt_pk_bf16(x[0], x[1]) | ((unsigned long long)cvt_pk_bf16(x[2], x[3]) << 32); \
                    *(unsigned long long*)(XS + off + bj * HALF + n * 16) = w; } } \
            if (XSOUT) { ss += __shfl_xor(ss, 16); ss += __shfl_xor(ss, 32); if (fq == 0) P[(ai * HALF + wr * 64 + m * 16 + fr) * 4 + wc] = ss; } } while (0)
        EPIF_LOAD(0, 0); EPIF_LOAD(1, 1);
        EPIF_DO(0, 0); EPIF_LOAD(0, 2); EPIF_DO(1, 1); EPIF_LOAD(1, 3); EPIF_DO(0, 2); EPIF_LOAD(0, 4); EPIF_DO(1, 3); EPIF_LOAD(1, 5);
        EPIF_DO(0, 4); EPIF_LOAD(0, 6); EPIF_DO(1, 5); EPIF_LOAD(1, 7); EPIF_DO(0, 6); EPIF_DO(1, 7);
#undef EPIF_LOAD
#undef EPIF_DO
        if (XSOUT) {
            asm volatile("s_waitcnt lgkmcnt(0)" ::: "memory"); __builtin_amdgcn_s_barrier(); asm volatile("" ::: "memory");
            const int tid = threadIdx.x;
            if (tid < BM) { const f32x4 p = *(const PG8_LAS f32x4*)(P + tid * 4); PS[(size_t)(u.pm * BM + tid) * 4 + u.pn] = (p[0] + p[1]) + (p[2] + p[3]); }
        }
    }
};

struct TwinOrder : StaticOrder {
    int reps;
    __device__ bool next(int i, Unit& u) const { if (i >= reps) return false; if (!StaticOrder::next(0, u)) return false; u.pn += 4 * i; return true; }
};
template <class Epi, class Sched, bool ALIGN_EPI = false, bool SP2 = false>
__device__ __forceinline__ void gemm_phase(PG8_LAS unsigned char* lds, const Gemm g, const Sched& S, Epi E) {
    const int tid = tid_opaque(), wid = __builtin_amdgcn_readfirstlane(tid >> 6), lane = tid & 63, wr = wid >> 2, wc = wid & 3, fr = lane & 15, fq = lane >> 4;
    const int K = g.K, nt = K / BK;
    unsigned voffA[2], voffB[2];
#pragma unroll
    for (int i = 0; i < 2; ++i) { int R, C; stage_rc(tid * 16 + i * 8192, R, C); const int Rb = Epi::PERM ? ((R & ~31) + perm32(R & 31)) : R;
        voffA[i] = (unsigned)(R * K + C) * 2u; voffB[i] = (unsigned)(Rb * K + C) * 2u; }
    const size_t kstep = (size_t)(BK * 2);
    const size_t hstep = (size_t)HALF * K * 2;
    const size_t tstep = 2 * hstep;
    const unsigned ldsw = (unsigned)wid * 1024u;
    const int aoff = lds_byte(wr * 64 + fr, fq * 8), boff = lds_byte(wc * 32 + fr, fq * 8);
#define PG8_SA(b, h) (((b) * 2 + (h)) * HTB)
#define PG8_SB(b, h) ((4 + (b) * 2 + (h)) * HTB)
#define PG8_STAGE(bufoff, gbase, voff) do { _Pragma("unroll") for (int _i = 0; _i < 2; ++_i) \
        __builtin_amdgcn_global_load_lds((const unsigned*)((const char*)(gbase) + (voff)[_i]), (PG8_LAS unsigned*)(lds + (bufoff) + ldsw + _i * 8192), 16, 0, 0); } while (0)
#define PG8_LDA(dst, b, h) do { _Pragma("unroll") for (int m = 0; m < 4; ++m) _Pragma("unroll") for (int k = 0; k < 2; ++k) dst[m][k] = *(const PG8_LAS bf16x8*)(lds + PG8_SA(b, h) + aoff + m * 2048 + k * 1024); } while (0)
#define PG8_LDB(dst, b, h) do { _Pragma("unroll") for (int n = 0; n < 2; ++n) _Pragma("unroll") for (int k = 0; k < 2; ++k) dst[n][k] = *(const PG8_LAS bf16x8*)(lds + PG8_SB(b, h) + boff + n * 2048 + k * 1024); } while (0)
#define PG8_MMA(ai, bj, At, Bt) do { __builtin_amdgcn_s_setprio(1); _Pragma("unroll") for (int m = 0; m < 4; ++m) _Pragma("unroll") for (int n = 0; n < 2; ++n) _Pragma("unroll") for (int k = 0; k < 2; ++k) \
        acc[ai][bj][m][n] = __builtin_amdgcn_mfma_f32_16x16x32_bf16(Bt[n][k], At[m][k], acc[ai][bj][m][n], 0, 0, 0); __builtin_amdgcn_s_setprio(0); } while (0)
#define PG8_WAIT_V(n) asm volatile("s_waitcnt vmcnt(" #n ")" ::: "memory")
#define PG8_WAIT_L(n) asm volatile("s_waitcnt lgkmcnt(" #n ")" ::: "memory")
#define PG8_BAR __builtin_amdgcn_s_barrier()
#define PG8_SCHED __builtin_amdgcn_sched_barrier(0)
    Unit cur, nxt; int ui = 0;
    if (!S.next(0, cur)) return;
    f32x4 acc[2][2][4][2];
#pragma unroll
    for (int a = 0; a < 2; ++a)
#pragma unroll
        for (int b = 0; b < 2; ++b)
#pragma unroll
            for (int m = 0; m < 4; ++m)
#pragma unroll
                for (int n = 0; n < 2; ++n) acc[a][b][m][n] = (f32x4){0.f, 0.f, 0.f, 0.f};
    bf16x8 At[4][2], B0[2][2], B1[2][2];
    const char* cA = (const char*)g.A + (size_t)cur.pm * tstep; const char* cB = (const char*)g.Bt + (size_t)cur.pn * tstep;
    S.a_ready(cur);
    if constexpr (Epi::PREFETCH) E.prefetch(cur, wid, 0);
    if constexpr (SP2) {
        PG8_STAGE(PG8_SB(0, 0), cB, voffB); PG8_STAGE(PG8_SB(0, 1), cB + hstep, voffB); PG8_STAGE(PG8_SA(0, 0), cA, voffA); PG8_STAGE(PG8_SA(0, 1), cA + hstep, voffA);
        if (wr == 1) PG8_BAR;
        PG8_WAIT_V(2); PG8_BAR;
        PG8_STAGE(PG8_SB(1, 0), cB + kstep, voffB); PG8_STAGE(PG8_SA(1, 0), cA + kstep, voffA); PG8_STAGE(PG8_SB(1, 1), cB + hstep + kstep, voffB);
        PG8_WAIT_V(6); PG8_BAR;
    } else {
        PG8_STAGE(PG8_SB(0, 0), cB, voffB); PG8_STAGE(PG8_SA(0, 0), cA, voffA); PG8_STAGE(PG8_SB(0, 1), cB + hstep, voffB); PG8_STAGE(PG8_SA(0, 1), cA + hstep, voffA);
        if (wr == 1) PG8_BAR;
        PG8_WAIT_V(4); PG8_BAR;
        PG8_STAGE(PG8_SB(1, 0), cB + kstep, voffB); PG8_STAGE(PG8_SA(1, 0), cA + kstep, voffA); PG8_STAGE(PG8_SB(1, 1), cB + hstep + kstep, voffB);
        PG8_WAIT_V(6); PG8_BAR;
    }
    for (;;) {
        const bool has_next = S.next(ui + 1, nxt);
        const char* nA = has_next ? (const char*)g.A + (size_t)nxt.pm * tstep : cA; const char* nB = has_next ? (const char*)g.Bt + (size_t)nxt.pn * tstep : cB;
        for (int t = 0; t < nt; t += 2) {
            const bool last = (t == nt - 2);
            const char* a1 = cA + (size_t)(t + 1) * kstep;
            const char* a2 = last ? nA : cA + (size_t)(t + 2) * kstep; const char* b2 = last ? nB : cB + (size_t)(t + 2) * kstep;
            const char* a3 = a2 + kstep; const char* b3 = b2 + kstep;
            if (last && has_next) S.a_ready(nxt);
            if constexpr (SP2) {
            PG8_LDB(B0, 0, 0); PG8_LDB(B1, 0, 1); PG8_SCHED; PG8_LDA(At, 0, 0); PG8_STAGE(PG8_SA(1, 1), a1 + hstep, voffA);
            PG8_WAIT_V(8); PG8_WAIT_L(0); PG8_BAR; PG8_MMA(0, 0, At, B0); PG8_MMA(0, 1, At, B1); PG8_BAR; PG8_SCHED;
            PG8_LDA(At, 0, 1); PG8_STAGE(PG8_SB(0, 0), b2, voffB); PG8_STAGE(PG8_SB(0, 1), b2 + hstep, voffB); PG8_STAGE(PG8_SA(0, 0), a2, voffA);
            PG8_WAIT_V(8); PG8_WAIT_L(0); PG8_BAR; PG8_MMA(1, 0, At, B0); PG8_MMA(1, 1, At, B1); PG8_BAR; PG8_SCHED;
            PG8_LDB(B0, 1, 0); PG8_LDB(B1, 1, 1); PG8_SCHED; PG8_LDA(At, 1, 0); PG8_STAGE(PG8_SA(0, 1), a2 + hstep, voffA);
            PG8_WAIT_V(8); PG8_WAIT_L(0); PG8_BAR; PG8_MMA(0, 0, At, B0); PG8_MMA(0, 1, At, B1); PG8_BAR; PG8_SCHED;
            PG8_LDA(At, 1, 1); PG8_STAGE(PG8_SB(1, 0), b3, voffB); PG8_STAGE(PG8_SB(1, 1), b3 + hstep, voffB); PG8_STAGE(PG8_SA(1, 0), a3, voffA);
            PG8_WAIT_V(8); PG8_WAIT_L(0); PG8_BAR; PG8_MMA(1, 0, At, B0); PG8_MMA(1, 1, At, B1); PG8_BAR; PG8_SCHED;
            } else {
            PG8_LDB(B0, 0, 0); PG8_SCHED; PG8_LDA(At, 0, 0); PG8_STAGE(PG8_SA(1, 1), a1 + hstep, voffA);
            PG8_WAIT_L(8); PG8_BAR; PG8_WAIT_L(0); PG8_MMA(0, 0, At, B0); PG8_BAR; PG8_SCHED;
            PG8_LDB(B1, 0, 1); PG8_STAGE(PG8_SB(0, 0), b2, voffB);
            PG8_BAR; PG8_WAIT_L(0); PG8_MMA(0, 1, At, B1); PG8_BAR;
            PG8_LDA(At, 0, 1); PG8_STAGE(PG8_SA(0, 0), a2, voffA);
            PG8_BAR; PG8_WAIT_L(0); PG8_MMA(1, 0, At, B0); PG8_BAR; PG8_SCHED;
            PG8_STAGE(PG8_SB(0, 1), b2 + hstep, voffB);
            PG8_WAIT_V(6); PG8_BAR; PG8_MMA(1, 1, At, B1); PG8_BAR;
            PG8_LDB(B0, 1, 0); PG8_SCHED; PG8_LDA(At, 1, 0); PG8_STAGE(PG8_SA(0, 1), a2 + hstep, voffA);
            PG8_WAIT_L(8); PG8_BAR; PG8_WAIT_L(0); PG8_MMA(0, 0, At, B0); PG8_BAR; PG8_SCHED;
            PG8_LDB(B1, 1, 1); PG8_STAGE(PG8_SB(1, 0), b3, voffB);
            PG8_BAR; PG8_WAIT_L(0); PG8_MMA(0, 1, At, B1); PG8_BAR;
            PG8_LDA(At, 1, 1); PG8_STAGE(PG8_SA(1, 0), a3, voffA);
            PG8_BAR; PG8_WAIT_L(0); PG8_MMA(1, 0, At, B0); PG8_BAR; PG8_SCHED;
            PG8_STAGE(PG8_SB(1, 1), b3 + hstep, voffB);
            PG8_WAIT_V(6); PG8_BAR; PG8_MMA(1, 1, At, B1); PG8_BAR;
            }
        }
        if constexpr (ALIGN_EPI) { if (wr == 0) PG8_BAR; }
        if constexpr (!Epi::AFTER_DRAIN) { if constexpr (Epi::PREFETCH) { E.par = ui & 1; } E(acc, cur, wr, wc, fr, fq); S.done(cur); }
        if (!has_next) break;
        if constexpr (Epi::PREFETCH) E.prefetch(nxt, wid, (ui + 1) & 1);
#pragma unroll
        for (int a = 0; a < 2; ++a)
#pragma unroll
            for (int b = 0; b < 2; ++b)
#pragma unroll
                for (int m = 0; m < 4; ++m)
#pragma unroll
                    for (int n = 0; n < 2; ++n) acc[a][b][m][n] = (f32x4){0.f, 0.f, 0.f, 0.f};
        cur = nxt; cA = nA; cB = nB; ++ui;
        if constexpr (ALIGN_EPI) { if (wr == 1) PG8_BAR; }
    }
    PG8_WAIT_V(0);
    if constexpr (!ALIGN_EPI) { if (wr == 0) PG8_BAR; }
    PG8_BAR;
    if constexpr (Epi::AFTER_DRAIN) { E.fused(acc, cur, wr, wc, fr, fq, lds, wid, lane); S.done(cur); }
#undef PG8_SA
#undef PG8_SB
#undef PG8_STAGE
#undef PG8_LDA
#undef PG8_LDB
#undef PG8_MMA
#undef PG8_WAIT_V
#undef PG8_WAIT_L
#undef PG8_BAR
#undef PG8_SCHED
}
}

namespace attn {
constexpr int D = 128;
constexpr int WINDOW = 129;
constexpr float THR = 8.f;
constexpr bool WSKIP = true;
constexpr float SCALE = 0.08838834764831845f;
constexpr int NW = 8, QBLK = 32, KVBLK = 64, QB = NW * QBLK;
constexpr int SHM_V = KVBLK * D * 2, SHM_K = KVBLK * D * 2;
constexpr int LDS_BYTES = 2 * SHM_V + 2 * SHM_K + NW * 64 * 4;
using bf16 = __hip_bfloat16;
typedef short bf16x8 __attribute__((ext_vector_type(8)));
typedef short s16x4 __attribute__((ext_vector_type(4)));
typedef float f32x16 __attribute__((ext_vector_type(16)));
typedef float f32x4 __attribute__((ext_vector_type(4)));
typedef unsigned u32x4 __attribute__((ext_vector_type(4)));
template <class A, class Bt> struct same_t { static constexpr bool v = false; };
template <class A> struct same_t<A, A> { static constexpr bool v = true; };

#define KSWZ(row, colB) ((row) * 256 + ((colB) ^ (((row) & 7) << 4)))
#define SBAR() __builtin_amdgcn_sched_barrier(0)
__device__ __forceinline__ int v_st(int k, int c) { const int kk = (k & ~0xC) | ((k & 4) << 1) | ((k & 8) >> 1); return ((kk >> 3) * 4 + (c >> 5)) * 512 + ((kk & 7) * 32 + (c & 31)) * 2; }
__device__ __forceinline__ int v_rd_base(int lane) { return ((lane & 3) << 3) | (((lane >> 2) & 3) << 6) | (((lane >> 4) & 1) << 5) | (((lane >> 5) & 1) << 8); }
constexpr int v_rd_off(int d0, int ks, int half) { return d0 * 512 + ks * 4096 + half * 2048; }
__device__ __forceinline__ int crow(int r, int hi) { return (r & 3) + 8 * (r >> 2) + 4 * hi; }
__device__ __forceinline__ unsigned cvtpk(float lo, float hi) {
    unsigned r; asm volatile("v_cvt_pk_bf16_f32 %0, %1, %2" : "=v"(r) : "v"(lo), "v"(hi)); return r;
}
__device__ __forceinline__ bf16x8 pack8(f32x4 a, f32x4 b) {
    u32x4 w = {cvtpk(a[0], a[1]), cvtpk(a[2], a[3]), cvtpk(b[0], b[1]), cvtpk(b[2], b[3])};
    return *reinterpret_cast<bf16x8*>(&w);
}
template <class T> __device__ __forceinline__ bf16x8 load8(const T* p) {
    if constexpr (same_t<T, float>::v) { return pack8(*(const f32x4*)p, *(const f32x4*)(p + 4)); }
    else { return *reinterpret_cast<const bf16x8*>(p); }
}
__device__ __forceinline__ void mask_tile(f32x16& p0, f32x16& p1, int dq, unsigned W) {
    const float NEG = -__builtin_inff();
#pragma unroll
    for (int r = 0; r < 16; ++r) {
        const int c = (r & 3) + 8 * (r >> 2);
        if ((unsigned)(dq - c) >= W) p0[r] = NEG;
        if ((unsigned)(dq - c - 32) >= W) p1[r] = NEG;
    }
}
__device__ __forceinline__ void partialSM(f32x16& p0, f32x16& p1, float& m_reg, float& mn, float& alpha) {
    float pmax = p0[0]; for (int r = 1; r < 16; ++r) pmax = fmaxf(pmax, p0[r]); for (int r = 0; r < 16; ++r) pmax = fmaxf(pmax, p1[r]);
    { auto rr = __builtin_amdgcn_permlane32_swap(__float_as_uint(pmax), __float_as_uint(pmax), false, false);
      pmax = fmaxf(__uint_as_float(rr[0]), __uint_as_float(rr[1])); }
    constexpr float C2 = 1.4426950408889634f * SCALE;
    if (__builtin_expect(__all((pmax - m_reg) * SCALE <= THR), 1)) { mn = m_reg; alpha = 1.f; }
    else { mn = fmaxf(m_reg, pmax); alpha = __builtin_amdgcn_exp2f((m_reg - mn) * C2); m_reg = mn; }
    const float mnL = -mn * C2;
    for (int r = 0; r < 16; ++r) p0[r] = fmaf(p0[r], C2, mnL); for (int r = 0; r < 16; ++r) p1[r] = fmaf(p1[r], C2, mnL);
    for (int r = 0; r < 16; ++r) p0[r] = __builtin_amdgcn_exp2f(p0[r]);
}
__device__ __forceinline__ void finishSM(f32x16& p0, f32x16& p1, float alpha, float& l_reg, bf16x8& pa0, bf16x8& pa1, bf16x8& pa2, bf16x8& pa3) {
    for (int r = 0; r < 16; ++r) p1[r] = __builtin_amdgcn_exp2f(p1[r]);
    float ps = 0; for (int r = 0; r < 16; ++r) ps += p0[r]; for (int r = 0; r < 16; ++r) ps += p1[r];
    { auto rr = __builtin_amdgcn_permlane32_swap(__float_as_uint(ps), __float_as_uint(ps), false, false);
      ps = __uint_as_float(rr[0]) + __uint_as_float(rr[1]); }
    l_reg = l_reg * alpha + ps;
#define PK4(P, B_, OUT) do { unsigned a0 = cvtpk(P[B_+0], P[B_+1]), a1 = cvtpk(P[B_+2], P[B_+3]);                          \
        unsigned b0 = cvtpk(P[B_+4], P[B_+5]), b1 = cvtpk(P[B_+6], P[B_+7]);                                             \
        auto r0 = __builtin_amdgcn_permlane32_swap(a0, b0, false, false); auto r1 = __builtin_amdgcn_permlane32_swap(a1, b1, false, false); \
        u32x4 w = {r0[0], r1[0], r0[1], r1[1]}; OUT = *reinterpret_cast<bf16x8*>(&w); } while (0)
    PK4(p0, 0, pa0); PK4(p0, 8, pa1); PK4(p1, 0, pa2); PK4(p1, 8, pa3);
#undef PK4
}
template <int KB, bool SK>
__device__ __forceinline__ void qkt(f32x16& p0, f32x16& p1, const char* K_lds, int r32, int hi, const bf16x8* qr, bool act) {
    if (SK && !act) { const float NEG = -__builtin_inff();
#pragma unroll
        for (int r = 0; r < 16; ++r) { p0[r] = NEG; p1[r] = NEG; } return; }
    p0 = f32x16{}; p1 = f32x16{};
    const char* kb[4];
#pragma unroll
    for (int dd = 0; dd < 4; ++dd) kb[dd] = K_lds + KB * SHM_K + KSWZ(r32, (dd * 16 + hi * 8) * 2);
#pragma unroll
    for (int d0 = 0; d0 < 8; ++d0) { const char* a = kb[d0 & 3] + (d0 >> 2) * 128;
        bf16x8 b0 = *reinterpret_cast<const bf16x8*>(a);
        bf16x8 b1 = *reinterpret_cast<const bf16x8*>(a + 32 * 256);
        p0 = __builtin_amdgcn_mfma_f32_32x32x16_bf16(b0, qr[d0], p0, 0, 0, 0);
        p1 = __builtin_amdgcn_mfma_f32_32x32x16_bf16(b1, qr[d0], p1, 0, 0, 0); }
}
template <int VB, bool SK>
__device__ __forceinline__ void pv_tile(f32x16* o, int vb0, bf16x8 pa0, bf16x8 pa1, bf16x8 pa2, bf16x8 pa3, bool act) {
    if (SK && !act) return;
#define TRRD(dst, off) asm volatile("ds_read_b64_tr_b16 %0, %1 offset:%2" : "=&v"(dst) : "v"(vb0), "i"(off) : "memory")
#define PV_D0(d0) do { s16x4 l0, l1, l2, l3, h0, h1, h2, h3; constexpr int b_ = VB * SHM_V + v_rd_off(d0, 0, 0);     \
        TRRD(l0, b_); TRRD(h0, b_ + 2048); TRRD(l1, b_ + 4096); TRRD(h1, b_ + 6144); TRRD(l2, b_ + 8192); TRRD(h2, b_ + 10240); TRRD(l3, b_ + 12288); TRRD(h3, b_ + 14336); \
        asm volatile("s_waitcnt lgkmcnt(0)" ::: "memory"); SBAR();                 \
        o[d0] = __builtin_amdgcn_mfma_f32_32x32x16_bf16(pa0, (bf16x8){l0[0], l0[1], l0[2], l0[3], h0[0], h0[1], h0[2], h0[3]}, o[d0], 0, 0, 0);   \
        o[d0] = __builtin_amdgcn_mfma_f32_32x32x16_bf16(pa1, (bf16x8){l1[0], l1[1], l1[2], l1[3], h1[0], h1[1], h1[2], h1[3]}, o[d0], 0, 0, 0);   \
        o[d0] = __builtin_amdgcn_mfma_f32_32x32x16_bf16(pa2, (bf16x8){l2[0], l2[1], l2[2], l2[3], h2[0], h2[1], h2[2], h2[3]}, o[d0], 0, 0, 0);   \
        o[d0] = __builtin_amdgcn_mfma_f32_32x32x16_bf16(pa3, (bf16x8){l3[0], l3[1], l3[2], l3[3], h3[0], h3[1], h3[2], h3[3]}, o[d0], 0, 0, 0); } while (0)
    PV_D0(0); PV_D0(1); PV_D0(2); PV_D0(3);
#undef PV_D0
#undef TRRD
}

template <class TIn, class TOut> struct BlockRef { const TIn* Q; const TIn* K; const TIn* V; TOut* O; float* LSE; int P0; int rs; int ls; };
template <class TIn> struct Seam {
    bf16x8 qr[8];
    bf16x8 st_v0, st_v1, st_k0, st_k1; f32x4 sf0, sf1, sf2, sf3;
    f32x4 tq[16];
};
__device__ __forceinline__ int swa_jlo(int P0, int W) { const int lowk = P0 - W + 1; return lowk > 0 ? lowk / KVBLK : 0; }
#define ROW(p, k0, rr, rs_) ((p) + (size_t)((k0) + (rr)) * (size_t)(rs_) + sc)
#define VMW() asm volatile("s_waitcnt vmcnt(0)" ::: "memory")
#define VMWN(n) asm volatile("s_waitcnt vmcnt(%0)" :: "i"(n) : "memory")
#define SLOAD_H(Kp, Vp, k0, rs_) do { S.st_v0 = load8<TIn>(ROW(Vp, k0, sr, rs_)); S.st_v1 = load8<TIn>(ROW(Vp, k0, 32 + sr, rs_));              \
                         S.st_k0 = load8<TIn>(ROW(Kp, k0, sr, rs_)); S.st_k1 = load8<TIn>(ROW(Kp, k0, 32 + sr, rs_)); } while (0)
#define SWRITE_HK(bf) do { *(bf16x8*)(K_lds + (bf) * SHM_K + kws) = S.st_k0; *(bf16x8*)(K_lds + (bf) * SHM_K + kws + 32 * 256) = S.st_k1; } while (0)
#define SWRITE_HV(bf) do { *(bf16x8*)(V_lds + (bf) * SHM_V + vst0) = S.st_v0; *(bf16x8*)(V_lds + (bf) * SHM_V + vst1) = S.st_v1; } while (0)
#define SWRITE_H(bf) do { SWRITE_HV(bf); SWRITE_HK(bf); } while (0)
#define SLOAD_F(p, k0) do { } while (0)
#define SWRITE_KF(bf) do { *(bf16x8*)(K_lds + (bf) * SHM_K + kws) = pack8(S.sf0, S.sf1); *(bf16x8*)(K_lds + (bf) * SHM_K + kws + 32 * 256) = pack8(S.sf2, S.sf3); } while (0)
#define SWRITE_VF(bf) do { *(bf16x8*)(V_lds + (bf) * SHM_V + vst0) = pack8(S.sf0, S.sf1); *(bf16x8*)(V_lds + (bf) * SHM_V + vst1) = pack8(S.sf2, S.sf3); } while (0)
template <class TIn, class TOut>
__device__ __forceinline__ void causal_swa_prime(const BlockRef<TIn, TOut>& cur, int W, char* lds, Seam<TIn>& S) {
    constexpr bool F32 = same_t<TIn, float>::v;
    const int tid = tid_opaque(), wid = __builtin_amdgcn_readfirstlane(tid >> 6), lane = tid & 63, r32 = lane & 31, hi = lane >> 5;
    const int sr = tid >> 4, sc = (tid & 15) * 8, kws = KSWZ(sr, sc * 2); char* K_lds = lds + 2 * SHM_V;
    const int kb0 = swa_jlo(cur.P0, W) * KVBLK;
    for (int d0 = 0; d0 < 8; ++d0) S.qr[d0] = load8<TIn>(cur.Q + (size_t)(wid * QBLK + r32) * (size_t)cur.rs + d0 * 16 + hi * 8);
    if constexpr (F32) { SLOAD_F((const float*)cur.K, kb0); VMW(); SWRITE_KF(0); SBAR(); SLOAD_F((const float*)cur.V, kb0); }
    else { SLOAD_H(cur.K, cur.V, kb0, cur.rs); VMW(); SWRITE_HK(0); }
    __syncthreads();
}
template <class TIn, class TOut>
__device__ __forceinline__ void causal_swa_block(const BlockRef<TIn, TOut>& cur, const BlockRef<TIn, TOut>& nxt, int skv, int W, char* lds, Seam<TIn>& S) {
    constexpr bool F32 = same_t<TIn, float>::v;
    const int tid = tid_opaque(), wid = __builtin_amdgcn_readfirstlane(tid >> 6), lane = tid & 63, r32 = lane & 31, hi = lane >> 5;
    const int j_lo = swa_jlo(cur.P0, W);
    int j_hi = (cur.P0 + QB - 1) / KVBLK + 1; if (j_hi > skv / KVBLK) j_hi = skv / KVBLK;
    const int NT = j_hi - j_lo;
    const int kbn = swa_jlo(nxt.P0, W) * KVBLK;
    const int qlo = cur.P0 + wid * QBLK, qm = qlo + r32 - 4 * hi;
    char* V_lds = lds; char* K_lds = lds + 2 * SHM_V;
    float* ws = (float*)(lds + 2 * SHM_V + 2 * SHM_K) + wid * 64; float* li_l = ws, * al_l = ws + 32;
    float m_reg = -1e30f, l_reg = 0; f32x16 o[4] = {};
    const int sr = tid >> 4, sc = (tid & 15) * 8, vst0 = v_st(sr, sc), vst1 = v_st(32 + sr, sc), kws = KSWZ(sr, sc * 2);
    const int vb0 = (int)(uintptr_t)V_lds + v_rd_base(lane);
    const TIn* Kh = cur.K; const TIn* Vh = cur.V;
#define RESC(a) do { if (__any((a) < 1.f)) { if (hi == 0) al_l[r32] = (a); asm volatile("s_waitcnt lgkmcnt(0)" ::: "memory");              \
                     for (int d_ = 0; d_ < 4; ++d_) for (int r = 0; r < 16; ++r) o[d_][r] *= al_l[crow(r, hi)]; } } while (0)
#define KBASE(t) ((j_lo + (t)) * KVBLK)
#define ACT(t) (KBASE(t) <= qlo + QBLK - 1 && KBASE(t) + KVBLK - 1 >= qlo - W + 1)
#define MASKT(P0_, P1_, t) do { const int kb_ = KBASE(t); if ((!SK || ACT(t)) && (kb_ + KVBLK - 1 > qlo || kb_ <= qlo + QBLK - 1 - W)) mask_tile(P0_, P1_, qm - kb_, (unsigned)W); } while (0)
    constexpr int NQL = F32 ? 16 : 8;
    constexpr bool SK = WSKIP && !F32;
#define SEAM_K0() do { VMWN(NQL); if constexpr (F32) { SWRITE_KF(0); SBAR(); SLOAD_F((const float*)nxt.V, kbn); } else { SWRITE_HK(0); } SBAR(); } while (0)
    f32x16 pA0, pA1, pB0, pB1; float mnA, mnB, alA, alB; bf16x8 pa0, pa1, pa2, pa3;
    if constexpr (F32) { VMW(); SWRITE_VF(0); SBAR(); } else { SWRITE_HV(0); SBAR(); }
    if (NT > 1) { if constexpr (F32) SLOAD_F((const float*)Kh, KBASE(1)); else SLOAD_H(Kh, Vh, KBASE(1), cur.rs); }
    SBAR(); qkt<0, SK>(pA0, pA1, K_lds, r32, hi, S.qr, ACT(0));
    if constexpr (F32) { if (NT > 1) { VMW(); SWRITE_KF(1); SBAR(); SLOAD_F((const float*)Vh, KBASE(1)); } }
    MASKT(pA0, pA1, 0); partialSM(pA0, pA1, m_reg, mnA, alA);
    if (NT > 1) { VMW(); if constexpr (F32) { SWRITE_VF(1); SBAR(); if (NT > 2) SLOAD_F((const float*)Kh, KBASE(2)); } else SWRITE_H(1); }
    __syncthreads();
#define HALF_STEP(PX0, PX1, mnX, alX, PY0, PY1, alY, t, KB, VB, SB) do {                                                      \
        SBAR(); qkt<KB, SK>(PX0, PX1, K_lds, r32, hi, S.qr, ACT(t));                                             \
        finishSM(PY0, PY1, alY, l_reg, pa0, pa1, pa2, pa3); SBAR();                                                           \
        if ((t) + 1 < NT) { if constexpr (F32) { VMW(); SWRITE_KF(SB); SBAR(); SLOAD_F((const float*)Vh, KBASE((t) + 1)); }  \
                            else { SLOAD_H(Kh, Vh, KBASE((t) + 1), cur.rs); } SBAR(); }                                               \
        pv_tile<VB, SK>(o, vb0, pa0, pa1, pa2, pa3, ACT((t) - 1)); MASKT(PX0, PX1, (t)); partialSM(PX0, PX1, m_reg, mnX, alX);                                        \
        __syncthreads();                                                                                                      \
        if ((t) + 1 < NT) { VMW(); if constexpr (F32) { SWRITE_VF(SB); SBAR(); if ((t) + 2 < NT) SLOAD_F((const float*)Kh, KBASE((t) + 2)); } \
                            else { SWRITE_H(SB); } }                                                                          \
        RESC(alX); __syncthreads(); } while (0)
    for (int t = 1; t + 1 < NT; t += 2) {
        HALF_STEP(pB0, pB1, mnB, alB, pA0, pA1, alA, t, 1, 0, 0);
        HALF_STEP(pA0, pA1, mnA, alA, pB0, pB1, alB, t + 1, 0, 1, 1);
    }
    const bool even = (NT & 1) == 0;
    if (even) { SBAR(); qkt<1, SK>(pB0, pB1, K_lds, r32, hi, S.qr, ACT(NT - 1)); SBAR(); }
#define QROW(e) (nxt.Q + (size_t)(wid * QBLK + r32) * (size_t)nxt.rs + ((e) >> 1) * 16 + hi * 8 + ((e) & 1) * 4)
    if constexpr (F32) { SLOAD_F((const float*)nxt.K, kbn); SBAR();
#pragma unroll
        for (int e = 0; e < 8; ++e) S.tq[e] = *(const f32x4*)QROW(e); }
    else { SLOAD_H(nxt.K, nxt.V, kbn, nxt.rs); SBAR();
#pragma unroll
        for (int d0 = 0; d0 < 8; ++d0) S.qr[d0] = load8<TIn>(nxt.Q + (size_t)(wid * QBLK + r32) * (size_t)nxt.rs + d0 * 16 + hi * 8); }
    SBAR();
    finishSM(pA0, pA1, alA, l_reg, pa0, pa1, pa2, pa3); SBAR();
    if constexpr (F32) {
#pragma unroll
        for (int e = 8; e < 16; ++e) S.tq[e] = *(const f32x4*)QROW(e); SBAR(); }
#undef QROW
    pv_tile<0, SK>(o, vb0, pa0, pa1, pa2, pa3, ACT(even ? NT - 2 : NT - 1));
    if (even) { MASKT(pB0, pB1, NT - 1); partialSM(pB0, pB1, m_reg, mnB, alB); __syncthreads(); RESC(alB);
        finishSM(pB0, pB1, alB, l_reg, pa0, pa1, pa2, pa3); SBAR(); pv_tile<1, SK>(o, vb0, pa0, pa1, pa2, pa3, ACT(NT - 1)); }
    SBAR(); SEAM_K0();
    if (hi == 0) li_l[r32] = l_reg; asm volatile("s_waitcnt lgkmcnt(0)" ::: "memory");
    float rli[16];
#pragma unroll
    for (int r = 0; r < 16; ++r) rli[r] = __builtin_amdgcn_rcpf(li_l[crow(r, hi)]);
    TOut* Ow = cur.O + (size_t)(wid * QBLK) * (size_t)cur.rs;
    if (hi == 0) cur.LSE[(size_t)(wid * QBLK + r32) * (size_t)cur.ls] = m_reg * SCALE + __logf(l_reg);
#pragma unroll
    for (int r = 0; r < 16; ++r) { const int orow = crow(r, hi);
#pragma unroll
        for (int d0 = 0; d0 < 4; ++d0) { const float v = o[d0][r] * rli[r];
            if constexpr (same_t<TOut, float>::v) { Ow[(size_t)orow * (size_t)cur.rs + d0 * 32 + r32] = v; }
            else { const float vn = __shfl_xor(v, 1);
                   if ((r32 & 1) == 0) *(unsigned*)(Ow + (size_t)orow * (size_t)cur.rs + d0 * 32 + r32) = cvtpk(v, vn); } } }
    if constexpr (F32) {
#pragma unroll
        for (int d0 = 0; d0 < 8; ++d0) S.qr[d0] = pack8(S.tq[2 * d0], S.tq[2 * d0 + 1]); }
    __syncthreads();
#undef RESC
#undef KBASE
#undef ACT
#undef MASKT
#undef SEAM_K0
#undef HALF_STEP
}
#undef ROW
#undef VMW
#undef VMWN
#undef SLOAD_H
#undef SWRITE_HK
#undef SWRITE_HV
#undef SWRITE_H
#undef SLOAD_F
#undef SWRITE_KF
#undef SWRITE_VF

#undef SBAR
}
#define GAS __attribute__((address_space(1)))
#define LAS __attribute__((address_space(3)))
typedef unsigned short bf16;
typedef unsigned v4u __attribute__((ext_vector_type(4)));
typedef float f32x4 __attribute__((ext_vector_type(4)));
typedef short bf16x8 __attribute__((ext_vector_type(8)));
typedef GAS unsigned gu32;
typedef GAS unsigned long long gu64;
#define RLX_AGENT __ATOMIC_RELAXED, __HIP_MEMORY_SCOPE_AGENT
#define LDS_WAIT() asm volatile("s_waitcnt lgkmcnt(0)" ::: "memory")
#define VM_WAIT() asm volatile("s_waitcnt vmcnt(0)" ::: "memory")
__device__ __forceinline__ unsigned long long rt() { return __builtin_amdgcn_s_memrealtime(); }
__device__ __forceinline__ unsigned f2bf(float f) { unsigned u = __builtin_bit_cast(unsigned, f); return (u + 0x7fffu + ((u >> 16) & 1u)) >> 16; }
__device__ __forceinline__ unsigned pk2(float lo, float hi) { return f2bf(lo) | (f2bf(hi) << 16); }

#define XB_TMO      128
#define XB_XCNT(j)  (256  + 64 * (j))
#define XB_XSUB(j)  (1280 + 64 * (j))
#define XB_XGEN(j)  (2304 + 64 * (j))
#define XB_TOP      3328
#define XB_TOPGEN   3392
#define XCD_BAR_WORDS 3456
#define XB_SPIN_CAP (1u << 18)

__device__ __forceinline__ unsigned xb_ld(unsigned* p)              { return __hip_atomic_load(p, __ATOMIC_RELAXED, __HIP_MEMORY_SCOPE_AGENT); }
__device__ __forceinline__ unsigned xb_add(unsigned* p, unsigned v) { return __hip_atomic_fetch_add(p, v, __ATOMIC_RELAXED, __HIP_MEMORY_SCOPE_AGENT); }
__device__ __forceinline__ unsigned xb_xcc_id() { return (unsigned)__builtin_amdgcn_s_getreg((3 << 11) | 20) & 0xFu; }
#define XB_SPIN(cond, bar) do { unsigned _sp = 0; while (cond) { __builtin_amdgcn_s_sleep(1); \
    if ((++_sp & 255u) == 0u) { if (xb_ld(&(bar)[XB_TMO])) break; if (_sp > XB_SPIN_CAP) { atomicAdd(&(bar)[XB_TMO], 1u); break; } } } } while (0)

struct XcdBarrier {
    unsigned* bar; unsigned x;
    volatile LAS unsigned* st;
};

__device__ __forceinline__ XcdBarrier xcd_barrier_post(unsigned* bar, volatile LAS unsigned* st) {
    XcdBarrier b; b.bar = bar; b.x = xb_xcc_id(); b.st = st;
    if (threadIdx.x == 0) (void)xb_add(&bar[XB_XCNT(b.x)], 1u);
    return b;
}
__device__ __forceinline__ void xcd_barrier_complete(unsigned* bar, unsigned x, unsigned& nloc, unsigned& nx) {
    const unsigned G = gridDim.x * gridDim.y * gridDim.z;
    unsigned sum, cnt, mine, sp = 0u;
    for (;;) {
        sum = 0u; cnt = 0u; mine = 0u;
#pragma unroll
        for (unsigned j = 0; j < 16; ++j) { const unsigned c = xb_ld(&bar[XB_XCNT(j)]); sum += c; cnt += (c > 0u) ? 1u : 0u; mine = (j == x) ? c : mine; }
        if (sum == G) break;
        __builtin_amdgcn_s_sleep(1);
        if ((++sp & 255u) == 0u) { if (xb_ld(&bar[XB_TMO])) break; if (sp > XB_SPIN_CAP) { atomicAdd(&bar[XB_TMO], 1u); break; } }
    }
    nloc = mine > 0u ? mine : 1u; nx = cnt > 0u ? cnt : 1u;
}

__device__ __forceinline__ void xcd_barrier(const XcdBarrier& b) {
    asm volatile("s_waitcnt vmcnt(0)" ::: "memory");
    __syncthreads();
    if (threadIdx.x == 0) {
        unsigned* bar = b.bar;
        __builtin_amdgcn_s_waitcnt(0);
        unsigned nloc = b.st[0], nx = b.st[1];
        if (nloc == 0u) { xcd_barrier_complete(bar, b.x, nloc, nx); b.st[0] = nloc; b.st[1] = nx; }
        const unsigned old = xb_add(&bar[XB_XSUB(b.x)], 1u);
        const unsigned gen = old / nloc;
        if (old + 1u == (gen + 1u) * nloc) {
            __builtin_amdgcn_fence(__ATOMIC_RELEASE, "agent");
            asm volatile("s_waitcnt vmcnt(0)" ::: "memory");
            const unsigned og = xb_add(&bar[XB_TOP], 1u);
            const unsigned tg = og / nx;
            if (og + 1u == (tg + 1u) * nx) xb_add(&bar[XB_TOPGEN], 1u);
            else XB_SPIN(xb_ld(&bar[XB_TOPGEN]) == tg, bar);
            __builtin_amdgcn_fence(__ATOMIC_ACQUIRE, "agent");
            xb_add(&bar[XB_XGEN(b.x)], 1u);
            asm volatile("s_waitcnt vmcnt(0)" ::: "memory");
        } else {
            XB_SPIN(xb_ld(&bar[XB_XGEN(b.x)]) == gen, bar);
            __builtin_amdgcn_fence(__ATOMIC_ACQUIRE, "agent");
            asm volatile("s_waitcnt vmcnt(0)" ::: "memory");
        }
    }
    __syncthreads();
}

constexpr int NWAVES = 8;

constexpr size_t MiB = 1u << 20, HMiB = 1u << 19;
constexpr size_t WS_CTL = 0, CTL_ZERO_BYTES = 64 * 1024;
constexpr size_t WS_MOD = 1 * MiB;
constexpr size_t WS_AVEC = WS_MOD + 80 * 1024;
constexpr size_t WS_BIAS_IN = WS_MOD + 96 * 1024;
constexpr size_t WS_BIAS_F2 = WS_MOD + 176 * 1024;
constexpr size_t WS_PS2 = WS_MOD + 256 * 1024, WS_PS3 = WS_MOD + 512 * 1024;
constexpr size_t WS_WGU1 = 2 * MiB;
constexpr size_t WS_WD1 = WS_WGU1 + 11 * MiB;
constexpr size_t WS_WIN = WS_WD1 + 11 * HMiB;
constexpr size_t WS_WA = WS_WIN + 19 * MiB;
constexpr size_t WS_WC = WS_WA + 1 * MiB;
constexpr size_t WS_WO = WS_WC + 2 * MiB;
constexpr size_t WS_WGU2 = WS_WO + 2 * MiB;
constexpr size_t WS_WD2 = WS_WGU2 + 11 * MiB;
constexpr size_t WS_XS = WS_WD2 + 11 * HMiB;
constexpr size_t WS_R = WS_XS + 32 * MiB;
constexpr size_t WS_ACT = WS_R;
constexpr size_t WS_Q = WS_R, WS_K = WS_R + 48 * MiB, WS_V = WS_R + 96 * MiB;
constexpr size_t WS_LSE = WS_R + 144 * MiB;
constexpr size_t WS_O = WS_R + 145 * MiB;
constexpr size_t WS_U = WS_R + 48 * MiB, WS_B = WS_R + 80 * MiB, WS_C = WS_R + 112 * MiB;
constexpr size_t WS_SGA = WS_R, WS_SGC = WS_R + 48 * MiB;
constexpr size_t WS_END = WS_O + 16 * MiB;
static_assert(WS_XS == 59 * MiB && WS_END <= 256 * MiB, "d_ws map");
constexpr int CW_BAR = 4096;

constexpr int RING_OFF = 0, RING_BYTES = 131072;
constexpr int LDSCTL_OFF = RING_BYTES, MISC_OFF = LDSCTL_OFF + 320, XL_OFF = RING_BYTES + 1024;
constexpr int LDS_BYTES = 151552;


struct Args { const float* in[20]; float* out; unsigned char* ws; int ph_lo, ph_hi; };
struct Frame {
    LAS unsigned char* lds;
    volatile LAS unsigned* MISC;
    gu32* ctl;
    int tid, lane, wave;
    int vcu, G;
    float* out; unsigned char* ws;
};
enum { I_X = 0, I_C, I_WADA, I_BADA, I_NF1, I_F1G, I_F1U, I_F1D, I_NMIX, I_WIN, I_QN, I_KN, I_CONVW, I_WAB, I_WCB, I_WOUT, I_NF2, I_F2G, I_F2U, I_F2D };
enum { MOD_SH1 = 0, MOD_SC1 = 1024, MOD_GT1 = 2048, MOD_SH2 = 3072, MOD_SC2 = 4096, MOD_GT2 = 5120, MOD_SH3 = 6144, MOD_SC3 = 7168, MOD_GT3 = 8192 };

__device__ __forceinline__ float silu_f(float x) { return x * __builtin_amdgcn_rcpf(1.0f + __builtin_amdgcn_exp2f(-1.4426950408889634f * x)); }
__device__ __forceinline__ float wave_sum(float v) {
#pragma unroll
    for (int o = 1; o < 64; o <<= 1) v += __shfl_xor(v, o);
    return v;
}
__device__ __forceinline__ float blo(unsigned w) { return __uint_as_float(w << 16); }
__device__ __forceinline__ float bhi(unsigned w) { return __uint_as_float(w & 0xffff0000u); }

constexpr int ADA_ITEMS = NMOD / 64;
__device__ __forceinline__ void p0_adaln_item(Frame& F, const Args& args, int item) {
    LAS float* sc = (LAS float*)(F.lds + RING_OFF);
    LAS float* red = sc + 2048;
    const float* c = args.in[I_C]; const float* wada = args.in[I_WADA]; const float* bada = args.in[I_BADA];
    for (int i = F.tid; i < 2 * DM; i += NWAVES * 64) sc[i] = silu_f(c[i]);
    __syncthreads();
    const int j0 = item * 64, cg = F.lane & 15, rs = F.lane >> 4;
    f32x4 a0 = {0.f, 0.f, 0.f, 0.f}, a1 = {0.f, 0.f, 0.f, 0.f};
    const GAS f32x4* wp = (const GAS f32x4*)(wada + (size_t)(F.wave * 128 + rs) * NMOD + j0 + 4 * cg);
#pragma unroll 16
    for (int it = 0; it < 32; ++it) { const int k = F.wave * 128 + 4 * it + rs; const f32x4 w = wp[(size_t)it * 4 * (NMOD / 4)];
        a0 = a0 + w * sc[k]; a1 = a1 + w * sc[DM + k]; }
#pragma unroll
    for (int i = 0; i < 4; ++i) { a0[i] += __shfl_xor(a0[i], 16); a0[i] += __shfl_xor(a0[i], 32); a1[i] += __shfl_xor(a1[i], 16); a1[i] += __shfl_xor(a1[i], 32); }
    if (F.lane < 16) {
#pragma unroll
        for (int i = 0; i < 4; ++i) { red[(F.wave * 2 + 0) * 64 + 4 * cg + i] = a0[i]; red[(F.wave * 2 + 1) * 64 + 4 * cg + i] = a1[i]; } }
    __syncthreads();
    if (F.tid < 128) { const int b = F.tid >> 6, j = F.tid & 63; float s = bada[j0 + j];
#pragma unroll
        for (int w = 0; w < NWAVES; ++w) s += red[(w * 2 + b) * 64 + j];
        ((float*)(F.ws + WS_MOD))[b * NMOD + j0 + j] = s; }
    __syncthreads();
}
__device__ __forceinline__ void p0_transpose_item(const float* W, int K, int N, bf16* WT, int rmode, LAS float* scr, int item, int lane) {
    const int nblk = N / 32, kb = item / nblk, nb = item % nblk, k0 = 64 * kb, n0 = 32 * nb;
    const int r0 = rmode == 0 ? n0 : 256 * (n0 >> 7) + 128 * (rmode - 1) + (n0 & 127);
#pragma unroll 8
    for (int i = 0; i < 32; ++i) { const int kk = 2 * i + (lane >> 5); scr[kk * 33 + (lane & 31)] = W[(size_t)(k0 + kk) * N + n0 + (lane & 31)]; }
    LDS_WAIT(); asm volatile("" ::: "memory");
    const int c = lane & 7;
#pragma unroll
    for (int j = 0; j < 4; ++j) { const int n = (lane >> 3) + 8 * j; const LAS float* s = scr + (8 * c) * 33 + n;
        v4u o; o.x = pk2(s[0 * 33], s[1 * 33]); o.y = pk2(s[2 * 33], s[3 * 33]); o.z = pk2(s[4 * 33], s[5 * 33]); o.w = pk2(s[6 * 33], s[7 * 33]);
        *(GAS v4u*)(WT + (size_t)(r0 + n) * K + k0 + 8 * c) = o; }
    LDS_WAIT(); asm volatile("" ::: "memory");
}
__device__ __forceinline__ void p0_transposes(Frame& F, const Args& args, int set, int gw, int NGW) {
    LAS float* scr = (LAS float*)(F.lds + RING_OFF + F.wave * 16384);
    int base = 0;
#define TR_JOB(SRC, K_, N_, RMODE, DST) do { const int n_it = ((K_) / 64) * ((N_) / 32); int it = gw - (base % NGW); if (it < 0) it += NGW;     \
        const float* W_ = args.in[SRC]; bf16* WT_ = (bf16*)(F.ws + (DST)); \
        for (; it < n_it; it += NGW) p0_transpose_item(W_, (K_), (N_), WT_, (RMODE), scr, it, F.lane); base += n_it; } while (0)
    if (set == 0) { TR_JOB(I_F1G, DM, DFF, 1, WS_WGU1); TR_JOB(I_F1U, DM, DFF, 2, WS_WGU1); TR_JOB(I_F1D, DFF, DM, 0, WS_WD1); }
    else if (set == 1) { TR_JOB(I_WIN, DM, INW, 0, WS_WIN); TR_JOB(I_WAB, 512, DM, 0, WS_WA); TR_JOB(I_WCB, DM, DM, 0, WS_WC); TR_JOB(I_WOUT, DM, DM, 0, WS_WO); }
    else { TR_JOB(I_F2G, DM, DFF, 1, WS_WGU2); TR_JOB(I_F2U, DM, DFF, 2, WS_WGU2); TR_JOB(I_F2D, DFF, DM, 0, WS_WD2); }
#undef TR_JOB
}
__device__ __forceinline__ void norm_pass(Frame& F, const float* X, const float* g, int mod_sh, int mod_sc) {
    const int gw = F.vcu * NWAVES + F.wave, NGW = F.G * NWAVES;
    const float* mod = (const float*)(F.ws + WS_MOD); bf16* XS = (bf16*)(F.ws + WS_XS);
    for (int r0 = gw * 8; r0 < M; r0 += NGW * 8) {
        const int b = r0 / SEQ;
        f32x4 a[4], s[4];
#pragma unroll
        for (int j = 0; j < 4; ++j) { const int c = 4 * F.lane + 256 * j;
            a[j] = *(const f32x4*)(g + c) * (*(const f32x4*)(mod + b * NMOD + mod_sc + c) + 1.0f); s[j] = *(const f32x4*)(mod + b * NMOD + mod_sh + c); }
#pragma unroll 4
        for (int r = 0; r < 8; ++r) {
            const GAS f32x4* xr = (const GAS f32x4*)(X + (size_t)(r0 + r) * DM) + F.lane;
            f32x4 v[4]; float ss = 0.f;
#pragma unroll
            for (int j = 0; j < 4; ++j) { v[j] = xr[64 * j]; ss += (v[j].x * v[j].x + v[j].y * v[j].y) + (v[j].z * v[j].z + v[j].w * v[j].w); }
            const float rstd = 1.0f / sqrtf(wave_sum(ss) * (1.f / DM) + EPS);
            GAS unsigned long long* o8 = (GAS unsigned long long*)(XS + (size_t)(r0 + r) * DM) + F.lane;
#pragma unroll
            for (int j = 0; j < 4; ++j) { const f32x4 y = v[j] * rstd * a[j] + s[j];
                o8[64 * j] = (unsigned long long)pk2(y.x, y.y) | ((unsigned long long)pk2(y.z, y.w) << 32); }
        }
    }
}
__device__ __forceinline__ void qknorm_pass(Frame& F, const Args& args) {
    const int gw = F.vcu * NWAVES + F.wave, NGW = F.G * NWAVES;
    const float* gq_ = args.in[I_QN]; const float* gk_ = args.in[I_KN];
    for (int it = gw; it < 2 * M; it += NGW) {
        const int which = it >= M, row = which ? it - M : it;
        bf16* buf = (bf16*)(F.ws + (which ? WS_K : WS_Q)) + (size_t)row * AW; const float* gm = (which ? gk_ : gq_) + 8 * (F.lane & 15);
        const f32x4 g0 = *(const f32x4*)gm, g1 = *(const f32x4*)(gm + 4);
#pragma unroll
        for (int j = 0; j < 3; ++j) { GAS v4u* p = (GAS v4u*)(buf + 512 * j + 8 * F.lane); const v4u w = *p;
            f32x4 v0 = {blo(w.x), bhi(w.x), blo(w.y), bhi(w.y)}, v1 = {blo(w.z), bhi(w.z), blo(w.w), bhi(w.w)};
            float ss = (v0.x * v0.x + v0.y * v0.y) + (v0.z * v0.z + v0.w * v0.w) + (v1.x * v1.x + v1.y * v1.y) + (v1.z * v1.z + v1.w * v1.w);
            ss += __shfl_xor(ss, 1); ss += __shfl_xor(ss, 2); ss += __shfl_xor(ss, 4); ss += __shfl_xor(ss, 8);
            const float r = 1.0f / sqrtf(ss * (1.f / 128.f) + EPS);
            v0 = v0 * r * g0; v1 = v1 * r * g1;
            v4u o; o.x = pk2(v0.x, v0.y); o.y = pk2(v0.z, v0.w); o.z = pk2(v1.x, v1.y); o.w = pk2(v1.z, v1.w); *p = o; }
    }
}
__device__ __forceinline__ void aux_avec(Frame& F, const Args& args) {
    const int gw = F.vcu * NWAVES + F.wave, NGW = F.G * NWAVES;
    const float* mod = (const float*)(F.ws + WS_MOD); float* avec = (float*)(F.ws + WS_AVEC);
    const float* g2 = args.in[I_NMIX]; const float* g3 = args.in[I_NF2];
    for (int idx = gw * 64 + F.lane; idx < 4 * DM; idx += NGW * 64) { const int which = idx >> 11, b = (idx >> 10) & 1, c = idx & (DM - 1);
        avec[idx] = (which ? g3[c] : g2[c]) * (1.0f + mod[b * NMOD + (which ? MOD_SC3 : MOD_SC2) + c]); }
}
__device__ __forceinline__ void aux_bias(Frame& F, int which) {
    const int gw = F.vcu * NWAVES + F.wave, NGW = F.G * NWAVES;
    const float* mod = (const float*)(F.ws + WS_MOD);
    const int nrows = which ? 2 * DFF : INW;
    const float* sh = mod + (which ? MOD_SH3 : MOD_SH2) + 16 * F.lane;
    f32x4 s0[4], s1[4];
#pragma unroll
    for (int q = 0; q < 4; ++q) { s0[q] = *(const f32x4*)(sh + 4 * q); s1[q] = *(const f32x4*)(sh + NMOD + 4 * q); }
    float* bo = (float*)(F.ws + (which ? WS_BIAS_F2 : WS_BIAS_IN));
    for (int n = gw; n < nrows; n += NGW) {
        const bf16* wrow = (const bf16*)(F.ws + (which ? WS_WGU2 : WS_WIN)) + (size_t)n * DM + 16 * F.lane;
        const v4u w0 = *(const GAS v4u*)wrow, w1 = *(const GAS v4u*)(wrow + 8);
        const float wv[16] = {blo(w0.x), bhi(w0.x), blo(w0.y), bhi(w0.y), blo(w0.z), bhi(w0.z), blo(w0.w), bhi(w0.w), blo(w1.x), bhi(w1.x), blo(w1.y), bhi(w1.y), blo(w1.z), bhi(w1.z), blo(w1.w), bhi(w1.w)};
        float d0 = 0.f, d1 = 0.f;
#pragma unroll
        for (int q = 0; q < 4; ++q)
#pragma unroll
            for (int i = 0; i < 4; ++i) { d0 += s0[q][i] * wv[4 * q + i]; d1 += s1[q][i] * wv[4 * q + i]; }
        d0 = wave_sum(d0); d1 = wave_sum(d1);
        if (F.lane == 0) { bo[n] = d0; bo[nrows + n] = d1; }
    }
}
typedef attn::BlockRef<attn::bf16, attn::bf16> ABlock;
__device__ __forceinline__ ABlock attn_ref(Frame& F, int id, int& skv) {
    const int bgh = id >> 5, x = id & 31, b = bgh / 12, gh = bgh - b * 12, g = gh >> 2, d = 1 << (2 * g), nqb = 32 >> (2 * g), r = x / nqb, qb = x - r * nqb;
    ABlock R; const size_t e0 = (size_t)(b * SEQ + r) * AW + gh * 128;
    R.rs = d * AW; R.ls = d * 12; R.P0 = qb * 256; skv = SEQ / d;
    R.K = (const attn::bf16*)(F.ws + WS_K) + e0; R.V = (const attn::bf16*)(F.ws + WS_V) + e0;
    attn::bf16* q = (attn::bf16*)(F.ws + WS_Q) + e0 + (size_t)(qb * 256) * R.rs; R.Q = q; R.O = q;
    R.LSE = (float*)(F.ws + WS_LSE) + (size_t)(b * SEQ + r + qb * 256 * d) * 12 + gh;
    return R;
}
__device__ __forceinline__ void attn_phase(Frame& F, char* lds) {
    constexpr int NITEMS = 768;
    const int per = (NITEMS + F.G - 1) / F.G; int id = F.vcu * per; const int end = (id + per < NITEMS) ? id + per : NITEMS;
    if (id >= end) return;
    int skv, skvn; ABlock cur = attn_ref(F, id, skv);
    attn::Seam<attn::bf16> S;
    attn::causal_swa_prime<attn::bf16, attn::bf16>(cur, attn::WINDOW, lds, S);
    for (;;) {
        const bool last = id + 1 >= end; skvn = skv;
        const ABlock nxt = last ? cur : attn_ref(F, id + 1, skvn);
        attn::causal_swa_block<attn::bf16, attn::bf16>(cur, nxt, skv, attn::WINDOW, lds, S);
        if (last) break;
        cur = nxt; skv = skvn; ++id;
    }
}
__device__ __forceinline__ void merge_conv_pass(Frame& F, const Args& args) {
    const int gw = F.vcu * NWAVES + F.wave, NGW = F.G * NWAVES;
    { const bf16* OG = (const bf16*)(F.ws + WS_Q); const float* LSE = (const float*)(F.ws + WS_LSE); bf16* O = (bf16*)(F.ws + WS_O);
      const int h = F.lane >> 4, e = 8 * (F.lane & 15);
      for (int t = gw; t < M; t += NGW) {
          const float l0 = LSE[(size_t)t * 12 + h], l1 = LSE[(size_t)t * 12 + 4 + h], l2 = LSE[(size_t)t * 12 + 8 + h];
          const float mx = fmaxf(l0, fmaxf(l1, l2)); const float e0 = __expf(l0 - mx), e1 = __expf(l1 - mx), e2 = __expf(l2 - mx); const float inv = 1.0f / (e0 + e1 + e2);
          const float wg[3] = {e0 * inv, e1 * inv, e2 * inv};
          f32x4 a0 = {0.f, 0.f, 0.f, 0.f}, a1 = {0.f, 0.f, 0.f, 0.f};
#pragma unroll
          for (int g = 0; g < 3; ++g) { const v4u w = *(const GAS v4u*)(OG + (size_t)t * AW + (g * 4 + h) * 128 + e);
              a0 = a0 + (f32x4){blo(w.x), bhi(w.x), blo(w.y), bhi(w.y)} * wg[g]; a1 = a1 + (f32x4){blo(w.z), bhi(w.z), blo(w.w), bhi(w.w)} * wg[g]; }
          v4u o; o.x = pk2(a0.x, a0.y); o.y = pk2(a0.z, a0.w); o.z = pk2(a1.x, a1.y); o.w = pk2(a1.z, a1.w);
          *(GAS v4u*)(O + (size_t)t * 512 + 8 * F.lane) = o; } }
    { const bf16* U = (const bf16*)(F.ws + WS_U); bf16* Bv = (bf16*)(F.ws + WS_B); const bf16* Cg = (const bf16*)(F.ws + WS_C); const float* cw = args.in[I_CONVW];
      for (int it = gw; it < 2 * (M / 16); it += NGW) {
          const int ch = it & 1, t0 = (it >> 1) * 16, c0 = 512 * ch + 8 * F.lane;
          float w0[8], w1[8], w2[8], x1[8], x2[8];
#pragma unroll
          for (int i = 0; i < 8; ++i) { w0[i] = cw[c0 + i]; w1[i] = cw[DM + c0 + i]; w2[i] = cw[2 * DM + c0 + i]; x1[i] = 0.f; x2[i] = 0.f; }
          if ((t0 & (SEQ - 1)) != 0) {
#pragma unroll
              for (int p = 2; p >= 1; --p) { const v4u wu = *(const GAS v4u*)(U + (size_t)(t0 - p) * DM + c0), wc = *(const GAS v4u*)(Cg + (size_t)(t0 - p) * DM + c0);
                  const float xu[8] = {blo(wu.x), bhi(wu.x), blo(wu.y), bhi(wu.y), blo(wu.z), bhi(wu.z), blo(wu.w), bhi(wu.w)}, xc[8] = {blo(wc.x), bhi(wc.x), blo(wc.y), bhi(wc.y), blo(wc.z), bhi(wc.z), blo(wc.w), bhi(wc.w)};
#pragma unroll
                  for (int i = 0; i < 8; ++i) { if (p == 2) x2[i] = xu[i] * xc[i]; else x1[i] = xu[i] * xc[i]; } } }
#pragma unroll 4
          for (int r = 0; r < 16; ++r) { const size_t off = (size_t)(t0 + r) * DM + c0;
              const v4u wu = *(const GAS v4u*)(U + off), wc = *(const GAS v4u*)(Cg + off), wb = *(const GAS v4u*)(Bv + off);
              const float xu[8] = {blo(wu.x), bhi(wu.x), blo(wu.y), bhi(wu.y), blo(wu.z), bhi(wu.z), blo(wu.w), bhi(wu.w)}, xc[8] = {blo(wc.x), bhi(wc.x), blo(wc.y), bhi(wc.y), blo(wc.z), bhi(wc.z), blo(wc.w), bhi(wc.w)};
              const float xb[8] = {blo(wb.x), bhi(wb.x), blo(wb.y), bhi(wb.y), blo(wb.z), bhi(wb.z), blo(wb.w), bhi(wb.w)};
              float y[8];
#pragma unroll
              for (int i = 0; i < 8; ++i) { const float x0 = xu[i] * xc[i]; y[i] = xb[i] * (w0[i] * x2[i] + w1[i] * x1[i] + w2[i] * x0); x2[i] = x1[i]; x1[i] = x0; }
              v4u o; o.x = pk2(y[0], y[1]); o.y = pk2(y[2], y[3]); o.z = pk2(y[4], y[5]); o.w = pk2(y[6], y[7]);
              *(GAS v4u*)(Bv + off) = o; } } }
}


#ifdef NAIVE
template <bool DUAL, class St>
__device__ __forceinline__ void naive_gemm(Frame& F, const bf16* A, int lda, const float* W, const float* W2, int ldw, int M_, int N_, int K_, St store) {
    LAS float* As = (LAS float*)(F.lds + RING_OFF);
    LAS float* Ws = As + 64 * 33;
    LAS float* Ws2 = Ws + 32 * 68;
    const int ty = F.tid >> 4, tx = F.tid & 15, ntn = N_ / 64, ntiles = (M_ / 64) * ntn;
    for (int tile = blockIdx.x; tile < ntiles; tile += F.G) {
        const int tm = tile / ntn, tn = tile - tm * ntn;
        float acc[2][4] = {{0.f, 0.f, 0.f, 0.f}, {0.f, 0.f, 0.f, 0.f}}, acc2[2][4] = {{0.f, 0.f, 0.f, 0.f}, {0.f, 0.f, 0.f, 0.f}};
        for (int k0 = 0; k0 < K_; k0 += 32) {
            __syncthreads();
#pragma unroll
            for (int i = 0; i < 4; ++i) { const int e = F.tid + 512 * i, r = e >> 5, c = e & 31; As[r * 33 + c] = __uint_as_float((unsigned)A[(size_t)(tm * 64 + r) * lda + k0 + c] << 16); }
#pragma unroll
            for (int i = 0; i < 4; ++i) { const int e = F.tid + 512 * i, r = e >> 6, c = e & 63; Ws[r * 68 + c] = W[(size_t)(k0 + r) * ldw + tn * 64 + c]; if (DUAL) Ws2[r * 68 + c] = W2[(size_t)(k0 + r) * ldw + tn * 64 + c]; }
            __syncthreads();
#pragma unroll 8
            for (int kk = 0; kk < 32; ++kk) { const float a0 = As[(ty * 2) * 33 + kk], a1 = As[(ty * 2 + 1) * 33 + kk];
#pragma unroll
                for (int j = 0; j < 4; ++j) { const float w = Ws[kk * 68 + tx * 4 + j]; acc[0][j] += a0 * w; acc[1][j] += a1 * w;
                    if (DUAL) { const float w2 = Ws2[kk * 68 + tx * 4 + j]; acc2[0][j] += a0 * w2; acc2[1][j] += a1 * w2; } } }
        }
#pragma unroll
        for (int i = 0; i < 2; ++i)
#pragma unroll
            for (int j = 0; j < 4; ++j) store(tm * 64 + ty * 2 + i, tn * 64 + tx * 4 + j, acc[i][j], acc2[i][j]);
    }
    __syncthreads();
}
__device__ __forceinline__ bf16 f2b(float v) { return (bf16)f2bf(v); }
__device__ __forceinline__ float b2f(bf16 v) { return __uint_as_float((unsigned)v << 16); }
__device__ __forceinline__ void naive_attn(Frame& F) {
    const int gw = F.vcu * NWAVES + F.wave, NGW = F.G * NWAVES;
    bf16* Qb = (bf16*)(F.ws + WS_Q); const bf16* Kb = (const bf16*)(F.ws + WS_K); const bf16* Vb = (const bf16*)(F.ws + WS_V); float* LSE = (float*)(F.ws + WS_LSE);
    for (int it = gw; it < M * 12; it += NGW) {
        const int t = it / 12, gh = it - t * 12, g = gh >> 2, d = 1 << (2 * g), tl = t & (SEQ - 1);
        const float q0 = b2f(Qb[(size_t)t * AW + gh * 128 + 2 * F.lane]), q1 = b2f(Qb[(size_t)t * AW + gh * 128 + 2 * F.lane + 1]);
        float s0 = -INFINITY, s1 = -INFINITY, s2 = -INFINITY;
        for (int j = 0; j <= 128; ++j) { if (tl - j * d < 0) break; const size_t kr = (size_t)(t - j * d) * AW + gh * 128 + 2 * F.lane;
            const float sc = wave_sum(q0 * b2f(Kb[kr]) + q1 * b2f(Kb[kr + 1])) * 0.08838834764831845f;
            if (j < 64) { if (F.lane == j) s0 = sc; } else if (j < 128) { if (F.lane == j - 64) s1 = sc; } else { if (F.lane == 0) s2 = sc; } }
        float mx = fmaxf(s0, fmaxf(s1, s2));
#pragma unroll
        for (int o = 1; o < 64; o <<= 1) mx = fmaxf(mx, __shfl_xor(mx, o));
        const float p0 = __expf(s0 - mx), p1 = __expf(s1 - mx), p2 = __expf(s2 - mx);
        const float l = wave_sum(p0 + p1 + p2);
        float o0 = 0.f, o1 = 0.f;
        for (int j = 0; j <= 128; ++j) { if (tl - j * d < 0) break; const size_t vr = (size_t)(t - j * d) * AW + gh * 128 + 2 * F.lane;
            const float p = (j < 64) ? __shfl(p0, j) : (j < 128) ? __shfl(p1, j - 64) : __shfl(p2, 0);
            o0 += p * b2f(Vb[vr]); o1 += p * b2f(Vb[vr + 1]); }
        const float inv = 1.0f / l;
        Qb[(size_t)t * AW + gh * 128 + 2 * F.lane] = f2b(o0 * inv); Qb[(size_t)t * AW + gh * 128 + 2 * F.lane + 1] = f2b(o1 * inv);
        if (F.lane == 0) LSE[(size_t)t * 12 + gh] = mx + __logf(l);
    }
}
#endif

constexpr int N_PHASES = 17;
__global__ void __launch_bounds__(NWAVES * 64, 2) mega_fwd(Args args) {
    extern __shared__ __attribute__((aligned(16))) unsigned char lds[];
    Frame F;
    F.lds = (LAS unsigned char*)lds;
    F.MISC = (volatile LAS unsigned*)(F.lds + MISC_OFF);
    F.tid = threadIdx.x; F.lane = F.tid & 63; F.wave = __builtin_amdgcn_readfirstlane(F.tid >> 6);
    F.G = gridDim.x; { const int bx = blockIdx.x; F.vcu = (F.G % 8 == 0) ? (bx % 8) * (F.G / 8) + bx / 8 : bx; }
    F.ws = args.ws; F.out = args.out;
    F.ctl = (gu32*)(args.ws + WS_CTL);
    for (int u = F.tid; u < (LDS_BYTES - LDSCTL_OFF) / 4; u += NWAVES * 64) ((LAS unsigned*)(F.lds + LDSCTL_OFF))[u] = 0u;
    __syncthreads();
    XcdBarrier bar = xcd_barrier_post((unsigned*)(F.ctl + CW_BAR), F.MISC + 8);
    const int lo = args.ph_lo, hi = args.ph_hi;
    typedef pg8::bf16_t pb;
#define mod ((const float*)(args.ws + WS_MOD))
#define XS ((const pb*)(args.ws + WS_XS))
    unsigned char* const ws = args.ws;
#define IN(k) (lo <= (k) && (k) < hi)
#define FRESH() do { F.tid = tid_opaque(); F.lane = F.tid & 63; } while (0)
#ifdef PROBE_TA
#define TSTAMP(slot) do { if (F.tid == 0) { const unsigned long long t_ = rt(); F.MISC[16 + 2 * (slot)] = (unsigned)t_; F.MISC[17 + 2 * (slot)] = (unsigned)(t_ >> 32); } } while (0)
#define SEAM(k) do { if (IN(k) && IN((k) + 1)) xcd_barrier(bar); if ((k) == PROBE_TA) TSTAMP(0); if ((k) == PROBE_TB) TSTAMP(1); } while (0)
    if (PROBE_TA == -1) TSTAMP(0);
#else
#define SEAM(k) do { if (IN(k) && IN((k) + 1)) xcd_barrier(bar); } while (0)
#endif
#ifdef NAIVE
#define FUSE_NORM 0
#else
#define FUSE_NORM 1
#endif
#define XL ((PG8_LAS float*)(F.lds + XL_OFF))
#define PS2 ((const float*)(args.ws + WS_PS2))
#define PS3 ((const float*)(args.ws + WS_PS3))
#define bias_in ((const float*)(args.ws + WS_BIAS_IN))
#define bias_f2 ((const float*)(args.ws + WS_BIAS_F2))
#define avec ((const float*)(args.ws + WS_AVEC))
#define GEMM_BX(SCHED_DECL, SCHED_T, A_, K_, BT, N_, MODE, NRM, QKN_, O_, LDC, SPC, SPS, I1, I2, PS_, BIAS_, BSTR) do { pg8::Gemm g{(const pb*)(A_), (const pb*)(BT), M, (N_), (K_)}; SCHED_DECL; \
        typedef pg8::EpiB<MODE, (NRM), (QKN_)> EpiT; EpiT E{(pb*)(O_), (LDC), (SPC), (SPS), (const pb*)(I1), (const pb*)(I2), (PS_), (BIAS_), (BSTR), args.in[I_QN], args.in[I_KN], 2 * AW, XL, 0}; \
        pg8::gemm_phase<EpiT, SCHED_T, true, true>(F.lds + RING_OFF, g, S, E); } while (0)
#define GEMM_B(A_, K_, BT, N_, MODE, NRM, QKN_, O_, LDC, SPC, SPS, I1, I2, PS_, BIAS_, BSTR) \
        GEMM_BX(pg8::StaticOrder S; S.init(M, (N_), F.G, (int)blockIdx.x), pg8::StaticOrder, A_, K_, BT, N_, MODE, NRM, QKN_, O_, LDC, SPC, SPS, I1, I2, PS_, BIAS_, BSTR)
#define GEMM_F(XSO, A_, K_, BT, BASE, COEF, SCALE, AVEC_, PS_) do { pg8::Gemm g{(const pb*)(A_), (const pb*)(BT), M, DM, (K_)}; pg8::StaticOrder S; S.init(M, DM, F.G, (int)blockIdx.x); \
        typedef pg8::EpiF<(XSO)> EpiT; EpiT E{(BASE), F.out, (COEF), (pb*)(ws + WS_XS), (AVEC_), (float*)(PS_), XL, (SCALE)}; pg8::gemm_phase<EpiT, pg8::StaticOrder, true, true>(F.lds + RING_OFF, g, S, E); } while (0)

#if FUSE_NORM
    FRESH();
    if (IN(0)) { for (int it = blockIdx.x; it < ADA_ITEMS; it += F.G) p0_adaln_item(F, args, it); }
#else
    FRESH();
    if (IN(0)) { for (int it = blockIdx.x; it < ADA_ITEMS; it += F.G) p0_adaln_item(F, args, it); for (int st = 0; st < 3; ++st) p0_transposes(F, args, st, F.vcu * NWAVES + F.wave, F.G * NWAVES); }
#endif
    SEAM(0);
    FRESH();
    if (IN(1)) { norm_pass(F, args.in[I_X], args.in[I_NF1], MOD_SH1, MOD_SC1); if (FUSE_NORM) { aux_avec(F, args); p0_transposes(F, args, 0, F.vcu * NWAVES + F.wave, F.G * NWAVES); } }
    SEAM(1);
#ifdef PROBE_XBAR
    xcd_barrier(bar); xcd_barrier(bar); xcd_barrier(bar); xcd_barrier(bar);
#endif
#if defined(NAIVE) && (NAIVE & 1)
    if (IN(2)) { bf16* ACT = (bf16*)(ws + WS_ACT); naive_gemm<true>(F, (const bf16*)XS, DM, args.in[I_F1G], args.in[I_F1U], DFF, M, DFF, DM, [=](int r, int c, float g, float u) { ACT[(size_t)r * DFF + c] = f2b(silu_f(g) * u); }); }
#else
    if (IN(2)) GEMM_B(XS, DM, ws + WS_WGU1, 2 * DFF, pg8::EB_SWIGLU, false, false, ws + WS_ACT, DFF, 0, 0, nullptr, nullptr, nullptr, nullptr, 0);
    FRESH();
    if (FUSE_NORM && IN(2) && F.G == 256 && (int)blockIdx.x >= 128) p0_transposes(F, args, 1, ((int)blockIdx.x - 128) * NWAVES + F.wave, 128 * NWAVES);
    else if (FUSE_NORM && IN(2) && F.G != 256) p0_transposes(F, args, 1, F.vcu * NWAVES + F.wave, F.G * NWAVES);
#endif
    SEAM(2);
#if defined(NAIVE) && (NAIVE & 2)
    if (IN(3)) { const float* xb = args.in[I_X]; float* ob = F.out; naive_gemm<false>(F, (const bf16*)(ws + WS_ACT), DFF, args.in[I_F1D], nullptr, DM, M, DM, DFF, [=](int r, int c, float v, float) { ob[(size_t)r * DM + c] = xb[(size_t)r * DM + c] + 0.5f * mod[(r / SEQ) * NMOD + MOD_GT1 + c] * v; }); }
#else
    FRESH();
    if (FUSE_NORM && IN(3)) aux_bias(F, 0);
    if (IN(3)) GEMM_F(FUSE_NORM, ws + WS_ACT, DFF, ws + WS_WD1, args.in[I_X], mod + MOD_GT1, 0.5f, avec, ws + WS_PS2);
#endif
    SEAM(3);
#if !FUSE_NORM
    if (IN(4)) norm_pass(F, F.out, args.in[I_NMIX], MOD_SH2, MOD_SC2);
    SEAM(4);
#endif
#if defined(NAIVE) && (NAIVE & 4)
    if (IN(5)) { bf16* Qb = (bf16*)(ws + WS_Q); naive_gemm<false>(F, (const bf16*)XS, DM, args.in[I_WIN] + COL_Q, nullptr, INW, M, 3 * AW, DM, [=](int r, int c, float v, float) { const int t = c / AW; Qb[(size_t)t * M * AW + (size_t)r * AW + (c - t * AW)] = f2b(v); }); }
#else
    if (IN(5)) GEMM_B(XS, DM, ws + WS_WIN + (size_t)COL_Q * DM * 2, 3 * AW, pg8::EB_PLAIN, FUSE_NORM, FUSE_NORM, ws + WS_Q, AW, AW, (size_t)(WS_K - WS_Q) / 2, nullptr, nullptr, PS2, bias_in + COL_Q, INW);
    FRESH();
    if (FUSE_NORM && IN(5) && F.G == 256 && (int)blockIdx.x >= 128) p0_transposes(F, args, 2, ((int)blockIdx.x - 128) * NWAVES + F.wave, 128 * NWAVES);
    else if (FUSE_NORM && IN(5) && F.G != 256) p0_transposes(F, args, 2, F.vcu * NWAVES + F.wave, F.G * NWAVES);
#endif
    SEAM(5);
#if !FUSE_NORM
    if (IN(6)) qknorm_pass(F, args);
    SEAM(6);
#endif
#if defined(NAIVE) && (NAIVE & 8)
    if (IN(7)) naive_attn(F);
#else
    if (IN(7)) attn_phase(F, (char*)lds + RING_OFF);
#endif
    SEAM(7);
#if defined(NAIVE) && (NAIVE & 16)
    if (IN(8)) { bf16* Ub = (bf16*)(ws + WS_U); naive_gemm<false>(F, (const bf16*)XS, DM, args.in[I_WIN] + COL_U, nullptr, INW, M, 3 * DM, DM, [=](int r, int c, float v, float) { const int t = c / DM; Ub[(size_t)t * M * DM + (size_t)r * DM + (c - t * DM)] = f2b(v); }); }
#else
    if (IN(8)) GEMM_B(XS, DM, ws + WS_WIN + (size_t)COL_U * DM * 2, 3 * DM, pg8::EB_PLAIN, FUSE_NORM, false, ws + WS_U, DM, DM, (size_t)(WS_B - WS_U) / 2, nullptr, nullptr, PS2, bias_in + COL_U, INW);
#endif
    SEAM(8);
    FRESH();
    if (IN(9)) { merge_conv_pass(F, args); if (FUSE_NORM) aux_bias(F, 1); }
    SEAM(9);
    { bf16* SGA = (bf16*)(ws + WS_SGA); bf16* SGC = (bf16*)(ws + WS_SGC); (void)SGA; (void)SGC;
#if defined(NAIVE) && (NAIVE & 32)
      if (IN(10)) naive_gemm<false>(F, (const bf16*)XS, DM, args.in[I_WIN] + COL_GA, nullptr, INW, M, DM, DM, [=](int r, int c, float v, float) { SGA[(size_t)r * DM + c] = f2b(1.0f / (1.0f + __expf(-v))); });
      if (IN(11)) naive_gemm<false>(F, (const bf16*)XS, DM, args.in[I_WIN] + COL_GC, nullptr, INW, M, DM, DM, [=](int r, int c, float v, float) { SGC[(size_t)r * DM + c] = f2b(1.0f / (1.0f + __expf(-v))); });
#else
    if (IN(10)) GEMM_BX(pg8::TwinOrder S; S.init(M, DM, F.G, (int)blockIdx.x); S.reps = 2, pg8::TwinOrder, XS, DM, ws + WS_WIN + (size_t)COL_GA * DM * 2, 2 * DM, pg8::EB_SIGMOID, FUSE_NORM, false,
                        ws + WS_SGA, DM, DM, (size_t)(WS_SGC - WS_SGA) / 2, nullptr, nullptr, PS2, bias_in + COL_GA, INW);
#endif
#ifdef NAIVE
    if (IN(11) && IN(12)) xcd_barrier(bar);
#endif
#if defined(NAIVE) && (NAIVE & 512)
      if (IN(12)) naive_gemm<false>(F, (const bf16*)(ws + WS_O), 512, args.in[I_WAB], nullptr, DM, M, DM, 512, [=](int r, int c, float v, float) { SGA[(size_t)r * DM + c] = f2b(b2f(SGA[(size_t)r * DM + c]) * v); });
#else
    if (IN(12)) GEMM_B(ws + WS_O, 512, ws + WS_WA, DM, pg8::EB_GATEMUL, false, false, ws + WS_SGA, DM, 0, 0, ws + WS_SGA, nullptr, nullptr, nullptr, 0);
#endif
#ifdef NAIVE
    if (IN(12) && IN(13)) xcd_barrier(bar);
#endif
#if defined(NAIVE) && (NAIVE & 1024)
      if (IN(13)) naive_gemm<false>(F, (const bf16*)(ws + WS_B), DM, args.in[I_WCB], nullptr, DM, M, DM, DM, [=](int r, int c, float v, float) { SGA[(size_t)r * DM + c] = f2b(b2f(SGA[(size_t)r * DM + c]) + b2f(SGC[(size_t)r * DM + c]) * v); });
#else
    if (IN(13)) GEMM_B(ws + WS_B, DM, ws + WS_WC, DM, pg8::EB_MERGE, false, false, ws + WS_SGA, DM, 0, 0, ws + WS_SGA, ws + WS_SGC, nullptr, nullptr, 0);
#endif
    }
    SEAM(13);
#if defined(NAIVE) && (NAIVE & 64)
    if (IN(14)) { float* ob = F.out; naive_gemm<false>(F, (const bf16*)(ws + WS_SGA), DM, args.in[I_WOUT], nullptr, DM, M, DM, DM, [=](int r, int c, float v, float) { ob[(size_t)r * DM + c] += mod[(r / SEQ) * NMOD + MOD_GT2 + c] * v; }); }
#else
    if (IN(14)) GEMM_F(FUSE_NORM, ws + WS_SGA, DM, ws + WS_WO, F.out, mod + MOD_GT2, 1.0f, avec + 2 * DM, ws + WS_PS3);
#endif
    SEAM(14);
#if !FUSE_NORM
    if (IN(15)) norm_pass(F, F.out, args.in[I_NF2], MOD_SH3, MOD_SC3);
    SEAM(15);
#endif
#if defined(NAIVE) && (NAIVE & 128)
    if (IN(16)) { bf16* ACT = (bf16*)(ws + WS_ACT); naive_gemm<true>(F, (const bf16*)XS, DM, args.in[I_F2G], args.in[I_F2U], DFF, M, DFF, DM, [=](int r, int c, float g, float u) { ACT[(size_t)r * DFF + c] = f2b(silu_f(g) * u); }); }
#else
    if (IN(16)) GEMM_B(XS, DM, ws + WS_WGU2, 2 * DFF, pg8::EB_SWIGLU, FUSE_NORM, false, ws + WS_ACT, DFF, 0, 0, nullptr, nullptr, PS3, bias_f2, 2 * DFF);
#endif
    SEAM(16);
#if defined(NAIVE) && (NAIVE & 256)
    if (IN(17)) { float* ob = F.out; naive_gemm<false>(F, (const bf16*)(ws + WS_ACT), DFF, args.in[I_F2D], nullptr, DM, M, DM, DFF, [=](int r, int c, float v, float) { ob[(size_t)r * DM + c] += 0.5f * mod[(r / SEQ) * NMOD + MOD_GT3 + c] * v; }); }
#else
    if (IN(17)) GEMM_F(false, ws + WS_ACT, DFF, ws + WS_WD2, F.out, mod + MOD_GT3, 0.5f, nullptr, nullptr);
#endif
#ifdef PROBE_TA
    if (PROBE_TB == 17) TSTAMP(1);
    xcd_barrier(bar);
    if (blockIdx.x == 0 && F.tid == 0) { const unsigned long long t0_ = ((unsigned long long)F.MISC[17] << 32) | F.MISC[16], t1_ = ((unsigned long long)F.MISC[19] << 32) | F.MISC[18];
#ifdef PROBE_CONST
        F.out[0] += (float)(PROBE_CONST); (void)t0_; (void)t1_; }
#else
        F.out[0] += (float)(PROBE_SCALE) * 0.01f * (float)(t1_ - t0_); }
#endif
#endif
#undef IN
#undef SEAM
#undef XL
#undef PS2
#undef PS3
#undef bias_in
#undef bias_f2
#undef avec
#undef mod
#undef XS
}

extern "C" void kernel_launch(void* const* d_in, const int* in_sizes, int n_in, void* d_out, int out_size, void* d_ws, size_t ws_size, hipStream_t stream) {
    static int grid = 0;
    if (grid == 0) {
        if (n_in != 20 || in_sizes[0] != M * DM || out_size != M * DM || ws_size < WS_END) { fprintf(stderr, "kernel_launch: shape/workspace mismatch (n_in %d, in0 %d, out %d, ws %zu < %zu)\n", n_in, n_in > 0 ? in_sizes[0] : -1, out_size, ws_size, (size_t)WS_END); grid = -1; return; }
        int dev = 0, cus = 0, per_cu = 0;
        if (hipGetDevice(&dev) != hipSuccess || hipDeviceGetAttribute(&cus, hipDeviceAttributeMultiprocessorCount, dev) != hipSuccess) { grid = -1; return; }
        if (hipFuncSetAttribute((const void*)mega_fwd, hipFuncAttributeMaxDynamicSharedMemorySize, LDS_BYTES) != hipSuccess) { fprintf(stderr, "kernel_launch: hipFuncSetAttribute failed\n"); grid = -1; return; }
        if (hipOccupancyMaxActiveBlocksPerMultiprocessor(&per_cu, (const void*)mega_fwd, NWAVES * 64, LDS_BYTES) != hipSuccess || per_cu < 1) { fprintf(stderr, "kernel_launch: occupancy query reports %d workgroups per CU\n", per_cu); }
        (void)hipGetLastError();
        grid = cus;
    }
    if (grid < 0) return;
    (void)hipMemsetAsync((char*)d_ws + WS_CTL, 0, CTL_ZERO_BYTES, stream);
#ifdef PROBE_MEMSET2
    (void)hipMemsetAsync((char*)d_ws + WS_CTL + CTL_ZERO_BYTES, 0, CTL_ZERO_BYTES, stream);
#endif
    Args a{};
    for (int i = 0; i < 20; ++i) a.in[i] = (const float*)d_in[i];
    a.out = (float*)d_out; a.ws = (unsigned char*)d_ws;
#if defined(PROBE_DUP)
    a.ph_lo = 0; a.ph_hi = PROBE_DUP + 1; hipLaunchKernelGGL(mega_fwd, dim3(grid), dim3(NWAVES * 64), LDS_BYTES, stream, a);
    (void)hipMemsetAsync((char*)d_ws + WS_CTL, 0, CTL_ZERO_BYTES, stream);
    a.ph_lo = PROBE_DUP; a.ph_hi = N_PHASES + 1; hipLaunchKernelGGL(mega_fwd, dim3(grid), dim3(NWAVES * 64), LDS_BYTES, stream, a);
#elif defined(PROBE_RLO)
    a.ph_lo = 0; a.ph_hi = PROBE_RHI + 1; hipLaunchKernelGGL(mega_fwd, dim3(grid), dim3(NWAVES * 64), LDS_BYTES, stream, a);
    (void)hipMemsetAsync((char*)d_ws + WS_CTL, 0, CTL_ZERO_BYTES, stream);
    a.ph_lo = PROBE_RLO; a.ph_hi = N_PHASES + 1; hipLaunchKernelGGL(mega_fwd, dim3(grid), dim3(NWAVES * 64), LDS_BYTES, stream, a);
#elif defined(PROBE_SPLIT)
    a.ph_lo = 0; a.ph_hi = PROBE_SPLIT + 1; hipLaunchKernelGGL(mega_fwd, dim3(grid), dim3(NWAVES * 64), LDS_BYTES, stream, a);
    (void)hipMemsetAsync((char*)d_ws + WS_CTL, 0, CTL_ZERO_BYTES, stream);
    a.ph_lo = PROBE_SPLIT + 1; a.ph_hi = N_PHASES + 1; hipLaunchKernelGGL(mega_fwd, dim3(grid), dim3(NWAVES * 64), LDS_BYTES, stream, a);
#elif !defined(MK_PER_PHASE)
    a.ph_lo = 0; a.ph_hi = N_PHASES + 1;
    hipLaunchKernelGGL(mega_fwd, dim3(grid), dim3(NWAVES * 64), LDS_BYTES, stream, a);
#else
    for (int p = 0; p <= N_PHASES; ++p) { a.ph_lo = p; a.ph_hi = p + 1; hipLaunchKernelGGL(mega_fwd, dim3(grid), dim3(NWAVES * 64), LDS_BYTES, stream, a); }
#endif
}
```

```cpp
#include <hip/hip_runtime.h>
#include <hip/hip_bf16.h>
#include <cstdio>
#include <cstdint>

constexpr int DM = 1024, BATCH = 2, SEQ = 8192, M = BATCH * SEQ;
constexpr int DFF = 2816, NMOD = 9 * DM;
constexpr int AW = 1536;
constexpr int INW = 9728;
constexpr int COL_Q = 0, COL_K = 1536, COL_V = 3072, COL_U = 4608, COL_B = 5632, COL_C = 6656, COL_GA = 7680, COL_GC = 8704;
constexpr float EPS = 1e-6f;

__device__ __forceinline__ int tid_opaque() { int t = (int)threadIdx.x; asm volatile("" : "+v"(t)); return t; }

namespace pg8 {
#define PG8_LAS __attribute__((address_space(3)))
typedef unsigned short bf16_t;
typedef short bf16x8 __attribute__((ext_vector_type(8)));
typedef float f32x4 __attribute__((ext_vector_type(4)));
typedef unsigned u32x4 __attribute__((ext_vector_type(4)));
constexpr int BM = 256, BK = 64, HALF = 128, HTB = HALF * BK * 2  , STAGE_BYTES = 8 * HTB, NXCD = 8, WGM = 8;

__host__ __device__ __forceinline__ int lds_byte(int r, int c) { const int st = (r >> 4) * 2 + (c >> 5), rr = r & 15, cc = c & 31, ob = rr * 64 + cc * 2; return st * 1024 + (ob ^ (((ob >> 9) & 1) << 5)); }
__host__ __device__ __forceinline__ void stage_rc(int b, int& R, int& C) { const int st = b / 1024, sb = b % 1024, swz = sb ^ (((sb >> 9) & 1) << 5); R = (st >> 1) * 16 + swz / 64; C = (st & 1) * 32 + (swz % 64) / 2; }
__host__ __device__ __forceinline__ int perm32(int rho) { const int n = rho >> 4, i = rho & 15; return 8 * (i >> 2) + 4 * n + (i & 3); }

struct Unit { int pm, pn; };
struct Gemm { const bf16_t* A; const bf16_t* Bt; int M, N, K; };

struct StaticOrder {
    int nM, nN, nwg, G, c;
    __host__ __device__ void init(int M, int N, int G_, int c_) { nM = M / BM; nN = N / BM; nwg = nM * nN; G = G_; c = c_; }
    __host__ __device__ bool next(int i, Unit& u) const {
        const long L = (long)i * G + c; if (L >= nwg) return false;
        int wgid = (int)L; { const int q = nwg / NXCD, r = nwg % NXCD, xcd = wgid % NXCD, off = wgid / NXCD; wgid = (xcd < r ? xcd * (q + 1) : r * (q + 1) + (xcd - r) * q) + off; }
        const int nig = WGM * nN, gid = wgid / nig, fm = gid * WGM, gsz = (nM - fm) < WGM ? (nM - fm) : WGM;
        u.pm = fm + ((wgid % nig) % gsz); u.pn = (wgid % nig) / gsz; return true;
    }
    __device__ __forceinline__ void a_ready(const Unit&) const {}
    __device__ __forceinline__ void done(const Unit&) const {}
};

typedef float f32x2_t __attribute__((ext_vector_type(2))); typedef __bf16 bf16x2_t __attribute__((ext_vector_type(2)));
__device__ __forceinline__ unsigned cvt_pk_bf16(float lo, float hi) { f32x2_t v = {lo, hi}; bf16x2_t b = __builtin_convertvector(v, bf16x2_t); return __builtin_bit_cast(unsigned, b); }
__device__ __forceinline__ float bf_lo(unsigned w) { return __uint_as_float(w << 16); }
__device__ __forceinline__ float bf_hi(unsigned w) { return __uint_as_float(w & 0xffff0000u); }
__device__ __forceinline__ float sigmoidf_(float x) { return __builtin_amdgcn_rcpf(1.0f + __builtin_amdgcn_exp2f(-1.4426950408889634f * x)); }
__device__ __forceinline__ void unpack8(const u32x4 w, f32x4& a, f32x4& b) { a = (f32x4){bf_lo(w.x), bf_hi(w.x), bf_lo(w.y), bf_hi(w.y)}; b = (f32x4){bf_lo(w.z), bf_hi(w.z), bf_lo(w.w), bf_hi(w.w)}; }
__device__ __forceinline__ u32x4 pack8(const f32x4 a, const f32x4 b) { u32x4 w; w.x = cvt_pk_bf16(a[0], a[1]); w.y = cvt_pk_bf16(a[2], a[3]); w.z = cvt_pk_bf16(b[0], b[1]); w.w = cvt_pk_bf16(b[2], b[3]); return w; }

enum { EB_PLAIN = 0, EB_SWIGLU = 1, EB_SIGMOID = 2, EB_GATEMUL = 3, EB_MERGE = 4 };
template <int mode, bool NORMED = false, bool QKN = false> struct EpiB {
    static constexpr bool PERM = true, AFTER_DRAIN = false, PREFETCH = NORMED;
    bf16_t* O; int ldc; int split_cols; size_t split_stride; const bf16_t* In1; const bf16_t* In2;
    const float* PS; const float* bias; int bias_bstride; const float* gamma_q; const float* gamma_k; int qk_cols; PG8_LAS float* XL; int par;
    __device__ __forceinline__ void prefetch(const Unit& u, int wid, int buf) const {
        if (NORMED && wid < 4) { const int lane = threadIdx.x & 63; PG8_LAS unsigned char* X2 = (PG8_LAS unsigned char*)(XL + 2048) + buf * 5120;
            __builtin_amdgcn_global_load_lds((const unsigned*)(PS + (size_t)(u.pm * BM + wid * 64 + lane) * 4), (PG8_LAS unsigned*)(X2 + wid * 1024), 16, 0, 0);
            if (wid == 0) __builtin_amdgcn_global_load_lds((const unsigned*)(bias + (size_t)((u.pm * BM) / SEQ) * bias_bstride + u.pn * BM + lane * 4), (PG8_LAS unsigned*)(X2 + 4096), 16, 0, 0); }
    }
    __device__ __forceinline__ void operator()(f32x4 (&acc)[2][2][4][2], const Unit& u, int wr, int wc, int fr, int fq) const {
        const int row0 = u.pm * BM + wr * 64 + fr;
        if (NORMED) {
            const PG8_LAS float* X2 = XL + 2048 + par * 1280;
            f32x4 bv[2][2];
#pragma unroll
            for (int bj = 0; bj < 2; ++bj)
#pragma unroll
                for (int n = 0; n < 2; ++n) bv[bj][n] = *(const PG8_LAS f32x4*)(X2 + 1024 + bj * HALF + wc * 32 + 8 * fq + 4 * n);
#pragma unroll
            for (int ai = 0; ai < 2; ++ai)
#pragma unroll
                for (int m = 0; m < 4; ++m) { const f32x4 p = *(const PG8_LAS f32x4*)(X2 + (ai * HALF + wr * 64 + m * 16 + fr) * 4);
                    const float rstd = __builtin_amdgcn_rsqf(((p[0] + p[1]) + (p[2] + p[3])) * (1.0f / 1024.0f) + 1e-6f);
#pragma unroll
                    for (int bj = 0; bj < 2; ++bj)
#pragma unroll
                        for (int n = 0; n < 2; ++n) acc[ai][bj][m][n] = acc[ai][bj][m][n] * rstd + bv[bj][n]; }
        }
        if (mode == EB_SWIGLU) {
            const int col0 = u.pn * HALF + wc * 32 + 8 * fq;
#pragma unroll
            for (int ai = 0; ai < 2; ++ai)
#pragma unroll
                for (int m = 0; m < 4; ++m) { bf16_t* rowp = O + (size_t)(row0 + ai * HALF + m * 16) * ldc + col0;
                    f32x4 v0, v1;
#pragma unroll
                    for (int i = 0; i < 4; ++i) { const float g0 = acc[ai][0][m][0][i], g1 = acc[ai][0][m][1][i];
                        v0[i] = g0 * sigmoidf_(g0) * acc[ai][1][m][0][i]; v1[i] = g1 * sigmoidf_(g1) * acc[ai][1][m][1][i]; }
                    *(u32x4*)rowp = pack8(v0, v1); }
            return;
        }
        int colt = u.pn * BM; size_t boff = 0;
        if (QKN && colt < qk_cols) {
            PG8_LAS float* P = XL;
#pragma unroll
            for (int ai = 0; ai < 2; ++ai)
#pragma unroll
                for (int m = 0; m < 4; ++m)
#pragma unroll
                    for (int bj = 0; bj < 2; ++bj) { const f32x4 a = acc[ai][bj][m][0], b = acc[ai][bj][m][1];
                        float s = ((a[0] * a[0] + a[1] * a[1]) + (a[2] * a[2] + a[3] * a[3])) + ((b[0] * b[0] + b[1] * b[1]) + (b[2] * b[2] + b[3] * b[3]));
                        s += __shfl_xor(s, 16); s += __shfl_xor(s, 32);
                        if (fq == 0) P[((ai * HALF + wr * 64 + m * 16 + fr) * 2 + bj) * 4 + wc] = s; }
            asm volatile("s_waitcnt lgkmcnt(0)" ::: "memory"); __builtin_amdgcn_s_barrier(); asm volatile("" ::: "memory");
            const float* gm = (colt < (qk_cols >> 1) ? gamma_q : gamma_k) + wc * 32 + 8 * fq;
            const f32x4 g0 = *(const f32x4*)gm, g1 = *(const f32x4*)(gm + 4);
#pragma unroll
            for (int ai = 0; ai < 2; ++ai)
#pragma unroll
                for (int m = 0; m < 4; ++m)
#pragma unroll
                    for (int bj = 0; bj < 2; ++bj) { const f32x4 p = *(const PG8_LAS f32x4*)(P + ((ai * HALF + wr * 64 + m * 16 + fr) * 2 + bj) * 4);
                        const float r = __builtin_amdgcn_rsqf(((p[0] + p[1]) + (p[2] + p[3])) * (1.0f / 128.0f) + 1e-6f);
                        acc[ai][bj][m][0] = acc[ai][bj][m][0] * r * g0; acc[ai][bj][m][1] = acc[ai][bj][m][1] * r * g1; }
        }
        if (split_cols) { const int t = colt / split_cols; boff = (size_t)t * split_stride; colt -= t * split_cols; }
        const int col0 = colt + wc * 32 + 8 * fq;
#pragma unroll
        for (int ai = 0; ai < 2; ++ai)
#pragma unroll
            for (int m = 0; m < 4; ++m) { const size_t roff = boff + (size_t)(row0 + ai * HALF + m * 16) * ldc + col0;
#pragma unroll
                for (int bj = 0; bj < 2; ++bj) { const size_t off = roff + bj * HALF; f32x4 v0 = acc[ai][bj][m][0], v1 = acc[ai][bj][m][1];
                    if (mode == EB_SIGMOID) {
#pragma unroll
                        for (int i = 0; i < 4; ++i) { v0[i] = sigmoidf_(v0[i]); v1[i] = sigmoidf_(v1[i]); }
                    } else if (mode == EB_GATEMUL) { f32x4 a0, a1; unpack8(*(const u32x4*)(In1 + off), a0, a1); v0 = v0 * a0; v1 = v1 * a1; }
                    else if (mode == EB_MERGE) { f32x4 a0, a1, g0, g1; unpack8(*(const u32x4*)(In1 + off), a0, a1); unpack8(*(const u32x4*)(In2 + off), g0, g1); v0 = a0 + g0 * v0; v1 = a1 + g1 * v1; }
                    *(u32x4*)(O + off) = pack8(v0, v1); } }
    }
};
template <bool XSOUT = false> struct EpiF {
    static constexpr bool PERM = true, AFTER_DRAIN = false, PREFETCH = false;
    const float* base; float* out; const float* coef; bf16_t* XS; const float* avec; float* PS; PG8_LAS float* XL; float scale;
    __device__ __forceinline__ void operator()(f32x4 (&acc)[2][2][4][2], const Unit& u, int wr, int wc, int fr, int fq) const {
        const int row0 = u.pm * BM + wr * 64 + fr, col0 = u.pn * BM + wc * 32 + 8 * fq, bt = (u.pm * BM) / SEQ;
        const float* cf = coef + (size_t)bt * NMOD + col0;
        f32x4 cv[2][2], av[2][2];
#pragma unroll
        for (int bj = 0; bj < 2; ++bj)
#pragma unroll
            for (int n = 0; n < 2; ++n) { cv[bj][n] = *(const f32x4*)(cf + bj * HALF + n * 4) * scale; if (XSOUT) av[bj][n] = *(const f32x4*)(avec + bt * DM + col0 + bj * HALF + n * 4); }
        PG8_LAS float* P = XL;
        f32x4 pre[2][2][2];
#define EPIF_LOAD(slot, q) do { const size_t off_ = (size_t)(row0 + ((q) >> 2) * HALF + ((q) & 3) * 16) * DM + col0; \
            _Pragma("unroll") for (int bj = 0; bj < 2; ++bj) _Pragma("unroll") for (int n = 0; n < 2; ++n) pre[slot][bj][n] = *(const f32x4*)(base + off_ + bj * HALF + n * 4); } while (0)
#define EPIF_DO(slot, q) do { const int ai = (q) >> 2, m = (q) & 3; const size_t off = (size_t)(row0 + ai * HALF + m * 16) * DM + col0; float ss = 0.f; \
            _Pragma("unroll") for (int bj = 0; bj < 2; ++bj) { const f32x4 o0 = pre[slot][bj][0] + cv[bj][0] * acc[ai][bj][m][0], o1 = pre[slot][bj][1] + cv[bj][1] * acc[ai][bj][m][1]; \
                *(f32x4*)(out + off + bj * HALF) = o0; *(f32x4*)(out + off + bj * HALF + 4) = o1; \
                if (XSOUT) { ss += ((o0[0] * o0[0] + o0[1] * o0[1]) + (o0[2] * o0[2] + o0[3] * o0[3])) + ((o1[0] * o1[0] + o1[1] * o1[1]) + (o1[2] * o1[2] + o1[3] * o1[3])); \
                    *(u32x4*)(XS + off + bj * HALF) = pack8(o0 * av[bj][0], o1 * av[bj][1]); } } \
            if (XSOUT) { ss += __shfl_xor(ss, 16); ss += __shfl_xor(ss, 32); if (fq == 0) P[(ai * HALF + wr * 64 + m * 16 + fr) * 4 + wc] = ss; } } while (0)
        EPIF_LOAD(0, 0); EPIF_LOAD(1, 1);
        EPIF_DO(0, 0); EPIF_LOAD(0, 2); EPIF_DO(1, 1); EPIF_LOAD(1, 3); EPIF_DO(0, 2); EPIF_LOAD(0, 4); EPIF_DO(1, 3); EPIF_LOAD(1, 5);
        EPIF_DO(0, 4); EPIF_LOAD(0, 6); EPIF_DO(1, 5); EPIF_LOAD(1, 7); EPIF_DO(0, 6); EPIF_DO(1, 7);
#undef EPIF_LOAD
#undef EPIF_DO
        if (XSOUT) {
            asm volatile("s_waitcnt lgkmcnt(0)" ::: "memory"); __builtin_amdgcn_s_barrier(); asm volatile("" ::: "memory");
            const int tid = threadIdx.x;
            if (tid < BM) { const f32x4 p = *(const PG8_LAS f32x4*)(P + tid * 4); PS[(size_t)(u.pm * BM + tid) * 4 + u.pn] = (p[0] + p[1]) + (p[2] + p[3]); }
        }
    }
};

struct TwinOrder : StaticOrder {
    int reps;
    __device__ bool next(int i, Unit& u) const { if (i >= reps) return false; if (!StaticOrder::next(0, u)) return false; u.pn += 4 * i; return true; }
};
template <class Epi, class Sched, bool ALIGN_EPI = false, bool SP2 = false>
__device__ __forceinline__ void gemm_phase(PG8_LAS unsigned char* lds, const Gemm g, const Sched& S, Epi E) {
    const int tid = tid_opaque(), wid = __builtin_amdgcn_readfirstlane(tid >> 6), lane = tid & 63, wr = wid >> 2, wc = wid & 3, fr = lane & 15, fq = lane >> 4;
    const int K = g.K, nt = K / BK;
    unsigned voffA[2], voffB[2];
#pragma unroll
    for (int i = 0; i < 2; ++i) { int R, C; stage_rc(tid * 16 + i * 8192, R, C); const int Rb = Epi::PERM ? ((R & ~31) + perm32(R & 31)) : R;
        voffA[i] = (unsigned)(R * K + C) * 2u; voffB[i] = (unsigned)(Rb * K + C) * 2u; }
    const size_t kstep = (size_t)(BK * 2);
    const size_t hstep = (size_t)HALF * K * 2;
    const size_t tstep = 2 * hstep;
    const unsigned ldsw = (unsigned)wid * 1024u;
    const int aoff = lds_byte(wr * 64 + fr, fq * 8), boff = lds_byte(wc * 32 + fr, fq * 8);
#define PG8_SA(b, h) (((b) * 2 + (h)) * HTB)
#define PG8_SB(b, h) ((4 + (b) * 2 + (h)) * HTB)
#define PG8_STAGE(bufoff, gbase, voff) do { _Pragma("unroll") for (int _i = 0; _i < 2; ++_i) \
        __builtin_amdgcn_global_load_lds((const unsigned*)((const char*)(gbase) + (voff)[_i]), (PG8_LAS unsigned*)(lds + (bufoff) + ldsw + _i * 8192), 16, 0, 0); } while (0)
#define PG8_LDA(dst, b, h) do { _Pragma("unroll") for (int m = 0; m < 4; ++m) _Pragma("unroll") for (int k = 0; k < 2; ++k) dst[m][k] = *(const PG8_LAS bf16x8*)(lds + PG8_SA(b, h) + aoff + m * 2048 + k * 1024); } while (0)
#define PG8_LDB(dst, b, h) do { _Pragma("unroll") for (int n = 0; n < 2; ++n) _Pragma("unroll") for (int k = 0; k < 2; ++k) dst[n][k] = *(const PG8_LAS bf16x8*)(lds + PG8_SB(b, h) + boff + n * 2048 + k * 1024); } while (0)
#define PG8_MMA(ai, bj, At, Bt) do { __builtin_amdgcn_s_setprio(1); _Pragma("unroll") for (int m = 0; m < 4; ++m) _Pragma("unroll") for (int n = 0; n < 2; ++n) _Pragma("unroll") for (int k = 0; k < 2; ++k) \
        acc[ai][bj][m][n] = __builtin_amdgcn_mfma_f32_16x16x32_bf16(Bt[n][k], At[m][k], acc[ai][bj][m][n], 0, 0, 0); __builtin_amdgcn_s_setprio(0); } while (0)
#define PG8_WAIT_V(n) asm volatile("s_waitcnt vmcnt(" #n ")" ::: "memory")
#define PG8_WAIT_L(n) asm volatile("s_waitcnt lgkmcnt(" #n ")" ::: "memory")
#define PG8_BAR __builtin_amdgcn_s_barrier()
#define PG8_SCHED __builtin_amdgcn_sched_barrier(0)
    Unit cur, nxt; int ui = 0;
    if (!S.next(0, cur)) return;
    f32x4 acc[2][2][4][2];
#pragma unroll
    for (int a = 0; a < 2; ++a)
#pragma unroll
        for (int b = 0; b < 2; ++b)
#pragma unroll
            for (int m = 0; m < 4; ++m)
#pragma unroll
                for (int n = 0; n < 2; ++n) acc[a][b][m][n] = (f32x4){0.f, 0.f, 0.f, 0.f};
    bf16x8 At[4][2], B0[2][2], B1[2][2];
    const char* cA = (const char*)g.A + (size_t)cur.pm * tstep; const char* cB = (const char*)g.Bt + (size_t)cur.pn * tstep;
    S.a_ready(cur);
    if constexpr (Epi::PREFETCH) E.prefetch(cur, wid, 0);
    if constexpr (SP2) {
        PG8_STAGE(PG8_SB(0, 0), cB, voffB); PG8_STAGE(PG8_SB(0, 1), cB + hstep, voffB); PG8_STAGE(PG8_SA(0, 0), cA, voffA); PG8_STAGE(PG8_SA(0, 1), cA + hstep, voffA);
        if (wr == 1) PG8_BAR;
        PG8_WAIT_V(2); PG8_BAR;
        PG8_STAGE(PG8_SB(1, 0), cB + kstep, voffB); PG8_STAGE(PG8_SA(1, 0), cA + kstep, voffA); PG8_STAGE(PG8_SB(1, 1), cB + hstep + kstep, voffB);
        PG8_WAIT_V(6); PG8_BAR;
    } else {
        PG8_STAGE(PG8_SB(0, 0), cB, voffB); PG8_STAGE(PG8_SA(0, 0), cA, voffA); PG8_STAGE(PG8_SB(0, 1), cB + hstep, voffB); PG8_STAGE(PG8_SA(0, 1), cA + hstep, voffA);
        if (wr == 1) PG8_BAR;
        PG8_WAIT_V(4); PG8_BAR;
        PG8_STAGE(PG8_SB(1, 0), cB + kstep, voffB); PG8_STAGE(PG8_SA(1, 0), cA + kstep, voffA); PG8_STAGE(PG8_SB(1, 1), cB + hstep + kstep, voffB);
        PG8_WAIT_V(6); PG8_BAR;
    }
    for (;;) {
        const bool has_next = S.next(ui + 1, nxt);
        const char* nA = has_next ? (const char*)g.A + (size_t)nxt.pm * tstep : cA; const char* nB = has_next ? (const char*)g.Bt + (size_t)nxt.pn * tstep : cB;
        for (int t = 0; t < nt; t += 2) {
            const bool last = (t == nt - 2);
            const char* a1 = cA + (size_t)(t + 1) * kstep;
            const char* a2 = last ? nA : cA + (size_t)(t + 2) * kstep; const char* b2 = last ? nB : cB + (size_t)(t + 2) * kstep;
            const char* a3 = a2 + kstep; const char* b3 = b2 + kstep;
            if (last && has_next) S.a_ready(nxt);
            if constexpr (SP2) {
            PG8_LDB(B0, 0, 0); PG8_LDB(B1, 0, 1); PG8_SCHED; PG8_LDA(At, 0, 0); PG8_STAGE(PG8_SA(1, 1), a1 + hstep, voffA);
            PG8_WAIT_V(8); PG8_WAIT_L(0); PG8_BAR; PG8_MMA(0, 0, At, B0); PG8_MMA(0, 1, At, B1); PG8_BAR; PG8_SCHED;
            PG8_LDA(At, 0, 1); PG8_STAGE(PG8_SB(0, 0), b2, voffB); PG8_STAGE(PG8_SB(0, 1), b2 + hstep, voffB); PG8_STAGE(PG8_SA(0, 0), a2, voffA);
            PG8_WAIT_V(8); PG8_WAIT_L(0); PG8_BAR; PG8_MMA(1, 0, At, B0); PG8_MMA(1, 1, At, B1); PG8_BAR; PG8_SCHED;
            PG8_LDB(B0, 1, 0); PG8_LDB(B1, 1, 1); PG8_SCHED; PG8_LDA(At, 1, 0); PG8_STAGE(PG8_SA(0, 1), a2 + hstep, voffA);
            PG8_WAIT_V(8); PG8_WAIT_L(0); PG8_BAR; PG8_MMA(0, 0, At, B0); PG8_MMA(0, 1, At, B1); PG8_BAR; PG8_SCHED;
            PG8_LDA(At, 1, 1); PG8_STAGE(PG8_SB(1, 0), b3, voffB); PG8_STAGE(PG8_SB(1, 1), b3 + hstep, voffB); PG8_STAGE(PG8_SA(1, 0), a3, voffA);
            PG8_WAIT_V(8); PG8_WAIT_L(0); PG8_BAR; PG8_MMA(1, 0, At, B0); PG8_MMA(1, 1, At, B1); PG8_BAR; PG8_SCHED;
            } else {
            PG8_LDB(B0, 0, 0); PG8_SCHED; PG8_LDA(At, 0, 0); PG8_STAGE(PG8_SA(1, 1), a1 + hstep, voffA);
            PG8_WAIT_L(8); PG8_BAR; PG8_WAIT_L(0); PG8_MMA(0, 0, At, B0); PG8_BAR; PG8_SCHED;
            PG8_LDB(B1, 0, 1); PG8_STAGE(PG8_SB(0, 0), b2, voffB);
            PG8_BAR; PG8_WAIT_L(0); PG8_MMA(0, 1, At, B1); PG8_BAR;
            PG8_LDA(At, 0, 1); PG8_STAGE(PG8_SA(0, 0), a2, voffA);
            PG8_BAR; PG8_WAIT_L(0); PG8_MMA(1, 0, At, B0); PG8_BAR; PG8_SCHED;
            PG8_STAGE(PG8_SB(0, 1), b2 + hstep, voffB);
            PG8_WAIT_V(6); PG8_BAR; PG8_MMA(1, 1, At, B1); PG8_BAR;
            PG8_LDB(B0, 1, 0); PG8_SCHED; PG8_LDA(At, 1, 0); PG8_STAGE(PG8_SA(0, 1), a2 + hstep, voffA);
            PG8_WAIT_L(8); PG8_BAR; PG8_WAIT_L(0); PG8_MMA(0, 0, At, B0); PG8_BAR; PG8_SCHED;
            PG8_LDB(B1, 1, 1); PG8_STAGE(PG8_SB(1, 0), b3, voffB);
            PG8_BAR; PG8_WAIT_L(0); PG8_MMA(0, 1, At, B1); PG8_BAR;
            PG8_LDA(At, 1, 1); PG8_STAGE(PG8_SA(1, 0), a3, voffA);
            PG8_BAR; PG8_WAIT_L(0); PG8_MMA(1, 0, At, B0); PG8_BAR; PG8_SCHED;
            PG8_STAGE(PG8_SB(1, 1), b3 + hstep, voffB);
            PG8_WAIT_V(6); PG8_BAR; PG8_MMA(1, 1, At, B1); PG8_BAR;
            }
        }
        if constexpr (ALIGN_EPI) { if (wr == 0) PG8_BAR; }
        if constexpr (!Epi::AFTER_DRAIN) { if constexpr (Epi::PREFETCH) { E.par = ui & 1; } E(acc, cur, wr, wc, fr, fq); S.done(cur); }
        if (!has_next) break;
        if constexpr (Epi::PREFETCH) E.prefetch(nxt, wid, (ui + 1) & 1);
#pragma unroll
        for (int a = 0; a < 2; ++a)
#pragma unroll
            for (int b = 0; b < 2; ++b)
#pragma unroll
                for (int m = 0; m < 4; ++m)
#pragma unroll
                    for (int n = 0; n < 2; ++n) acc[a][b][m][n] = (f32x4){0.f, 0.f, 0.f, 0.f};
        cur = nxt; cA = nA; cB = nB; ++ui;
        if constexpr (ALIGN_EPI) { if (wr == 1) PG8_BAR; }
    }
    PG8_WAIT_V(0);
    if constexpr (!ALIGN_EPI) { if (wr == 0) PG8_BAR; }
    PG8_BAR;
    if constexpr (Epi::AFTER_DRAIN) { E.fused(acc, cur, wr, wc, fr, fq, lds, wid, lane); S.done(cur); }
#undef PG8_SA
#undef PG8_SB
#undef PG8_STAGE
#undef PG8_LDA
#undef PG8_LDB
#undef PG8_MMA
#undef PG8_WAIT_V
#undef PG8_WAIT_L
#undef PG8_BAR
#undef PG8_SCHED
}
}

namespace attn {
constexpr int D = 128;
constexpr int WINDOW = 129;
constexpr float THR = 8.f;
constexpr bool WSKIP = true;
constexpr float SCALE = 0.08838834764831845f;
constexpr int NW = 8, QBLK = 32, KVBLK = 64, QB = NW * QBLK;
constexpr int SHM_V = KVBLK * D * 2, SHM_K = KVBLK * D * 2;
constexpr int LDS_BYTES = 2 * SHM_V + 2 * SHM_K + NW * 64 * 4;
using bf16 = __hip_bfloat16;
typedef short bf16x8 __attribute__((ext_vector_type(8)));
typedef short s16x4 __attribute__((ext_vector_type(4)));
typedef float f32x16 __attribute__((ext_vector_type(16)));
typedef float f32x4 __attribute__((ext_vector_type(4)));
typedef unsigned u32x4 __attribute__((ext_vector_type(4)));
template <class A, class Bt> struct same_t { static constexpr bool v = false; };
template <class A> struct same_t<A, A> { static constexpr bool v = true; };

#define KSWZ(row, colB) ((row) * 256 + ((colB) ^ (((row) & 7) << 4)))
#define SBAR() __builtin_amdgcn_sched_barrier(0)
__device__ __forceinline__ int v_st(int k, int c) { const int kk = (k & ~0xC) | ((k & 4) << 1) | ((k & 8) >> 1); return ((kk >> 3) * 4 + (c >> 5)) * 512 + ((kk & 7) * 32 + (c & 31)) * 2; }
__device__ __forceinline__ int v_rd_base(int lane) { return ((lane & 3) << 3) | (((lane >> 2) & 3) << 6) | (((lane >> 4) & 1) << 5) | (((lane >> 5) & 1) << 8); }
constexpr int v_rd_off(int d0, int ks, int half) { return d0 * 512 + ks * 4096 + half * 2048; }
__device__ __forceinline__ int crow(int r, int hi) { return (r & 3) + 8 * (r >> 2) + 4 * hi; }
__device__ __forceinline__ unsigned cvtpk(float lo, float hi) {
    unsigned r; asm volatile("v_cvt_pk_bf16_f32 %0, %1, %2" : "=v"(r) : "v"(lo), "v"(hi)); return r;
}
__device__ __forceinline__ bf16x8 pack8(f32x4 a, f32x4 b) {
    u32x4 w = {cvtpk(a[0], a[1]), cvtpk(a[2], a[3]), cvtpk(b[0], b[1]), cvtpk(b[2], b[3])};
    return *reinterpret_cast<bf16x8*>(&w);
}
template <class T> __device__ __forceinline__ bf16x8 load8(const T* p) {
    if constexpr (same_t<T, float>::v) { return pack8(*(const f32x4*)p, *(const f32x4*)(p + 4)); }
    else { return *reinterpret_cast<const bf16x8*>(p); }
}
__device__ __forceinline__ void mask_tile(f32x16& p0, f32x16& p1, int dq, unsigned W) {
    const float NEG = -__builtin_inff();
#pragma unroll
    for (int r = 0; r < 16; ++r) {
        const int c = (r & 3) + 8 * (r >> 2);
        if ((unsigned)(dq - c) >= W) p0[r] = NEG;
        if ((unsigned)(dq - c - 32) >= W) p1[r] = NEG;
    }
}
__device__ __forceinline__ void partialSM(f32x16& p0, f32x16& p1, float& m_reg, float& mn, float& alpha) {
    float pmax = p0[0]; for (int r = 1; r < 16; ++r) pmax = fmaxf(pmax, p0[r]); for (int r = 0; r < 16; ++r) pmax = fmaxf(pmax, p1[r]);
    { auto rr = __builtin_amdgcn_permlane32_swap(__float_as_uint(pmax), __float_as_uint(pmax), false, false);
      pmax = fmaxf(__uint_as_float(rr[0]), __uint_as_float(rr[1])); }
    constexpr float C2 = 1.4426950408889634f * SCALE;
    if (__builtin_expect(__all((pmax - m_reg) * SCALE <= THR), 1)) { mn = m_reg; alpha = 1.f; }
    else { mn = fmaxf(m_reg, pmax); alpha = __builtin_amdgcn_exp2f((m_reg - mn) * C2); m_reg = mn; }
    const float mnL = -mn * C2;
    for (int r = 0; r < 16; ++r) p0[r] = fmaf(p0[r], C2, mnL); for (int r = 0; r < 16; ++r) p1[r] = fmaf(p1[r], C2, mnL);
    for (int r = 0; r < 16; ++r) p0[r] = __builtin_amdgcn_exp2f(p0[r]);
}
__device__ __forceinline__ void finishSM(f32x16& p0, f32x16& p1, float alpha, float& l_reg, bf16x8& pa0, bf16x8& pa1, bf16x8& pa2, bf16x8& pa3) {
    for (int r = 0; r < 16; ++r) p1[r] = __builtin_amdgcn_exp2f(p1[r]);
    float ps = 0; for (int r = 0; r < 16; ++r) ps += p0[r]; for (int r = 0; r < 16; ++r) ps += p1[r];
    { auto rr = __builtin_amdgcn_permlane32_swap(__float_as_uint(ps), __float_as_uint(ps), false, false);
      ps = __uint_as_float(rr[0]) + __uint_as_float(rr[1]); }
    l_reg = l_reg * alpha + ps;
#define PK4(P, B_, OUT) do { unsigned a0 = cvtpk(P[B_+0], P[B_+1]), a1 = cvtpk(P[B_+2], P[B_+3]);                          \
        unsigned b0 = cvtpk(P[B_+4], P[B_+5]), b1 = cvtpk(P[B_+6], P[B_+7]);                                             \
        auto r0 = __builtin_amdgcn_permlane32_swap(a0, b0, false, false); auto r1 = __builtin_amdgcn_permlane32_swap(a1, b1, false, false); \
        u32x4 w = {r0[0], r1[0], r0[1], r1[1]}; OUT = *reinterpret_cast<bf16x8*>(&w); } while (0)
    PK4(p0, 0, pa0); PK4(p0, 8, pa1); PK4(p1, 0, pa2); PK4(p1, 8, pa3);
#undef PK4
}
template <int KB, bool SK>
__device__ __forceinline__ void qkt(f32x16& p0, f32x16& p1, const char* K_lds, int r32, int hi, const bf16x8* qr, bool act) {
    if (SK && !act) { const float NEG = -__builtin_inff();
#pragma unroll
        for (int r = 0; r < 16; ++r) { p0[r] = NEG; p1[r] = NEG; } return; }
    p0 = f32x16{}; p1 = f32x16{};
    const char* kb[4];
#pragma unroll
    for (int dd = 0; dd < 4; ++dd) kb[dd] = K_lds + KB * SHM_K + KSWZ(r32, (dd * 16 + hi * 8) * 2);
#pragma unroll
    for (int d0 = 0; d0 < 8; ++d0) { const char* a = kb[d0 & 3] + (d0 >> 2) * 128;
        bf16x8 b0 = *reinterpret_cast<const bf16x8*>(a);
        bf16x8 b1 = *reinterpret_cast<const bf16x8*>(a + 32 * 256);
        p0 = __builtin_amdgcn_mfma_f32_32x32x16_bf16(b0, qr[d0], p0, 0, 0, 0);
        p1 = __builtin_amdgcn_mfma_f32_32x32x16_bf16(b1, qr[d0], p1, 0, 0, 0); }
}
template <int VB, bool SK>
__device__ __forceinline__ void pv_tile(f32x16* o, int vb0, bf16x8 pa0, bf16x8 pa1, bf16x8 pa2, bf16x8 pa3, bool act) {
    if (SK && !act) return;
#define TRRD(dst, off) asm volatile("ds_read_b64_tr_b16 %0, %1 offset:%2" : "=&v"(dst) : "v"(vb0), "i"(off) : "memory")
#define PV_D0(d0) do { s16x4 l0, l1, l2, l3, h0, h1, h2, h3; constexpr int b_ = VB * SHM_V + v_rd_off(d0, 0, 0);     \
        TRRD(l0, b_); TRRD(h0, b_ + 2048); TRRD(l1, b_ + 4096); TRRD(h1, b_ + 6144); TRRD(l2, b_ + 8192); TRRD(h2, b_ + 10240); TRRD(l3, b_ + 12288); TRRD(h3, b_ + 14336); \
        asm volatile("s_waitcnt lgkmcnt(0)" ::: "memory"); SBAR();                 \
        o[d0] = __builtin_amdgcn_mfma_f32_32x32x16_bf16(pa0, (bf16x8){l0[0], l0[1], l0[2], l0[3], h0[0], h0[1], h0[2], h0[3]}, o[d0], 0, 0, 0);   \
        o[d0] = __builtin_amdgcn_mfma_f32_32x32x16_bf16(pa1, (bf16x8){l1[0], l1[1], l1[2], l1[3], h1[0], h1[1], h1[2], h1[3]}, o[d0], 0, 0, 0);   \
        o[d0] = __builtin_amdgcn_mfma_f32_32x32x16_bf16(pa2, (bf16x8){l2[0], l2[1], l2[2], l2[3], h2[0], h2[1], h2[2], h2[3]}, o[d0], 0, 0, 0);   \
        o[d0] = __builtin_amdgcn_mfma_f32_32x32x16_bf16(pa3, (bf16x8){l3[0], l3[1], l3[2], l3[3], h3[0], h3[1], h3[2], h3[3]}, o[d0], 0, 0, 0); } while (0)
    PV_D0(0); PV_D0(1); PV_D0(2); PV_D0(3);
#undef PV_D0
#undef TRRD
}

template <class TIn, class TOut> struct BlockRef { const TIn* Q; const TIn* K; const TIn* V; TOut* O; float* LSE; int P0; int rs; int ls; };
template <class TIn> struct Seam {
    bf16x8 qr[8];
    bf16x8 st_v0, st_v1, st_k0, st_k1; f32x4 sf0, sf1, sf2, sf3;
    f32x4 tq[16];
};
__device__ __forceinline__ int swa_jlo(int P0, int W) { const int lowk = P0 - W + 1; return lowk > 0 ? lowk / KVBLK : 0; }
#define ROW(p, k0, rr, rs_) ((p) + (size_t)((k0) + (rr)) * (size_t)(rs_) + sc)
#define VMW() asm volatile("s_waitcnt vmcnt(0)" ::: "memory")
#define VMWN(n) asm volatile("s_waitcnt vmcnt(%0)" :: "i"(n) : "memory")
#define SLOAD_H(Kp, Vp, k0, rs_) do { S.st_v0 = load8<TIn>(ROW(Vp, k0, sr, rs_)); S.st_v1 = load8<TIn>(ROW(Vp, k0, 32 + sr, rs_));              \
                         S.st_k0 = load8<TIn>(ROW(Kp, k0, sr, rs_)); S.st_k1 = load8<TIn>(ROW(Kp, k0, 32 + sr, rs_)); } while (0)
#define SWRITE_HK(bf) do { *(bf16x8*)(K_lds + (bf) * SHM_K + kws) = S.st_k0; *(bf16x8*)(K_lds + (bf) * SHM_K + kws + 32 * 256) = S.st_k1; } while (0)
#define SWRITE_HV(bf) do { *(bf16x8*)(V_lds + (bf) * SHM_V + vst0) = S.st_v0; *(bf16x8*)(V_lds + (bf) * SHM_V + vst1) = S.st_v1; } while (0)
#define SWRITE_H(bf) do { SWRITE_HV(bf); SWRITE_HK(bf); } while (0)
#define SLOAD_F(p, k0) do { } while (0)
#define SWRITE_KF(bf) do { *(bf16x8*)(K_lds + (bf) * SHM_K + kws) = pack8(S.sf0, S.sf1); *(bf16x8*)(K_lds + (bf) * SHM_K + kws + 32 * 256) = pack8(S.sf2, S.sf3); } while (0)
#define SWRITE_VF(bf) do { *(bf16x8*)(V_lds + (bf) * SHM_V + vst0) = pack8(S.sf0, S.sf1); *(bf16x8*)(V_lds + (bf) * SHM_V + vst1) = pack8(S.sf2, S.sf3); } while (0)
template <class TIn, class TOut>
__device__ __forceinline__ void causal_swa_prime(const BlockRef<TIn, TOut>& cur, int W, char* lds, Seam<TIn>& S) {
    constexpr bool F32 = same_t<TIn, float>::v;
    const int tid = tid_opaque(), wid = __builtin_amdgcn_readfirstlane(tid >> 6), lane = tid & 63, r32 = lane & 31, hi = lane >> 5;
    const int sr = tid >> 4, sc = (tid & 15) * 8, kws = KSWZ(sr, sc * 2); char* K_lds = lds + 2 * SHM_V;
    const int kb0 = swa_jlo(cur.P0, W) * KVBLK;
    for (int d0 = 0; d0 < 8; ++d0) S.qr[d0] = load8<TIn>(cur.Q + (size_t)(wid * QBLK + r32) * (size_t)cur.rs + d0 * 16 + hi * 8);
    if constexpr (F32) { SLOAD_F((const float*)cur.K, kb0); VMW(); SWRITE_KF(0); SBAR(); SLOAD_F((const float*)cur.V, kb0); }
    else { SLOAD_H(cur.K, cur.V, kb0, cur.rs); VMW(); SWRITE_HK(0); }
    __syncthreads();
}
template <class TIn, class TOut>
__device__ __forceinline__ void causal_swa_block(const BlockRef<TIn, TOut>& cur, const BlockRef<TIn, TOut>& nxt, int skv, int W, char* lds, Seam<TIn>& S) {
    constexpr bool F32 = same_t<TIn, float>::v;
    const int tid = tid_opaque(), wid = __builtin_amdgcn_readfirstlane(tid >> 6), lane = tid & 63, r32 = lane & 31, hi = lane >> 5;
    const int j_lo = swa_jlo(cur.P0, W);
    int j_hi = (cur.P0 + QB - 1) / KVBLK + 1; if (j_hi > skv / KVBLK) j_hi = skv / KVBLK;
    const int NT = j_hi - j_lo;
    const int kbn = swa_jlo(nxt.P0, W) * KVBLK;
    const int qlo = cur.P0 + wid * QBLK, qm = qlo + r32 - 4 * hi;
    char* V_lds = lds; char* K_lds = lds + 2 * SHM_V;
    float* ws = (float*)(lds + 2 * SHM_V + 2 * SHM_K) + wid * 64; float* li_l = ws, * al_l = ws + 32;
    float m_reg = -1e30f, l_reg = 0; f32x16 o[4] = {};
    const int sr = tid >> 4, sc = (tid & 15) * 8, vst0 = v_st(sr, sc), vst1 = v_st(32 + sr, sc), kws = KSWZ(sr, sc * 2);
    const int vb0 = (int)(uintptr_t)V_lds + v_rd_base(lane);
    const TIn* Kh = cur.K; const TIn* Vh = cur.V;
#define RESC(a) do { if (__any((a) < 1.f)) { if (hi == 0) al_l[r32] = (a); asm volatile("s_waitcnt lgkmcnt(0)" ::: "memory");              \
                     for (int d_ = 0; d_ < 4; ++d_) for (int r = 0; r < 16; ++r) o[d_][r] *= al_l[crow(r, hi)]; } } while (0)
#define KBASE(t) ((j_lo + (t)) * KVBLK)
#define ACT(t) (KBASE(t) <= qlo + QBLK - 1 && KBASE(t) + KVBLK - 1 >= qlo - W + 1)
#define MASKT(P0_, P1_, t) do { const int kb_ = KBASE(t); if ((!SK || ACT(t)) && (kb_ + KVBLK - 1 > qlo || kb_ <= qlo + QBLK - 1 - W)) mask_tile(P0_, P1_, qm - kb_, (unsigned)W); } while (0)
    constexpr int NQL = F32 ? 16 : 8;
    constexpr bool SK = WSKIP && !F32;
#define SEAM_K0() do { VMWN(NQL); if constexpr (F32) { SWRITE_KF(0); SBAR(); SLOAD_F((const float*)nxt.V, kbn); } else { SWRITE_HK(0); } SBAR(); } while (0)
    f32x16 pA0, pA1, pB0, pB1; float mnA, mnB, alA, alB; bf16x8 pa0, pa1, pa2, pa3;
    if constexpr (F32) { VMW(); SWRITE_VF(0); SBAR(); } else { SWRITE_HV(0); SBAR(); }
    if (NT > 1) { if constexpr (F32) SLOAD_F((const float*)Kh, KBASE(1)); else SLOAD_H(Kh, Vh, KBASE(1), cur.rs); }
    SBAR(); qkt<0, SK>(pA0, pA1, K_lds, r32, hi, S.qr, ACT(0));
    if constexpr (F32) { if (NT > 1) { VMW(); SWRITE_KF(1); SBAR(); SLOAD_F((const float*)Vh, KBASE(1)); } }
    MASKT(pA0, pA1, 0); partialSM(pA0, pA1, m_reg, mnA, alA);
    if (NT > 1) { VMW(); if constexpr (F32) { SWRITE_VF(1); SBAR(); if (NT > 2) SLOAD_F((const float*)Kh, KBASE(2)); } else SWRITE_H(1); }
    __syncthreads();
#define HALF_STEP(PX0, PX1, mnX, alX, PY0, PY1, alY, t, KB, VB, SB) do {                                                      \
        SBAR(); qkt<KB, SK>(PX0, PX1, K_lds, r32, hi, S.qr, ACT(t));                                             \
        finishSM(PY0, PY1, alY, l_reg, pa0, pa1, pa2, pa3); SBAR();                                                           \
        if ((t) + 1 < NT) { if constexpr (F32) { VMW(); SWRITE_KF(SB); SBAR(); SLOAD_F((const float*)Vh, KBASE((t) + 1)); }  \
                            else { SLOAD_H(Kh, Vh, KBASE((t) + 1), cur.rs); } SBAR(); }                                               \
        pv_tile<VB, SK>(o, vb0, pa0, pa1, pa2, pa3, ACT((t) - 1)); MASKT(PX0, PX1, (t)); partialSM(PX0, PX1, m_reg, mnX, alX);                                        \
        __syncthreads();                                                                                                      \
        if ((t) + 1 < NT) { VMW(); if constexpr (F32) { SWRITE_VF(SB); SBAR(); if ((t) + 2 < NT) SLOAD_F((const float*)Kh, KBASE((t) + 2)); } \
                            else { SWRITE_H(SB); } }                                                                          \
        RESC(alX); __syncthreads(); } while (0)
    for (int t = 1; t + 1 < NT; t += 2) {
        HALF_STEP(pB0, pB1, mnB, alB, pA0, pA1, alA, t, 1, 0, 0);
        HALF_STEP(pA0, pA1, mnA, alA, pB0, pB1, alB, t + 1, 0, 1, 1);
    }
    const bool even = (NT & 1) == 0;
    if (even) { SBAR(); qkt<1, SK>(pB0, pB1, K_lds, r32, hi, S.qr, ACT(NT - 1)); SBAR(); }
#define QROW(e) (nxt.Q + (size_t)(wid * QBLK + r32) * (size_t)nxt.rs + ((e) >> 1) * 16 + hi * 8 + ((e) & 1) * 4)
    if constexpr (F32) { SLOAD_F((const float*)nxt.K, kbn); SBAR();
#pragma unroll
        for (int e = 0; e < 8; ++e) S.tq[e] = *(const f32x4*)QROW(e); }
    else { SLOAD_H(nxt.K, nxt.V, kbn, nxt.rs); SBAR();
#pragma unroll
        for (int d0 = 0; d0 < 8; ++d0) S.qr[d0] = load8<TIn>(nxt.Q + (size_t)(wid * QBLK + r32) * (size_t)nxt.rs + d0 * 16 + hi * 8); }
    SBAR();
    finishSM(pA0, pA1, alA, l_reg, pa0, pa1, pa2, pa3); SBAR();
    if constexpr (F32) {
#pragma unroll
        for (int e = 8; e < 16; ++e) S.tq[e] = *(const f32x4*)QROW(e); SBAR(); }
#undef QROW
    pv_tile<0, SK>(o, vb0, pa0, pa1, pa2, pa3, ACT(even ? NT - 2 : NT - 1));
    if (even) { MASKT(pB0, pB1, NT - 1); partialSM(pB0, pB1, m_reg, mnB, alB); __syncthreads(); RESC(alB);
        finishSM(pB0, pB1, alB, l_reg, pa0, pa1, pa2, pa3); SBAR(); pv_tile<1, SK>(o, vb0, pa0, pa1, pa2, pa3, ACT(NT - 1)); }
    SBAR(); SEAM_K0();
    if (hi == 0) li_l[r32] = l_reg; asm volatile("s_waitcnt lgkmcnt(0)" ::: "memory");
    float rli[16];
#pragma unroll
    for (int r = 0; r < 16; ++r) rli[r] = __builtin_amdgcn_rcpf(li_l[crow(r, hi)]);
    TOut* Ow = cur.O + (size_t)(wid * QBLK) * (size_t)cur.rs;
    if (hi == 0) cur.LSE[(size_t)(wid * QBLK + r32) * (size_t)cur.ls] = m_reg * SCALE + __logf(l_reg);
#pragma unroll
    for (int r = 0; r < 16; ++r) { const int orow = crow(r, hi);
#pragma unroll
        for (int d0 = 0; d0 < 4; ++d0) { const float v = o[d0][r] * rli[r];
            if constexpr (same_t<TOut, float>::v) { Ow[(size_t)orow * (size_t)cur.rs + d0 * 32 + r32] = v; }
            else { const float vn = __shfl_xor(v, 1);
                   if ((r32 & 1) == 0) *(unsigned*)(Ow + (size_t)orow * (size_t)cur.rs + d0 * 32 + r32) = cvtpk(v, vn); } } }
    if constexpr (F32) {
#pragma unroll
        for (int d0 = 0; d0 < 8; ++d0) S.qr[d0] = pack8(S.tq[2 * d0], S.tq[2 * d0 + 1]); }
    __syncthreads();
#undef RESC
#undef KBASE
#undef ACT
#undef MASKT
#undef SEAM_K0
#undef HALF_STEP
}
#undef ROW
#undef VMW
#undef VMWN
#undef SLOAD_H
#undef SWRITE_HK
#undef SWRITE_HV
#undef SWRITE_H
#undef SLOAD_F
#undef SWRITE_KF
#undef SWRITE_VF

#undef SBAR
}
#define GAS __attribute__((address_space(1)))
#define LAS __attribute__((address_space(3)))
typedef unsigned short bf16;
typedef unsigned v4u __attribute__((ext_vector_type(4)));
typedef float f32x4 __attribute__((ext_vector_type(4)));
typedef short bf16x8 __attribute__((ext_vector_type(8)));
typedef GAS unsigned gu32;
typedef GAS unsigned long long gu64;
#define RLX_AGENT __ATOMIC_RELAXED, __HIP_MEMORY_SCOPE_AGENT
#define LDS_WAIT() asm volatile("s_waitcnt lgkmcnt(0)" ::: "memory")
#define VM_WAIT() asm volatile("s_waitcnt vmcnt(0)" ::: "memory")
__device__ __forceinline__ unsigned long long rt() { return __builtin_amdgcn_s_memrealtime(); }
__device__ __forceinline__ unsigned f2bf(float f) { unsigned u = __builtin_bit_cast(unsigned, f); return (u + 0x7fffu + ((u >> 16) & 1u)) >> 16; }
__device__ __forceinline__ unsigned pk2(float lo, float hi) { return f2bf(lo) | (f2bf(hi) << 16); }

#define XB_TMO      128
#define XB_XCNT(j)  (256  + 64 * (j))
#define XB_XSUB(j)  (1280 + 64 * (j))
#define XB_XGEN(j)  (2304 + 64 * (j))
#define XB_TOP      3328
#define XB_TOPGEN   3392
#define XCD_BAR_WORDS 3456
#define XB_SPIN_CAP (1u << 18)

__device__ __forceinline__ unsigned xb_ld(unsigned* p)              { return __hip_atomic_load(p, __ATOMIC_RELAXED, __HIP_MEMORY_SCOPE_AGENT); }
__device__ __forceinline__ unsigned xb_add(unsigned* p, unsigned v) { return __hip_atomic_fetch_add(p, v, __ATOMIC_RELAXED, __HIP_MEMORY_SCOPE_AGENT); }
__device__ __forceinline__ unsigned xb_xcc_id() { return (unsigned)__builtin_amdgcn_s_getreg((3 << 11) | 20) & 0xFu; }
#define XB_SPIN(cond, bar) do { unsigned _sp = 0; while (cond) { __builtin_amdgcn_s_sleep(1); \
    if ((++_sp & 255u) == 0u) { if (xb_ld(&(bar)[XB_TMO])) break; if (_sp > XB_SPIN_CAP) { atomicAdd(&(bar)[XB_TMO], 1u); break; } } } } while (0)

struct XcdBarrier {
    unsigned* bar; unsigned x;
    volatile LAS unsigned* st;
};

__device__ __forceinline__ XcdBarrier xcd_barrier_post(unsigned* bar, volatile LAS unsigned* st) {
    XcdBarrier b; b.bar = bar; b.x = xb_xcc_id(); b.st = st;
    if (threadIdx.x == 0) (void)xb_add(&bar[XB_XCNT(b.x)], 1u);
    return b;
}
__device__ __forceinline__ void xcd_barrier_complete(unsigned* bar, unsigned x, unsigned& nloc, unsigned& nx) {
    const unsigned G = gridDim.x * gridDim.y * gridDim.z;
    unsigned sum, cnt, mine, sp = 0u;
    for (;;) {
        sum = 0u; cnt = 0u; mine = 0u;
#pragma unroll
        for (unsigned j = 0; j < 16; ++j) { const unsigned c = xb_ld(&bar[XB_XCNT(j)]); sum += c; cnt += (c > 0u) ? 1u : 0u; mine = (j == x) ? c : mine; }
        if (sum == G) break;
        __builtin_amdgcn_s_sleep(1);
        if ((++sp & 255u) == 0u) { if (xb_ld(&bar[XB_TMO])) break; if (sp > XB_SPIN_CAP) { atomicAdd(&bar[XB_TMO], 1u); break; } }
    }
    nloc = mine > 0u ? mine : 1u; nx = cnt > 0u ? cnt : 1u;
}

__device__ __forceinline__ void xcd_barrier(const XcdBarrier& b) {
    asm volatile("s_waitcnt vmcnt(0)" ::: "memory");
    __syncthreads();
    if (threadIdx.x == 0) {
        unsigned* bar = b.bar;
        __builtin_amdgcn_s_waitcnt(0);
        unsigned nloc = b.st[0], nx = b.st[1];
        if (nloc == 0u) { xcd_barrier_complete(bar, b.x, nloc, nx); b.st[0] = nloc; b.st[1] = nx; }
        const unsigned old = xb_add(&bar[XB_XSUB(b.x)], 1u);
        const unsigned gen = old / nloc;
        if (old + 1u == (gen + 1u) * nloc) {
            __builtin_amdgcn_fence(__ATOMIC_RELEASE, "agent");
            asm volatile("s_waitcnt vmcnt(0)" ::: "memory");
            const unsigned og = xb_add(&bar[XB_TOP], 1u);
            const unsigned tg = og / nx;
            if (og + 1u == (tg + 1u) * nx) xb_add(&bar[XB_TOPGEN], 1u);
            else XB_SPIN(xb_ld(&bar[XB_TOPGEN]) == tg, bar);
            __builtin_amdgcn_fence(__ATOMIC_ACQUIRE, "agent");
            xb_add(&bar[XB_XGEN(b.x)], 1u);
            asm volatile("s_waitcnt vmcnt(0)" ::: "memory");
        } else {
            XB_SPIN(xb_ld(&bar[XB_XGEN(b.x)]) == gen, bar);
            __builtin_amdgcn_fence(__ATOMIC_ACQUIRE, "agent");
            asm volatile("s_waitcnt vmcnt(0)" ::: "memory");
        }
    }
    __syncthreads();
}

constexpr int NWAVES = 8;

constexpr size_t MiB = 1u << 20, HMiB = 1u << 19;
constexpr size_t WS_CTL = 0, CTL_ZERO_BYTES = 64 * 1024;
constexpr size_t WS_MOD = 1 * MiB;
constexpr size_t WS_AVEC = WS_MOD + 80 * 1024;
constexpr size_t WS_BIAS_IN = WS_MOD + 96 * 1024;
constexpr size_t WS_BIAS_F2 = WS_MOD + 176 * 1024;
constexpr size_t WS_PS2 = WS_MOD + 256 * 1024, WS_PS3 = WS_MOD + 512 * 1024;
constexpr size_t WS_WGU1 = 2 * MiB;
constexpr size_t WS_WD1 = WS_WGU1 + 11 * MiB;
constexpr size_t WS_WIN = WS_WD1 + 11 * HMiB;
constexpr size_t WS_WA = WS_WIN + 19 * MiB;
constexpr size_t WS_WC = WS_WA + 1 * MiB;
constexpr size_t WS_WO = WS_WC + 2 * MiB;
constexpr size_t WS_WGU2 = WS_WO + 2 * MiB;
constexpr size_t WS_WD2 = WS_WGU2 + 11 * MiB;
constexpr size_t WS_XS = WS_WD2 + 11 * HMiB;
constexpr size_t WS_R = WS_XS + 32 * MiB;
constexpr size_t WS_ACT = WS_R;
constexpr size_t WS_Q = WS_R, WS_K = WS_R + 48 * MiB, WS_V = WS_R + 96 * MiB;
constexpr size_t WS_LSE = WS_R + 144 * MiB;
constexpr size_t WS_O = WS_R + 145 * MiB;
constexpr size_t WS_U = WS_R + 48 * MiB, WS_B = WS_R + 80 * MiB, WS_C = WS_R + 112 * MiB;
constexpr size_t WS_SGA = WS_R, WS_SGC = WS_R + 48 * MiB;
constexpr size_t WS_END = WS_O + 16 * MiB;
static_assert(WS_XS == 59 * MiB && WS_END <= 256 * MiB, "d_ws map");
constexpr int CW_BAR = 4096;

constexpr int RING_OFF = 0, RING_BYTES = 131072;
constexpr int LDSCTL_OFF = RING_BYTES, MISC_OFF = LDSCTL_OFF + 320, XL_OFF = RING_BYTES + 1024;
constexpr int LDS_BYTES = 151552;


struct Args { const float* in[20]; float* out; unsigned char* ws; int ph_lo, ph_hi; };
struct Frame {
    LAS unsigned char* lds;
    volatile LAS unsigned* MISC;
    gu32* ctl;
    int tid, lane, wave;
    int vcu, G;
    float* out; unsigned char* ws;
};
enum { I_X = 0, I_C, I_WADA, I_BADA, I_NF1, I_F1G, I_F1U, I_F1D, I_NMIX, I_WIN, I_QN, I_KN, I_CONVW, I_WAB, I_WCB, I_WOUT, I_NF2, I_F2G, I_F2U, I_F2D };
enum { MOD_SH1 = 0, MOD_SC1 = 1024, MOD_GT1 = 2048, MOD_SH2 = 3072, MOD_SC2 = 4096, MOD_GT2 = 5120, MOD_SH3 = 6144, MOD_SC3 = 7168, MOD_GT3 = 8192 };

__device__ __forceinline__ float silu_f(float x) { return x * __builtin_amdgcn_rcpf(1.0f + __builtin_amdgcn_exp2f(-1.4426950408889634f * x)); }
__device__ __forceinline__ float wave_sum(float v) {
#pragma unroll
    for (int o = 1; o < 64; o <<= 1) v += __shfl_xor(v, o);
    return v;
}
__device__ __forceinline__ float blo(unsigned w) { return __uint_as_float(w << 16); }
__device__ __forceinline__ float bhi(unsigned w) { return __uint_as_float(w & 0xffff0000u); }

constexpr int ADA_ITEMS = NMOD / 64;
__device__ __forceinline__ void p0_adaln_item(Frame& F, const Args& args, int item) {
    LAS float* sc = (LAS float*)(F.lds + RING_OFF);
    LAS float* red = sc + 2048;
    const float* c = args.in[I_C]; const float* wada = args.in[I_WADA]; const float* bada = args.in[I_BADA];
    for (int i = F.tid; i < 2 * DM; i += NWAVES * 64) sc[i] = silu_f(c[i]);
    __syncthreads();
    const int j0 = item * 64, cg = F.lane & 15, rs = F.lane >> 4;
    f32x4 a0 = {0.f, 0.f, 0.f, 0.f}, a1 = {0.f, 0.f, 0.f, 0.f};
    const GAS f32x4* wp = (const GAS f32x4*)(wada + (size_t)(F.wave * 128 + rs) * NMOD + j0 + 4 * cg);
#pragma unroll 16
    for (int it = 0; it < 32; ++it) { const int k = F.wave * 128 + 4 * it + rs; const f32x4 w = wp[(size_t)it * 4 * (NMOD / 4)];
        a0 = a0 + w * sc[k]; a1 = a1 + w * sc[DM + k]; }
#pragma unroll
    for (int i = 0; i < 4; ++i) { a0[i] += __shfl_xor(a0[i], 16); a0[i] += __shfl_xor(a0[i], 32); a1[i] += __shfl_xor(a1[i], 16); a1[i] += __shfl_xor(a1[i], 32); }
    if (F.lane < 16) {
#pragma unroll
        for (int i = 0; i < 4; ++i) { red[(F.wave * 2 + 0) * 64 + 4 * cg + i] = a0[i]; red[(F.wave * 2 + 1) * 64 + 4 * cg + i] = a1[i]; } }
    __syncthreads();
    if (F.tid < 128) { const int b = F.tid >> 6, j = F.tid & 63; float s = bada[j0 + j];
#pragma unroll
        for (int w = 0; w < NWAVES; ++w) s += red[(w * 2 + b) * 64 + j];
        ((float*)(F.ws + WS_MOD))[b * NMOD + j0 + j] = s; }
    __syncthreads();
}
__device__ __forceinline__ void p0_transpose_item(const float* W, int K, int N, bf16* WT, int rmode, LAS float* scr, int item, int lane) {
    const int nblk = N / 32, kb = item / nblk, nb = item % nblk, k0 = 64 * kb, n0 = 32 * nb;
    const int r0 = rmode == 0 ? n0 : 256 * (n0 >> 7) + 128 * (rmode - 1) + (n0 & 127);
#pragma unroll 8
    for (int i = 0; i < 32; ++i) { const int kk = 2 * i + (lane >> 5); scr[kk * 33 + (lane & 31)] = W[(size_t)(k0 + kk) * N + n0 + (lane & 31)]; }
    LDS_WAIT(); asm volatile("" ::: "memory");
    const int c = lane & 7;
#pragma unroll
    for (int j = 0; j < 4; ++j) { const int n = (lane >> 3) + 8 * j; const LAS float* s = scr + (8 * c) * 33 + n;
        v4u o; o.x = pk2(s[0 * 33], s[1 * 33]); o.y = pk2(s[2 * 33], s[3 * 33]); o.z = pk2(s[4 * 33], s[5 * 33]); o.w = pk2(s[6 * 33], s[7 * 33]);
        *(GAS v4u*)(WT + (size_t)(r0 + n) * K + k0 + 8 * c) = o; }
    LDS_WAIT(); asm volatile("" ::: "memory");
}
__device__ __forceinline__ void p0_transposes(Frame& F, const Args& args, int set, int gw, int NGW) {
    LAS float* scr = (LAS float*)(F.lds + RING_OFF + F.wave * 16384);
    int base = 0;
#define TR_JOB(SRC, K_, N_, RMODE, DST) do { const int n_it = ((K_) / 64) * ((N_) / 32); int it = gw - (base % NGW); if (it < 0) it += NGW;     \
        const float* W_ = args.in[SRC]; bf16* WT_ = (bf16*)(F.ws + (DST)); \
        for (; it < n_it; it += NGW) p0_transpose_item(W_, (K_), (N_), WT_, (RMODE), scr, it, F.lane); base += n_it; } while (0)
    if (set == 0) { TR_JOB(I_F1G, DM, DFF, 1, WS_WGU1); TR_JOB(I_F1U, DM, DFF, 2, WS_WGU1); TR_JOB(I_F1D, DFF, DM, 0, WS_WD1); }
    else if (set == 1) { TR_JOB(I_WIN, DM, INW, 0, WS_WIN); TR_JOB(I_WAB, 512, DM, 0, WS_WA); TR_JOB(I_WCB, DM, DM, 0, WS_WC); TR_JOB(I_WOUT, DM, DM, 0, WS_WO); }
    else { TR_JOB(I_F2G, DM, DFF, 1, WS_WGU2); TR_JOB(I_F2U, DM, DFF, 2, WS_WGU2); TR_JOB(I_F2D, DFF, DM, 0, WS_WD2); }
#undef TR_JOB
}
__device__ __forceinline__ void norm_pass(Frame& F, const float* X, const float* g, int mod_sh, int mod_sc) {
    const int gw = F.vcu * NWAVES + F.wave, NGW = F.G * NWAVES;
    const float* mod = (const float*)(F.ws + WS_MOD); bf16* XS = (bf16*)(F.ws + WS_XS);
    for (int r0 = gw * 8; r0 < M; r0 += NGW * 8) {
        const int b = r0 / SEQ;
        f32x4 a[4], s[4];
#pragma unroll
        for (int j = 0; j < 4; ++j) { const int c = 4 * F.lane + 256 * j;
            a[j] = *(const f32x4*)(g + c) * (*(const f32x4*)(mod + b * NMOD + mod_sc + c) + 1.0f); s[j] = *(const f32x4*)(mod + b * NMOD + mod_sh + c); }
#pragma unroll 4
        for (int r = 0; r < 8; ++r) {
            const GAS f32x4* xr = (const GAS f32x4*)(X + (size_t)(r0 + r) * DM) + F.lane;
            f32x4 v[4]; float ss = 0.f;
#pragma unroll
            for (int j = 0; j < 4; ++j) { v[j] = xr[64 * j]; ss += (v[j].x * v[j].x + v[j].y * v[j].y) + (v[j].z * v[j].z + v[j].w * v[j].w); }
            const float rstd = 1.0f / sqrtf(wave_sum(ss) * (1.f / DM) + EPS);
            GAS unsigned long long* o8 = (GAS unsigned long long*)(XS + (size_t)(r0 + r) * DM) + F.lane;
#pragma unroll
            for (int j = 0; j < 4; ++j) { const f32x4 y = v[j] * rstd * a[j] + s[j];
                o8[64 * j] = (unsigned long long)pk2(y.x, y.y) | ((unsigned long long)pk2(y.z, y.w) << 32); }
        }
    }
}
__device__ __forceinline__ void qknorm_pass(Frame& F, const Args& args) {
    const int gw = F.vcu * NWAVES + F.wave, NGW = F.G * NWAVES;
    const float* gq_ = args.in[I_QN]; const float* gk_ = args.in[I_KN];
    for (int it = gw; it < 2 * M; it += NGW) {
        const int which = it >= M, row = which ? it - M : it;
        bf16* buf = (bf16*)(F.ws + (which ? WS_K : WS_Q)) + (size_t)row * AW; const float* gm = (which ? gk_ : gq_) + 8 * (F.lane & 15);
        const f32x4 g0 = *(const f32x4*)gm, g1 = *(const f32x4*)(gm + 4);
#pragma unroll
        for (int j = 0; j < 3; ++j) { GAS v4u* p = (GAS v4u*)(buf + 512 * j + 8 * F.lane); const v4u w = *p;
            f32x4 v0 = {blo(w.x), bhi(w.x), blo(w.y), bhi(w.y)}, v1 = {blo(w.z), bhi(w.z), blo(w.w), bhi(w.w)};
            float ss = (v0.x * v0.x + v0.y * v0.y) + (v0.z * v0.z + v0.w * v0.w) + (v1.x * v1.x + v1.y * v1.y) + (v1.z * v1.z + v1.w * v1.w);
            ss += __shfl_xor(ss, 1); ss += __shfl_xor(ss, 2); ss += __shfl_xor(ss, 4); ss += __shfl_xor(ss, 8);
            const float r = 1.0f / sqrtf(ss * (1.f / 128.f) + EPS);
            v0 = v0 * r * g0; v1 = v1 * r * g1;
            v4u o; o.x = pk2(v0.x, v0.y); o.y = pk2(v0.z, v0.w); o.z = pk2(v1.x, v1.y); o.w = pk2(v1.z, v1.w); *p = o; }
    }
}
__device__ __forceinline__ void aux_avec(Frame& F, const Args& args) {
    const int gw = F.vcu * NWAVES + F.wave, NGW = F.G * NWAVES;
    const float* mod = (const float*)(F.ws + WS_MOD); float* avec = (float*)(F.ws + WS_AVEC);
    const float* g2 = args.in[I_NMIX]; const float* g3 = args.in[I_NF2];
    for (int idx = gw * 64 + F.lane; idx < 4 * DM; idx += NGW * 64) { const int which = idx >> 11, b = (idx >> 10) & 1, c = idx & (DM - 1);
        avec[idx] = (which ? g3[c] : g2[c]) * (1.0f + mod[b * NMOD + (which ? MOD_SC3 : MOD_SC2) + c]); }
}
__device__ __forceinline__ void aux_bias(Frame& F, int which) {
    const int gw = F.vcu * NWAVES + F.wave, NGW = F.G * NWAVES;
    const float* mod = (const float*)(F.ws + WS_MOD);
    const int nrows = which ? 2 * DFF : INW;
    const float* sh = mod + (which ? MOD_SH3 : MOD_SH2) + 16 * F.lane;
    f32x4 s0[4], s1[4];
#pragma unroll
    for (int q = 0; q < 4; ++q) { s0[q] = *(const f32x4*)(sh + 4 * q); s1[q] = *(const f32x4*)(sh + NMOD + 4 * q); }
    float* bo = (float*)(F.ws + (which ? WS_BIAS_F2 : WS_BIAS_IN));
    for (int n = gw; n < nrows; n += NGW) {
        const bf16* wrow = (const bf16*)(F.ws + (which ? WS_WGU2 : WS_WIN)) + (size_t)n * DM + 16 * F.lane;
        const v4u w0 = *(const GAS v4u*)wrow, w1 = *(const GAS v4u*)(wrow + 8);
        const float wv[16] = {blo(w0.x), bhi(w0.x), blo(w0.y), bhi(w0.y), blo(w0.z), bhi(w0.z), blo(w0.w), bhi(w0.w), blo(w1.x), bhi(w1.x), blo(w1.y), bhi(w1.y), blo(w1.z), bhi(w1.z), blo(w1.w), bhi(w1.w)};
        float d0 = 0.f, d1 = 0.f;
#pragma unroll
        for (int q = 0; q < 4; ++q)
#pragma unroll
            for (int i = 0; i < 4; ++i) { d0 += s0[q][i] * wv[4 * q + i]; d1 += s1[q][i] * wv[4 * q + i]; }
        d0 = wave_sum(d0); d1 = wave_sum(d1);
        if (F.lane == 0) { bo[n] = d0; bo[nrows + n] = d1; }
    }
}
typedef attn::BlockRef<attn::bf16, attn::bf16> ABlock;
__device__ __forceinline__ ABlock attn_ref(Frame& F, int id, int& skv) {
    const int bgh = id >> 5, x = id & 31, b = bgh / 12, gh = bgh - b * 12, g = gh >> 2, d = 1 << (2 * g), nqb = 32 >> (2 * g), r = x / nqb, qb = x - r * nqb;
    ABlock R; const size_t e0 = (size_t)(b * SEQ + r) * AW + gh * 128;
    R.rs = d * AW; R.ls = d * 12; R.P0 = qb * 256; skv = SEQ / d;
    R.K = (const attn::bf16*)(F.ws + WS_K) + e0; R.V = (const attn::bf16*)(F.ws + WS_V) + e0;
    attn::bf16* q = (attn::bf16*)(F.ws + WS_Q) + e0 + (size_t)(qb * 256) * R.rs; R.Q = q; R.O = q;
    R.LSE = (float*)(F.ws + WS_LSE) + (size_t)(b * SEQ + r + qb * 256 * d) * 12 + gh;
    return R;
}
__device__ __forceinline__ void attn_phase(Frame& F, char* lds) {
    constexpr int NITEMS = 768;
    const int per = (NITEMS + F.G - 1) / F.G; int id = F.vcu * per; const int end = (id + per < NITEMS) ? id + per : NITEMS;
    if (id >= end) return;
    int skv, skvn; ABlock cur = attn_ref(F, id, skv);
    attn::Seam<attn::bf16> S;
    attn::causal_swa_prime<attn::bf16, attn::bf16>(cur, attn::WINDOW, lds, S);
    for (;;) {
        const bool last = id + 1 >= end; skvn = skv;
        const ABlock nxt = last ? cur : attn_ref(F, id + 1, skvn);
        attn::causal_swa_block<attn::bf16, attn::bf16>(cur, nxt, skv, attn::WINDOW, lds, S);
        if (last) break;
        cur = nxt; skv = skvn; ++id;
    }
}
__device__ __forceinline__ void merge_conv_pass(Frame& F, const Args& args) {
    const int gw = F.vcu * NWAVES + F.wave, NGW = F.G * NWAVES;
    { const bf16* OG = (const bf16*)(F.ws + WS_Q); const float* LSE = (const float*)(F.ws + WS_LSE); bf16* O = (bf16*)(F.ws + WS_O);
      const int h = F.lane >> 4, e = 8 * (F.lane & 15);
      for (int t = gw; t < M; t += NGW) {
          const float l0 = LSE[(size_t)t * 12 + h], l1 = LSE[(size_t)t * 12 + 4 + h], l2 = LSE[(size_t)t * 12 + 8 + h];
          const float mx = fmaxf(l0, fmaxf(l1, l2)); const float e0 = __expf(l0 - mx), e1 = __expf(l1 - mx), e2 = __expf(l2 - mx); const float inv = 1.0f / (e0 + e1 + e2);
          const float wg[3] = {e0 * inv, e1 * inv, e2 * inv};
          f32x4 a0 = {0.f, 0.f, 0.f, 0.f}, a1 = {0.f, 0.f, 0.f, 0.f};
#pragma unroll
          for (int g = 0; g < 3; ++g) { const v4u w = *(const GAS v4u*)(OG + (size_t)t * AW + (g * 4 + h) * 128 + e);
              a0 = a0 + (f32x4){blo(w.x), bhi(w.x), blo(w.y), bhi(w.y)} * wg[g]; a1 = a1 + (f32x4){blo(w.z), bhi(w.z), blo(w.w), bhi(w.w)} * wg[g]; }
          v4u o; o.x = pk2(a0.x, a0.y); o.y = pk2(a0.z, a0.w); o.z = pk2(a1.x, a1.y); o.w = pk2(a1.z, a1.w);
          *(GAS v4u*)(O + (size_t)t * 512 + 8 * F.lane) = o; } }
    { const bf16* U = (const bf16*)(F.ws + WS_U); bf16* Bv = (bf16*)(F.ws + WS_B); const bf16* Cg = (const bf16*)(F.ws + WS_C); const float* cw = args.in[I_CONVW];
      for (int it = gw; it < 2 * (M / 16); it += NGW) {
          const int ch = it & 1, t0 = (it >> 1) * 16, c0 = 512 * ch + 8 * F.lane;
          float w0[8], w1[8], w2[8], x1[8], x2[8];
#pragma unroll
          for (int i = 0; i < 8; ++i) { w0[i] = cw[c0 + i]; w1[i] = cw[DM + c0 + i]; w2[i] = cw[2 * DM + c0 + i]; x1[i] = 0.f; x2[i] = 0.f; }
          if ((t0 & (SEQ - 1)) != 0) {
#pragma unroll
              for (int p = 2; p >= 1; --p) { const v4u wu = *(const GAS v4u*)(U + (size_t)(t0 - p) * DM + c0), wc = *(const GAS v4u*)(Cg + (size_t)(t0 - p) * DM + c0);
                  const float xu[8] = {blo(wu.x), bhi(wu.x), blo(wu.y), bhi(wu.y), blo(wu.z), bhi(wu.z), blo(wu.w), bhi(wu.w)}, xc[8] = {blo(wc.x), bhi(wc.x), blo(wc.y), bhi(wc.y), blo(wc.z), bhi(wc.z), blo(wc.w), bhi(wc.w)};
#pragma unroll
                  for (int i = 0; i < 8; ++i) { if (p == 2) x2[i] = xu[i] * xc[i]; else x1[i] = xu[i] * xc[i]; } } }
#pragma unroll 4
          for (int r = 0; r < 16; ++r) { const size_t off = (size_t)(t0 + r) * DM + c0;
              const v4u wu = *(const GAS v4u*)(U + off), wc = *(const GAS v4u*)(Cg + off), wb = *(const GAS v4u*)(Bv + off);
              const float xu[8] = {blo(wu.x), bhi(wu.x), blo(wu.y), bhi(wu.y), blo(wu.z), bhi(wu.z), blo(wu.w), bhi(wu.w)}, xc[8] = {blo(wc.x), bhi(wc.x), blo(wc.y), bhi(wc.y), blo(wc.z), bhi(wc.z), blo(wc.w), bhi(wc.w)};
              const float xb[8] = {blo(wb.x), bhi(wb.x), blo(wb.y), bhi(wb.y), blo(wb.z), bhi(wb.z), blo(wb.w), bhi(wb.w)};
              float y[8];
#pragma unroll
              for (int i = 0; i < 8; ++i) { const float x0 = xu[i] * xc[i]; y[i] = xb[i] * (w0[i] * x2[i] + w1[i] * x1[i] + w2[i] * x0); x2[i] = x1[i]; x1[i] = x0; }
              v4u o; o.x = pk2(y[0], y[1]); o.y = pk2(y[2], y[3]); o.z = pk2(y[4], y[5]); o.w = pk2(y[6], y[7]);
              *(GAS v4u*)(Bv + off) = o; } } }
}


#ifdef NAIVE
template <bool DUAL, class St>
__device__ __forceinline__ void naive_gemm(Frame& F, const bf16* A, int lda, const float* W, const float* W2, int ldw, int M_, int N_, int K_, St store) {
    LAS float* As = (LAS float*)(F.lds + RING_OFF);
    LAS float* Ws = As + 64 * 33;
    LAS float* Ws2 = Ws + 32 * 68;
    const int ty = F.tid >> 4, tx = F.tid & 15, ntn = N_ / 64, ntiles = (M_ / 64) * ntn;
    for (int tile = blockIdx.x; tile < ntiles; tile += F.G) {
        const int tm = tile / ntn, tn = tile - tm * ntn;
        float acc[2][4] = {{0.f, 0.f, 0.f, 0.f}, {0.f, 0.f, 0.f, 0.f}}, acc2[2][4] = {{0.f, 0.f, 0.f, 0.f}, {0.f, 0.f, 0.f, 0.f}};
        for (int k0 = 0; k0 < K_; k0 += 32) {
            __syncthreads();
#pragma unroll
            for (int i = 0; i < 4; ++i) { const int e = F.tid + 512 * i, r = e >> 5, c = e & 31; As[r * 33 + c] = __uint_as_float((unsigned)A[(size_t)(tm * 64 + r) * lda + k0 + c] << 16); }
#pragma unroll
            for (int i = 0; i < 4; ++i) { const int e = F.tid + 512 * i, r = e >> 6, c = e & 63; Ws[r * 68 + c] = W[(size_t)(k0 + r) * ldw + tn * 64 + c]; if (DUAL) Ws2[r * 68 + c] = W2[(size_t)(k0 + r) * ldw + tn * 64 + c]; }
            __syncthreads();
#pragma unroll 8
            for (int kk = 0; kk < 32; ++kk) { const float a0 = As[(ty * 2) * 33 + kk], a1 = As[(ty * 2 + 1) * 33 + kk];
#pragma unroll
                for (int j = 0; j < 4; ++j) { const float w = Ws[kk * 68 + tx * 4 + j]; acc[0][j] += a0 * w; acc[1][j] += a1 * w;
                    if (DUAL) { const float w2 = Ws2[kk * 68 + tx * 4 + j]; acc2[0][j] += a0 * w2; acc2[1][j] += a1 * w2; } } }
        }
#pragma unroll
        for (int i = 0; i < 2; ++i)
#pragma unroll
            for (int j = 0; j < 4; ++j) store(tm * 64 + ty * 2 + i, tn * 64 + tx * 4 + j, acc[i][j], acc2[i][j]);
    }
    __syncthreads();
}
__device__ __forceinline__ bf16 f2b(float v) { return (bf16)f2bf(v); }
__device__ __forceinline__ float b2f(bf16 v) { return __uint_as_float((unsigned)v << 16); }
__device__ __forceinline__ void naive_attn(Frame& F) {
    const int gw = F.vcu * NWAVES + F.wave, NGW = F.G * NWAVES;
    bf16* Qb = (bf16*)(F.ws + WS_Q); const bf16* Kb = (const bf16*)(F.ws + WS_K); const bf16* Vb = (const bf16*)(F.ws + WS_V); float* LSE = (float*)(F.ws + WS_LSE);
    for (int it = gw; it < M * 12; it += NGW) {
        const int t = it / 12, gh = it - t * 12, g = gh >> 2, d = 1 << (2 * g), tl = t & (SEQ - 1);
        const float q0 = b2f(Qb[(size_t)t * AW + gh * 128 + 2 * F.lane]), q1 = b2f(Qb[(size_t)t * AW + gh * 128 + 2 * F.lane + 1]);
        float s0 = -INFINITY, s1 = -INFINITY, s2 = -INFINITY;
        for (int j = 0; j <= 128; ++j) { if (tl - j * d < 0) break; const size_t kr = (size_t)(t - j * d) * AW + gh * 128 + 2 * F.lane;
            const float sc = wave_sum(q0 * b2f(Kb[kr]) + q1 * b2f(Kb[kr + 1])) * 0.08838834764831845f;
            if (j < 64) { if (F.lane == j) s0 = sc; } else if (j < 128) { if (F.lane == j - 64) s1 = sc; } else { if (F.lane == 0) s2 = sc; } }
        float mx = fmaxf(s0, fmaxf(s1, s2));
#pragma unroll
        for (int o = 1; o < 64; o <<= 1) mx = fmaxf(mx, __shfl_xor(mx, o));
        const float p0 = __expf(s0 - mx), p1 = __expf(s1 - mx), p2 = __expf(s2 - mx);
        const float l = wave_sum(p0 + p1 + p2);
        float o0 = 0.f, o1 = 0.f;
        for (int j = 0; j <= 128; ++j) { if (tl - j * d < 0) break; const size_t vr = (size_t)(t - j * d) * AW + gh * 128 + 2 * F.lane;
            const float p = (j < 64) ? __shfl(p0, j) : (j < 128) ? __shfl(p1, j - 64) : __shfl(p2, 0);
            o0 += p * b2f(Vb[vr]); o1 += p * b2f(Vb[vr + 1]); }
        const float inv = 1.0f / l;
        Qb[(size_t)t * AW + gh * 128 + 2 * F.lane] = f2b(o0 * inv); Qb[(size_t)t * AW + gh * 128 + 2 * F.lane + 1] = f2b(o1 * inv);
        if (F.lane == 0) LSE[(size_t)t * 12 + gh] = mx + __logf(l);
    }
}
#endif

constexpr int N_PHASES = 17;
__global__ void __launch_bounds__(NWAVES * 64, 2) mega_fwd(Args args) {
    extern __shared__ __attribute__((aligned(16))) unsigned char lds[];
    Frame F;
    F.lds = (LAS unsigned char*)lds;
    F.MISC = (volatile LAS unsigned*)(F.lds + MISC_OFF);
    F.tid = threadIdx.x; F.lane = F.tid & 63; F.wave = __builtin_amdgcn_readfirstlane(F.tid >> 6);
    F.G = gridDim.x; { const int bx = blockIdx.x; F.vcu = (F.G % 8 == 0) ? (bx % 8) * (F.G / 8) + bx / 8 : bx; }
    F.ws = args.ws; F.out = args.out;
    F.ctl = (gu32*)(args.ws + WS_CTL);
    for (int u = F.tid; u < (LDS_BYTES - LDSCTL_OFF) / 4; u += NWAVES * 64) ((LAS unsigned*)(F.lds + LDSCTL_OFF))[u] = 0u;
    __syncthreads();
    XcdBarrier bar = xcd_barrier_post((unsigned*)(F.ctl + CW_BAR), F.MISC + 8);
    const int lo = args.ph_lo, hi = args.ph_hi;
    typedef pg8::bf16_t pb;
#define mod ((const float*)(args.ws + WS_MOD))
#define XS ((const pb*)(args.ws + WS_XS))
    unsigned char* const ws = args.ws;
#define IN(k) (lo <= (k) && (k) < hi)
#define FRESH() do { F.tid = tid_opaque(); F.lane = F.tid & 63; } while (0)
#ifdef PROBE_TA
#define TSTAMP(slot) do { if (F.tid == 0) { const unsigned long long t_ = rt(); F.MISC[16 + 2 * (slot)] = (unsigned)t_; F.MISC[17 + 2 * (slot)] = (unsigned)(t_ >> 32); } } while (0)
#define SEAM(k) do { if (IN(k) && IN((k) + 1)) xcd_barrier(bar); if ((k) == PROBE_TA) TSTAMP(0); if ((k) == PROBE_TB) TSTAMP(1); } while (0)
    if (PROBE_TA == -1) TSTAMP(0);
#else
#define SEAM(k) do { if (IN(k) && IN((k) + 1)) xcd_barrier(bar); } while (0)
#endif
#ifdef NAIVE
#define FUSE_NORM 0
#else
#define FUSE_NORM 1
#endif
#define XL ((PG8_LAS float*)(F.lds + XL_OFF))
#define PS2 ((const float*)(args.ws + WS_PS2))
#define PS3 ((const float*)(args.ws + WS_PS3))
#define bias_in ((const float*)(args.ws + WS_BIAS_IN))
#define bias_f2 ((const float*)(args.ws + WS_BIAS_F2))
#define avec ((const float*)(args.ws + WS_AVEC))
#define GEMM_BX(SCHED_DECL, SCHED_T, A_, K_, BT, N_, MODE, NRM, QKN_, O_, LDC, SPC, SPS, I1, I2, PS_, BIAS_, BSTR) do { pg8::Gemm g{(const pb*)(A_), (const pb*)(BT), M, (N_), (K_)}; SCHED_DECL; \
        typedef pg8::EpiB<MODE, (NRM), (QKN_)> EpiT; EpiT E{(pb*)(O_), (LDC), (SPC), (SPS), (const pb*)(I1), (const pb*)(I2), (PS_), (BIAS_), (BSTR), args.in[I_QN], args.in[I_KN], 2 * AW, XL, 0}; \
        pg8::gemm_phase<EpiT, SCHED_T, true, true>(F.lds + RING_OFF, g, S, E); } while (0)
#define GEMM_B(A_, K_, BT, N_, MODE, NRM, QKN_, O_, LDC, SPC, SPS, I1, I2, PS_, BIAS_, BSTR) \
        GEMM_BX(pg8::StaticOrder S; S.init(M, (N_), F.G, (int)blockIdx.x), pg8::StaticOrder, A_, K_, BT, N_, MODE, NRM, QKN_, O_, LDC, SPC, SPS, I1, I2, PS_, BIAS_, BSTR)
#define GEMM_F(XSO, A_, K_, BT, BASE, COEF, SCALE, AVEC_, PS_) do { pg8::Gemm g{(const pb*)(A_), (const pb*)(BT), M, DM, (K_)}; pg8::StaticOrder S; S.init(M, DM, F.G, (int)blockIdx.x); \
        typedef pg8::EpiF<(XSO)> EpiT; EpiT E{(BASE), F.out, (COEF), (pb*)(ws + WS_XS), (AVEC_), (float*)(PS_), XL, (SCALE)}; pg8::gemm_phase<EpiT, pg8::StaticOrder, true, true>(F.lds + RING_OFF, g, S, E); } while (0)

    const bool p0_split = false;
#if FUSE_NORM
    FRESH();
    if (IN(0)) { for (int it = blockIdx.x; it < ADA_ITEMS; it += F.G) p0_adaln_item(F, args, it);
                 if (p0_split && (int)blockIdx.x >= ADA_ITEMS) p0_transposes(F, args, 0, ((int)blockIdx.x - ADA_ITEMS) * NWAVES + F.wave, (256 - ADA_ITEMS) * NWAVES); }
#else
    FRESH();
    if (IN(0)) { for (int it = blockIdx.x; it < ADA_ITEMS; it += F.G) p0_adaln_item(F, args, it); for (int st = 0; st < 3; ++st) p0_transposes(F, args, st, F.vcu * NWAVES + F.wave, F.G * NWAVES); }
#endif
    SEAM(0);
    FRESH();
    if (IN(1)) { norm_pass(F, args.in[I_X], args.in[I_NF1], MOD_SH1, MOD_SC1); if (FUSE_NORM) { aux_avec(F, args); if (!p0_split) p0_transposes(F, args, 0, F.vcu * NWAVES + F.wave, F.G * NWAVES); } }
    SEAM(1);
#ifdef PROBE_XBAR
    xcd_barrier(bar); xcd_barrier(bar); xcd_barrier(bar); xcd_barrier(bar);
#endif
#if defined(NAIVE) && (NAIVE & 1)
    if (IN(2)) { bf16* ACT = (bf16*)(ws + WS_ACT); naive_gemm<true>(F, (const bf16*)XS, DM, args.in[I_F1G], args.in[I_F1U], DFF, M, DFF, DM, [=](int r, int c, float g, float u) { ACT[(size_t)r * DFF + c] = f2b(silu_f(g) * u); }); }
#else
    if (IN(2)) GEMM_B(XS, DM, ws + WS_WGU1, 2 * DFF, pg8::EB_SWIGLU, false, false, ws + WS_ACT, DFF, 0, 0, nullptr, nullptr, nullptr, nullptr, 0);
    FRESH();
    if (FUSE_NORM && IN(2) && F.G == 256 && (int)blockIdx.x >= 128) p0_transposes(F, args, 1, ((int)blockIdx.x - 128) * NWAVES + F.wave, 128 * NWAVES);
    else if (FUSE_NORM && IN(2) && F.G != 256) p0_transposes(F, args, 1, F.vcu * NWAVES + F.wave, F.G * NWAVES);
#endif
    SEAM(2);
#if defined(NAIVE) && (NAIVE & 2)
    if (IN(3)) { const float* xb = args.in[I_X]; float* ob = F.out; naive_gemm<false>(F, (const bf16*)(ws + WS_ACT), DFF, args.in[I_F1D], nullptr, DM, M, DM, DFF, [=](int r, int c, float v, float) { ob[(size_t)r * DM + c] = xb[(size_t)r * DM + c] + 0.5f * mod[(r / SEQ) * NMOD + MOD_GT1 + c] * v; }); }
#else
    FRESH();
    if (FUSE_NORM && IN(3)) aux_bias(F, 0);
    if (IN(3)) GEMM_F(FUSE_NORM, ws + WS_ACT, DFF, ws + WS_WD1, args.in[I_X], mod + MOD_GT1, 0.5f, avec, ws + WS_PS2);
#endif
    SEAM(3);
#if !FUSE_NORM
    if (IN(4)) norm_pass(F, F.out, args.in[I_NMIX], MOD_SH2, MOD_SC2);
    SEAM(4);
#endif
#if defined(NAIVE) && (NAIVE & 4)
    if (IN(5)) { bf16* Qb = (bf16*)(ws + WS_Q); naive_gemm<false>(F, (const bf16*)XS, DM, args.in[I_WIN] + COL_Q, nullptr, INW, M, 3 * AW, DM, [=](int r, int c, float v, float) { const int t = c / AW; Qb[(size_t)t * M * AW + (size_t)r * AW + (c - t * AW)] = f2b(v); }); }
#else
    if (IN(5)) GEMM_B(XS, DM, ws + WS_WIN + (size_t)COL_Q * DM * 2, 3 * AW, pg8::EB_PLAIN, FUSE_NORM, FUSE_NORM, ws + WS_Q, AW, AW, (size_t)(WS_K - WS_Q) / 2, nullptr, nullptr, PS2, bias_in + COL_Q, INW);
    FRESH();
    if (FUSE_NORM && IN(5) && F.G == 256 && (int)blockIdx.x >= 128) p0_transposes(F, args, 2, ((int)blockIdx.x - 128) * NWAVES + F.wave, 128 * NWAVES);
    else if (FUSE_NORM && IN(5) && F.G != 256) p0_transposes(F, args, 2, F.vcu * NWAVES + F.wave, F.G * NWAVES);
#endif
    SEAM(5);
#if !FUSE_NORM
    if (IN(6)) qknorm_pass(F, args);
    SEAM(6);
#endif
#if defined(NAIVE) && (NAIVE & 8)
    if (IN(7)) naive_attn(F);
#else
    if (IN(7)) attn_phase(F, (char*)lds + RING_OFF);
#endif
    SEAM(7);
#if defined(NAIVE) && (NAIVE & 16)
    if (IN(8)) { bf16* Ub = (bf16*)(ws + WS_U); naive_gemm<false>(F, (const bf16*)XS, DM, args.in[I_WIN] + COL_U, nullptr, INW, M, 3 * DM, DM, [=](int r, int c, float v, float) { const int t = c / DM; Ub[(size_t)t * M * DM + (size_t)r * DM + (c - t * DM)] = f2b(v); }); }
#else
    if (IN(8)) GEMM_B(XS, DM, ws + WS_WIN + (size_t)COL_U * DM * 2, 3 * DM, pg8::EB_PLAIN, FUSE_NORM, false, ws + WS_U, DM, DM, (size_t)(WS_B - WS_U) / 2, nullptr, nullptr, PS2, bias_in + COL_U, INW);
#endif
    SEAM(8);
    FRESH();
    if (IN(9)) { merge_conv_pass(F, args); if (FUSE_NORM) aux_bias(F, 1); }
    SEAM(9);
    { bf16* SGA = (bf16*)(ws + WS_SGA); bf16* SGC = (bf16*)(ws + WS_SGC); (void)SGA; (void)SGC;
#if defined(NAIVE) && (NAIVE & 32)
      if (IN(10)) naive_gemm<false>(F, (const bf16*)XS, DM, args.in[I_WIN] + COL_GA, nullptr, INW, M, DM, DM, [=](int r, int c, float v, float) { SGA[(size_t)r * DM + c] = f2b(1.0f / (1.0f + __expf(-v))); });
      if (IN(11)) naive_gemm<false>(F, (const bf16*)XS, DM, args.in[I_WIN] + COL_GC, nullptr, INW, M, DM, DM, [=](int r, int c, float v, float) { SGC[(size_t)r * DM + c] = f2b(1.0f / (1.0f + __expf(-v))); });
#else
    if (IN(10)) GEMM_BX(pg8::TwinOrder S; S.init(M, DM, F.G, (int)blockIdx.x); S.reps = 2, pg8::TwinOrder, XS, DM, ws + WS_WIN + (size_t)COL_GA * DM * 2, 2 * DM, pg8::EB_SIGMOID, FUSE_NORM, false,
                        ws + WS_SGA, DM, DM, (size_t)(WS_SGC - WS_SGA) / 2, nullptr, nullptr, PS2, bias_in + COL_GA, INW);
#endif
#ifdef NAIVE
    if (IN(11) && IN(12)) xcd_barrier(bar);
#endif
#if defined(NAIVE) && (NAIVE & 512)
      if (IN(12)) naive_gemm<false>(F, (const bf16*)(ws + WS_O), 512, args.in[I_WAB], nullptr, DM, M, DM, 512, [=](int r, int c, float v, float) { SGA[(size_t)r * DM + c] = f2b(b2f(SGA[(size_t)r * DM + c]) * v); });
#else
    if (IN(12)) GEMM_B(ws + WS_O, 512, ws + WS_WA, DM, pg8::EB_GATEMUL, false, false, ws + WS_SGA, DM, 0, 0, ws + WS_SGA, nullptr, nullptr, nullptr, 0);
#endif
#ifdef NAIVE
    if (IN(12) && IN(13)) xcd_barrier(bar);
#endif
#if defined(NAIVE) && (NAIVE & 1024)
      if (IN(13)) naive_gemm<false>(F, (const bf16*)(ws + WS_B), DM, args.in[I_WCB], nullptr, DM, M, DM, DM, [=](int r, int c, float v, float) { SGA[(size_t)r * DM + c] = f2b(b2f(SGA[(size_t)r * DM + c]) + b2f(SGC[(size_t)r * DM + c]) * v); });
#else
    if (IN(13)) GEMM_B(ws + WS_B, DM, ws + WS_WC, DM, pg8::EB_MERGE, false, false, ws + WS_SGA, DM, 0, 0, ws + WS_SGA, ws + WS_SGC, nullptr, nullptr, 0);
#endif
    }
    SEAM(13);
#if defined(NAIVE) && (NAIVE & 64)
    if (IN(14)) { float* ob = F.out; naive_gemm<false>(F, (const bf16*)(ws + WS_SGA), DM, args.in[I_WOUT], nullptr, DM, M, DM, DM, [=](int r, int c, float v, float) { ob[(size_t)r * DM + c] += mod[(r / SEQ) * NMOD + MOD_GT2 + c] * v; }); }
#else
    if (IN(14)) GEMM_F(FUSE_NORM, ws + WS_SGA, DM, ws + WS_WO, F.out, mod + MOD_GT2, 1.0f, avec + 2 * DM, ws + WS_PS3);
#endif
    SEAM(14);
#if !FUSE_NORM
    if (IN(15)) norm_pass(F, F.out, args.in[I_NF2], MOD_SH3, MOD_SC3);
    SEAM(15);
#endif
#if defined(NAIVE) && (NAIVE & 128)
    if (IN(16)) { bf16* ACT = (bf16*)(ws + WS_ACT); naive_gemm<true>(F, (const bf16*)XS, DM, args.in[I_F2G], args.in[I_F2U], DFF, M, DFF, DM, [=](int r, int c, float g, float u) { ACT[(size_t)r * DFF + c] = f2b(silu_f(g) * u); }); }
#else
    if (IN(16)) GEMM_B(XS, DM, ws + WS_WGU2, 2 * DFF, pg8::EB_SWIGLU, FUSE_NORM, false, ws + WS_ACT, DFF, 0, 0, nullptr, nullptr, PS3, bias_f2, 2 * DFF);
#endif
    SEAM(16);
#if defined(NAIVE) && (NAIVE & 256)
    if (IN(17)) { float* ob = F.out; naive_gemm<false>(F, (const bf16*)(ws + WS_ACT), DFF, args.in[I_F2D], nullptr, DM, M, DM, DFF, [=](int r, int c, float v, float) { ob[(size_t)r * DM + c] += 0.5f * mod[(r / SEQ) * NMOD + MOD_GT3 + c] * v; }); }
#else
    if (IN(17)) GEMM_F(false, ws + WS_ACT, DFF, ws + WS_WD2, F.out, mod + MOD_GT3, 0.5f, nullptr, nullptr);
#endif
#ifdef PROBE_TA
    if (PROBE_TB == 17) TSTAMP(1);
    xcd_barrier(bar);
    if (blockIdx.x == 0 && F.tid == 0) { const unsigned long long t0_ = ((unsigned long long)F.MISC[17] << 32) | F.MISC[16], t1_ = ((unsigned long long)F.MISC[19] << 32) | F.MISC[18];
#ifdef PROBE_CONST
        F.out[0] += (float)(PROBE_CONST); (void)t0_; (void)t1_; }
#else
        F.out[0] += (float)(PROBE_SCALE) * 0.01f * (float)(t1_ - t0_); }
#endif
#endif
#undef IN
#undef SEAM
#undef XL
#undef PS2
#undef PS3
#undef bias_in
#undef bias_f2
#undef avec
#undef mod
#undef XS
}

extern "C" void kernel_launch(void* const* d_in, const int* in_sizes, int n_in, void* d_out, int out_size, void* d_ws, size_t ws_size, hipStream_t stream) {
    static int grid = 0;
    if (grid == 0) {
        if (n_in != 20 || in_sizes[0] != M * DM || out_size != M * DM || ws_size < WS_END) { fprintf(stderr, "kernel_launch: shape/workspace mismatch (n_in %d, in0 %d, out %d, ws %zu < %zu)\n", n_in, n_in > 0 ? in_sizes[0] : -1, out_size, ws_size, (size_t)WS_END); grid = -1; return; }
        int dev = 0, cus = 0, per_cu = 0;
        if (hipGetDevice(&dev) != hipSuccess || hipDeviceGetAttribute(&cus, hipDeviceAttributeMultiprocessorCount, dev) != hipSuccess) { grid = -1; return; }
        if (hipFuncSetAttribute((const void*)mega_fwd, hipFuncAttributeMaxDynamicSharedMemorySize, LDS_BYTES) != hipSuccess) { fprintf(stderr, "kernel_launch: hipFuncSetAttribute failed\n"); grid = -1; return; }
        if (hipOccupancyMaxActiveBlocksPerMultiprocessor(&per_cu, (const void*)mega_fwd, NWAVES * 64, LDS_BYTES) != hipSuccess || per_cu < 1) { fprintf(stderr, "kernel_launch: occupancy query reports %d workgroups per CU\n", per_cu); }
        (void)hipGetLastError();
        grid = cus;
    }
    if (grid < 0) return;
    (void)hipMemsetAsync((char*)d_ws + WS_CTL, 0, CTL_ZERO_BYTES, stream);
#ifdef PROBE_MEMSET2
    (void)hipMemsetAsync((char*)d_ws + WS_CTL + CTL_ZERO_BYTES, 0, CTL_ZERO_BYTES, stream);
#endif
    Args a{};
    for (int i = 0; i < 20; ++i) a.in[i] = (const float*)d_in[i];
    a.out = (float*)d_out; a.ws = (unsigned char*)d_ws;
#if defined(PROBE_DUP)
    a.ph_lo = 0; a.ph_hi = PROBE_DUP + 1; hipLaunchKernelGGL(mega_fwd, dim3(grid), dim3(NWAVES * 64), LDS_BYTES, stream, a);
    (void)hipMemsetAsync((char*)d_ws + WS_CTL, 0, CTL_ZERO_BYTES, stream);
    a.ph_lo = PROBE_DUP; a.ph_hi = N_PHASES + 1; hipLaunchKernelGGL(mega_fwd, dim3(grid), dim3(NWAVES * 64), LDS_BYTES, stream, a);
#elif defined(PROBE_RLO)
    a.ph_lo = 0; a.ph_hi = PROBE_RHI + 1; hipLaunchKernelGGL(mega_fwd, dim3(grid), dim3(NWAVES * 64), LDS_BYTES, stream, a);
    (void)hipMemsetAsync((char*)d_ws + WS_CTL, 0, CTL_ZERO_BYTES, stream);
    a.ph_lo = PROBE_RLO; a.ph_hi = N_PHASES + 1; hipLaunchKernelGGL(mega_fwd, dim3(grid), dim3(NWAVES * 64), LDS_BYTES, stream, a);
#elif defined(PROBE_SPLIT)
    a.ph_lo = 0; a.ph_hi = PROBE_SPLIT + 1; hipLaunchKernelGGL(mega_fwd, dim3(grid), dim3(NWAVES * 64), LDS_BYTES, stream, a);
    (void)hipMemsetAsync((char*)d_ws + WS_CTL, 0, CTL_ZERO_BYTES, stream);
    a.ph_lo = PROBE_SPLIT + 1; a.ph_hi = N_PHASES + 1; hipLaunchKernelGGL(mega_fwd, dim3(grid), dim3(NWAVES * 64), LDS_BYTES, stream, a);
#elif !defined(MK_PER_PHASE)
    a.ph_lo = 0; a.ph_hi = N_PHASES + 1;
    hipLaunchKernelGGL(mega_fwd, dim3(grid), dim3(NWAVES * 64), LDS_BYTES, stream, a);
#else
    for (int p = 0; p <= N_PHASES; ++p) { a.ph_lo = p; a.ph_hi = p + 1; hipLaunchKernelGGL(mega_fwd, dim3(grid), dim3(NWAVES * 64), LDS_BYTES, stream, a); }
#endif
}
```

```cpp
#include <hip/hip_runtime.h>
#include <hip/hip_bf16.h>
#include <cstdio>
#include <cstdint>

constexpr int DM = 1024, BATCH = 2, SEQ = 8192, M = BATCH * SEQ;
constexpr int DFF = 2816, NMOD = 9 * DM;
constexpr int AW = 1536;
constexpr int INW = 9728;
constexpr int COL_Q = 0, COL_K = 1536, COL_V = 3072, COL_U = 4608, COL_B = 5632, COL_C = 6656, COL_GA = 7680, COL_GC = 8704;
constexpr float EPS = 1e-6f;

__device__ __forceinline__ int tid_opaque() { int t = (int)threadIdx.x; asm volatile("" : "+v"(t)); return t; }

namespace pg8 {
#define PG8_LAS __attribute__((address_space(3)))
typedef unsigned short bf16_t;
typedef short bf16x8 __attribute__((ext_vector_type(8)));
typedef float f32x4 __attribute__((ext_vector_type(4)));
typedef unsigned u32x4 __attribute__((ext_vector_type(4)));
constexpr int BM = 256, BK = 64, HALF = 128, HTB = HALF * BK * 2  , STAGE_BYTES = 8 * HTB, NXCD = 8, WGM = 8;

__host__ __device__ __forceinline__ int lds_byte(int r, int c) { const int st = (r >> 4) * 2 + (c >> 5), rr = r & 15, cc = c & 31, ob = rr * 64 + cc * 2; return st * 1024 + (ob ^ (((ob >> 9) & 1) << 5)); }
__host__ __device__ __forceinline__ void stage_rc(int b, int& R, int& C) { const int st = b / 1024, sb = b % 1024, swz = sb ^ (((sb >> 9) & 1) << 5); R = (st >> 1) * 16 + swz / 64; C = (st & 1) * 32 + (swz % 64) / 2; }
__host__ __device__ __forceinline__ int perm32(int rho) { const int n = rho >> 4, i = rho & 15; return 8 * (i >> 2) + 4 * n + (i & 3); }

struct Unit { int pm, pn; };
struct Gemm { const bf16_t* A; const bf16_t* Bt; int M, N, K; };

struct StaticOrder {
    int nM, nN, nwg, G, c;
    __host__ __device__ void init(int M, int N, int G_, int c_) { nM = M / BM; nN = N / BM; nwg = nM * nN; G = G_; c = c_; }
    __host__ __device__ bool next(int i, Unit& u) const {
        const long L = (long)i * G + c; if (L >= nwg) return false;
        int wgid = (int)L; { const int q = nwg / NXCD, r = nwg % NXCD, xcd = wgid % NXCD, off = wgid / NXCD; wgid = (xcd < r ? xcd * (q + 1) : r * (q + 1) + (xcd - r) * q) + off; }
        const int nig = WGM * nN, gid = wgid / nig, fm = gid * WGM, gsz = (nM - fm) < WGM ? (nM - fm) : WGM;
        u.pm = fm + ((wgid % nig) % gsz); u.pn = (wgid % nig) / gsz; return true;
    }
    __device__ __forceinline__ void a_ready(const Unit&) const {}
    __device__ __forceinline__ void done(const Unit&) const {}
};

typedef float f32x2_t __attribute__((ext_vector_type(2))); typedef __bf16 bf16x2_t __attribute__((ext_vector_type(2)));
__device__ __forceinline__ unsigned cvt_pk_bf16(float lo, float hi) { f32x2_t v = {lo, hi}; bf16x2_t b = __builtin_convertvector(v, bf16x2_t); return __builtin_bit_cast(unsigned, b); }
__device__ __forceinline__ float bf_lo(unsigned w) { return __uint_as_float(w << 16); }
__device__ __forceinline__ float bf_hi(unsigned w) { return __uint_as_float(w & 0xffff0000u); }
__device__ __forceinline__ float sigmoidf_(float x) { return __builtin_amdgcn_rcpf(1.0f + __builtin_amdgcn_exp2f(-1.4426950408889634f * x)); }
__device__ __forceinline__ void unpack8(const u32x4 w, f32x4& a, f32x4& b) { a = (f32x4){bf_lo(w.x), bf_hi(w.x), bf_lo(w.y), bf_hi(w.y)}; b = (f32x4){bf_lo(w.z), bf_hi(w.z), bf_lo(w.w), bf_hi(w.w)}; }
__device__ __forceinline__ u32x4 pack8(const f32x4 a, const f32x4 b) { u32x4 w; w.x = cvt_pk_bf16(a[0], a[1]); w.y = cvt_pk_bf16(a[2], a[3]); w.z = cvt_pk_bf16(b[0], b[1]); w.w = cvt_pk_bf16(b[2], b[3]); return w; }

enum { EB_PLAIN = 0, EB_SWIGLU = 1, EB_SIGMOID = 2, EB_GATEMUL = 3, EB_MERGE = 4 };
template <int mode, bool NORMED = false, bool QKN = false> struct EpiB {
    static constexpr bool PERM = true, AFTER_DRAIN = false, PREFETCH = NORMED;
    bf16_t* O; int ldc; int split_cols; size_t split_stride; const bf16_t* In1; const bf16_t* In2;
    const float* PS; const float* bias; int bias_bstride; const float* gamma_q; const float* gamma_k; int qk_cols; PG8_LAS float* XL; int par;
    __device__ __forceinline__ void prefetch(const Unit& u, int wid, int buf) const {
        if (NORMED && wid < 4) { const int lane = threadIdx.x & 63; PG8_LAS unsigned char* X2 = (PG8_LAS unsigned char*)(XL + 2048) + buf * 5120;
            __builtin_amdgcn_global_load_lds((const unsigned*)(PS + (size_t)(u.pm * BM + wid * 64 + lane) * 4), (PG8_LAS unsigned*)(X2 + wid * 1024), 16, 0, 0);
            if (wid == 0) __builtin_amdgcn_global_load_lds((const unsigned*)(bias + (size_t)((u.pm * BM) / SEQ) * bias_bstride + u.pn * BM + lane * 4), (PG8_LAS unsigned*)(X2 + 4096), 16, 0, 0); }
    }
    __device__ __forceinline__ void operator()(f32x4 (&acc)[2][2][4][2], const Unit& u, int wr, int wc, int fr, int fq) const {
        const int row0 = u.pm * BM + wr * 64 + fr;
        if (NORMED) {
            const PG8_LAS float* X2 = XL + 2048 + par * 1280;
            f32x4 bv[2][2];
#pragma unroll
            for (int bj = 0; bj < 2; ++bj)
#pragma unroll
                for (int n = 0; n < 2; ++n) bv[bj][n] = *(const PG8_LAS f32x4*)(X2 + 1024 + bj * HALF + wc * 32 + 8 * fq + 4 * n);
#pragma unroll
            for (int ai = 0; ai < 2; ++ai)
#pragma unroll
                for (int m = 0; m < 4; ++m) { const f32x4 p = *(const PG8_LAS f32x4*)(X2 + (ai * HALF + wr * 64 + m * 16 + fr) * 4);
                    const float rstd = __builtin_amdgcn_rsqf(((p[0] + p[1]) + (p[2] + p[3])) * (1.0f / 1024.0f) + 1e-6f);
#pragma unroll
                    for (int bj = 0; bj < 2; ++bj)
#pragma unroll
                        for (int n = 0; n < 2; ++n) acc[ai][bj][m][n] = acc[ai][bj][m][n] * rstd + bv[bj][n]; }
        }
        if (mode == EB_SWIGLU) {
            const int col0 = u.pn * HALF + wc * 32 + 8 * fq;
#pragma unroll
            for (int ai = 0; ai < 2; ++ai)
#pragma unroll
                for (int m = 0; m < 4; ++m) { bf16_t* rowp = O + (size_t)(row0 + ai * HALF + m * 16) * ldc + col0;
                    f32x4 v0, v1;
#pragma unroll
                    for (int i = 0; i < 4; ++i) { const float g0 = acc[ai][0][m][0][i], g1 = acc[ai][0][m][1][i];
                        v0[i] = g0 * sigmoidf_(g0) * acc[ai][1][m][0][i]; v1[i] = g1 * sigmoidf_(g1) * acc[ai][1][m][1][i]; }
                    *(u32x4*)rowp = pack8(v0, v1); }
            return;
        }
        int colt = u.pn * BM; size_t boff = 0;
        if (QKN && colt < qk_cols) {
            PG8_LAS float* P = XL;
#pragma unroll
            for (int ai = 0; ai < 2; ++ai)
#pragma unroll
                for (int m = 0; m < 4; ++m)
#pragma unroll
                    for (int bj = 0; bj < 2; ++bj) { const f32x4 a = acc[ai][bj][m][0], b = acc[ai][bj][m][1];
                        float s = ((a[0] * a[0] + a[1] * a[1]) + (a[2] * a[2] + a[3] * a[3])) + ((b[0] * b[0] + b[1] * b[1]) + (b[2] * b[2] + b[3] * b[3]));
                        s += __shfl_xor(s, 16); s += __shfl_xor(s, 32);
                        if (fq == 0) P[((ai * HALF + wr * 64 + m * 16 + fr) * 2 + bj) * 4 + wc] = s; }
            asm volatile("s_waitcnt lgkmcnt(0)" ::: "memory"); __builtin_amdgcn_s_barrier(); asm volatile("" ::: "memory");
            const float* gm = (colt < (qk_cols >> 1) ? gamma_q : gamma_k) + wc * 32 + 8 * fq;
            const f32x4 g0 = *(const f32x4*)gm, g1 = *(const f32x4*)(gm + 4);
#pragma unroll
            for (int ai = 0; ai < 2; ++ai)
#pragma unroll
                for (int m = 0; m < 4; ++m)
#pragma unroll
                    for (int bj = 0; bj < 2; ++bj) { const f32x4 p = *(const PG8_LAS f32x4*)(P + ((ai * HALF + wr * 64 + m * 16 + fr) * 2 + bj) * 4);
                        const float r = __builtin_amdgcn_rsqf(((p[0] + p[1]) + (p[2] + p[3])) * (1.0f / 128.0f) + 1e-6f);
                        acc[ai][bj][m][0] = acc[ai][bj][m][0] * r * g0; acc[ai][bj][m][1] = acc[ai][bj][m][1] * r * g1; }
        }
        if (split_cols) { const int t = colt / split_cols; boff = (size_t)t * split_stride; colt -= t * split_cols; }
        const int col0 = colt + wc * 32 + 8 * fq;
#pragma unroll
        for (int ai = 0; ai < 2; ++ai)
#pragma unroll
            for (int m = 0; m < 4; ++m) { const size_t roff = boff + (size_t)(row0 + ai * HALF + m * 16) * ldc + col0;
#pragma unroll
                for (int bj = 0; bj < 2; ++bj) { const size_t off = roff + bj * HALF; f32x4 v0 = acc[ai][bj][m][0], v1 = acc[ai][bj][m][1];
                    if (mode == EB_SIGMOID) {
#pragma unroll
                        for (int i = 0; i < 4; ++i) { v0[i] = sigmoidf_(v0[i]); v1[i] = sigmoidf_(v1[i]); }
                    } else if (mode == EB_GATEMUL) { f32x4 a0, a1; unpack8(*(const u32x4*)(In1 + off), a0, a1); v0 = v0 * a0; v1 = v1 * a1; }
                    else if (mode == EB_MERGE) { f32x4 a0, a1, g0, g1; unpack8(*(const u32x4*)(In1 + off), a0, a1); unpack8(*(const u32x4*)(In2 + off), g0, g1); v0 = a0 + g0 * v0; v1 = a1 + g1 * v1; }
                    *(u32x4*)(O + off) = pack8(v0, v1); } }
    }
};
template <bool XSOUT = false> struct EpiF {
    static constexpr bool PERM = true, AFTER_DRAIN = false, PREFETCH = false;
    const float* base; float* out; const float* coef; bf16_t* XS; const float* avec; float* PS; PG8_LAS float* XL; float scale;
    __device__ __forceinline__ void operator()(f32x4 (&acc)[2][2][4][2], const Unit& u, int wr, int wc, int fr, int fq) const {
        const int row0 = u.pm * BM + wr * 64 + fr, col0 = u.pn * BM + wc * 32 + 8 * fq, bt = (u.pm * BM) / SEQ;
        const float* cf = coef + (size_t)bt * NMOD + col0;
        f32x4 cv[2][2], av[2][2];
#pragma unroll
        for (int bj = 0; bj < 2; ++bj)
#pragma unroll
            for (int n = 0; n < 2; ++n) { cv[bj][n] = *(const f32x4*)(cf + bj * HALF + n * 4) * scale; if (XSOUT) av[bj][n] = *(const f32x4*)(avec + bt * DM + col0 + bj * HALF + n * 4); }
        PG8_LAS float* P = XL;
        f32x4 pre[2][2][2];
#define EPIF_LOAD(slot, q) do { const size_t off_ = (size_t)(row0 + ((q) >> 2) * HALF + ((q) & 3) * 16) * DM + col0; \
            _Pragma("unroll") for (int bj = 0; bj < 2; ++bj) _Pragma("unroll") for (int n = 0; n < 2; ++n) pre[slot][bj][n] = *(const f32x4*)(base + off_ + bj * HALF + n * 4); } while (0)
#define EPIF_DO(slot, q) do { const int ai = (q) >> 2, m = (q) & 3; const size_t off = (size_t)(row0 + ai * HALF + m * 16) * DM + col0; float ss = 0.f; \
            _Pragma("unroll") for (int bj = 0; bj < 2; ++bj) { const f32x4 o0 = pre[slot][bj][0] + cv[bj][0] * acc[ai][bj][m][0], o1 = pre[slot][bj][1] + cv[bj][1] * acc[ai][bj][m][1]; \
                *(f32x4*)(out + off + bj * HALF) = o0; *(f32x4*)(out + off + bj * HALF + 4) = o1; \
                if (XSOUT) { ss += ((o0[0] * o0[0] + o0[1] * o0[1]) + (o0[2] * o0[2] + o0[3] * o0[3])) + ((o1[0] * o1[0] + o1[1] * o1[1]) + (o1[2] * o1[2] + o1[3] * o1[3])); \
                    *(u32x4*)(XS + off + bj * HALF) = pack8(o0 * av[bj][0], o1 * av[bj][1]); } } \
            if (XSOUT) { ss += __shfl_xor(ss, 16); ss += __shfl_xor(ss, 32); if (fq == 0) P[(ai * HALF + wr * 64 + m * 16 + fr) * 4 + wc] = ss; } } while (0)
        EPIF_LOAD(0, 0); EPIF_LOAD(1, 1);
        EPIF_DO(0, 0); EPIF_LOAD(0, 2); EPIF_DO(1, 1); EPIF_LOAD(1, 3); EPIF_DO(0, 2); EPIF_LOAD(0, 4); EPIF_DO(1, 3); EPIF_LOAD(1, 5);
        EPIF_DO(0, 4); EPIF_LOAD(0, 6); EPIF_DO(1, 5); EPIF_LOAD(1, 7); EPIF_DO(0, 6); EPIF_DO(1, 7);
#undef EPIF_LOAD
#undef EPIF_DO
        if (XSOUT) {
            asm volatile("s_waitcnt lgkmcnt(0)" ::: "memory"); __builtin_amdgcn_s_barrier(); asm volatile("" ::: "memory");
            const int tid = threadIdx.x;
            if (tid < BM) { const f32x4 p = *(const PG8_LAS f32x4*)(P + tid * 4); PS[(size_t)(u.pm * BM + tid) * 4 + u.pn] = (p[0] + p[1]) + (p[2] + p[3]); }
        }
    }
};

struct TwinOrder : StaticOrder {
    int reps;
    __device__ bool next(int i, Unit& u) const { if (i >= reps) return false; if (!StaticOrder::next(0, u)) return false; u.pn += 4 * i; return true; }
};
template <class Epi, class Sched, bool ALIGN_EPI = false, bool SP2 = false>
__device__ __forceinline__ void gemm_phase(PG8_LAS unsigned char* lds, const Gemm g, const Sched& S, Epi E) {
    const int tid = tid_opaque(), wid = __builtin_amdgcn_readfirstlane(tid >> 6), lane = tid & 63, wr = wid >> 2, wc = wid & 3, fr = lane & 15, fq = lane >> 4;
    const int K = g.K, nt = K / BK;
    unsigned voffA[2], voffB[2];
#pragma unroll
    for (int i = 0; i < 2; ++i) { int R, C; stage_rc(tid * 16 + i * 8192, R, C); const int Rb = Epi::PERM ? ((R & ~31) + perm32(R & 31)) : R;
        voffA[i] = (unsigned)(R * K + C) * 2u; voffB[i] = (unsigned)(Rb * K + C) * 2u; }
    const size_t kstep = (size_t)(BK * 2);
    const size_t hstep = (size_t)HALF * K * 2;
    const size_t tstep = 2 * hstep;
    const unsigned ldsw = (unsigned)wid * 1024u;
    const int aoff = lds_byte(wr * 64 + fr, fq * 8), boff = lds_byte(wc * 32 + fr, fq * 8);
#define PG8_SA(b, h) (((b) * 2 + (h)) * HTB)
#define PG8_SB(b, h) ((4 + (b) * 2 + (h)) * HTB)
#define PG8_STAGE(bufoff, gbase, voff) do { _Pragma("unroll") for (int _i = 0; _i < 2; ++_i) \
        __builtin_amdgcn_global_load_lds((const unsigned*)((const char*)(gbase) + (voff)[_i]), (PG8_LAS unsigned*)(lds + (bufoff) + ldsw + _i * 8192), 16, 0, 0); } while (0)
#define PG8_LDA(dst, b, h) do { _Pragma("unroll") for (int m = 0; m < 4; ++m) _Pragma("unroll") for (int k = 0; k < 2; ++k) dst[m][k] = *(const PG8_LAS bf16x8*)(lds + PG8_SA(b, h) + aoff + m * 2048 + k * 1024); } while (0)
#define PG8_LDB(dst, b, h) do { _Pragma("unroll") for (int n = 0; n < 2; ++n) _Pragma("unroll") for (int k = 0; k < 2; ++k) dst[n][k] = *(const PG8_LAS bf16x8*)(lds + PG8_SB(b, h) + boff + n * 2048 + k * 1024); } while (0)
#define PG8_MMA(ai, bj, At, Bt) do { __builtin_amdgcn_s_setprio(1); _Pragma("unroll") for (int m = 0; m < 4; ++m) _Pragma("unroll") for (int n = 0; n < 2; ++n) _Pragma("unroll") for (int k = 0; k < 2; ++k) \
        acc[ai][bj][m][n] = __builtin_amdgcn_mfma_f32_16x16x32_bf16(Bt[n][k], At[m][k], acc[ai][bj][m][n], 0, 0, 0); __builtin_amdgcn_s_setprio(0); } while (0)
#define PG8_WAIT_V(n) asm volatile("s_waitcnt vmcnt(" #n ")" ::: "memory")
#define PG8_WAIT_L(n) asm volatile("s_waitcnt lgkmcnt(" #n ")" ::: "memory")
#define PG8_BAR __builtin_amdgcn_s_barrier()
#define PG8_SCHED __builtin_amdgcn_sched_barrier(0)
    Unit cur, nxt; int ui = 0;
    if (!S.next(0, cur)) return;
    f32x4 acc[2][2][4][2];
#pragma unroll
    for (int a = 0; a < 2; ++a)
#pragma unroll
        for (int b = 0; b < 2; ++b)
#pragma unroll
            for (int m = 0; m < 4; ++m)
#pragma unroll
                for (int n = 0; n < 2; ++n) acc[a][b][m][n] = (f32x4){0.f, 0.f, 0.f, 0.f};
    bf16x8 At[4][2], B0[2][2], B1[2][2];
    const char* cA = (const char*)g.A + (size_t)cur.pm * tstep; const char* cB = (const char*)g.Bt + (size_t)cur.pn * tstep;
    S.a_ready(cur);
    if constexpr (Epi::PREFETCH) E.prefetch(cur, wid, 0);
    if constexpr (SP2) {
        PG8_STAGE(PG8_SB(0, 0), cB, voffB); PG8_STAGE(PG8_SB(0, 1), cB + hstep, voffB); PG8_STAGE(PG8_SA(0, 0), cA, voffA); PG8_STAGE(PG8_SA(0, 1), cA + hstep, voffA);
        if (wr == 1) PG8_BAR;
        PG8_WAIT_V(2); PG8_BAR;
        PG8_STAGE(PG8_SB(1, 0), cB + kstep, voffB); PG8_STAGE(PG8_SA(1, 0), cA + kstep, voffA); PG8_STAGE(PG8_SB(1, 1), cB + hstep + kstep, voffB);
        PG8_WAIT_V(6); PG8_BAR;
    } else {
        PG8_STAGE(PG8_SB(0, 0), cB, voffB); PG8_STAGE(PG8_SA(0, 0), cA, voffA); PG8_STAGE(PG8_SB(0, 1), cB + hstep, voffB); PG8_STAGE(PG8_SA(0, 1), cA + hstep, voffA);
        if (wr == 1) PG8_BAR;
        PG8_WAIT_V(4); PG8_BAR;
        PG8_STAGE(PG8_SB(1, 0), cB + kstep, voffB); PG8_STAGE(PG8_SA(1, 0), cA + kstep, voffA); PG8_STAGE(PG8_SB(1, 1), cB + hstep + kstep, voffB);
        PG8_WAIT_V(6); PG8_BAR;
    }
    for (;;) {
        const bool has_next = S.next(ui + 1, nxt);
        const char* nA = has_next ? (const char*)g.A + (size_t)nxt.pm * tstep : cA; const char* nB = has_next ? (const char*)g.Bt + (size_t)nxt.pn * tstep : cB;
        for (int t = 0; t < nt; t += 2) {
            const bool last = (t == nt - 2);
            const char* a1 = cA + (size_t)(t + 1) * kstep;
            const char* a2 = last ? nA : cA + (size_t)(t + 2) * kstep; const char* b2 = last ? nB : cB + (size_t)(t + 2) * kstep;
            const char* a3 = a2 + kstep; const char* b3 = b2 + kstep;
            if (last && has_next) S.a_ready(nxt);
            if constexpr (SP2) {
            PG8_LDB(B0, 0, 0); PG8_LDB(B1, 0, 1); PG8_SCHED; PG8_LDA(At, 0, 0); PG8_STAGE(PG8_SA(1, 1), a1 + hstep, voffA);
            PG8_WAIT_V(8); PG8_WAIT_L(0); PG8_BAR; PG8_MMA(0, 0, At, B0); PG8_MMA(0, 1, At, B1); PG8_BAR; PG8_SCHED;
            PG8_LDA(At, 0, 1); PG8_STAGE(PG8_SB(0, 0), b2, voffB); PG8_STAGE(PG8_SB(0, 1), b2 + hstep, voffB); PG8_STAGE(PG8_SA(0, 0), a2, voffA);
            PG8_WAIT_V(8); PG8_WAIT_L(0); PG8_BAR; PG8_MMA(1, 0, At, B0); PG8_MMA(1, 1, At, B1); PG8_BAR; PG8_SCHED;
            PG8_LDB(B0, 1, 0); PG8_LDB(B1, 1, 1); PG8_SCHED; PG8_LDA(At, 1, 0); PG8_STAGE(PG8_SA(0, 1), a2 + hstep, voffA);
            PG8_WAIT_V(8); PG8_WAIT_L(0); PG8_BAR; PG8_MMA(0, 0, At, B0); PG8_MMA(0, 1, At, B1); PG8_BAR; PG8_SCHED;
            PG8_LDA(At, 1, 1); PG8_STAGE(PG8_SB(1, 0), b3, voffB); PG8_STAGE(PG8_SB(1, 1), b3 + hstep, voffB); PG8_STAGE(PG8_SA(1, 0), a3, voffA);
            PG8_WAIT_V(8); PG8_WAIT_L(0); PG8_BAR; PG8_MMA(1, 0, At, B0); PG8_MMA(1, 1, At, B1); PG8_BAR; PG8_SCHED;
            } else {
            PG8_LDB(B0, 0, 0); PG8_SCHED; PG8_LDA(At, 0, 0); PG8_STAGE(PG8_SA(1, 1), a1 + hstep, voffA);
            PG8_WAIT_L(8); PG8_BAR; PG8_WAIT_L(0); PG8_MMA(0, 0, At, B0); PG8_BAR; PG8_SCHED;
            PG8_LDB(B1, 0, 1); PG8_STAGE(PG8_SB(0, 0), b2, voffB);
            PG8_BAR; PG8_WAIT_L(0); PG8_MMA(0, 1, At, B1); PG8_BAR;
            PG8_LDA(At, 0, 1); PG8_STAGE(PG8_SA(0, 0), a2, voffA);
            PG8_BAR; PG8_WAIT_L(0); PG8_MMA(1, 0, At, B0); PG8_BAR; PG8_SCHED;
            PG8_STAGE(PG8_SB(0, 1), b2 + hstep, voffB);
            PG8_WAIT_V(6); PG8_BAR; PG8_MMA(1, 1, At, B1); PG8_BAR;
            PG8_LDB(B0, 1, 0); PG8_SCHED; PG8_LDA(At, 1, 0); PG8_STAGE(PG8_SA(0, 1), a2 + hstep, voffA);
            PG8_WAIT_L(8); PG8_BAR; PG8_WAIT_L(0); PG8_MMA(0, 0, At, B0); PG8_BAR; PG8_SCHED;
            PG8_LDB(B1, 1, 1); PG8_STAGE(PG8_SB(1, 0), b3, voffB);
            PG8_BAR; PG8_WAIT_L(0); PG8_MMA(0, 1, At, B1); PG8_BAR;
            PG8_LDA(At, 1, 1); PG8_STAGE(PG8_SA(1, 0), a3, voffA);
            PG8_BAR; PG8_WAIT_L(0); PG8_MMA(1, 0, At, B0); PG8_BAR; PG8_SCHED;
            PG8_STAGE(PG8_SB(1, 1), b3 + hstep, voffB);
            PG8_WAIT_V(6); PG8_BAR; PG8_MMA(1, 1, At, B1); PG8_BAR;
            }
        }
        if constexpr (ALIGN_EPI) { if (wr == 0) PG8_BAR; }
        if constexpr (!Epi::AFTER_DRAIN) { if constexpr (Epi::PREFETCH) { E.par = ui & 1; } E(acc, cur, wr, wc, fr, fq); S.done(cur); }
        if (!has_next) break;
        if constexpr (Epi::PREFETCH) E.prefetch(nxt, wid, (ui + 1) & 1);
#pragma unroll
        for (int a = 0; a < 2; ++a)
#pragma unroll
            for (int b = 0; b < 2; ++b)
#pragma unroll
                for (int m = 0; m < 4; ++m)
#pragma unroll
                    for (int n = 0; n < 2; ++n) acc[a][b][m][n] = (f32x4){0.f, 0.f, 0.f, 0.f};
        cur = nxt; cA = nA; cB = nB; ++ui;
        if constexpr (ALIGN_EPI) { if (wr == 1) PG8_BAR; }
    }
    PG8_WAIT_V(0);
    if constexpr (!ALIGN_EPI) { if (wr == 0) PG8_BAR; }
    PG8_BAR;
    if constexpr (Epi::AFTER_DRAIN) { E.fused(acc, cur, wr, wc, fr, fq, lds, wid, lane); S.done(cur); }
#undef PG8_SA
#undef PG8_SB
#undef PG8_STAGE
#undef PG8_LDA
#undef PG8_LDB
#undef PG8_MMA
#undef PG8_WAIT_V
#undef PG8_WAIT_L
#undef PG8_BAR
#undef PG8_SCHED
}
}

namespace attn {
constexpr int D = 128;
constexpr int WINDOW = 129;
constexpr float THR = 8.f;
constexpr bool WSKIP = true;
constexpr float SCALE = 0.08838834764831845f;
constexpr int NW = 8, QBLK = 32, KVBLK = 64, QB = NW * QBLK;
constexpr int SHM_V = KVBLK * D * 2, SHM_K = KVBLK * D * 2;
constexpr int LDS_BYTES = 2 * SHM_V + 2 * SHM_K + NW * 64 * 4;
using bf16 = __hip_bfloat16;
typedef short bf16x8 __attribute__((ext_vector_type(8)));
typedef short s16x4 __attribute__((ext_vector_type(4)));
typedef float f32x16 __attribute__((ext_vector_type(16)));
typedef float f32x4 __attribute__((ext_vector_type(4)));
typedef unsigned u32x4 __attribute__((ext_vector_type(4)));
template <class A, class Bt> struct same_t { static constexpr bool v = false; };
template <class A> struct same_t<A, A> { static constexpr bool v = true; };

#define KSWZ(row, colB) ((row) * 256 + ((colB) ^ (((row) & 7) << 4)))
#define SBAR() __builtin_amdgcn_sched_barrier(0)
__device__ __forceinline__ int v_st(int k, int c) { const int kk = (k & ~0xC) | ((k & 4) << 1) | ((k & 8) >> 1); return ((kk >> 3) * 4 + (c >> 5)) * 512 + ((kk & 7) * 32 + (c & 31)) * 2; }
__device__ __forceinline__ int v_rd_base(int lane) { return ((lane & 3) << 3) | (((lane >> 2) & 3) << 6) | (((lane >> 4) & 1) << 5) | (((lane >> 5) & 1) << 8); }
constexpr int v_rd_off(int d0, int ks, int half) { return d0 * 512 + ks * 4096 + half * 2048; }
__device__ __forceinline__ int crow(int r, int hi) { return (r & 3) + 8 * (r >> 2) + 4 * hi; }
__device__ __forceinline__ unsigned cvtpk(float lo, float hi) {
    unsigned r; asm volatile("v_cvt_pk_bf16_f32 %0, %1, %2" : "=v"(r) : "v"(lo), "v"(hi)); return r;
}
__device__ __forceinline__ bf16x8 pack8(f32x4 a, f32x4 b) {
    u32x4 w = {cvtpk(a[0], a[1]), cvtpk(a[2], a[3]), cvtpk(b[0], b[1]), cvtpk(b[2], b[3])};
    return *reinterpret_cast<bf16x8*>(&w);
}
template <class T> __device__ __forceinline__ bf16x8 load8(const T* p) {
    if constexpr (same_t<T, float>::v) { return pack8(*(const f32x4*)p, *(const f32x4*)(p + 4)); }
    else { return *reinterpret_cast<const bf16x8*>(p); }
}
__device__ __forceinline__ void mask_tile(f32x16& p0, f32x16& p1, int dq, unsigned W) {
    const float NEG = -__builtin_inff();
#pragma unroll
    for (int r = 0; r < 16; ++r) {
        const int c = (r & 3) + 8 * (r >> 2);
        if ((unsigned)(dq - c) >= W) p0[r] = NEG;
        if ((unsigned)(dq - c - 32) >= W) p1[r] = NEG;
    }
}
__device__ __forceinline__ void partialSM(f32x16& p0, f32x16& p1, float& m_reg, float& mn, float& alpha) {
    float pmax = p0[0]; for (int r = 1; r < 16; ++r) pmax = fmaxf(pmax, p0[r]); for (int r = 0; r < 16; ++r) pmax = fmaxf(pmax, p1[r]);
    { auto rr = __builtin_amdgcn_permlane32_swap(__float_as_uint(pmax), __float_as_uint(pmax), false, false);
      pmax = fmaxf(__uint_as_float(rr[0]), __uint_as_float(rr[1])); }
    constexpr float C2 = 1.4426950408889634f * SCALE;
    if (__builtin_expect(__all((pmax - m_reg) * SCALE <= THR), 1)) { mn = m_reg; alpha = 1.f; }
    else { mn = fmaxf(m_reg, pmax); alpha = __builtin_amdgcn_exp2f((m_reg - mn) * C2); m_reg = mn; }
    const float mnL = -mn * C2;
    for (int r = 0; r < 16; ++r) p0[r] = fmaf(p0[r], C2, mnL); for (int r = 0; r < 16; ++r) p1[r] = fmaf(p1[r], C2, mnL);
    for (int r = 0; r < 16; ++r) p0[r] = __builtin_amdgcn_exp2f(p0[r]);
}
__device__ __forceinline__ void finishSM(f32x16& p0, f32x16& p1, float alpha, float& l_reg, bf16x8& pa0, bf16x8& pa1, bf16x8& pa2, bf16x8& pa3) {
    for (int r = 0; r < 16; ++r) p1[r] = __builtin_amdgcn_exp2f(p1[r]);
    float ps = 0; for (int r = 0; r < 16; ++r) ps += p0[r]; for (int r = 0; r < 16; ++r) ps += p1[r];
    { auto rr = __builtin_amdgcn_permlane32_swap(__float_as_uint(ps), __float_as_uint(ps), false, false);
      ps = __uint_as_float(rr[0]) + __uint_as_float(rr[1]); }
    l_reg = l_reg * alpha + ps;
#define PK4(P, B_, OUT) do { unsigned a0 = cvtpk(P[B_+0], P[B_+1]), a1 = cvtpk(P[B_+2], P[B_+3]);                          \
        unsigned b0 = cvtpk(P[B_+4], P[B_+5]), b1 = cvtpk(P[B_+6], P[B_+7]);                                             \
        auto r0 = __builtin_amdgcn_permlane32_swap(a0, b0, false, false); auto r1 = __builtin_amdgcn_permlane32_swap(a1, b1, false, false); \
        u32x4 w = {r0[0], r1[0], r0[1], r1[1]}; OUT = *reinterpret_cast<bf16x8*>(&w); } while (0)
    PK4(p0, 0, pa0); PK4(p0, 8, pa1); PK4(p1, 0, pa2); PK4(p1, 8, pa3);
#undef PK4
}
template <int KB, bool SK>
__device__ __forceinline__ void qkt(f32x16& p0, f32x16& p1, const char* K_lds, int r32, int hi, const bf16x8* qr, bool act) {
    if (SK && !act) { const float NEG = -__builtin_inff();
#pragma unroll
        for (int r = 0; r < 16; ++r) { p0[r] = NEG; p1[r] = NEG; } return; }
    p0 = f32x16{}; p1 = f32x16{};
    const char* kb[4];
#pragma unroll
    for (int dd = 0; dd < 4; ++dd) kb[dd] = K_lds + KB * SHM_K + KSWZ(r32, (dd * 16 + hi * 8) * 2);
#pragma unroll
    for (int d0 = 0; d0 < 8; ++d0) { const char* a = kb[d0 & 3] + (d0 >> 2) * 128;
        bf16x8 b0 = *reinterpret_cast<const bf16x8*>(a);
        bf16x8 b1 = *reinterpret_cast<const bf16x8*>(a + 32 * 256);
        p0 = __builtin_amdgcn_mfma_f32_32x32x16_bf16(b0, qr[d0], p0, 0, 0, 0);
        p1 = __builtin_amdgcn_mfma_f32_32x32x16_bf16(b1, qr[d0], p1, 0, 0, 0); }
}
template <int VB, bool SK>
__device__ __forceinline__ void pv_tile(f32x16* o, int vb0, bf16x8 pa0, bf16x8 pa1, bf16x8 pa2, bf16x8 pa3, bool act) {
    if (SK && !act) return;
#define TRRD(dst, off) asm volatile("ds_read_b64_tr_b16 %0, %1 offset:%2" : "=&v"(dst) : "v"(vb0), "i"(off) : "memory")
#define PV_D0(d0) do { s16x4 l0, l1, l2, l3, h0, h1, h2, h3; constexpr int b_ = VB * SHM_V + v_rd_off(d0, 0, 0);     \
        TRRD(l0, b_); TRRD(h0, b_ + 2048); TRRD(l1, b_ + 4096); TRRD(h1, b_ + 6144); TRRD(l2, b_ + 8192); TRRD(h2, b_ + 10240); TRRD(l3, b_ + 12288); TRRD(h3, b_ + 14336); \
        asm volatile("s_waitcnt lgkmcnt(0)" ::: "memory"); SBAR();                 \
        o[d0] = __builtin_amdgcn_mfma_f32_32x32x16_bf16(pa0, (bf16x8){l0[0], l0[1], l0[2], l0[3], h0[0], h0[1], h0[2], h0[3]}, o[d0], 0, 0, 0);   \
        o[d0] = __builtin_amdgcn_mfma_f32_32x32x16_bf16(pa1, (bf16x8){l1[0], l1[1], l1[2], l1[3], h1[0], h1[1], h1[2], h1[3]}, o[d0], 0, 0, 0);   \
        o[d0] = __builtin_amdgcn_mfma_f32_32x32x16_bf16(pa2, (bf16x8){l2[0], l2[1], l2[2], l2[3], h2[0], h2[1], h2[2], h2[3]}, o[d0], 0, 0, 0);   \
        o[d0] = __builtin_amdgcn_mfma_f32_32x32x16_bf16(pa3, (bf16x8){l3[0], l3[1], l3[2], l3[3], h3[0], h3[1], h3[2], h3[3]}, o[d0], 0, 0, 0); } while (0)
    PV_D0(0); PV_D0(1); PV_D0(2); PV_D0(3);
#undef PV_D0
#undef TRRD
}

template <class TIn, class TOut> struct BlockRef { const TIn* Q; const TIn* K; const TIn* V; TOut* O; float* LSE; int P0; int rs; int ls; };
template <class TIn> struct Seam {
    bf16x8 qr[8];
    bf16x8 st_v0, st_v1, st_k0, st_k1; f32x4 sf0, sf1, sf2, sf3;
    f32x4 tq[16];
};
__device__ __forceinline__ int swa_jlo(int P0, int W) { const int lowk = P0 - W + 1; return lowk > 0 ? lowk / KVBLK : 0; }
#define ROW(p, k0, rr, rs_) ((p) + (size_t)((k0) + (rr)) * (size_t)(rs_) + sc)
#define VMW() asm volatile("s_waitcnt vmcnt(0)" ::: "memory")
#define VMWN(n) asm volatile("s_waitcnt vmcnt(%0)" :: "i"(n) : "memory")
#define SLOAD_H(Kp, Vp, k0, rs_) do { S.st_v0 = load8<TIn>(ROW(Vp, k0, sr, rs_)); S.st_v1 = load8<TIn>(ROW(Vp, k0, 32 + sr, rs_));              \
                         S.st_k0 = load8<TIn>(ROW(Kp, k0, sr, rs_)); S.st_k1 = load8<TIn>(ROW(Kp, k0, 32 + sr, rs_)); } while (0)
#define SWRITE_HK(bf) do { *(bf16x8*)(K_lds + (bf) * SHM_K + kws) = S.st_k0; *(bf16x8*)(K_lds + (bf) * SHM_K + kws + 32 * 256) = S.st_k1; } while (0)
#define SWRITE_HV(bf) do { *(bf16x8*)(V_lds + (bf) * SHM_V + vst0) = S.st_v0; *(bf16x8*)(V_lds + (bf) * SHM_V + vst1) = S.st_v1; } while (0)
#define SWRITE_H(bf) do { SWRITE_HV(bf); SWRITE_HK(bf); } while (0)
#define SLOAD_F(p, k0) do { } while (0)
#define SWRITE_KF(bf) do { *(bf16x8*)(K_lds + (bf) * SHM_K + kws) = pack8(S.sf0, S.sf1); *(bf16x8*)(K_lds + (bf) * SHM_K + kws + 32 * 256) = pack8(S.sf2, S.sf3); } while (0)
#define SWRITE_VF(bf) do { *(bf16x8*)(V_lds + (bf) * SHM_V + vst0) = pack8(S.sf0, S.sf1); *(bf16x8*)(V_lds + (bf) * SHM_V + vst1) = pack8(S.sf2, S.sf3); } while (0)
template <class TIn, class TOut>
__device__ __forceinline__ void causal_swa_prime(const BlockRef<TIn, TOut>& cur, int W, char* lds, Seam<TIn>& S) {
    constexpr bool F32 = same_t<TIn, float>::v;
    const int tid = tid_opaque(), wid = __builtin_amdgcn_readfirstlane(tid >> 6), lane = tid & 63, r32 = lane & 31, hi = lane >> 5;
    const int sr = tid >> 4, sc = (tid & 15) * 8, kws = KSWZ(sr, sc * 2); char* K_lds = lds + 2 * SHM_V;
    const int kb0 = swa_jlo(cur.P0, W) * KVBLK;
    for (int d0 = 0; d0 < 8; ++d0) S.qr[d0] = load8<TIn>(cur.Q + (size_t)(wid * QBLK + r32) * (size_t)cur.rs + d0 * 16 + hi * 8);
    if constexpr (F32) { SLOAD_F((const float*)cur.K, kb0); VMW(); SWRITE_KF(0); SBAR(); SLOAD_F((const float*)cur.V, kb0); }
    else { SLOAD_H(cur.K, cur.V, kb0, cur.rs); VMW(); SWRITE_HK(0); }
    __syncthreads();
}
template <class TIn, class TOut>
__device__ __forceinline__ void causal_swa_block(const BlockRef<TIn, TOut>& cur, const BlockRef<TIn, TOut>& nxt, int skv, int W, char* lds, Seam<TIn>& S) {
    constexpr bool F32 = same_t<TIn, float>::v;
    const int tid = tid_opaque(), wid = __builtin_amdgcn_readfirstlane(tid >> 6), lane = tid & 63, r32 = lane & 31, hi = lane >> 5;
    const int j_lo = swa_jlo(cur.P0, W);
    int j_hi = (cur.P0 + QB - 1) / KVBLK + 1; if (j_hi > skv / KVBLK) j_hi = skv / KVBLK;
    const int NT = j_hi - j_lo;
    const int kbn = swa_jlo(nxt.P0, W) * KVBLK;
    const int qlo = cur.P0 + wid * QBLK, qm = qlo + r32 - 4 * hi;
    char* V_lds = lds; char* K_lds = lds + 2 * SHM_V;
    float* ws = (float*)(lds + 2 * SHM_V + 2 * SHM_K) + wid * 64; float* li_l = ws, * al_l = ws + 32;
    float m_reg = -1e30f, l_reg = 0; f32x16 o[4] = {};
    const int sr = tid >> 4, sc = (tid & 15) * 8, vst0 = v_st(sr, sc), vst1 = v_st(32 + sr, sc), kws = KSWZ(sr, sc * 2);
    const int vb0 = (int)(uintptr_t)V_lds + v_rd_base(lane);
    const TIn* Kh = cur.K; const TIn* Vh = cur.V;
#define RESC(a) do { if (__any((a) < 1.f)) { if (hi == 0) al_l[r32] = (a); asm volatile("s_waitcnt lgkmcnt(0)" ::: "memory");              \
                     for (int d_ = 0; d_ < 4; ++d_) for (int r = 0; r < 16; ++r) o[d_][r] *= al_l[crow(r, hi)]; } } while (0)
#define KBASE(t) ((j_lo + (t)) * KVBLK)
#define ACT(t) (KBASE(t) <= qlo + QBLK - 1 && KBASE(t) + KVBLK - 1 >= qlo - W + 1)
#define MASKT(P0_, P1_, t) do { const int kb_ = KBASE(t); if ((!SK || ACT(t)) && (kb_ + KVBLK - 1 > qlo || kb_ <= qlo + QBLK - 1 - W)) mask_tile(P0_, P1_, qm - kb_, (unsigned)W); } while (0)
    constexpr int NQL = F32 ? 16 : 8;
    constexpr bool SK = WSKIP && !F32;
#define SEAM_K0() do { VMWN(NQL); if constexpr (F32) { SWRITE_KF(0); SBAR(); SLOAD_F((const float*)nxt.V, kbn); } else { SWRITE_HK(0); } SBAR(); } while (0)
    f32x16 pA0, pA1, pB0, pB1; float mnA, mnB, alA, alB; bf16x8 pa0, pa1, pa2, pa3;
    if constexpr (F32) { VMW(); SWRITE_VF(0); SBAR(); } else { SWRITE_HV(0); SBAR(); }
    if (NT > 1) { if constexpr (F32) SLOAD_F((const float*)Kh, KBASE(1)); else SLOAD_H(Kh, Vh, KBASE(1), cur.rs); }
    SBAR(); qkt<0, SK>(pA0, pA1, K_lds, r32, hi, S.qr, ACT(0));
    if constexpr (F32) { if (NT > 1) { VMW(); SWRITE_KF(1); SBAR(); SLOAD_F((const float*)Vh, KBASE(1)); } }
    MASKT(pA0, pA1, 0); partialSM(pA0, pA1, m_reg, mnA, alA);
    if (NT > 1) { VMW(); if constexpr (F32) { SWRITE_VF(1); SBAR(); if (NT > 2) SLOAD_F((const float*)Kh, KBASE(2)); } else SWRITE_H(1); }
    __syncthreads();
#define HALF_STEP(PX0, PX1, mnX, alX, PY0, PY1, alY, t, KB, VB, SB) do {                                                      \
        SBAR(); qkt<KB, SK>(PX0, PX1, K_lds, r32, hi, S.qr, ACT(t));                                             \
        finishSM(PY0, PY1, alY, l_reg, pa0, pa1, pa2, pa3); SBAR();                                                           \
        if ((t) + 1 < NT) { if constexpr (F32) { VMW(); SWRITE_KF(SB); SBAR(); SLOAD_F((const float*)Vh, KBASE((t) + 1)); }  \
                            else { SLOAD_H(Kh, Vh, KBASE((t) + 1), cur.rs); } SBAR(); }                                               \
        pv_tile<VB, SK>(o, vb0, pa0, pa1, pa2, pa3, ACT((t) - 1)); MASKT(PX0, PX1, (t)); partialSM(PX0, PX1, m_reg, mnX, alX);                                        \
        __syncthreads();                                                                                                      \
        if ((t) + 1 < NT) { VMW(); if constexpr (F32) { SWRITE_VF(SB); SBAR(); if ((t) + 2 < NT) SLOAD_F((const float*)Kh, KBASE((t) + 2)); } \
                            else { SWRITE_H(SB); } }                                                                          \
        RESC(alX); __syncthreads(); } while (0)
    for (int t = 1; t + 1 < NT; t += 2) {
        HALF_STEP(pB0, pB1, mnB, alB, pA0, pA1, alA, t, 1, 0, 0);
        HALF_STEP(pA0, pA1, mnA, alA, pB0, pB1, alB, t + 1, 0, 1, 1);
    }
    const bool even = (NT & 1) == 0;
    if (even) { SBAR(); qkt<1, SK>(pB0, pB1, K_lds, r32, hi, S.qr, ACT(NT - 1)); SBAR(); }
#define QROW(e) (nxt.Q + (size_t)(wid * QBLK + r32) * (size_t)nxt.rs + ((e) >> 1) * 16 + hi * 8 + ((e) & 1) * 4)
    if constexpr (F32) { SLOAD_F((const float*)nxt.K, kbn); SBAR();
#pragma unroll
        for (int e = 0; e < 8; ++e) S.tq[e] = *(const f32x4*)QROW(e); }
    else { SLOAD_H(nxt.K, nxt.V, kbn, nxt.rs); SBAR();
#pragma unroll
        for (int d0 = 0; d0 < 8; ++d0) S.qr[d0] = load8<TIn>(nxt.Q + (size_t)(wid * QBLK + r32) * (size_t)nxt.rs + d0 * 16 + hi * 8); }
    SBAR();
    finishSM(pA0, pA1, alA, l_reg, pa0, pa1, pa2, pa3); SBAR();
    if constexpr (F32) {
#pragma unroll
        for (int e = 8; e < 16; ++e) S.tq[e] = *(const f32x4*)QROW(e); SBAR(); }
#undef QROW
    pv_tile<0, SK>(o, vb0, pa0, pa1, pa2, pa3, ACT(even ? NT - 2 : NT - 1));
    if (even) { MASKT(pB0, pB1, NT - 1); partialSM(pB0, pB1, m_reg, mnB, alB); __syncthreads(); RESC(alB);
        finishSM(pB0, pB1, alB, l_reg, pa0, pa1, pa2, pa3); SBAR(); pv_tile<1, SK>(o, vb0, pa0, pa1, pa2, pa3, ACT(NT - 1)); }
    SBAR(); SEAM_K0();
    if (hi == 0) li_l[r32] = l_reg; asm volatile("s_waitcnt lgkmcnt(0)" ::: "memory");
    float rli[16];
#pragma unroll
    for (int r = 0; r < 16; ++r) rli[r] = __builtin_amdgcn_rcpf(li_l[crow(r, hi)]);
    TOut* Ow = cur.O + (size_t)(wid * QBLK) * (size_t)cur.rs;
    if (hi == 0) cur.LSE[(size_t)(wid * QBLK + r32) * (size_t)cur.ls] = m_reg * SCALE + __logf(l_reg);
#pragma unroll
    for (int r = 0; r < 16; ++r) { const int orow = crow(r, hi);
#pragma unroll
        for (int d0 = 0; d0 < 4; ++d0) { const float v = o[d0][r] * rli[r];
            if constexpr (same_t<TOut, float>::v) { Ow[(size_t)orow * (size_t)cur.rs + d0 * 32 + r32] = v; }
            else { const float vn = __shfl_xor(v, 1);
                   if ((r32 & 1) == 0) *(unsigned*)(Ow + (size_t)orow * (size_t)cur.rs + d0 * 32 + r32) = cvtpk(v, vn); } } }
    if constexpr (F32) {
#pragma unroll
        for (int d0 = 0; d0 < 8; ++d0) S.qr[d0] = pack8(S.tq[2 * d0], S.tq[2 * d0 + 1]); }
    __syncthreads();
#undef RESC
#undef KBASE
#undef ACT
#undef MASKT
#undef SEAM_K0
#undef HALF_STEP
}
#undef ROW
#undef VMW
#undef VMWN
#undef SLOAD_H
#undef SWRITE_HK
#undef SWRITE_HV
#undef SWRITE_H
#undef SLOAD_F
#undef SWRITE_KF
#undef SWRITE_VF

#undef SBAR
}
#define GAS __attribute__((address_space(1)))
#define LAS __attribute__((address_space(3)))
typedef unsigned short bf16;
typedef unsigned v4u __attribute__((ext_vector_type(4)));
typedef float f32x4 __attribute__((ext_vector_type(4)));
typedef short bf16x8 __attribute__((ext_vector_type(8)));
typedef GAS unsigned gu32;
typedef GAS unsigned long long gu64;
#define RLX_AGENT __ATOMIC_RELAXED, __HIP_MEMORY_SCOPE_AGENT
#define LDS_WAIT() asm volatile("s_waitcnt lgkmcnt(0)" ::: "memory")
#define VM_WAIT() asm volatile("s_waitcnt vmcnt(0)" ::: "memory")
__device__ __forceinline__ unsigned long long rt() { return __builtin_amdgcn_s_memrealtime(); }
__device__ __forceinline__ unsigned f2bf(float f) { unsigned u = __builtin_bit_cast(unsigned, f); return (u + 0x7fffu + ((u >> 16) & 1u)) >> 16; }
__device__ __forceinline__ unsigned pk2(float lo, float hi) { return f2bf(lo) | (f2bf(hi) << 16); }

#define XB_TMO      128
#define XB_XCNT(j)  (256  + 64 * (j))
#define XB_XSUB(j)  (1280 + 64 * (j))
#define XB_XGEN(j)  (2304 + 64 * (j))
#define XB_TOP      3328
#define XB_TOPGEN   3392
#define XCD_BAR_WORDS 3456
#define XB_SPIN_CAP (1u << 18)

__device__ __forceinline__ unsigned xb_ld(unsigned* p)              { return __hip_atomic_load(p, __ATOMIC_RELAXED, __HIP_MEMORY_SCOPE_AGENT); }
__device__ __forceinline__ unsigned xb_add(unsigned* p, unsigned v) { return __hip_atomic_fetch_add(p, v, __ATOMIC_RELAXED, __HIP_MEMORY_SCOPE_AGENT); }
__device__ __forceinline__ unsigned xb_xcc_id() { return (unsigned)__builtin_amdgcn_s_getreg((3 << 11) | 20) & 0xFu; }
#define XB_SPIN(cond, bar) do { unsigned _sp = 0; while (cond) { __builtin_amdgcn_s_sleep(1); \
    if ((++_sp & 255u) == 0u) { if (xb_ld(&(bar)[XB_TMO])) break; if (_sp > XB_SPIN_CAP) { atomicAdd(&(bar)[XB_TMO], 1u); break; } } } } while (0)

struct XcdBarrier {
    unsigned* bar; unsigned x;
    volatile LAS unsigned* st;
};

__device__ __forceinline__ XcdBarrier xcd_barrier_post(unsigned* bar, volatile LAS unsigned* st) {
    XcdBarrier b; b.bar = bar; b.x = xb_xcc_id(); b.st = st;
    if (threadIdx.x == 0) (void)xb_add(&bar[XB_XCNT(b.x)], 1u);
    return b;
}
__device__ __forceinline__ void xcd_barrier_complete(unsigned* bar, unsigned x, unsigned& nloc, unsigned& nx) {
    const unsigned G = gridDim.x * gridDim.y * gridDim.z;
    unsigned sum, cnt, mine, sp = 0u;
    for (;;) {
        sum = 0u; cnt = 0u; mine = 0u;
#pragma unroll
        for (unsigned j = 0; j < 16; ++j) { const unsigned c = xb_ld(&bar[XB_XCNT(j)]); sum += c; cnt += (c > 0u) ? 1u : 0u; mine = (j == x) ? c : mine; }
        if (sum == G) break;
        __builtin_amdgcn_s_sleep(1);
        if ((++sp & 255u) == 0u) { if (xb_ld(&bar[XB_TMO])) break; if (sp > XB_SPIN_CAP) { atomicAdd(&bar[XB_TMO], 1u); break; } }
    }
    nloc = mine > 0u ? mine : 1u; nx = cnt > 0u ? cnt : 1u;
}

__device__ __forceinline__ void xcd_barrier(const XcdBarrier& b) {
    asm volatile("s_waitcnt vmcnt(0)" ::: "memory");
    __syncthreads();
    if (threadIdx.x == 0) {
        unsigned* bar = b.bar;
        __builtin_amdgcn_s_waitcnt(0);
        unsigned nloc = b.st[0], nx = b.st[1];
        if (nloc == 0u) { xcd_barrier_complete(bar, b.x, nloc, nx); b.st[0] = nloc; b.st[1] = nx; }
        const unsigned old = xb_add(&bar[XB_XSUB(b.x)], 1u);
        const unsigned gen = old / nloc;
        if (old + 1u == (gen + 1u) * nloc) {
            __builtin_amdgcn_fence(__ATOMIC_RELEASE, "agent");
            asm volatile("s_waitcnt vmcnt(0)" ::: "memory");
            const unsigned og = xb_add(&bar[XB_TOP], 1u);
            const unsigned tg = og / nx;
            if (og + 1u == (tg + 1u) * nx) xb_add(&bar[XB_TOPGEN], 1u);
            else XB_SPIN(xb_ld(&bar[XB_TOPGEN]) == tg, bar);
            __builtin_amdgcn_fence(__ATOMIC_ACQUIRE, "agent");
            xb_add(&bar[XB_XGEN(b.x)], 1u);
            asm volatile("s_waitcnt vmcnt(0)" ::: "memory");
        } else {
            XB_SPIN(xb_ld(&bar[XB_XGEN(b.x)]) == gen, bar);
            __builtin_amdgcn_fence(__ATOMIC_ACQUIRE, "agent");
            asm volatile("s_waitcnt vmcnt(0)" ::: "memory");
        }
    }
    __syncthreads();
}

constexpr int NWAVES = 8;

constexpr size_t MiB = 1u << 20, HMiB = 1u << 19;
constexpr size_t WS_CTL = 0, CTL_ZERO_BYTES = 64 * 1024;
constexpr size_t WS_MOD = 1 * MiB;
constexpr size_t WS_AVEC = WS_MOD + 80 * 1024;
constexpr size_t WS_BIAS_IN = WS_MOD + 96 * 1024;
constexpr size_t WS_BIAS_F2 = WS_MOD + 176 * 1024;
constexpr size_t WS_PS2 = WS_MOD + 256 * 1024, WS_PS3 = WS_MOD + 512 * 1024;
constexpr size_t WS_WGU1 = 2 * MiB;
constexpr size_t WS_WD1 = WS_WGU1 + 11 * MiB;
constexpr size_t WS_WIN = WS_WD1 + 11 * HMiB;
constexpr size_t WS_WA = WS_WIN + 19 * MiB;
constexpr size_t WS_WC = WS_WA + 1 * MiB;
constexpr size_t WS_WO = WS_WC + 2 * MiB;
constexpr size_t WS_WGU2 = WS_WO + 2 * MiB;
constexpr size_t WS_WD2 = WS_WGU2 + 11 * MiB;
constexpr size_t WS_XS = WS_WD2 + 11 * HMiB;
constexpr size_t WS_R = WS_XS + 32 * MiB;
constexpr size_t WS_ACT = WS_R;
constexpr size_t WS_Q = WS_R, WS_K = WS_R + 48 * MiB, WS_V = WS_R + 96 * MiB;
constexpr size_t WS_LSE = WS_R + 144 * MiB;
constexpr size_t WS_O = WS_R + 145 * MiB;
constexpr size_t WS_U = WS_R + 48 * MiB, WS_B = WS_R + 80 * MiB, WS_C = WS_R + 112 * MiB;
constexpr size_t WS_SGA = WS_R, WS_SGC = WS_R + 48 * MiB;
constexpr size_t WS_END = WS_O + 16 * MiB;
static_assert(WS_XS == 59 * MiB && WS_END <= 256 * MiB, "d_ws map");
constexpr int CW_BAR = 4096;

constexpr int RING_OFF = 0, RING_BYTES = 131072;
constexpr int LDSCTL_OFF = RING_BYTES, MISC_OFF = LDSCTL_OFF + 320, XL_OFF = RING_BYTES + 1024;
constexpr int LDS_BYTES = 151552;


struct Args { const float* in[20]; float* out; unsigned char* ws; int ph_lo, ph_hi; };
struct Frame {
    LAS unsigned char* lds;
    volatile LAS unsigned* MISC;
    gu32* ctl;
    int tid, lane, wave;
    int vcu, G;
    float* out; unsigned char* ws;
};
enum { I_X = 0, I_C, I_WADA, I_BADA, I_NF1, I_F1G, I_F1U, I_F1D, I_NMIX, I_WIN, I_QN, I_KN, I_CONVW, I_WAB, I_WCB, I_WOUT, I_NF2, I_F2G, I_F2U, I_F2D };
enum { MOD_SH1 = 0, MOD_SC1 = 1024, MOD_GT1 = 2048, MOD_SH2 = 3072, MOD_SC2 = 4096, MOD_GT2 = 5120, MOD_SH3 = 6144, MOD_SC3 = 7168, MOD_GT3 = 8192 };

__device__ __forceinline__ float silu_f(float x) { return x * __builtin_amdgcn_rcpf(1.0f + __builtin_amdgcn_exp2f(-1.4426950408889634f * x)); }
__device__ __forceinline__ float wave_sum(float v) {
#pragma unroll
    for (int o = 1; o < 64; o <<= 1) v += __shfl_xor(v, o);
    return v;
}
__device__ __forceinline__ float blo(unsigned w) { return __uint_as_float(w << 16); }
__device__ __forceinline__ float bhi(unsigned w) { return __uint_as_float(w & 0xffff0000u); }

constexpr int ADA_ITEMS = NMOD / 64;
__device__ __forceinline__ void p0_adaln_item(Frame& F, const Args& args, int item) {
    LAS float* sc = (LAS float*)(F.lds + RING_OFF);
    LAS float* red = sc + 2048;
    const float* c = args.in[I_C]; const float* wada = args.in[I_WADA]; const float* bada = args.in[I_BADA];
    for (int i = F.tid; i < 2 * DM; i += NWAVES * 64) sc[i] = silu_f(c[i]);
    __syncthreads();
    const int j0 = item * 64, cg = F.lane & 15, rs = F.lane >> 4;
    f32x4 a0 = {0.f, 0.f, 0.f, 0.f}, a1 = {0.f, 0.f, 0.f, 0.f};
    const GAS f32x4* wp = (const GAS f32x4*)(wada + (size_t)(F.wave * 128 + rs) * NMOD + j0 + 4 * cg);
#pragma unroll 16
    for (int it = 0; it < 32; ++it) { const int k = F.wave * 128 + 4 * it + rs; const f32x4 w = __builtin_nontemporal_load(&wp[(size_t)it * 4 * (NMOD / 4)]);
        a0 = a0 + w * sc[k]; a1 = a1 + w * sc[DM + k]; }
#pragma unroll
    for (int i = 0; i < 4; ++i) { a0[i] += __shfl_xor(a0[i], 16); a0[i] += __shfl_xor(a0[i], 32); a1[i] += __shfl_xor(a1[i], 16); a1[i] += __shfl_xor(a1[i], 32); }
    if (F.lane < 16) {
#pragma unroll
        for (int i = 0; i < 4; ++i) { red[(F.wave * 2 + 0) * 64 + 4 * cg + i] = a0[i]; red[(F.wave * 2 + 1) * 64 + 4 * cg + i] = a1[i]; } }
    __syncthreads();
    if (F.tid < 128) { const int b = F.tid >> 6, j = F.tid & 63; float s = bada[j0 + j];
#pragma unroll
        for (int w = 0; w < NWAVES; ++w) s += red[(w * 2 + b) * 64 + j];
        ((float*)(F.ws + WS_MOD))[b * NMOD + j0 + j] = s; }
    __syncthreads();
}
__device__ __forceinline__ void p0_transpose_item(const float* W, int K, int N, bf16* WT, int rmode, LAS float* scr, int item, int lane) {
    const int nblk = N / 32, kb = item / nblk, nb = item % nblk, k0 = 64 * kb, n0 = 32 * nb;
    const int r0 = rmode == 0 ? n0 : 256 * (n0 >> 7) + 128 * (rmode - 1) + (n0 & 127);
#pragma unroll 16
    for (int i = 0; i < 32; ++i) { const int kk = 2 * i + (lane >> 5); scr[kk * 33 + (lane & 31)] = __builtin_nontemporal_load(&W[(size_t)(k0 + kk) * N + n0 + (lane & 31)]); }
    LDS_WAIT(); asm volatile("" ::: "memory");
    const int c = lane & 7;
#pragma unroll
    for (int j = 0; j < 4; ++j) { const int n = (lane >> 3) + 8 * j; const LAS float* s = scr + (8 * c) * 33 + n;
        v4u o; o.x = pk2(s[0 * 33], s[1 * 33]); o.y = pk2(s[2 * 33], s[3 * 33]); o.z = pk2(s[4 * 33], s[5 * 33]); o.w = pk2(s[6 * 33], s[7 * 33]);
        *(GAS v4u*)(WT + (size_t)(r0 + n) * K + k0 + 8 * c) = o; }
    LDS_WAIT(); asm volatile("" ::: "memory");
}
__device__ __forceinline__ void p0_transposes(Frame& F, const Args& args, int set, int gw, int NGW) {
    LAS float* scr = (LAS float*)(F.lds + RING_OFF + F.wave * 16384);
    int base = 0;
#define TR_JOB(SRC, K_, N_, RMODE, DST) do { const int n_it = ((K_) / 64) * ((N_) / 32); int it = gw - (base % NGW); if (it < 0) it += NGW;     \
        const float* W_ = args.in[SRC]; bf16* WT_ = (bf16*)(F.ws + (DST)); \
        for (; it < n_it; it += NGW) p0_transpose_item(W_, (K_), (N_), WT_, (RMODE), scr, it, F.lane); base += n_it; } while (0)
    if (set == 0) { TR_JOB(I_F1G, DM, DFF, 1, WS_WGU1); TR_JOB(I_F1U, DM, DFF, 2, WS_WGU1); TR_JOB(I_F1D, DFF, DM, 0, WS_WD1); }
    else if (set == 1) { TR_JOB(I_WIN, DM, INW, 0, WS_WIN); TR_JOB(I_WAB, 512, DM, 0, WS_WA); TR_JOB(I_WCB, DM, DM, 0, WS_WC); TR_JOB(I_WOUT, DM, DM, 0, WS_WO); }
    else { TR_JOB(I_F2G, DM, DFF, 1, WS_WGU2); TR_JOB(I_F2U, DM, DFF, 2, WS_WGU2); TR_JOB(I_F2D, DFF, DM, 0, WS_WD2); }
#undef TR_JOB
}
__device__ __forceinline__ void norm_pass(Frame& F, const float* X, const float* g, int mod_sh, int mod_sc) {
    const int gw = F.vcu * NWAVES + F.wave, NGW = F.G * NWAVES;
    const float* mod = (const float*)(F.ws + WS_MOD); bf16* XS = (bf16*)(F.ws + WS_XS);
    for (int r0 = gw * 8; r0 < M; r0 += NGW * 8) {
        const int b = r0 / SEQ;
        f32x4 a[4], s[4];
#pragma unroll
        for (int j = 0; j < 4; ++j) { const int c = 4 * F.lane + 256 * j;
            a[j] = *(const f32x4*)(g + c) * (*(const f32x4*)(mod + b * NMOD + mod_sc + c) + 1.0f); s[j] = *(const f32x4*)(mod + b * NMOD + mod_sh + c); }
#pragma unroll 4
        for (int r = 0; r < 8; ++r) {
            const GAS f32x4* xr = (const GAS f32x4*)(X + (size_t)(r0 + r) * DM) + F.lane;
            f32x4 v[4]; float ss = 0.f;
#pragma unroll
            for (int j = 0; j < 4; ++j) { v[j] = xr[64 * j]; ss += (v[j].x * v[j].x + v[j].y * v[j].y) + (v[j].z * v[j].z + v[j].w * v[j].w); }
            const float rstd = 1.0f / sqrtf(wave_sum(ss) * (1.f / DM) + EPS);
            GAS unsigned long long* o8 = (GAS unsigned long long*)(XS + (size_t)(r0 + r) * DM) + F.lane;
#pragma unroll
            for (int j = 0; j < 4; ++j) { const f32x4 y = v[j] * rstd * a[j] + s[j];
                o8[64 * j] = (unsigned long long)pk2(y.x, y.y) | ((unsigned long long)pk2(y.z, y.w) << 32); }
        }
    }
}
__device__ __forceinline__ void qknorm_pass(Frame& F, const Args& args) {
    const int gw = F.vcu * NWAVES + F.wave, NGW = F.G * NWAVES;
    const float* gq_ = args.in[I_QN]; const float* gk_ = args.in[I_KN];
    for (int it = gw; it < 2 * M; it += NGW) {
        const int which = it >= M, row = which ? it - M : it;
        bf16* buf = (bf16*)(F.ws + (which ? WS_K : WS_Q)) + (size_t)row * AW; const float* gm = (which ? gk_ : gq_) + 8 * (F.lane & 15);
        const f32x4 g0 = *(const f32x4*)gm, g1 = *(const f32x4*)(gm + 4);
#pragma unroll
        for (int j = 0; j < 3; ++j) { GAS v4u* p = (GAS v4u*)(buf + 512 * j + 8 * F.lane); const v4u w = *p;
            f32x4 v0 = {blo(w.x), bhi(w.x), blo(w.y), bhi(w.y)}, v1 = {blo(w.z), bhi(w.z), blo(w.w), bhi(w.w)};
            float ss = (v0.x * v0.x + v0.y * v0.y) + (v0.z * v0.z + v0.w * v0.w) + (v1.x * v1.x + v1.y * v1.y) + (v1.z * v1.z + v1.w * v1.w);
            ss += __shfl_xor(ss, 1); ss += __shfl_xor(ss, 2); ss += __shfl_xor(ss, 4); ss += __shfl_xor(ss, 8);
            const float r = 1.0f / sqrtf(ss * (1.f / 128.f) + EPS);
            v0 = v0 * r * g0; v1 = v1 * r * g1;
            v4u o; o.x = pk2(v0.x, v0.y); o.y = pk2(v0.z, v0.w); o.z = pk2(v1.x, v1.y); o.w = pk2(v1.z, v1.w); *p = o; }
    }
}
__device__ __forceinline__ void aux_avec(Frame& F, const Args& args) {
    const int gw = F.vcu * NWAVES + F.wave, NGW = F.G * NWAVES;
    const float* mod = (const float*)(F.ws + WS_MOD); float* avec = (float*)(F.ws + WS_AVEC);
    const float* g2 = args.in[I_NMIX]; const float* g3 = args.in[I_NF2];
    for (int idx = gw * 64 + F.lane; idx < 4 * DM; idx += NGW * 64) { const int which = idx >> 11, b = (idx >> 10) & 1, c = idx & (DM - 1);
        avec[idx] = (which ? g3[c] : g2[c]) * (1.0f + mod[b * NMOD + (which ? MOD_SC3 : MOD_SC2) + c]); }
}
__device__ __forceinline__ void aux_bias(Frame& F, int which) {
    const int gw = F.vcu * NWAVES + F.wave, NGW = F.G * NWAVES;
    const float* mod = (const float*)(F.ws + WS_MOD);
    const int nrows = which ? 2 * DFF : INW;
    const float* sh = mod + (which ? MOD_SH3 : MOD_SH2) + 16 * F.lane;
    f32x4 s0[4], s1[4];
#pragma unroll
    for (int q = 0; q < 4; ++q) { s0[q] = *(const f32x4*)(sh + 4 * q); s1[q] = *(const f32x4*)(sh + NMOD + 4 * q); }
    float* bo = (float*)(F.ws + (which ? WS_BIAS_F2 : WS_BIAS_IN));
    for (int n = gw; n < nrows; n += NGW) {
        const bf16* wrow = (const bf16*)(F.ws + (which ? WS_WGU2 : WS_WIN)) + (size_t)n * DM + 16 * F.lane;
        const v4u w0 = *(const GAS v4u*)wrow, w1 = *(const GAS v4u*)(wrow + 8);
        const float wv[16] = {blo(w0.x), bhi(w0.x), blo(w0.y), bhi(w0.y), blo(w0.z), bhi(w0.z), blo(w0.w), bhi(w0.w), blo(w1.x), bhi(w1.x), blo(w1.y), bhi(w1.y), blo(w1.z), bhi(w1.z), blo(w1.w), bhi(w1.w)};
        float d0 = 0.f, d1 = 0.f;
#pragma unroll
        for (int q = 0; q < 4; ++q)
#pragma unroll
            for (int i = 0; i < 4; ++i) { d0 += s0[q][i] * wv[4 * q + i]; d1 += s1[q][i] * wv[4 * q + i]; }
        d0 = wave_sum(d0); d1 = wave_sum(d1);
        if (F.lane == 0) { bo[n] = d0; bo[nrows + n] = d1; }
    }
}
typedef attn::BlockRef<attn::bf16, attn::bf16> ABlock;
__device__ __forceinline__ ABlock attn_ref(Frame& F, int id, int& skv) {
    const int bgh = id >> 5, x = id & 31, b = bgh / 12, gh = bgh - b * 12, g = gh >> 2, d = 1 << (2 * g), nqb = 32 >> (2 * g), r = x / nqb, qb = x - r * nqb;
    ABlock R; const size_t e0 = (size_t)(b * SEQ + r) * AW + gh * 128;
    R.rs = d * AW; R.ls = d * 12; R.P0 = qb * 256; skv = SEQ / d;
    R.K = (const attn::bf16*)(F.ws + WS_K) + e0; R.V = (const attn::bf16*)(F.ws + WS_V) + e0;
    attn::bf16* q = (attn::bf16*)(F.ws + WS_Q) + e0 + (size_t)(qb * 256) * R.rs; R.Q = q; R.O = q;
    R.LSE = (float*)(F.ws + WS_LSE) + (size_t)(b * SEQ + r + qb * 256 * d) * 12 + gh;
    return R;
}
__device__ __forceinline__ void attn_phase(Frame& F, char* lds) {
    constexpr int NITEMS = 768;
    const int per = (NITEMS + F.G - 1) / F.G; int id = F.vcu * per; const int end = (id + per < NITEMS) ? id + per : NITEMS;
    if (id >= end) return;
    int skv, skvn; ABlock cur = attn_ref(F, id, skv);
    attn::Seam<attn::bf16> S;
    attn::causal_swa_prime<attn::bf16, attn::bf16>(cur, attn::WINDOW, lds, S);
    for (;;) {
        const bool last = id + 1 >= end; skvn = skv;
        const ABlock nxt = last ? cur : attn_ref(F, id + 1, skvn);
        attn::causal_swa_block<attn::bf16, attn::bf16>(cur, nxt, skv, attn::WINDOW, lds, S);
        if (last) break;
        cur = nxt; skv = skvn; ++id;
    }
}
__device__ __forceinline__ void merge_conv_pass(Frame& F, const Args& args) {
    const int gw = F.vcu * NWAVES + F.wave, NGW = F.G * NWAVES;
    { const bf16* OG = (const bf16*)(F.ws + WS_Q); const float* LSE = (const float*)(F.ws + WS_LSE); bf16* O = (bf16*)(F.ws + WS_O);
      const int h = F.lane >> 4, e = 8 * (F.lane & 15);
      for (int t = gw; t < M; t += NGW) {
          const float l0 = LSE[(size_t)t * 12 + h], l1 = LSE[(size_t)t * 12 + 4 + h], l2 = LSE[(size_t)t * 12 + 8 + h];
          const float mx = fmaxf(l0, fmaxf(l1, l2)); const float e0 = __expf(l0 - mx), e1 = __expf(l1 - mx), e2 = __expf(l2 - mx); const float inv = 1.0f / (e0 + e1 + e2);
          const float wg[3] = {e0 * inv, e1 * inv, e2 * inv};
          f32x4 a0 = {0.f, 0.f, 0.f, 0.f}, a1 = {0.f, 0.f, 0.f, 0.f};
#pragma unroll
          for (int g = 0; g < 3; ++g) { const v4u w = *(const GAS v4u*)(OG + (size_t)t * AW + (g * 4 + h) * 128 + e);
              a0 = a0 + (f32x4){blo(w.x), bhi(w.x), blo(w.y), bhi(w.y)} * wg[g]; a1 = a1 + (f32x4){blo(w.z), bhi(w.z), blo(w.w), bhi(w.w)} * wg[g]; }
          v4u o; o.x = pk2(a0.x, a0.y); o.y = pk2(a0.z, a0.w); o.z = pk2(a1.x, a1.y); o.w = pk2(a1.z, a1.w);
          *(GAS v4u*)(O + (size_t)t * 512 + 8 * F.lane) = o; } }
    { const bf16* U = (const bf16*)(F.ws + WS_U); bf16* Bv = (bf16*)(F.ws + WS_B); const bf16* Cg = (const bf16*)(F.ws + WS_C); const float* cw = args.in[I_CONVW];
      for (int it = gw; it < 2 * (M / 16); it += NGW) {
          const int ch = it & 1, t0 = (it >> 1) * 16, c0 = 512 * ch + 8 * F.lane;
          float w0[8], w1[8], w2[8], x1[8], x2[8];
#pragma unroll
          for (int i = 0; i < 8; ++i) { w0[i] = cw[c0 + i]; w1[i] = cw[DM + c0 + i]; w2[i] = cw[2 * DM + c0 + i]; x1[i] = 0.f; x2[i] = 0.f; }
          if ((t0 & (SEQ - 1)) != 0) {
#pragma unroll
              for (int p = 2; p >= 1; --p) { const v4u wu = *(const GAS v4u*)(U + (size_t)(t0 - p) * DM + c0), wc = *(const GAS v4u*)(Cg + (size_t)(t0 - p) * DM + c0);
                  const float xu[8] = {blo(wu.x), bhi(wu.x), blo(wu.y), bhi(wu.y), blo(wu.z), bhi(wu.z), blo(wu.w), bhi(wu.w)}, xc[8] = {blo(wc.x), bhi(wc.x), blo(wc.y), bhi(wc.y), blo(wc.z), bhi(wc.z), blo(wc.w), bhi(wc.w)};
#pragma unroll
                  for (int i = 0; i < 8; ++i) { if (p == 2) x2[i] = xu[i] * xc[i]; else x1[i] = xu[i] * xc[i]; } } }
#pragma unroll 4
          for (int r = 0; r < 16; ++r) { const size_t off = (size_t)(t0 + r) * DM + c0;
              const v4u wu = *(const GAS v4u*)(U + off), wc = *(const GAS v4u*)(Cg + off), wb = *(const GAS v4u*)(Bv + off);
              const float xu[8] = {blo(wu.x), bhi(wu.x), blo(wu.y), bhi(wu.y), blo(wu.z), bhi(wu.z), blo(wu.w), bhi(wu.w)}, xc[8] = {blo(wc.x), bhi(wc.x), blo(wc.y), bhi(wc.y), blo(wc.z), bhi(wc.z), blo(wc.w), bhi(wc.w)};
              const float xb[8] = {blo(wb.x), bhi(wb.x), blo(wb.y), bhi(wb.y), blo(wb.z), bhi(wb.z), blo(wb.w), bhi(wb.w)};
              float y[8];
#pragma unroll
              for (int i = 0; i < 8; ++i) { const float x0 = xu[i] * xc[i]; y[i] = xb[i] * (w0[i] * x2[i] + w1[i] * x1[i] + w2[i] * x0); x2[i] = x1[i]; x1[i] = x0; }
              v4u o; o.x = pk2(y[0], y[1]); o.y = pk2(y[2], y[3]); o.z = pk2(y[4], y[5]); o.w = pk2(y[6], y[7]);
              *(GAS v4u*)(Bv + off) = o; } } }
}


#ifdef NAIVE
template <bool DUAL, class St>
__device__ __forceinline__ void naive_gemm(Frame& F, const bf16* A, int lda, const float* W, const float* W2, int ldw, int M_, int N_, int K_, St store) {
    LAS float* As = (LAS float*)(F.lds + RING_OFF);
    LAS float* Ws = As + 64 * 33;
    LAS float* Ws2 = Ws + 32 * 68;
    const int ty = F.tid >> 4, tx = F.tid & 15, ntn = N_ / 64, ntiles = (M_ / 64) * ntn;
    for (int tile = blockIdx.x; tile < ntiles; tile += F.G) {
        const int tm = tile / ntn, tn = tile - tm * ntn;
        float acc[2][4] = {{0.f, 0.f, 0.f, 0.f}, {0.f, 0.f, 0.f, 0.f}}, acc2[2][4] = {{0.f, 0.f, 0.f, 0.f}, {0.f, 0.f, 0.f, 0.f}};
        for (int k0 = 0; k0 < K_; k0 += 32) {
            __syncthreads();
#pragma unroll
            for (int i = 0; i < 4; ++i) { const int e = F.tid + 512 * i, r = e >> 5, c = e & 31; As[r * 33 + c] = __uint_as_float((unsigned)A[(size_t)(tm * 64 + r) * lda + k0 + c] << 16); }
#pragma unroll
            for (int i = 0; i < 4; ++i) { const int e = F.tid + 512 * i, r = e >> 6, c = e & 63; Ws[r * 68 + c] = W[(size_t)(k0 + r) * ldw + tn * 64 + c]; if (DUAL) Ws2[r * 68 + c] = W2[(size_t)(k0 + r) * ldw + tn * 64 + c]; }
            __syncthreads();
#pragma unroll 8
            for (int kk = 0; kk < 32; ++kk) { const float a0 = As[(ty * 2) * 33 + kk], a1 = As[(ty * 2 + 1) * 33 + kk];
#pragma unroll
                for (int j = 0; j < 4; ++j) { const float w = Ws[kk * 68 + tx * 4 + j]; acc[0][j] += a0 * w; acc[1][j] += a1 * w;
                    if (DUAL) { const float w2 = Ws2[kk * 68 + tx * 4 + j]; acc2[0][j] += a0 * w2; acc2[1][j] += a1 * w2; } } }
        }
#pragma unroll
        for (int i = 0; i < 2; ++i)
#pragma unroll
            for (int j = 0; j < 4; ++j) store(tm * 64 + ty * 2 + i, tn * 64 + tx * 4 + j, acc[i][j], acc2[i][j]);
    }
    __syncthreads();
}
__device__ __forceinline__ bf16 f2b(float v) { return (bf16)f2bf(v); }
__device__ __forceinline__ float b2f(bf16 v) { return __uint_as_float((unsigned)v << 16); }
__device__ __forceinline__ void naive_attn(Frame& F) {
    const int gw = F.vcu * NWAVES + F.wave, NGW = F.G * NWAVES;
    bf16* Qb = (bf16*)(F.ws + WS_Q); const bf16* Kb = (const bf16*)(F.ws + WS_K); const bf16* Vb = (const bf16*)(F.ws + WS_V); float* LSE = (float*)(F.ws + WS_LSE);
    for (int it = gw; it < M * 12; it += NGW) {
        const int t = it / 12, gh = it - t * 12, g = gh >> 2, d = 1 << (2 * g), tl = t & (SEQ - 1);
        const float q0 = b2f(Qb[(size_t)t * AW + gh * 128 + 2 * F.lane]), q1 = b2f(Qb[(size_t)t * AW + gh * 128 + 2 * F.lane + 1]);
        float s0 = -INFINITY, s1 = -INFINITY, s2 = -INFINITY;
        for (int j = 0; j <= 128; ++j) { if (tl - j * d < 0) break; const size_t kr = (size_t)(t - j * d) * AW + gh * 128 + 2 * F.lane;
            const float sc = wave_sum(q0 * b2f(Kb[kr]) + q1 * b2f(Kb[kr + 1])) * 0.08838834764831845f;
            if (j < 64) { if (F.lane == j) s0 = sc; } else if (j < 128) { if (F.lane == j - 64) s1 = sc; } else { if (F.lane == 0) s2 = sc; } }
        float mx = fmaxf(s0, fmaxf(s1, s2));
#pragma unroll
        for (int o = 1; o < 64; o <<= 1) mx = fmaxf(mx, __shfl_xor(mx, o));
        const float p0 = __expf(s0 - mx), p1 = __expf(s1 - mx), p2 = __expf(s2 - mx);
        const float l = wave_sum(p0 + p1 + p2);
        float o0 = 0.f, o1 = 0.f;
        for (int j = 0; j <= 128; ++j) { if (tl - j * d < 0) break; const size_t vr = (size_t)(t - j * d) * AW + gh * 128 + 2 * F.lane;
            const float p = (j < 64) ? __shfl(p0, j) : (j < 128) ? __shfl(p1, j - 64) : __shfl(p2, 0);
            o0 += p * b2f(Vb[vr]); o1 += p * b2f(Vb[vr + 1]); }
        const float inv = 1.0f / l;
        Qb[(size_t)t * AW + gh * 128 + 2 * F.lane] = f2b(o0 * inv); Qb[(size_t)t * AW + gh * 128 + 2 * F.lane + 1] = f2b(o1 * inv);
        if (F.lane == 0) LSE[(size_t)t * 12 + gh] = mx + __logf(l);
    }
}
#endif

constexpr int N_PHASES = 17;
__global__ void __launch_bounds__(NWAVES * 64, 2) mega_fwd(Args args) {
    extern __shared__ __attribute__((aligned(16))) unsigned char lds[];
    Frame F;
    F.lds = (LAS unsigned char*)lds;
    F.MISC = (volatile LAS unsigned*)(F.lds + MISC_OFF);
    F.tid = threadIdx.x; F.lane = F.tid & 63; F.wave = __builtin_amdgcn_readfirstlane(F.tid >> 6);
    F.G = gridDim.x; { const int bx = blockIdx.x; F.vcu = (F.G % 8 == 0) ? (bx % 8) * (F.G / 8) + bx / 8 : bx; }
    F.ws = args.ws; F.out = args.out;
    F.ctl = (gu32*)(args.ws + WS_CTL);
    for (int u = F.tid; u < (LDS_BYTES - LDSCTL_OFF) / 4; u += NWAVES * 64) ((LAS unsigned*)(F.lds + LDSCTL_OFF))[u] = 0u;
    __syncthreads();
    XcdBarrier bar = xcd_barrier_post((unsigned*)(F.ctl + CW_BAR), F.MISC + 8);
    const int lo = args.ph_lo, hi = args.ph_hi;
    typedef pg8::bf16_t pb;
#define mod ((const float*)(args.ws + WS_MOD))
#define XS ((const pb*)(args.ws + WS_XS))
    unsigned char* const ws = args.ws;
#define IN(k) (lo <= (k) && (k) < hi)
#define FRESH() do { F.tid = tid_opaque(); F.lane = F.tid & 63; } while (0)
#ifdef PROBE_TA
#define TSTAMP(slot) do { if (F.tid == 0) { const unsigned long long t_ = rt(); F.MISC[16 + 2 * (slot)] = (unsigned)t_; F.MISC[17 + 2 * (slot)] = (unsigned)(t_ >> 32); } } while (0)
#define SEAM(k) do { if (IN(k) && IN((k) + 1)) xcd_barrier(bar); if ((k) == PROBE_TA) TSTAMP(0); if ((k) == PROBE_TB) TSTAMP(1); } while (0)
    if (PROBE_TA == -1) TSTAMP(0);
#else
#define SEAM(k) do { if (IN(k) && IN((k) + 1)) xcd_barrier(bar); } while (0)
#endif
#ifdef NAIVE
#define FUSE_NORM 0
#else
#define FUSE_NORM 1
#endif
#define XL ((PG8_LAS float*)(F.lds + XL_OFF))
#define PS2 ((const float*)(args.ws + WS_PS2))
#define PS3 ((const float*)(args.ws + WS_PS3))
#define bias_in ((const float*)(args.ws + WS_BIAS_IN))
#define bias_f2 ((const float*)(args.ws + WS_BIAS_F2))
#define avec ((const float*)(args.ws + WS_AVEC))
#define GEMM_BX(SCHED_DECL, SCHED_T, A_, K_, BT, N_, MODE, NRM, QKN_, O_, LDC, SPC, SPS, I1, I2, PS_, BIAS_, BSTR) do { pg8::Gemm g{(const pb*)(A_), (const pb*)(BT), M, (N_), (K_)}; SCHED_DECL; \
        typedef pg8::EpiB<MODE, (NRM), (QKN_)> EpiT; EpiT E{(pb*)(O_), (LDC), (SPC), (SPS), (const pb*)(I1), (const pb*)(I2), (PS_), (BIAS_), (BSTR), args.in[I_QN], args.in[I_KN], 2 * AW, XL, 0}; \
        pg8::gemm_phase<EpiT, SCHED_T, true, true>(F.lds + RING_OFF, g, S, E); } while (0)
#define GEMM_B(A_, K_, BT, N_, MODE, NRM, QKN_, O_, LDC, SPC, SPS, I1, I2, PS_, BIAS_, BSTR) \
        GEMM_BX(pg8::StaticOrder S; S.init(M, (N_), F.G, (int)blockIdx.x), pg8::StaticOrder, A_, K_, BT, N_, MODE, NRM, QKN_, O_, LDC, SPC, SPS, I1, I2, PS_, BIAS_, BSTR)
#define GEMM_F(XSO, A_, K_, BT, BASE, COEF, SCALE, AVEC_, PS_) do { pg8::Gemm g{(const pb*)(A_), (const pb*)(BT), M, DM, (K_)}; pg8::StaticOrder S; S.init(M, DM, F.G, (int)blockIdx.x); \
        typedef pg8::EpiF<(XSO)> EpiT; EpiT E{(BASE), F.out, (COEF), (pb*)(ws + WS_XS), (AVEC_), (float*)(PS_), XL, (SCALE)}; pg8::gemm_phase<EpiT, pg8::StaticOrder, true, true>(F.lds + RING_OFF, g, S, E); } while (0)

    const bool p0_split = false;
#if FUSE_NORM
    FRESH();
    if (IN(0)) { for (int it = blockIdx.x; it < ADA_ITEMS; it += F.G) p0_adaln_item(F, args, it);
                 if (p0_split && (int)blockIdx.x >= ADA_ITEMS) p0_transposes(F, args, 0, ((int)blockIdx.x - ADA_ITEMS) * NWAVES + F.wave, (256 - ADA_ITEMS) * NWAVES); }
#else
    FRESH();
    if (IN(0)) { for (int it = blockIdx.x; it < ADA_ITEMS; it += F.G) p0_adaln_item(F, args, it); for (int st = 0; st < 3; ++st) p0_transposes(F, args, st, F.vcu * NWAVES + F.wave, F.G * NWAVES); }
#endif
    SEAM(0);
    FRESH();
    if (IN(1)) { norm_pass(F, args.in[I_X], args.in[I_NF1], MOD_SH1, MOD_SC1); if (FUSE_NORM) { aux_avec(F, args); if (!p0_split) p0_transposes(F, args, 0, F.vcu * NWAVES + F.wave, F.G * NWAVES); } }
    SEAM(1);
#ifdef PROBE_XBAR
    xcd_barrier(bar); xcd_barrier(bar); xcd_barrier(bar); xcd_barrier(bar);
#endif
#if defined(NAIVE) && (NAIVE & 1)
    if (IN(2)) { bf16* ACT = (bf16*)(ws + WS_ACT); naive_gemm<true>(F, (const bf16*)XS, DM, args.in[I_F1G], args.in[I_F1U], DFF, M, DFF, DM, [=](int r, int c, float g, float u) { ACT[(size_t)r * DFF + c] = f2b(silu_f(g) * u); }); }
#else
    if (IN(2)) GEMM_B(XS, DM, ws + WS_WGU1, 2 * DFF, pg8::EB_SWIGLU, false, false, ws + WS_ACT, DFF, 0, 0, nullptr, nullptr, nullptr, nullptr, 0);
    FRESH();
    if (FUSE_NORM && IN(2) && F.G == 256 && (int)blockIdx.x >= 128) p0_transposes(F, args, 1, ((int)blockIdx.x - 128) * NWAVES + F.wave, 128 * NWAVES);
    else if (FUSE_NORM && IN(2) && F.G != 256) p0_transposes(F, args, 1, F.vcu * NWAVES + F.wave, F.G * NWAVES);
#endif
    SEAM(2);
#if defined(NAIVE) && (NAIVE & 2)
    if (IN(3)) { const float* xb = args.in[I_X]; float* ob = F.out; naive_gemm<false>(F, (const bf16*)(ws + WS_ACT), DFF, args.in[I_F1D], nullptr, DM, M, DM, DFF, [=](int r, int c, float v, float) { ob[(size_t)r * DM + c] = xb[(size_t)r * DM + c] + 0.5f * mod[(r / SEQ) * NMOD + MOD_GT1 + c] * v; }); }
#else
    FRESH();
    if (FUSE_NORM && IN(3)) aux_bias(F, 0);
    if (IN(3)) GEMM_F(FUSE_NORM, ws + WS_ACT, DFF, ws + WS_WD1, args.in[I_X], mod + MOD_GT1, 0.5f, avec, ws + WS_PS2);
#endif
    SEAM(3);
#if !FUSE_NORM
    if (IN(4)) norm_pass(F, F.out, args.in[I_NMIX], MOD_SH2, MOD_SC2);
    SEAM(4);
#endif
#if defined(NAIVE) && (NAIVE & 4)
    if (IN(5)) { bf16* Qb = (bf16*)(ws + WS_Q); naive_gemm<false>(F, (const bf16*)XS, DM, args.in[I_WIN] + COL_Q, nullptr, INW, M, 3 * AW, DM, [=](int r, int c, float v, float) { const int t = c / AW; Qb[(size_t)t * M * AW + (size_t)r * AW + (c - t * AW)] = f2b(v); }); }
#else
    if (IN(5)) GEMM_B(XS, DM, ws + WS_WIN + (size_t)COL_Q * DM * 2, 3 * AW, pg8::EB_PLAIN, FUSE_NORM, FUSE_NORM, ws + WS_Q, AW, AW, (size_t)(WS_K - WS_Q) / 2, nullptr, nullptr, PS2, bias_in + COL_Q, INW);
    FRESH();
    if (FUSE_NORM && IN(5) && F.G == 256 && (int)blockIdx.x >= 128) p0_transposes(F, args, 2, ((int)blockIdx.x - 128) * NWAVES + F.wave, 128 * NWAVES);
    else if (FUSE_NORM && IN(5) && F.G != 256) p0_transposes(F, args, 2, F.vcu * NWAVES + F.wave, F.G * NWAVES);
#endif
    SEAM(5);
#if !FUSE_NORM
    if (IN(6)) qknorm_pass(F, args);
    SEAM(6);
#endif
#if defined(NAIVE) && (NAIVE & 8)
    if (IN(7)) naive_attn(F);
#else
    if (IN(7)) attn_phase(F, (char*)lds + RING_OFF);
#endif
    SEAM(7);
#if defined(NAIVE) && (NAIVE & 16)
    if (IN(8)) { bf16* Ub = (bf16*)(ws + WS_U); naive_gemm<false>(F, (const bf16*)XS, DM, args.in[I_WIN] + COL_U, nullptr, INW, M, 3 * DM, DM, [=](int r, int c, float v, float) { const int t = c / DM; Ub[(size_t)t * M * DM + (size_t)r * DM + (c - t * DM)] = f2b(v); }); }
#else
    if (IN(8)) GEMM_B(XS, DM, ws + WS_WIN + (size_t)COL_U * DM * 2, 3 * DM, pg8::EB_PLAIN, FUSE_NORM, false, ws + WS_U, DM, DM, (size_t)(WS_B - WS_U) / 2, nullptr, nullptr, PS2, bias_in + COL_U, INW);
#endif
    SEAM(8);
    FRESH();
    if (IN(9)) { merge_conv_pass(F, args); if (FUSE_NORM) aux_bias(F, 1); }
    SEAM(9);
    { bf16* SGA = (bf16*)(ws + WS_SGA); bf16* SGC = (bf16*)(ws + WS_SGC); (void)SGA; (void)SGC;
#if defined(NAIVE) && (NAIVE & 32)
      if (IN(10)) naive_gemm<false>(F, (const bf16*)XS, DM, args.in[I_WIN] + COL_GA, nullptr, INW, M, DM, DM, [=](int r, int c, float v, float) { SGA[(size_t)r * DM + c] = f2b(1.0f / (1.0f + __expf(-v))); });
      if (IN(11)) naive_gemm<false>(F, (const bf16*)XS, DM, args.in[I_WIN] + COL_GC, nullptr, INW, M, DM, DM, [=](int r, int c, float v, float) { SGC[(size_t)r * DM + c] = f2b(1.0f / (1.0f + __expf(-v))); });
#else
    if (IN(10)) GEMM_BX(pg8::TwinOrder S; S.init(M, DM, F.G, (int)blockIdx.x); S.reps = 2, pg8::TwinOrder, XS, DM, ws + WS_WIN + (size_t)COL_GA * DM * 2, 2 * DM, pg8::EB_SIGMOID, FUSE_NORM, false,
                        ws + WS_SGA, DM, DM, (size_t)(WS_SGC - WS_SGA) / 2, nullptr, nullptr, PS2, bias_in + COL_GA, INW);
#endif
#ifdef NAIVE
    if (IN(11) && IN(12)) xcd_barrier(bar);
#endif
#if defined(NAIVE) && (NAIVE & 512)
      if (IN(12)) naive_gemm<false>(F, (const bf16*)(ws + WS_O), 512, args.in[I_WAB], nullptr, DM, M, DM, 512, [=](int r, int c, float v, float) { SGA[(size_t)r * DM + c] = f2b(b2f(SGA[(size_t)r * DM + c]) * v); });
#else
    if (IN(12)) GEMM_B(ws + WS_O, 512, ws + WS_WA, DM, pg8::EB_GATEMUL, false, false, ws + WS_SGA, DM, 0, 0, ws + WS_SGA, nullptr, nullptr, nullptr, 0);
#endif
#ifdef NAIVE
    if (IN(12) && IN(13)) xcd_barrier(bar);
#endif
#if defined(NAIVE) && (NAIVE & 1024)
      if (IN(13)) naive_gemm<false>(F, (const bf16*)(ws + WS_B), DM, args.in[I_WCB], nullptr, DM, M, DM, DM, [=](int r, int c, float v, float) { SGA[(size_t)r * DM + c] = f2b(b2f(SGA[(size_t)r * DM + c]) + b2f(SGC[(size_t)r * DM + c]) * v); });
#else
    if (IN(13)) GEMM_B(ws + WS_B, DM, ws + WS_WC, DM, pg8::EB_MERGE, false, false, ws + WS_SGA, DM, 0, 0, ws + WS_SGA, ws + WS_SGC, nullptr, nullptr, 0);
#endif
    }
    SEAM(13);
#if defined(NAIVE) && (NAIVE & 64)
    if (IN(14)) { float* ob = F.out; naive_gemm<false>(F, (const bf16*)(ws + WS_SGA), DM, args.in[I_WOUT], nullptr, DM, M, DM, DM, [=](int r, int c, float v, float) { ob[(size_t)r * DM + c] += mod[(r / SEQ) * NMOD + MOD_GT2 + c] * v; }); }
#else
    if (IN(14)) GEMM_F(FUSE_NORM, ws + WS_SGA, DM, ws + WS_WO, F.out, mod + MOD_GT2, 1.0f, avec + 2 * DM, ws + WS_PS3);
#endif
    SEAM(14);
#if !FUSE_NORM
    if (IN(15)) norm_pass(F, F.out, args.in[I_NF2], MOD_SH3, MOD_SC3);
    SEAM(15);
#endif
#if defined(NAIVE) && (NAIVE & 128)
    if (IN(16)) { bf16* ACT = (bf16*)(ws + WS_ACT); naive_gemm<true>(F, (const bf16*)XS, DM, args.in[I_F2G], args.in[I_F2U], DFF, M, DFF, DM, [=](int r, int c, float g, float u) { ACT[(size_t)r * DFF + c] = f2b(silu_f(g) * u); }); }
#else
    if (IN(16)) GEMM_B(XS, DM, ws + WS_WGU2, 2 * DFF, pg8::EB_SWIGLU, FUSE_NORM, false, ws + WS_ACT, DFF, 0, 0, nullptr, nullptr, PS3, bias_f2, 2 * DFF);
#endif
    SEAM(16);
#if defined(NAIVE) && (NAIVE & 256)
    if (IN(17)) { float* ob = F.out; naive_gemm<false>(F, (const bf16*)(ws + WS_ACT), DFF, args.in[I_F2D], nullptr, DM, M, DM, DFF, [=](int r, int c, float v, float) { ob[(size_t)r * DM + c] += 0.5f * mod[(r / SEQ) * NMOD + MOD_GT3 + c] * v; }); }
#else
    if (IN(17)) GEMM_F(false, ws + WS_ACT, DFF, ws + WS_WD2, F.out, mod + MOD_GT3, 0.5f, nullptr, nullptr);
#endif
#ifdef PROBE_TA
    if (PROBE_TB == 17) TSTAMP(1);
    xcd_barrier(bar);
    if (blockIdx.x == 0 && F.tid == 0) { const unsigned long long t0_ = ((unsigned long long)F.MISC[17] << 32) | F.MISC[16], t1_ = ((unsigned long long)F.MISC[19] << 32) | F.MISC[18];
#ifdef PROBE_CONST
        F.out[0] += (float)(PROBE_CONST); (void)t0_; (void)t1_; }
#else
        F.out[0] += (float)(PROBE_SCALE) * 0.01f * (float)(t1_ - t0_); }
#endif
#endif
#undef IN
#undef SEAM
#undef XL
#undef PS2
#undef PS3
#undef bias_in
#undef bias_f2
#undef avec
#undef mod
#undef XS
}

extern "C" void kernel_launch(void* const* d_in, const int* in_sizes, int n_in, void* d_out, int out_size, void* d_ws, size_t ws_size, hipStream_t stream) {
    static int grid = 0;
    if (grid == 0) {
        if (n_in != 20 || in_sizes[0] != M * DM || out_size != M * DM || ws_size < WS_END) { fprintf(stderr, "kernel_launch: shape/workspace mismatch (n_in %d, in0 %d, out %d, ws %zu < %zu)\n", n_in, n_in > 0 ? in_sizes[0] : -1, out_size, ws_size, (size_t)WS_END); grid = -1; return; }
        int dev = 0, cus = 0, per_cu = 0;
        if (hipGetDevice(&dev) != hipSuccess || hipDeviceGetAttribute(&cus, hipDeviceAttributeMultiprocessorCount, dev) != hipSuccess) { grid = -1; return; }
        if (hipFuncSetAttribute((const void*)mega_fwd, hipFuncAttributeMaxDynamicSharedMemorySize, LDS_BYTES) != hipSuccess) { fprintf(stderr, "kernel_launch: hipFuncSetAttribute failed\n"); grid = -1; return; }
        if (hipOccupancyMaxActiveBlocksPerMultiprocessor(&per_cu, (const void*)mega_fwd, NWAVES * 64, LDS_BYTES) != hipSuccess || per_cu < 1) { fprintf(stderr, "kernel_launch: occupancy query reports %d workgroups per CU\n", per_cu); }
        (void)hipGetLastError();
        grid = cus;
    }
    if (grid < 0) return;
    (void)hipMemsetAsync((char*)d_ws + WS_CTL, 0, CTL_ZERO_BYTES, stream);
#ifdef PROBE_MEMSET2
    (void)hipMemsetAsync((char*)d_ws + WS_CTL + CTL_ZERO_BYTES, 0, CTL_ZERO_BYTES, stream);
#endif
    Args a{};
    for (int i = 0; i < 20; ++i) a.in[i] = (const float*)d_in[i];
    a.out = (float*)d_out; a.ws = (unsigned char*)d_ws;
#if defined(PROBE_DUP)
    a.ph_lo = 0; a.ph_hi = PROBE_DUP + 1; hipLaunchKernelGGL(mega_fwd, dim3(grid), dim3(NWAVES * 64), LDS_BYTES, stream, a);
    (void)hipMemsetAsync((char*)d_ws + WS_CTL, 0, CTL_ZERO_BYTES, stream);
    a.ph_lo = PROBE_DUP; a.ph_hi = N_PHASES + 1; hipLaunchKernelGGL(mega_fwd, dim3(grid), dim3(NWAVES * 64), LDS_BYTES, stream, a);
#elif defined(PROBE_RLO)
    a.ph_lo = 0; a.ph_hi = PROBE_RHI + 1; hipLaunchKernelGGL(mega_fwd, dim3(grid), dim3(NWAVES * 64), LDS_BYTES, stream, a);
    (void)hipMemsetAsync((char*)d_ws + WS_CTL, 0, CTL_ZERO_BYTES, stream);
    a.ph_lo = PROBE_RLO; a.ph_hi = N_PHASES + 1; hipLaunchKernelGGL(mega_fwd, dim3(grid), dim3(NWAVES * 64), LDS_BYTES, stream, a);
#elif defined(PROBE_SPLIT)
    a.ph_lo = 0; a.ph_hi = PROBE_SPLIT + 1; hipLaunchKernelGGL(mega_fwd, dim3(grid), dim3(NWAVES * 64), LDS_BYTES, stream, a);
    (void)hipMemsetAsync((char*)d_ws + WS_CTL, 0, CTL_ZERO_BYTES, stream);
    a.ph_lo = PROBE_SPLIT + 1; a.ph_hi = N_PHASES + 1; hipLaunchKernelGGL(mega_fwd, dim3(grid), dim3(NWAVES * 64), LDS_BYTES, stream, a);
#elif !defined(MK_PER_PHASE)
    a.ph_lo = 0; a.ph_hi = N_PHASES + 1;
    hipLaunchKernelGGL(mega_fwd, dim3(grid), dim3(NWAVES * 64), LDS_BYTES, stream, a);
#else
    for (int p = 0; p <= N_PHASES; ++p) { a.ph_lo = p; a.ph_hi = p + 1; hipLaunchKernelGGL(mega_fwd, dim3(grid), dim3(NWAVES * 64), LDS_BYTES, stream, a); }
#endif
}
```

```cpp
#include <hip/hip_runtime.h>
#include <hip/hip_bf16.h>
#include <cstdio>
#include <cstdint>

constexpr int DM = 1024, BATCH = 2, SEQ = 8192, M = BATCH * SEQ;
constexpr int DFF = 2816, NMOD = 9 * DM;
constexpr int AW = 1536;
constexpr int INW = 9728;
constexpr int COL_Q = 0, COL_K = 1536, COL_V = 3072, COL_U = 4608, COL_B = 5632, COL_C = 6656, COL_GA = 7680, COL_GC = 8704;
constexpr float EPS = 1e-6f;

__device__ __forceinline__ int tid_opaque() { int t = (int)threadIdx.x; asm volatile("" : "+v"(t)); return t; }

namespace pg8 {
#define PG8_LAS __attribute__((address_space(3)))
typedef unsigned short bf16_t;
typedef short bf16x8 __attribute__((ext_vector_type(8)));
typedef float f32x4 __attribute__((ext_vector_type(4)));
typedef unsigned u32x4 __attribute__((ext_vector_type(4)));
constexpr int BM = 256, BK = 64, HALF = 128, HTB = HALF * BK * 2  , STAGE_BYTES = 8 * HTB, NXCD = 8, WGM = 8;

__host__ __device__ __forceinline__ int lds_byte(int r, int c) { const int st = (r >> 4) * 2 + (c >> 5), rr = r & 15, cc = c & 31, ob = rr * 64 + cc * 2; return st * 1024 + (ob ^ (((ob >> 9) & 1) << 5)); }
__host__ __device__ __forceinline__ void stage_rc(int b, int& R, int& C) { const int st = b / 1024, sb = b % 1024, swz = sb ^ (((sb >> 9) & 1) << 5); R = (st >> 1) * 16 + swz / 64; C = (st & 1) * 32 + (swz % 64) / 2; }
__host__ __device__ __forceinline__ int perm32(int rho) { const int n = rho >> 4, i = rho & 15; return 8 * (i >> 2) + 4 * n + (i & 3); }

struct Unit { int pm, pn; };
struct Gemm { const bf16_t* A; const bf16_t* Bt; int M, N, K; };

struct StaticOrder {
    int nM, nN, nwg, G, c;
    __host__ __device__ void init(int M, int N, int G_, int c_) { nM = M / BM; nN = N / BM; nwg = nM * nN; G = G_; c = c_; }
    __host__ __device__ bool next(int i, Unit& u) const {
        const long L = (long)i * G + c; if (L >= nwg) return false;
        int wgid = (int)L; { const int q = nwg / NXCD, r = nwg % NXCD, xcd = wgid % NXCD, off = wgid / NXCD; wgid = (xcd < r ? xcd * (q + 1) : r * (q + 1) + (xcd - r) * q) + off; }
        const int nig = WGM * nN, gid = wgid / nig, fm = gid * WGM, gsz = (nM - fm) < WGM ? (nM - fm) : WGM;
        u.pm = fm + ((wgid % nig) % gsz); u.pn = (wgid % nig) / gsz; return true;
    }
    __device__ __forceinline__ void a_ready(const Unit&) const {}
    __device__ __forceinline__ void done(const Unit&) const {}
};

typedef float f32x2_t __attribute__((ext_vector_type(2))); typedef __bf16 bf16x2_t __attribute__((ext_vector_type(2)));
__device__ __forceinline__ unsigned cvt_pk_bf16(float lo, float hi) { f32x2_t v = {lo, hi}; bf16x2_t b = __builtin_convertvector(v, bf16x2_t); return __builtin_bit_cast(unsigned, b); }
__device__ __forceinline__ float bf_lo(unsigned w) { return __uint_as_float(w << 16); }
__device__ __forceinline__ float bf_hi(unsigned w) { return __uint_as_float(w & 0xffff0000u); }
__device__ __forceinline__ float sigmoidf_(float x) { return __builtin_amdgcn_rcpf(1.0f + __builtin_amdgcn_exp2f(-1.4426950408889634f * x)); }
__device__ __forceinline__ void unpack8(const u32x4 w, f32x4& a, f32x4& b) { a = (f32x4){bf_lo(w.x), bf_hi(w.x), bf_lo(w.y), bf_hi(w.y)}; b = (f32x4){bf_lo(w.z), bf_hi(w.z), bf_lo(w.w), bf_hi(w.w)}; }
__device__ __forceinline__ u32x4 pack8(const f32x4 a, const f32x4 b) { u32x4 w; w.x = cvt_pk_bf16(a[0], a[1]); w.y = cvt_pk_bf16(a[2], a[3]); w.z = cvt_pk_bf16(b[0], b[1]); w.w = cvt_pk_bf16(b[2], b[3]); return w; }

enum { EB_PLAIN = 0, EB_SWIGLU = 1, EB_SIGMOID = 2, EB_GATEMUL = 3, EB_MERGE = 4, EB_RSMERGE = 5 };
template <int mode, bool NORMED = false, bool QKN = false> struct EpiB {
    static constexpr bool PERM = true, AFTER_DRAIN = false, PREFETCH = NORMED, MIDHOOK = (mode == EB_RSMERGE); static constexpr int MID_T = 8;
    bf16_t* O; int ldc; int split_cols; size_t split_stride; const bf16_t* In1; const bf16_t* In2;
    const float* PS; const float* bias; int bias_bstride; const float* gamma_q; const float* gamma_k; int qk_cols; PG8_LAS float* XL; int par;
    __device__ __forceinline__ void prefetch(const Unit& u, int wid, int buf) const {
        if (NORMED && wid < 4) { const int lane = threadIdx.x & 63; PG8_LAS unsigned char* X2 = (PG8_LAS unsigned char*)(XL + 2048) + buf * 5120;
            __builtin_amdgcn_global_load_lds((const unsigned*)(PS + (size_t)(u.pm * BM + wid * 64 + lane) * 4), (PG8_LAS unsigned*)(X2 + wid * 1024), 16, 0, 0);
            if (wid == 0) __builtin_amdgcn_global_load_lds((const unsigned*)(bias + (size_t)((u.pm * BM) / SEQ) * bias_bstride + u.pn * BM + lane * 4), (PG8_LAS unsigned*)(X2 + 4096), 16, 0, 0); }
    }
    __device__ __forceinline__ void mid(f32x4 (&acc)[2][2][4][2], const Unit& u, int wr, int wc, int fr, int fq) const {
        int row0 = u.pm * BM + wr * 64 + fr; const int col0 = u.pn * BM + wc * 32 + 8 * fq;
        asm volatile("" : "+v"(row0));
#pragma unroll
        for (int ai = 0; ai < 2; ++ai)
#pragma unroll
            for (int m = 0; m < 4; ++m)
#pragma unroll
                for (int bj = 0; bj < 2; ++bj) { const size_t off = (size_t)(row0 + ai * HALF + m * 16) * ldc + col0 + bj * HALF;
                    f32x4 a0, a1, c0, c1; unpack8(*(const u32x4*)(In1 + off), a0, a1); unpack8(*(const u32x4*)(In2 + off), c0, c1);
#pragma unroll
                    for (int i = 0; i < 4; ++i) { acc[ai][bj][m][0][i] *= a0[i] * __builtin_amdgcn_rcpf(fmaxf(c0[i], 1e-20f)); acc[ai][bj][m][1][i] *= a1[i] * __builtin_amdgcn_rcpf(fmaxf(c1[i], 1e-20f)); }
                    asm volatile("" : "+v"(acc[ai][bj][m][0]), "+v"(acc[ai][bj][m][1]) :: "memory"); }
    }
    __device__ __forceinline__ void operator()(f32x4 (&acc)[2][2][4][2], const Unit& u, int wr, int wc, int fr, int fq) const {
        const int row0 = u.pm * BM + wr * 64 + fr;
        if (NORMED) {
            const PG8_LAS float* X2 = XL + 2048 + par * 1280;
            f32x4 bv[2][2];
#pragma unroll
            for (int bj = 0; bj < 2; ++bj)
#pragma unroll
                for (int n = 0; n < 2; ++n) bv[bj][n] = *(const PG8_LAS f32x4*)(X2 + 1024 + bj * HALF + wc * 32 + 8 * fq + 4 * n);
#pragma unroll
            for (int ai = 0; ai < 2; ++ai)
#pragma unroll
                for (int m = 0; m < 4; ++m) { const f32x4 p = *(const PG8_LAS f32x4*)(X2 + (ai * HALF + wr * 64 + m * 16 + fr) * 4);
                    const float rstd = __builtin_amdgcn_rsqf(((p[0] + p[1]) + (p[2] + p[3])) * (1.0f / 1024.0f) + 1e-6f);
#pragma unroll
                    for (int bj = 0; bj < 2; ++bj)
#pragma unroll
                        for (int n = 0; n < 2; ++n) acc[ai][bj][m][n] = acc[ai][bj][m][n] * rstd + bv[bj][n]; }
        }
        if (mode == EB_SWIGLU) {
            const int col0 = u.pn * HALF + wc * 32 + 8 * fq;
#pragma unroll
            for (int ai = 0; ai < 2; ++ai)
#pragma unroll
                for (int m = 0; m < 4; ++m) { bf16_t* rowp = O + (size_t)(row0 + ai * HALF + m * 16) * ldc + col0;
                    f32x4 v0, v1;
#pragma unroll
                    for (int i = 0; i < 4; ++i) { const float g0 = acc[ai][0][m][0][i], g1 = acc[ai][0][m][1][i];
                        v0[i] = g0 * sigmoidf_(g0) * acc[ai][1][m][0][i]; v1[i] = g1 * sigmoidf_(g1) * acc[ai][1][m][1][i]; }
                    *(u32x4*)rowp = pack8(v0, v1); }
            return;
        }
        int colt = u.pn * BM; size_t boff = 0;
        if (QKN && colt < qk_cols) {
            PG8_LAS float* P = XL;
#pragma unroll
            for (int ai = 0; ai < 2; ++ai)
#pragma unroll
                for (int m = 0; m < 4; ++m)
#pragma unroll
                    for (int bj = 0; bj < 2; ++bj) { const f32x4 a = acc[ai][bj][m][0], b = acc[ai][bj][m][1];
                        float s = ((a[0] * a[0] + a[1] * a[1]) + (a[2] * a[2] + a[3] * a[3])) + ((b[0] * b[0] + b[1] * b[1]) + (b[2] * b[2] + b[3] * b[3]));
                        s += __shfl_xor(s, 16); s += __shfl_xor(s, 32);
                        if (fq == 0) P[((ai * HALF + wr * 64 + m * 16 + fr) * 2 + bj) * 4 + wc] = s; }
            asm volatile("s_waitcnt lgkmcnt(0)" ::: "memory"); __builtin_amdgcn_s_barrier(); asm volatile("" ::: "memory");
            const float* gm = (colt < (qk_cols >> 1) ? gamma_q : gamma_k) + wc * 32 + 8 * fq;
            const f32x4 g0 = *(const f32x4*)gm, g1 = *(const f32x4*)(gm + 4);
#pragma unroll
            for (int ai = 0; ai < 2; ++ai)
#pragma unroll
                for (int m = 0; m < 4; ++m)
#pragma unroll
                    for (int bj = 0; bj < 2; ++bj) { const f32x4 p = *(const PG8_LAS f32x4*)(P + ((ai * HALF + wr * 64 + m * 16 + fr) * 2 + bj) * 4);
                        const float r = __builtin_amdgcn_rsqf(((p[0] + p[1]) + (p[2] + p[3])) * (1.0f / 128.0f) + 1e-6f);
                        acc[ai][bj][m][0] = acc[ai][bj][m][0] * r * g0; acc[ai][bj][m][1] = acc[ai][bj][m][1] * r * g1; }
        }
        if (split_cols) { const int t = colt / split_cols; boff = (size_t)t * split_stride; colt -= t * split_cols; }
        const int col0 = colt + wc * 32 + 8 * fq;
#pragma unroll
        for (int ai = 0; ai < 2; ++ai)
#pragma unroll
            for (int m = 0; m < 4; ++m) { const size_t roff = boff + (size_t)(row0 + ai * HALF + m * 16) * ldc + col0;
#pragma unroll
                for (int bj = 0; bj < 2; ++bj) { const size_t off = roff + bj * HALF; f32x4 v0 = acc[ai][bj][m][0], v1 = acc[ai][bj][m][1];
                    if (mode == EB_SIGMOID) {
#pragma unroll
                        for (int i = 0; i < 4; ++i) { v0[i] = sigmoidf_(v0[i]); v1[i] = sigmoidf_(v1[i]); }
                    } else if (mode == EB_GATEMUL) { f32x4 a0, a1; unpack8(*(const u32x4*)(In1 + off), a0, a1); v0 = v0 * a0; v1 = v1 * a1; }
                    else if (mode == EB_MERGE) { f32x4 a0, a1, g0, g1; unpack8(*(const u32x4*)(In1 + off), a0, a1); unpack8(*(const u32x4*)(In2 + off), g0, g1); v0 = a0 + g0 * v0; v1 = a1 + g1 * v1; }
                    else if (mode == EB_RSMERGE) { f32x4 g0, g1; unpack8(*(const u32x4*)(In2 + off), g0, g1);
#pragma unroll
                        for (int i = 0; i < 4; ++i) { v0[i] *= fmaxf(g0[i], 1e-20f); v1[i] *= fmaxf(g1[i], 1e-20f); } }
                    *(u32x4*)(O + off) = pack8(v0, v1); } }
    }
};
template <bool XSOUT = false> struct EpiF {
    static constexpr bool PERM = true, AFTER_DRAIN = false, PREFETCH = false, MIDHOOK = false; static constexpr int MID_T = 0;
    const float* base; float* out; const float* coef; bf16_t* XS; const float* avec; float* PS; PG8_LAS float* XL; float scale;
    __device__ __forceinline__ void operator()(f32x4 (&acc)[2][2][4][2], const Unit& u, int wr, int wc, int fr, int fq) const {
        const int row0 = u.pm * BM + wr * 64 + fr, col0 = u.pn * BM + wc * 32 + 8 * fq, bt = (u.pm * BM) / SEQ;
        const float* cf = coef + (size_t)bt * NMOD + col0;
        f32x4 cv[2][2], av[2][2];
#pragma unroll
        for (int bj = 0; bj < 2; ++bj)
#pragma unroll
            for (int n = 0; n < 2; ++n) { cv[bj][n] = *(const f32x4*)(cf + bj * HALF + n * 4) * scale; if (XSOUT) av[bj][n] = *(const f32x4*)(avec + bt * DM + col0 + bj * HALF + n * 4); }
        PG8_LAS float* P = XL;
        f32x4 pre[2][2][2];
#define EPIF_LOAD(slot, q) do { const size_t off_ = (size_t)(row0 + ((q) >> 2) * HALF + ((q) & 3) * 16) * DM + col0; \
            _Pragma("unroll") for (int bj = 0; bj < 2; ++bj) _Pragma("unroll") for (int n = 0; n < 2; ++n) pre[slot][bj][n] = *(const f32x4*)(base + off_ + bj * HALF + n * 4); } while (0)
#define EPIF_DO(slot, q) do { const int ai = (q) >> 2, m = (q) & 3; const size_t off = (size_t)(row0 + ai * HALF + m * 16) * DM + col0; float ss = 0.f; \
            _Pragma("unroll") for (int bj = 0; bj < 2; ++bj) { const f32x4 o0 = pre[slot][bj][0] + cv[bj][0] * acc[ai][bj][m][0], o1 = pre[slot][bj][1] + cv[bj][1] * acc[ai][bj][m][1]; \
                *(f32x4*)(out + off + bj * HALF) = o0; *(f32x4*)(out + off + bj * HALF + 4) = o1; \
                if (XSOUT) { ss += ((o0[0] * o0[0] + o0[1] * o0[1]) + (o0[2] * o0[2] + o0[3] * o0[3])) + ((o1[0] * o1[0] + o1[1] * o1[1]) + (o1[2] * o1[2] + o1[3] * o1[3])); \
                    *(u32x4*)(XS + off + bj * HALF) = pack8(o0 * av[bj][0], o1 * av[bj][1]); } } \
            if (XSOUT) { ss += __shfl_xor(ss, 16); ss += __shfl_xor(ss, 32); if (fq == 0) P[(ai * HALF + wr * 64 + m * 16 + fr) * 4 + wc] = ss; } } while (0)
        EPIF_LOAD(0, 0); EPIF_LOAD(1, 1);
        EPIF_DO(0, 0); EPIF_LOAD(0, 2); EPIF_DO(1, 1); EPIF_LOAD(1, 3); EPIF_DO(0, 2); EPIF_LOAD(0, 4); EPIF_DO(1, 3); EPIF_LOAD(1, 5);
        EPIF_DO(0, 4); EPIF_LOAD(0, 6); EPIF_DO(1, 5); EPIF_LOAD(1, 7); EPIF_DO(0, 6); EPIF_DO(1, 7);
#undef EPIF_LOAD
#undef EPIF_DO
        if (XSOUT) {
            asm volatile("s_waitcnt lgkmcnt(0)" ::: "memory"); __builtin_amdgcn_s_barrier(); asm volatile("" ::: "memory");
            const int tid = threadIdx.x;
            if (tid < BM) { const f32x4 p = *(const PG8_LAS f32x4*)(P + tid * 4); PS[(size_t)(u.pm * BM + tid) * 4 + u.pn] = (p[0] + p[1]) + (p[2] + p[3]); }
        }
    }
};

struct TwinOrder : StaticOrder {
    int reps;
    __device__ bool next(int i, Unit& u) const { if (i >= reps) return false; if (!StaticOrder::next(0, u)) return false; u.pn += 4 * i; return true; }
};
template <class Epi, class Sched, bool ALIGN_EPI = false, bool SP2 = false>
__device__ __forceinline__ void gemm_phase(PG8_LAS unsigned char* lds, const Gemm g, const Sched& S, Epi E) {
    const int tid = tid_opaque(), wid = __builtin_amdgcn_readfirstlane(tid >> 6), lane = tid & 63, wr = wid >> 2, wc = wid & 3, fr = lane & 15, fq = lane >> 4;
    const int K = g.K, nt = K / BK;
    unsigned voffA[2], voffB[2];
#pragma unroll
    for (int i = 0; i < 2; ++i) { int R, C; stage_rc(tid * 16 + i * 8192, R, C); const int Rb = Epi::PERM ? ((R & ~31) + perm32(R & 31)) : R;
        voffA[i] = (unsigned)(R * K + C) * 2u; voffB[i] = (unsigned)(Rb * K + C) * 2u; }
    const size_t kstep = (size_t)(BK * 2);
    const size_t hstep = (size_t)HALF * K * 2;
    const size_t tstep = 2 * hstep;
    const unsigned ldsw = (unsigned)wid * 1024u;
    const int aoff = lds_byte(wr * 64 + fr, fq * 8), boff = lds_byte(wc * 32 + fr, fq * 8);
#define PG8_SA(b, h) (((b) * 2 + (h)) * HTB)
#define PG8_SB(b, h) ((4 + (b) * 2 + (h)) * HTB)
#define PG8_STAGE(bufoff, gbase, voff) do { _Pragma("unroll") for (int _i = 0; _i < 2; ++_i) \
        __builtin_amdgcn_global_load_lds((const unsigned*)((const char*)(gbase) + (voff)[_i]), (PG8_LAS unsigned*)(lds + (bufoff) + ldsw + _i * 8192), 16, 0, 0); } while (0)
#define PG8_LDA(dst, b, h) do { _Pragma("unroll") for (int m = 0; m < 4; ++m) _Pragma("unroll") for (int k = 0; k < 2; ++k) dst[m][k] = *(const PG8_LAS bf16x8*)(lds + PG8_SA(b, h) + aoff + m * 2048 + k * 1024); } while (0)
#define PG8_LDB(dst, b, h) do { _Pragma("unroll") for (int n = 0; n < 2; ++n) _Pragma("unroll") for (int k = 0; k < 2; ++k) dst[n][k] = *(const PG8_LAS bf16x8*)(lds + PG8_SB(b, h) + boff + n * 2048 + k * 1024); } while (0)
#define PG8_MMA(ai, bj, At, Bt) do { __builtin_amdgcn_s_setprio(1); _Pragma("unroll") for (int m = 0; m < 4; ++m) _Pragma("unroll") for (int n = 0; n < 2; ++n) _Pragma("unroll") for (int k = 0; k < 2; ++k) \
        acc[ai][bj][m][n] = __builtin_amdgcn_mfma_f32_16x16x32_bf16(Bt[n][k], At[m][k], acc[ai][bj][m][n], 0, 0, 0); __builtin_amdgcn_s_setprio(0); } while (0)
#define PG8_WAIT_V(n) asm volatile("s_waitcnt vmcnt(" #n ")" ::: "memory")
#define PG8_WAIT_L(n) asm volatile("s_waitcnt lgkmcnt(" #n ")" ::: "memory")
#define PG8_BAR __builtin_amdgcn_s_barrier()
#define PG8_SCHED __builtin_amdgcn_sched_barrier(0)
    Unit cur, nxt; int ui = 0;
    if (!S.next(0, cur)) return;
    f32x4 acc[2][2][4][2];
#pragma unroll
    for (int a = 0; a < 2; ++a)
#pragma unroll
        for (int b = 0; b < 2; ++b)
#pragma unroll
            for (int m = 0; m < 4; ++m)
#pragma unroll
                for (int n = 0; n < 2; ++n) acc[a][b][m][n] = (f32x4){0.f, 0.f, 0.f, 0.f};
    bf16x8 At[4][2], B0[2][2], B1[2][2];
    const char* cA = (const char*)g.A + (size_t)cur.pm * tstep; const char* cB = (const char*)g.Bt + (size_t)cur.pn * tstep;
    S.a_ready(cur);
    if constexpr (Epi::PREFETCH) E.prefetch(cur, wid, 0);
    if constexpr (SP2) {
        PG8_STAGE(PG8_SB(0, 0), cB, voffB); PG8_STAGE(PG8_SB(0, 1), cB + hstep, voffB); PG8_STAGE(PG8_SA(0, 0), cA, voffA); PG8_STAGE(PG8_SA(0, 1), cA + hstep, voffA);
        if (wr == 1) PG8_BAR;
        PG8_WAIT_V(2); PG8_BAR;
        PG8_STAGE(PG8_SB(1, 0), cB + kstep, voffB); PG8_STAGE(PG8_SA(1, 0), cA + kstep, voffA); PG8_STAGE(PG8_SB(1, 1), cB + hstep + kstep, voffB);
        PG8_WAIT_V(6); PG8_BAR;
    } else {
        PG8_STAGE(PG8_SB(0, 0), cB, voffB); PG8_STAGE(PG8_SA(0, 0), cA, voffA); PG8_STAGE(PG8_SB(0, 1), cB + hstep, voffB); PG8_STAGE(PG8_SA(0, 1), cA + hstep, voffA);
        if (wr == 1) PG8_BAR;
        PG8_WAIT_V(4); PG8_BAR;
        PG8_STAGE(PG8_SB(1, 0), cB + kstep, voffB); PG8_STAGE(PG8_SA(1, 0), cA + kstep, voffA); PG8_STAGE(PG8_SB(1, 1), cB + hstep + kstep, voffB);
        PG8_WAIT_V(6); PG8_BAR;
    }
    for (;;) {
        const bool has_next = S.next(ui + 1, nxt);
        const char* nA = has_next ? (const char*)g.A + (size_t)nxt.pm * tstep : cA; const char* nB = has_next ? (const char*)g.Bt + (size_t)nxt.pn * tstep : cB;
        for (int t = 0; t < nt; t += 2) {
            if constexpr (Epi::MIDHOOK) { if (t == Epi::MID_T) E.mid(acc, cur, wr, wc, fr, fq); }
            const bool last = (t == nt - 2);
            const char* a1 = cA + (size_t)(t + 1) * kstep;
            const char* a2 = last ? nA : cA + (size_t)(t + 2) * kstep; const char* b2 = last ? nB : cB + (size_t)(t + 2) * kstep;
            const char* a3 = a2 + kstep; const char* b3 = b2 + kstep;
            if (last && has_next) S.a_ready(nxt);
            if constexpr (SP2) {
            PG8_LDB(B0, 0, 0); PG8_LDB(B1, 0, 1); PG8_SCHED; PG8_LDA(At, 0, 0); PG8_STAGE(PG8_SA(1, 1), a1 + hstep, voffA);
            PG8_WAIT_V(8); PG8_WAIT_L(0); PG8_BAR; PG8_MMA(0, 0, At, B0); PG8_MMA(0, 1, At, B1); PG8_BAR; PG8_SCHED;
            PG8_LDA(At, 0, 1); PG8_STAGE(PG8_SB(0, 0), b2, voffB); PG8_STAGE(PG8_SB(0, 1), b2 + hstep, voffB); PG8_STAGE(PG8_SA(0, 0), a2, voffA);
            PG8_WAIT_V(8); PG8_WAIT_L(0); PG8_BAR; PG8_MMA(1, 0, At, B0); PG8_MMA(1, 1, At, B1); PG8_BAR; PG8_SCHED;
            PG8_LDB(B0, 1, 0); PG8_LDB(B1, 1, 1); PG8_SCHED; PG8_LDA(At, 1, 0); PG8_STAGE(PG8_SA(0, 1), a2 + hstep, voffA);
            PG8_WAIT_V(8); PG8_WAIT_L(0); PG8_BAR; PG8_MMA(0, 0, At, B0); PG8_MMA(0, 1, At, B1); PG8_BAR; PG8_SCHED;
            PG8_LDA(At, 1, 1); PG8_STAGE(PG8_SB(1, 0), b3, voffB); PG8_STAGE(PG8_SB(1, 1), b3 + hstep, voffB); PG8_STAGE(PG8_SA(1, 0), a3, voffA);
            PG8_WAIT_V(8); PG8_WAIT_L(0); PG8_BAR; PG8_MMA(1, 0, At, B0); PG8_MMA(1, 1, At, B1); PG8_BAR; PG8_SCHED;
            } else {
            PG8_LDB(B0, 0, 0); PG8_SCHED; PG8_LDA(At, 0, 0); PG8_STAGE(PG8_SA(1, 1), a1 + hstep, voffA);
            PG8_WAIT_L(8); PG8_BAR; PG8_WAIT_L(0); PG8_MMA(0, 0, At, B0); PG8_BAR; PG8_SCHED;
            PG8_LDB(B1, 0, 1); PG8_STAGE(PG8_SB(0, 0), b2, voffB);
            PG8_BAR; PG8_WAIT_L(0); PG8_MMA(0, 1, At, B1); PG8_BAR;
            PG8_LDA(At, 0, 1); PG8_STAGE(PG8_SA(0, 0), a2, voffA);
            PG8_BAR; PG8_WAIT_L(0); PG8_MMA(1, 0, At, B0); PG8_BAR; PG8_SCHED;
            PG8_STAGE(PG8_SB(0, 1), b2 + hstep, voffB);
            PG8_WAIT_V(6); PG8_BAR; PG8_MMA(1, 1, At, B1); PG8_BAR;
            PG8_LDB(B0, 1, 0); PG8_SCHED; PG8_LDA(At, 1, 0); PG8_STAGE(PG8_SA(0, 1), a2 + hstep, voffA);
            PG8_WAIT_L(8); PG8_BAR; PG8_WAIT_L(0); PG8_MMA(0, 0, At, B0); PG8_BAR; PG8_SCHED;
            PG8_LDB(B1, 1, 1); PG8_STAGE(PG8_SB(1, 0), b3, voffB);
            PG8_BAR; PG8_WAIT_L(0); PG8_MMA(0, 1, At, B1); PG8_BAR;
            PG8_LDA(At, 1, 1); PG8_STAGE(PG8_SA(1, 0), a3, voffA);
            PG8_BAR; PG8_WAIT_L(0); PG8_MMA(1, 0, At, B0); PG8_BAR; PG8_SCHED;
            PG8_STAGE(PG8_SB(1, 1), b3 + hstep, voffB);
            PG8_WAIT_V(6); PG8_BAR; PG8_MMA(1, 1, At, B1); PG8_BAR;
            }
        }
        if constexpr (ALIGN_EPI) { if (wr == 0) PG8_BAR; }
        if constexpr (!Epi::AFTER_DRAIN) { if constexpr (Epi::PREFETCH) { E.par = ui & 1; } E(acc, cur, wr, wc, fr, fq); S.done(cur); }
        if (!has_next) break;
        if constexpr (Epi::PREFETCH) E.prefetch(nxt, wid, (ui + 1) & 1);
#pragma unroll
        for (int a = 0; a < 2; ++a)
#pragma unroll
            for (int b = 0; b < 2; ++b)
#pragma unroll
                for (int m = 0; m < 4; ++m)
#pragma unroll
                    for (int n = 0; n < 2; ++n) acc[a][b][m][n] = (f32x4){0.f, 0.f, 0.f, 0.f};
        cur = nxt; cA = nA; cB = nB; ++ui;
        if constexpr (ALIGN_EPI) { if (wr == 1) PG8_BAR; }
    }
    PG8_WAIT_V(0);
    if constexpr (!ALIGN_EPI) { if (wr == 0) PG8_BAR; }
    PG8_BAR;
    if constexpr (Epi::AFTER_DRAIN) { E.fused(acc, cur, wr, wc, fr, fq, lds, wid, lane); S.done(cur); }
#undef PG8_SA
#undef PG8_SB
#undef PG8_STAGE
#undef PG8_LDA
#undef PG8_LDB
#undef PG8_MMA
#undef PG8_WAIT_V
#undef PG8_WAIT_L
#undef PG8_BAR
#undef PG8_SCHED
}
}

namespace attn {
constexpr int D = 128;
constexpr int WINDOW = 129;
constexpr float THR = 8.f;
constexpr bool WSKIP = true;
constexpr float SCALE = 0.08838834764831845f;
constexpr int NW = 8, QBLK = 32, KVBLK = 64, QB = NW * QBLK;
constexpr int SHM_V = KVBLK * D * 2, SHM_K = KVBLK * D * 2;
constexpr int LDS_BYTES = 2 * SHM_V + 2 * SHM_K + NW * 64 * 4;
using bf16 = __hip_bfloat16;
typedef short bf16x8 __attribute__((ext_vector_type(8)));
typedef short s16x4 __attribute__((ext_vector_type(4)));
typedef float f32x16 __attribute__((ext_vector_type(16)));
typedef float f32x4 __attribute__((ext_vector_type(4)));
typedef unsigned u32x4 __attribute__((ext_vector_type(4)));
template <class A, class Bt> struct same_t { static constexpr bool v = false; };
template <class A> struct same_t<A, A> { static constexpr bool v = true; };

#define KSWZ(row, colB) ((row) * 256 + ((colB) ^ (((row) & 7) << 4)))
#define SBAR() __builtin_amdgcn_sched_barrier(0)
__device__ __forceinline__ int v_st(int k, int c) { const int kk = (k & ~0xC) | ((k & 4) << 1) | ((k & 8) >> 1); return ((kk >> 3) * 4 + (c >> 5)) * 512 + ((kk & 7) * 32 + (c & 31)) * 2; }
__device__ __forceinline__ int v_rd_base(int lane) { return ((lane & 3) << 3) | (((lane >> 2) & 3) << 6) | (((lane >> 4) & 1) << 5) | (((lane >> 5) & 1) << 8); }
constexpr int v_rd_off(int d0, int ks, int half) { return d0 * 512 + ks * 4096 + half * 2048; }
__device__ __forceinline__ int crow(int r, int hi) { return (r & 3) + 8 * (r >> 2) + 4 * hi; }
__device__ __forceinline__ unsigned cvtpk(float lo, float hi) {
    unsigned r; asm volatile("v_cvt_pk_bf16_f32 %0, %1, %2" : "=v"(r) : "v"(lo), "v"(hi)); return r;
}
__device__ __forceinline__ bf16x8 pack8(f32x4 a, f32x4 b) {
    u32x4 w = {cvtpk(a[0], a[1]), cvtpk(a[2], a[3]), cvtpk(b[0], b[1]), cvtpk(b[2], b[3])};
    return *reinterpret_cast<bf16x8*>(&w);
}
template <class T> __device__ __forceinline__ bf16x8 load8(const T* p) {
    if constexpr (same_t<T, float>::v) { return pack8(*(const f32x4*)p, *(const f32x4*)(p + 4)); }
    else { return *reinterpret_cast<const bf16x8*>(p); }
}
__device__ __forceinline__ void mask_tile(f32x16& p0, f32x16& p1, int dq, unsigned W) {
    const float NEG = -__builtin_inff();
#pragma unroll
    for (int r = 0; r < 16; ++r) {
        const int c = (r & 3) + 8 * (r >> 2);
        if ((unsigned)(dq - c) >= W) p0[r] = NEG;
        if ((unsigned)(dq - c - 32) >= W) p1[r] = NEG;
    }
}
__device__ __forceinline__ void partialSM(f32x16& p0, f32x16& p1, float& m_reg, float& mn, float& alpha) {
    float pmax = p0[0]; for (int r = 1; r < 16; ++r) pmax = fmaxf(pmax, p0[r]); for (int r = 0; r < 16; ++r) pmax = fmaxf(pmax, p1[r]);
    { auto rr = __builtin_amdgcn_permlane32_swap(__float_as_uint(pmax), __float_as_uint(pmax), false, false);
      pmax = fmaxf(__uint_as_float(rr[0]), __uint_as_float(rr[1])); }
    constexpr float C2 = 1.4426950408889634f * SCALE;
    if (__builtin_expect(__all((pmax - m_reg) * SCALE <= THR), 1)) { mn = m_reg; alpha = 1.f; }
    else { mn = fmaxf(m_reg, pmax); alpha = __builtin_amdgcn_exp2f((m_reg - mn) * C2); m_reg = mn; }
    const float mnL = -mn * C2;
    for (int r = 0; r < 16; ++r) p0[r] = fmaf(p0[r], C2, mnL); for (int r = 0; r < 16; ++r) p1[r] = fmaf(p1[r], C2, mnL);
    for (int r = 0; r < 16; ++r) p0[r] = __builtin_amdgcn_exp2f(p0[r]);
}
__device__ __forceinline__ void finishSM(f32x16& p0, f32x16& p1, float alpha, float& l_reg, bf16x8& pa0, bf16x8& pa1, bf16x8& pa2, bf16x8& pa3) {
    for (int r = 0; r < 16; ++r) p1[r] = __builtin_amdgcn_exp2f(p1[r]);
    float ps = 0; for (int r = 0; r < 16; ++r) ps += p0[r]; for (int r = 0; r < 16; ++r) ps += p1[r];
    { auto rr = __builtin_amdgcn_permlane32_swap(__float_as_uint(ps), __float_as_uint(ps), false, false);
      ps = __uint_as_float(rr[0]) + __uint_as_float(rr[1]); }
    l_reg = l_reg * alpha + ps;
#define PK4(P, B_, OUT) do { unsigned a0 = cvtpk(P[B_+0], P[B_+1]), a1 = cvtpk(P[B_+2], P[B_+3]);                          \
        unsigned b0 = cvtpk(P[B_+4], P[B_+5]), b1 = cvtpk(P[B_+6], P[B_+7]);                                             \
        auto r0 = __builtin_amdgcn_permlane32_swap(a0, b0, false, false); auto r1 = __builtin_amdgcn_permlane32_swap(a1, b1, false, false); \
        u32x4 w = {r0[0], r1[0], r0[1], r1[1]}; OUT = *reinterpret_cast<bf16x8*>(&w); } while (0)
    PK4(p0, 0, pa0); PK4(p0, 8, pa1); PK4(p1, 0, pa2); PK4(p1, 8, pa3);
#undef PK4
}
template <int KB, bool SK>
__device__ __forceinline__ void qkt(f32x16& p0, f32x16& p1, const char* K_lds, int r32, int hi, const bf16x8* qr, bool act) {
    if (SK && !act) { const float NEG = -__builtin_inff();
#pragma unroll
        for (int r = 0; r < 16; ++r) { p0[r] = NEG; p1[r] = NEG; } return; }
    p0 = f32x16{}; p1 = f32x16{};
    const char* kb[4];
#pragma unroll
    for (int dd = 0; dd < 4; ++dd) kb[dd] = K_lds + KB * SHM_K + KSWZ(r32, (dd * 16 + hi * 8) * 2);
#pragma unroll
    for (int d0 = 0; d0 < 8; ++d0) { const char* a = kb[d0 & 3] + (d0 >> 2) * 128;
        bf16x8 b0 = *reinterpret_cast<const bf16x8*>(a);
        bf16x8 b1 = *reinterpret_cast<const bf16x8*>(a + 32 * 256);
        p0 = __builtin_amdgcn_mfma_f32_32x32x16_bf16(b0, qr[d0], p0, 0, 0, 0);
        p1 = __builtin_amdgcn_mfma_f32_32x32x16_bf16(b1, qr[d0], p1, 0, 0, 0); }
}
template <int VB, bool SK>
__device__ __forceinline__ void pv_tile(f32x16* o, int vb0, bf16x8 pa0, bf16x8 pa1, bf16x8 pa2, bf16x8 pa3, bool act) {
    if (SK && !act) return;
#define TRRD(dst, off) asm volatile("ds_read_b64_tr_b16 %0, %1 offset:%2" : "=&v"(dst) : "v"(vb0), "i"(off) : "memory")
#define PV_D0(d0) do { s16x4 l0, l1, l2, l3, h0, h1, h2, h3; constexpr int b_ = VB * SHM_V + v_rd_off(d0, 0, 0);     \
        TRRD(l0, b_); TRRD(h0, b_ + 2048); TRRD(l1, b_ + 4096); TRRD(h1, b_ + 6144); TRRD(l2, b_ + 8192); TRRD(h2, b_ + 10240); TRRD(l3, b_ + 12288); TRRD(h3, b_ + 14336); \
        asm volatile("s_waitcnt lgkmcnt(0)" ::: "memory"); SBAR();                 \
        o[d0] = __builtin_amdgcn_mfma_f32_32x32x16_bf16(pa0, (bf16x8){l0[0], l0[1], l0[2], l0[3], h0[0], h0[1], h0[2], h0[3]}, o[d0], 0, 0, 0);   \
        o[d0] = __builtin_amdgcn_mfma_f32_32x32x16_bf16(pa1, (bf16x8){l1[0], l1[1], l1[2], l1[3], h1[0], h1[1], h1[2], h1[3]}, o[d0], 0, 0, 0);   \
        o[d0] = __builtin_amdgcn_mfma_f32_32x32x16_bf16(pa2, (bf16x8){l2[0], l2[1], l2[2], l2[3], h2[0], h2[1], h2[2], h2[3]}, o[d0], 0, 0, 0);   \
        o[d0] = __builtin_amdgcn_mfma_f32_32x32x16_bf16(pa3, (bf16x8){l3[0], l3[1], l3[2], l3[3], h3[0], h3[1], h3[2], h3[3]}, o[d0], 0, 0, 0); } while (0)
    PV_D0(0); PV_D0(1); PV_D0(2); PV_D0(3);
#undef PV_D0
#undef TRRD
}

template <class TIn, class TOut> struct BlockRef { const TIn* Q; const TIn* K; const TIn* V; TOut* O; float* LSE; int P0; int rs; int ls; };
template <class TIn> struct Seam {
    bf16x8 qr[8];
    bf16x8 st_v0, st_v1, st_k0, st_k1; f32x4 sf0, sf1, sf2, sf3;
    f32x4 tq[16];
};
__device__ __forceinline__ int swa_jlo(int P0, int W) { const int lowk = P0 - W + 1; return lowk > 0 ? lowk / KVBLK : 0; }
#define ROW(p, k0, rr, rs_) ((p) + (size_t)((k0) + (rr)) * (size_t)(rs_) + sc)
#define VMW() asm volatile("s_waitcnt vmcnt(0)" ::: "memory")
#define VMWN(n) asm volatile("s_waitcnt vmcnt(%0)" :: "i"(n) : "memory")
#define SLOAD_H(Kp, Vp, k0, rs_) do { S.st_v0 = load8<TIn>(ROW(Vp, k0, sr, rs_)); S.st_v1 = load8<TIn>(ROW(Vp, k0, 32 + sr, rs_));              \
                         S.st_k0 = load8<TIn>(ROW(Kp, k0, sr, rs_)); S.st_k1 = load8<TIn>(ROW(Kp, k0, 32 + sr, rs_)); } while (0)
#define SWRITE_HK(bf) do { *(bf16x8*)(K_lds + (bf) * SHM_K + kws) = S.st_k0; *(bf16x8*)(K_lds + (bf) * SHM_K + kws + 32 * 256) = S.st_k1; } while (0)
#define SWRITE_HV(bf) do { *(bf16x8*)(V_lds + (bf) * SHM_V + vst0) = S.st_v0; *(bf16x8*)(V_lds + (bf) * SHM_V + vst1) = S.st_v1; } while (0)
#define SWRITE_H(bf) do { SWRITE_HV(bf); SWRITE_HK(bf); } while (0)
#define SLOAD_F(p, k0) do { } while (0)
#define SWRITE_KF(bf) do { *(bf16x8*)(K_lds + (bf) * SHM_K + kws) = pack8(S.sf0, S.sf1); *(bf16x8*)(K_lds + (bf) * SHM_K + kws + 32 * 256) = pack8(S.sf2, S.sf3); } while (0)
#define SWRITE_VF(bf) do { *(bf16x8*)(V_lds + (bf) * SHM_V + vst0) = pack8(S.sf0, S.sf1); *(bf16x8*)(V_lds + (bf) * SHM_V + vst1) = pack8(S.sf2, S.sf3); } while (0)
template <class TIn, class TOut>
__device__ __forceinline__ void causal_swa_prime(const BlockRef<TIn, TOut>& cur, int W, char* lds, Seam<TIn>& S) {
    constexpr bool F32 = same_t<TIn, float>::v;
    const int tid = tid_opaque(), wid = __builtin_amdgcn_readfirstlane(tid >> 6), lane = tid & 63, r32 = lane & 31, hi = lane >> 5;
    const int sr = tid >> 4, sc = (tid & 15) * 8, kws = KSWZ(sr, sc * 2); char* K_lds = lds + 2 * SHM_V;
    const int kb0 = swa_jlo(cur.P0, W) * KVBLK;
    for (int d0 = 0; d0 < 8; ++d0) S.qr[d0] = load8<TIn>(cur.Q + (size_t)(wid * QBLK + r32) * (size_t)cur.rs + d0 * 16 + hi * 8);
    if constexpr (F32) { SLOAD_F((const float*)cur.K, kb0); VMW(); SWRITE_KF(0); SBAR(); SLOAD_F((const float*)cur.V, kb0); }
    else { SLOAD_H(cur.K, cur.V, kb0, cur.rs); VMW(); SWRITE_HK(0); }
    __syncthreads();
}
template <class TIn, class TOut>
__device__ __forceinline__ void causal_swa_block(const BlockRef<TIn, TOut>& cur, const BlockRef<TIn, TOut>& nxt, int skv, int W, char* lds, Seam<TIn>& S) {
    constexpr bool F32 = same_t<TIn, float>::v;
    const int tid = tid_opaque(), wid = __builtin_amdgcn_readfirstlane(tid >> 6), lane = tid & 63, r32 = lane & 31, hi = lane >> 5;
    const int j_lo = swa_jlo(cur.P0, W);
    int j_hi = (cur.P0 + QB - 1) / KVBLK + 1; if (j_hi > skv / KVBLK) j_hi = skv / KVBLK;
    const int NT = j_hi - j_lo;
    const int kbn = swa_jlo(nxt.P0, W) * KVBLK;
    const int qlo = cur.P0 + wid * QBLK, qm = qlo + r32 - 4 * hi;
    char* V_lds = lds; char* K_lds = lds + 2 * SHM_V;
    float* ws = (float*)(lds + 2 * SHM_V + 2 * SHM_K) + wid * 64; float* li_l = ws, * al_l = ws + 32;
    float m_reg = -1e30f, l_reg = 0; f32x16 o[4] = {};
    const int sr = tid >> 4, sc = (tid & 15) * 8, vst0 = v_st(sr, sc), vst1 = v_st(32 + sr, sc), kws = KSWZ(sr, sc * 2);
    const int vb0 = (int)(uintptr_t)V_lds + v_rd_base(lane);
    const TIn* Kh = cur.K; const TIn* Vh = cur.V;
#define RESC(a) do { if (__any((a) < 1.f)) { if (hi == 0) al_l[r32] = (a); asm volatile("s_waitcnt lgkmcnt(0)" ::: "memory");              \
                     for (int d_ = 0; d_ < 4; ++d_) for (int r = 0; r < 16; ++r) o[d_][r] *= al_l[crow(r, hi)]; } } while (0)
#define KBASE(t) ((j_lo + (t)) * KVBLK)
#define ACT(t) (KBASE(t) <= qlo + QBLK - 1 && KBASE(t) + KVBLK - 1 >= qlo - W + 1)
#define MASKT(P0_, P1_, t) do { const int kb_ = KBASE(t); if ((!SK || ACT(t)) && (kb_ + KVBLK - 1 > qlo || kb_ <= qlo + QBLK - 1 - W)) mask_tile(P0_, P1_, qm - kb_, (unsigned)W); } while (0)
    constexpr int NQL = F32 ? 16 : 8;
    constexpr bool SK = WSKIP && !F32;
#define SEAM_K0() do { VMWN(NQL); if constexpr (F32) { SWRITE_KF(0); SBAR(); SLOAD_F((const float*)nxt.V, kbn); } else { SWRITE_HK(0); } SBAR(); } while (0)
    f32x16 pA0, pA1, pB0, pB1; float mnA, mnB, alA, alB; bf16x8 pa0, pa1, pa2, pa3;
    if constexpr (F32) { VMW(); SWRITE_VF(0); SBAR(); } else { SWRITE_HV(0); SBAR(); }
    if (NT > 1) { if constexpr (F32) SLOAD_F((const float*)Kh, KBASE(1)); else SLOAD_H(Kh, Vh, KBASE(1), cur.rs); }
    SBAR(); qkt<0, SK>(pA0, pA1, K_lds, r32, hi, S.qr, ACT(0));
    if constexpr (F32) { if (NT > 1) { VMW(); SWRITE_KF(1); SBAR(); SLOAD_F((const float*)Vh, KBASE(1)); } }
    MASKT(pA0, pA1, 0); partialSM(pA0, pA1, m_reg, mnA, alA);
    if (NT > 1) { VMW(); if constexpr (F32) { SWRITE_VF(1); SBAR(); if (NT > 2) SLOAD_F((const float*)Kh, KBASE(2)); } else SWRITE_H(1); }
    __syncthreads();
#define HALF_STEP(PX0, PX1, mnX, alX, PY0, PY1, alY, t, KB, VB, SB) do {                                                      \
        SBAR(); qkt<KB, SK>(PX0, PX1, K_lds, r32, hi, S.qr, ACT(t));                                             \
        finishSM(PY0, PY1, alY, l_reg, pa0, pa1, pa2, pa3); SBAR();                                                           \
        if ((t) + 1 < NT) { if constexpr (F32) { VMW(); SWRITE_KF(SB); SBAR(); SLOAD_F((const float*)Vh, KBASE((t) + 1)); }  \
                            else { SLOAD_H(Kh, Vh, KBASE((t) + 1), cur.rs); } SBAR(); }                                               \
        pv_tile<VB, SK>(o, vb0, pa0, pa1, pa2, pa3, ACT((t) - 1)); MASKT(PX0, PX1, (t)); partialSM(PX0, PX1, m_reg, mnX, alX);                                        \
        __syncthreads();                                                                                                      \
        if ((t) + 1 < NT) { VMW(); if constexpr (F32) { SWRITE_VF(SB); SBAR(); if ((t) + 2 < NT) SLOAD_F((const float*)Kh, KBASE((t) + 2)); } \
                            else { SWRITE_H(SB); } }                                                                          \
        RESC(alX); __syncthreads(); } while (0)
    for (int t = 1; t + 1 < NT; t += 2) {
        HALF_STEP(pB0, pB1, mnB, alB, pA0, pA1, alA, t, 1, 0, 0);
        HALF_STEP(pA0, pA1, mnA, alA, pB0, pB1, alB, t + 1, 0, 1, 1);
    }
    const bool even = (NT & 1) == 0;
    if (even) { SBAR(); qkt<1, SK>(pB0, pB1, K_lds, r32, hi, S.qr, ACT(NT - 1)); SBAR(); }
#define QROW(e) (nxt.Q + (size_t)(wid * QBLK + r32) * (size_t)nxt.rs + ((e) >> 1) * 16 + hi * 8 + ((e) & 1) * 4)
    if constexpr (F32) { SLOAD_F((const float*)nxt.K, kbn); SBAR();
#pragma unroll
        for (int e = 0; e < 8; ++e) S.tq[e] = *(const f32x4*)QROW(e); }
    else { SLOAD_H(nxt.K, nxt.V, kbn, nxt.rs); SBAR();
#pragma unroll
        for (int d0 = 0; d0 < 8; ++d0) S.qr[d0] = load8<TIn>(nxt.Q + (size_t)(wid * QBLK + r32) * (size_t)nxt.rs + d0 * 16 + hi * 8); }
    SBAR();
    finishSM(pA0, pA1, alA, l_reg, pa0, pa1, pa2, pa3); SBAR();
    if constexpr (F32) {
#pragma unroll
        for (int e = 8; e < 16; ++e) S.tq[e] = *(const f32x4*)QROW(e); SBAR(); }
#undef QROW
    pv_tile<0, SK>(o, vb0, pa0, pa1, pa2, pa3, ACT(even ? NT - 2 : NT - 1));
    if (even) { MASKT(pB0, pB1, NT - 1); partialSM(pB0, pB1, m_reg, mnB, alB); __syncthreads(); RESC(alB);
        finishSM(pB0, pB1, alB, l_reg, pa0, pa1, pa2, pa3); SBAR(); pv_tile<1, SK>(o, vb0, pa0, pa1, pa2, pa3, ACT(NT - 1)); }
    SBAR(); SEAM_K0();
    if (hi == 0) li_l[r32] = l_reg; asm volatile("s_waitcnt lgkmcnt(0)" ::: "memory");
    float rli[16];
#pragma unroll
    for (int r = 0; r < 16; ++r) rli[r] = __builtin_amdgcn_rcpf(li_l[crow(r, hi)]);
    TOut* Ow = cur.O + (size_t)(wid * QBLK) * (size_t)cur.rs;
    if (hi == 0) cur.LSE[(size_t)(wid * QBLK + r32) * (size_t)cur.ls] = m_reg * SCALE + __logf(l_reg);
#pragma unroll
    for (int r = 0; r < 16; ++r) { const int orow = crow(r, hi);
#pragma unroll
        for (int d0 = 0; d0 < 4; ++d0) { const float v = o[d0][r] * rli[r];
            if constexpr (same_t<TOut, float>::v) { Ow[(size_t)orow * (size_t)cur.rs + d0 * 32 + r32] = v; }
            else { const float vn = __shfl_xor(v, 1);
                   if ((r32 & 1) == 0) *(unsigned*)(Ow + (size_t)orow * (size_t)cur.rs + d0 * 32 + r32) = cvtpk(v, vn); } } }
    if constexpr (F32) {
#pragma unroll
        for (int d0 = 0; d0 < 8; ++d0) S.qr[d0] = pack8(S.tq[2 * d0], S.tq[2 * d0 + 1]); }
    __syncthreads();
#undef RESC
#undef KBASE
#undef ACT
#undef MASKT
#undef SEAM_K0
#undef HALF_STEP
}
#undef ROW
#undef VMW
#undef VMWN
#undef SLOAD_H
#undef SWRITE_HK
#undef SWRITE_HV
#undef SWRITE_H
#undef SLOAD_F
#undef SWRITE_KF
#undef SWRITE_VF

#undef SBAR
}
#define GAS __attribute__((address_space(1)))
#define LAS __attribute__((address_space(3)))
typedef unsigned short bf16;
typedef unsigned v4u __attribute__((ext_vector_type(4)));
typedef float f32x4 __attribute__((ext_vector_type(4)));
typedef short bf16x8 __attribute__((ext_vector_type(8)));
typedef GAS unsigned gu32;
typedef GAS unsigned long long gu64;
#define RLX_AGENT __ATOMIC_RELAXED, __HIP_MEMORY_SCOPE_AGENT
#define LDS_WAIT() asm volatile("s_waitcnt lgkmcnt(0)" ::: "memory")
#define VM_WAIT() asm volatile("s_waitcnt vmcnt(0)" ::: "memory")
__device__ __forceinline__ unsigned long long rt() { return __builtin_amdgcn_s_memrealtime(); }
__device__ __forceinline__ unsigned f2bf(float f) { unsigned u = __builtin_bit_cast(unsigned, f); return (u + 0x7fffu + ((u >> 16) & 1u)) >> 16; }
__device__ __forceinline__ unsigned pk2(float lo, float hi) { return f2bf(lo) | (f2bf(hi) << 16); }

#define XB_TMO      128
#define XB_XCNT(j)  (256  + 64 * (j))
#define XB_XSUB(j)  (1280 + 64 * (j))
#define XB_XGEN(j)  (2304 + 64 * (j))
#define XB_TOP      3328
#define XB_TOPGEN   3392
#define XCD_BAR_WORDS 3456
#define XB_SPIN_CAP (1u << 18)

__device__ __forceinline__ unsigned xb_ld(unsigned* p)              { return __hip_atomic_load(p, __ATOMIC_RELAXED, __HIP_MEMORY_SCOPE_AGENT); }
__device__ __forceinline__ unsigned xb_add(unsigned* p, unsigned v) { return __hip_atomic_fetch_add(p, v, __ATOMIC_RELAXED, __HIP_MEMORY_SCOPE_AGENT); }
__device__ __forceinline__ unsigned xb_xcc_id() { return (unsigned)__builtin_amdgcn_s_getreg((3 << 11) | 20) & 0xFu; }
#define XB_SPIN(cond, bar) do { unsigned _sp = 0; while (cond) { __builtin_amdgcn_s_sleep(1); \
    if ((++_sp & 255u) == 0u) { if (xb_ld(&(bar)[XB_TMO])) break; if (_sp > XB_SPIN_CAP) { atomicAdd(&(bar)[XB_TMO], 1u); break; } } } } while (0)

struct XcdBarrier {
    unsigned* bar; unsigned x;
    volatile LAS unsigned* st;
};

__device__ __forceinline__ XcdBarrier xcd_barrier_post(unsigned* bar, volatile LAS unsigned* st) {
    XcdBarrier b; b.bar = bar; b.x = xb_xcc_id(); b.st = st;
    if (threadIdx.x == 0) (void)xb_add(&bar[XB_XCNT(b.x)], 1u);
    return b;
}
__device__ __forceinline__ void xcd_barrier_complete(unsigned* bar, unsigned x, unsigned& nloc, unsigned& nx) {
    const unsigned G = gridDim.x * gridDim.y * gridDim.z;
    unsigned sum, cnt, mine, sp = 0u;
    for (;;) {
        sum = 0u; cnt = 0u; mine = 0u;
#pragma unroll
        for (unsigned j = 0; j < 16; ++j) { const unsigned c = xb_ld(&bar[XB_XCNT(j)]); sum += c; cnt += (c > 0u) ? 1u : 0u; mine = (j == x) ? c : mine; }
        if (sum == G) break;
        __builtin_amdgcn_s_sleep(1);
        if ((++sp & 255u) == 0u) { if (xb_ld(&bar[XB_TMO])) break; if (sp > XB_SPIN_CAP) { atomicAdd(&bar[XB_TMO], 1u); break; } }
    }
    nloc = mine > 0u ? mine : 1u; nx = cnt > 0u ? cnt : 1u;
}

__device__ __forceinline__ void xcd_barrier(const XcdBarrier& b) {
    asm volatile("s_waitcnt vmcnt(0)" ::: "memory");
    __syncthreads();
    if (threadIdx.x == 0) {
        unsigned* bar = b.bar;
        __builtin_amdgcn_s_waitcnt(0);
        unsigned nloc = b.st[0], nx = b.st[1];
        if (nloc == 0u) { xcd_barrier_complete(bar, b.x, nloc, nx); b.st[0] = nloc; b.st[1] = nx; }
        const unsigned old = xb_add(&bar[XB_XSUB(b.x)], 1u);
        const unsigned gen = old / nloc;
        if (old + 1u == (gen + 1u) * nloc) {
            __builtin_amdgcn_fence(__ATOMIC_RELEASE, "agent");
            asm volatile("s_waitcnt vmcnt(0)" ::: "memory");
            const unsigned og = xb_add(&bar[XB_TOP], 1u);
            const unsigned tg = og / nx;
            if (og + 1u == (tg + 1u) * nx) xb_add(&bar[XB_TOPGEN], 1u);
            else XB_SPIN(xb_ld(&bar[XB_TOPGEN]) == tg, bar);
            __builtin_amdgcn_fence(__ATOMIC_ACQUIRE, "agent");
            xb_add(&bar[XB_XGEN(b.x)], 1u);
            asm volatile("s_waitcnt vmcnt(0)" ::: "memory");
        } else {
            XB_SPIN(xb_ld(&bar[XB_XGEN(b.x)]) == gen, bar);
            __builtin_amdgcn_fence(__ATOMIC_ACQUIRE, "agent");
            asm volatile("s_waitcnt vmcnt(0)" ::: "memory");
        }
    }
    __syncthreads();
}

constexpr int NWAVES = 8;

constexpr size_t MiB = 1u << 20, HMiB = 1u << 19;
constexpr size_t WS_CTL = 0, CTL_ZERO_BYTES = 64 * 1024;
constexpr size_t WS_MOD = 1 * MiB;
constexpr size_t WS_AVEC = WS_MOD + 80 * 1024;
constexpr size_t WS_BIAS_IN = WS_MOD + 96 * 1024;
constexpr size_t WS_BIAS_F2 = WS_MOD + 176 * 1024;
constexpr size_t WS_PS2 = WS_MOD + 256 * 1024, WS_PS3 = WS_MOD + 512 * 1024;
constexpr size_t WS_WGU1 = 2 * MiB;
constexpr size_t WS_WD1 = WS_WGU1 + 11 * MiB;
constexpr size_t WS_WIN = WS_WD1 + 11 * HMiB;
constexpr size_t WS_WA = WS_WIN + 19 * MiB;
constexpr size_t WS_WC = WS_WA + 1 * MiB;
constexpr size_t WS_WO = WS_WC + 2 * MiB;
constexpr size_t WS_WGU2 = WS_WO + 2 * MiB;
constexpr size_t WS_WD2 = WS_WGU2 + 11 * MiB;
constexpr size_t WS_XS = WS_WD2 + 11 * HMiB;
constexpr size_t WS_R = WS_XS + 32 * MiB;
constexpr size_t WS_ACT = WS_R;
constexpr size_t WS_Q = WS_R, WS_K = WS_R + 48 * MiB, WS_V = WS_R + 96 * MiB;
constexpr size_t WS_LSE = WS_R + 144 * MiB;
constexpr size_t WS_O = WS_R + 145 * MiB;
constexpr size_t WS_U = WS_R + 48 * MiB, WS_B = WS_R + 80 * MiB, WS_C = WS_R + 112 * MiB;
constexpr size_t WS_SGA = WS_R, WS_SGC = WS_R + 48 * MiB;
constexpr size_t WS_END = WS_O + 16 * MiB;
static_assert(WS_XS == 59 * MiB && WS_END <= 256 * MiB, "d_ws map");
constexpr int CW_BAR = 4096;

constexpr int RING_OFF = 0, RING_BYTES = 131072;
constexpr int LDSCTL_OFF = RING_BYTES, MISC_OFF = LDSCTL_OFF + 320, XL_OFF = RING_BYTES + 1024;
constexpr int LDS_BYTES = 151552;


#ifdef NAIVE
#define FUSE_RS 0
#else
#define FUSE_RS 1
#endif
struct Args { const float* in[20]; float* out; unsigned char* ws; int ph_lo, ph_hi; };
struct Frame {
    LAS unsigned char* lds;
    volatile LAS unsigned* MISC;
    gu32* ctl;
    int tid, lane, wave;
    int vcu, G;
    float* out; unsigned char* ws;
};
enum { I_X = 0, I_C, I_WADA, I_BADA, I_NF1, I_F1G, I_F1U, I_F1D, I_NMIX, I_WIN, I_QN, I_KN, I_CONVW, I_WAB, I_WCB, I_WOUT, I_NF2, I_F2G, I_F2U, I_F2D };
enum { MOD_SH1 = 0, MOD_SC1 = 1024, MOD_GT1 = 2048, MOD_SH2 = 3072, MOD_SC2 = 4096, MOD_GT2 = 5120, MOD_SH3 = 6144, MOD_SC3 = 7168, MOD_GT3 = 8192 };

__device__ __forceinline__ float silu_f(float x) { return x * __builtin_amdgcn_rcpf(1.0f + __builtin_amdgcn_exp2f(-1.4426950408889634f * x)); }
__device__ __forceinline__ float wave_sum(float v) {
#pragma unroll
    for (int o = 1; o < 64; o <<= 1) v += __shfl_xor(v, o);
    return v;
}
__device__ __forceinline__ float blo(unsigned w) { return __uint_as_float(w << 16); }
__device__ __forceinline__ float bhi(unsigned w) { return __uint_as_float(w & 0xffff0000u); }

constexpr int ADA_ITEMS = NMOD / 64;
__device__ __forceinline__ void p0_adaln_item(Frame& F, const Args& args, int item) {
    LAS float* sc = (LAS float*)(F.lds + RING_OFF);
    LAS float* red = sc + 2048;
    const float* c = args.in[I_C]; const float* wada = args.in[I_WADA]; const float* bada = args.in[I_BADA];
    for (int i = F.tid; i < 2 * DM; i += NWAVES * 64) sc[i] = silu_f(c[i]);
    __syncthreads();
    const int j0 = item * 64, cg = F.lane & 15, rs = F.lane >> 4;
    f32x4 a0 = {0.f, 0.f, 0.f, 0.f}, a1 = {0.f, 0.f, 0.f, 0.f};
    const GAS f32x4* wp = (const GAS f32x4*)(wada + (size_t)(F.wave * 128 + rs) * NMOD + j0 + 4 * cg);
#pragma unroll 16
    for (int it = 0; it < 32; ++it) { const int k = F.wave * 128 + 4 * it + rs; const f32x4 w = __builtin_nontemporal_load(&wp[(size_t)it * 4 * (NMOD / 4)]);
        a0 = a0 + w * sc[k]; a1 = a1 + w * sc[DM + k]; }
#pragma unroll
    for (int i = 0; i < 4; ++i) { a0[i] += __shfl_xor(a0[i], 16); a0[i] += __shfl_xor(a0[i], 32); a1[i] += __shfl_xor(a1[i], 16); a1[i] += __shfl_xor(a1[i], 32); }
    if (F.lane < 16) {
#pragma unroll
        for (int i = 0; i < 4; ++i) { red[(F.wave * 2 + 0) * 64 + 4 * cg + i] = a0[i]; red[(F.wave * 2 + 1) * 64 + 4 * cg + i] = a1[i]; } }
    __syncthreads();
    if (F.tid < 128) { const int b = F.tid >> 6, j = F.tid & 63; float s = bada[j0 + j];
#pragma unroll
        for (int w = 0; w < NWAVES; ++w) s += red[(w * 2 + b) * 64 + j];
        ((float*)(F.ws + WS_MOD))[b * NMOD + j0 + j] = s; }
    __syncthreads();
}
__device__ __forceinline__ void p0_transpose_item(const float* W, int K, int N, bf16* WT, int rmode, LAS float* scr, int item, int lane, int dpitch, int koff) {
    const int nblk = N / 32, kb = item / nblk, nb = item % nblk, k0 = 64 * kb, n0 = 32 * nb;
    const int r0 = rmode == 0 ? n0 : 256 * (n0 >> 7) + 128 * (rmode - 1) + (n0 & 127);
#pragma unroll 16
    for (int i = 0; i < 32; ++i) { const int kk = 2 * i + (lane >> 5); scr[kk * 33 + (lane & 31)] = __builtin_nontemporal_load(&W[(size_t)(k0 + kk) * N + n0 + (lane & 31)]); }
    LDS_WAIT(); asm volatile("" ::: "memory");
    const int c = lane & 7;
#pragma unroll
    for (int j = 0; j < 4; ++j) { const int n = (lane >> 3) + 8 * j; const LAS float* s = scr + (8 * c) * 33 + n;
        v4u o; o.x = pk2(s[0 * 33], s[1 * 33]); o.y = pk2(s[2 * 33], s[3 * 33]); o.z = pk2(s[4 * 33], s[5 * 33]); o.w = pk2(s[6 * 33], s[7 * 33]);
        *(GAS v4u*)(WT + (size_t)(r0 + n) * dpitch + koff + k0 + 8 * c) = o; }
    LDS_WAIT(); asm volatile("" ::: "memory");
}
__device__ __forceinline__ void p0_transposes(Frame& F, const Args& args, int set, int gw, int NGW) {
    LAS float* scr = (LAS float*)(F.lds + RING_OFF + F.wave * 16384);
    int base = 0;
#define TR_JOBX(SRC, K_, N_, RMODE, DST, DP, KO) do { const int n_it = ((K_) / 64) * ((N_) / 32); int it = gw - (base % NGW); if (it < 0) it += NGW;     \
        const float* W_ = args.in[SRC]; bf16* WT_ = (bf16*)(F.ws + (DST)); \
        for (; it < n_it; it += NGW) p0_transpose_item(W_, (K_), (N_), WT_, (RMODE), scr, it, F.lane, (DP), (KO)); base += n_it; } while (0)
#define TR_JOB(SRC, K_, N_, RMODE, DST) TR_JOBX(SRC, K_, N_, RMODE, DST, K_, 0)
    if (set == 0) { TR_JOB(I_F1G, DM, DFF, 1, WS_WGU1); TR_JOB(I_F1U, DM, DFF, 2, WS_WGU1); TR_JOB(I_F1D, DFF, DM, 0, WS_WD1); }
    else if (set == 1) { TR_JOB(I_WIN, DM, INW, 0, WS_WIN);
#if FUSE_RS
        TR_JOBX(I_WAB, 512, DM, 0, WS_WA, 1536, 0); TR_JOBX(I_WCB, DM, DM, 0, WS_WA, 1536, 512);
#else
        TR_JOB(I_WAB, 512, DM, 0, WS_WA); TR_JOB(I_WCB, DM, DM, 0, WS_WC);
#endif
        TR_JOB(I_WOUT, DM, DM, 0, WS_WO); }
    else { TR_JOB(I_F2G, DM, DFF, 1, WS_WGU2); TR_JOB(I_F2U, DM, DFF, 2, WS_WGU2); TR_JOB(I_F2D, DFF, DM, 0, WS_WD2); }
#undef TR_JOB
#undef TR_JOBX
}
__device__ __forceinline__ void norm_pass(Frame& F, const float* X, const float* g, int mod_sh, int mod_sc) {
    const int gw = F.vcu * NWAVES + F.wave, NGW = F.G * NWAVES;
    const float* mod = (const float*)(F.ws + WS_MOD); bf16* XS = (bf16*)(F.ws + WS_XS);
    for (int r0 = gw * 8; r0 < M; r0 += NGW * 8) {
        const int b = r0 / SEQ;
        f32x4 a[4], s[4];
#pragma unroll
        for (int j = 0; j < 4; ++j) { const int c = 4 * F.lane + 256 * j;
            a[j] = *(const f32x4*)(g + c) * (*(const f32x4*)(mod + b * NMOD + mod_sc + c) + 1.0f); s[j] = *(const f32x4*)(mod + b * NMOD + mod_sh + c); }
#pragma unroll 4
        for (int r = 0; r < 8; ++r) {
            const GAS f32x4* xr = (const GAS f32x4*)(X + (size_t)(r0 + r) * DM) + F.lane;
            f32x4 v[4]; float ss = 0.f;
#pragma unroll
            for (int j = 0; j < 4; ++j) { v[j] = xr[64 * j]; ss += (v[j].x * v[j].x + v[j].y * v[j].y) + (v[j].z * v[j].z + v[j].w * v[j].w); }
            const float rstd = 1.0f / sqrtf(wave_sum(ss) * (1.f / DM) + EPS);
            GAS unsigned long long* o8 = (GAS unsigned long long*)(XS + (size_t)(r0 + r) * DM) + F.lane;
#pragma unroll
            for (int j = 0; j < 4; ++j) { const f32x4 y = v[j] * rstd * a[j] + s[j];
                o8[64 * j] = (unsigned long long)pk2(y.x, y.y) | ((unsigned long long)pk2(y.z, y.w) << 32); }
        }
    }
}
__device__ __forceinline__ void qknorm_pass(Frame& F, const Args& args) {
    const int gw = F.vcu * NWAVES + F.wave, NGW = F.G * NWAVES;
    const float* gq_ = args.in[I_QN]; const float* gk_ = args.in[I_KN];
    for (int it = gw; it < 2 * M; it += NGW) {
        const int which = it >= M, row = which ? it - M : it;
        bf16* buf = (bf16*)(F.ws + (which ? WS_K : WS_Q)) + (size_t)row * AW; const float* gm = (which ? gk_ : gq_) + 8 * (F.lane & 15);
        const f32x4 g0 = *(const f32x4*)gm, g1 = *(const f32x4*)(gm + 4);
#pragma unroll
        for (int j = 0; j < 3; ++j) { GAS v4u* p = (GAS v4u*)(buf + 512 * j + 8 * F.lane); const v4u w = *p;
            f32x4 v0 = {blo(w.x), bhi(w.x), blo(w.y), bhi(w.y)}, v1 = {blo(w.z), bhi(w.z), blo(w.w), bhi(w.w)};
            float ss = (v0.x * v0.x + v0.y * v0.y) + (v0.z * v0.z + v0.w * v0.w) + (v1.x * v1.x + v1.y * v1.y) + (v1.z * v1.z + v1.w * v1.w);
            ss += __shfl_xor(ss, 1); ss += __shfl_xor(ss, 2); ss += __shfl_xor(ss, 4); ss += __shfl_xor(ss, 8);
            const float r = 1.0f / sqrtf(ss * (1.f / 128.f) + EPS);
            v0 = v0 * r * g0; v1 = v1 * r * g1;
            v4u o; o.x = pk2(v0.x, v0.y); o.y = pk2(v0.z, v0.w); o.z = pk2(v1.x, v1.y); o.w = pk2(v1.z, v1.w); *p = o; }
    }
}
__device__ __forceinline__ void aux_avec(Frame& F, const Args& args) {
    const int gw = F.vcu * NWAVES + F.wave, NGW = F.G * NWAVES;
    const float* mod = (const float*)(F.ws + WS_MOD); float* avec = (float*)(F.ws + WS_AVEC);
    const float* g2 = args.in[I_NMIX]; const float* g3 = args.in[I_NF2];
    for (int idx = gw * 64 + F.lane; idx < 4 * DM; idx += NGW * 64) { const int which = idx >> 11, b = (idx >> 10) & 1, c = idx & (DM - 1);
        avec[idx] = (which ? g3[c] : g2[c]) * (1.0f + mod[b * NMOD + (which ? MOD_SC3 : MOD_SC2) + c]); }
}
__device__ __forceinline__ void aux_bias(Frame& F, int which) {
    const int gw = F.vcu * NWAVES + F.wave, NGW = F.G * NWAVES;
    const float* mod = (const float*)(F.ws + WS_MOD);
    const int nrows = which ? 2 * DFF : INW;
    const float* sh = mod + (which ? MOD_SH3 : MOD_SH2) + 16 * F.lane;
    f32x4 s0[4], s1[4];
#pragma unroll
    for (int q = 0; q < 4; ++q) { s0[q] = *(const f32x4*)(sh + 4 * q); s1[q] = *(const f32x4*)(sh + NMOD + 4 * q); }
    float* bo = (float*)(F.ws + (which ? WS_BIAS_F2 : WS_BIAS_IN));
    for (int n = gw; n < nrows; n += NGW) {
        const bf16* wrow = (const bf16*)(F.ws + (which ? WS_WGU2 : WS_WIN)) + (size_t)n * DM + 16 * F.lane;
        const v4u w0 = *(const GAS v4u*)wrow, w1 = *(const GAS v4u*)(wrow + 8);
        const float wv[16] = {blo(w0.x), bhi(w0.x), blo(w0.y), bhi(w0.y), blo(w0.z), bhi(w0.z), blo(w0.w), bhi(w0.w), blo(w1.x), bhi(w1.x), blo(w1.y), bhi(w1.y), blo(w1.z), bhi(w1.z), blo(w1.w), bhi(w1.w)};
        float d0 = 0.f, d1 = 0.f;
#pragma unroll
        for (int q = 0; q < 4; ++q)
#pragma unroll
            for (int i = 0; i < 4; ++i) { d0 += s0[q][i] * wv[4 * q + i]; d1 += s1[q][i] * wv[4 * q + i]; }
        d0 = wave_sum(d0); d1 = wave_sum(d1);
        if (F.lane == 0) { bo[n] = d0; bo[nrows + n] = d1; }
    }
}
typedef attn::BlockRef<attn::bf16, attn::bf16> ABlock;
__device__ __forceinline__ ABlock attn_ref(Frame& F, int id, int& skv) {
    const int bgh = id >> 5, x = id & 31, b = bgh / 12, gh = bgh - b * 12, g = gh >> 2, d = 1 << (2 * g), nqb = 32 >> (2 * g), r = x / nqb, qb = x - r * nqb;
    ABlock R; const size_t e0 = (size_t)(b * SEQ + r) * AW + gh * 128;
    R.rs = d * AW; R.ls = d * 12; R.P0 = qb * 256; skv = SEQ / d;
    R.K = (const attn::bf16*)(F.ws + WS_K) + e0; R.V = (const attn::bf16*)(F.ws + WS_V) + e0;
    attn::bf16* q = (attn::bf16*)(F.ws + WS_Q) + e0 + (size_t)(qb * 256) * R.rs; R.Q = q; R.O = q;
    R.LSE = (float*)(F.ws + WS_LSE) + (size_t)(b * SEQ + r + qb * 256 * d) * 12 + gh;
    return R;
}
__device__ __forceinline__ void attn_phase(Frame& F, char* lds) {
    constexpr int NITEMS = 768;
    const int per = (NITEMS + F.G - 1) / F.G; int id = F.vcu * per; const int end = (id + per < NITEMS) ? id + per : NITEMS;
    if (id >= end) return;
    int skv, skvn; ABlock cur = attn_ref(F, id, skv);
    attn::Seam<attn::bf16> S;
    attn::causal_swa_prime<attn::bf16, attn::bf16>(cur, attn::WINDOW, lds, S);
    for (;;) {
        const bool last = id + 1 >= end; skvn = skv;
        const ABlock nxt = last ? cur : attn_ref(F, id + 1, skvn);
        attn::causal_swa_block<attn::bf16, attn::bf16>(cur, nxt, skv, attn::WINDOW, lds, S);
        if (last) break;
        cur = nxt; skv = skvn; ++id;
    }
}
__device__ __forceinline__ void merge_conv_pass(Frame& F, const Args& args) {
    const int gw = F.vcu * NWAVES + F.wave, NGW = F.G * NWAVES;
    { const bf16* OG = (const bf16*)(F.ws + WS_Q); const float* LSE = (const float*)(F.ws + WS_LSE); bf16* O = (bf16*)(F.ws + WS_O);
      const int h = F.lane >> 4, e = 8 * (F.lane & 15);
      for (int t = gw; t < M; t += NGW) {
          const float l0 = LSE[(size_t)t * 12 + h], l1 = LSE[(size_t)t * 12 + 4 + h], l2 = LSE[(size_t)t * 12 + 8 + h];
          const float mx = fmaxf(l0, fmaxf(l1, l2)); const float e0 = __expf(l0 - mx), e1 = __expf(l1 - mx), e2 = __expf(l2 - mx); const float inv = 1.0f / (e0 + e1 + e2);
          const float wg[3] = {e0 * inv, e1 * inv, e2 * inv};
          f32x4 a0 = {0.f, 0.f, 0.f, 0.f}, a1 = {0.f, 0.f, 0.f, 0.f};
#pragma unroll
          for (int g = 0; g < 3; ++g) { const v4u w = *(const GAS v4u*)(OG + (size_t)t * AW + (g * 4 + h) * 128 + e);
              a0 = a0 + (f32x4){blo(w.x), bhi(w.x), blo(w.y), bhi(w.y)} * wg[g]; a1 = a1 + (f32x4){blo(w.z), bhi(w.z), blo(w.w), bhi(w.w)} * wg[g]; }
          v4u o; o.x = pk2(a0.x, a0.y); o.y = pk2(a0.z, a0.w); o.z = pk2(a1.x, a1.y); o.w = pk2(a1.z, a1.w);
          *(GAS v4u*)(O + (size_t)t * 512 + 8 * F.lane) = o; } }
    { const bf16* U = (const bf16*)(F.ws + WS_U); bf16* Bv = (bf16*)(F.ws + WS_B); const bf16* Cg = (const bf16*)(F.ws + WS_C); const float* cw = args.in[I_CONVW];
      for (int it = gw; it < 2 * (M / 16); it += NGW) {
          const int ch = it & 1, t0 = (it >> 1) * 16, c0 = 512 * ch + 8 * F.lane;
          float w0[8], w1[8], w2[8], x1[8], x2[8];
#pragma unroll
          for (int i = 0; i < 8; ++i) { w0[i] = cw[c0 + i]; w1[i] = cw[DM + c0 + i]; w2[i] = cw[2 * DM + c0 + i]; x1[i] = 0.f; x2[i] = 0.f; }
          if ((t0 & (SEQ - 1)) != 0) {
#pragma unroll
              for (int p = 2; p >= 1; --p) { const v4u wu = *(const GAS v4u*)(U + (size_t)(t0 - p) * DM + c0), wc = *(const GAS v4u*)(Cg + (size_t)(t0 - p) * DM + c0);
                  const float xu[8] = {blo(wu.x), bhi(wu.x), blo(wu.y), bhi(wu.y), blo(wu.z), bhi(wu.z), blo(wu.w), bhi(wu.w)}, xc[8] = {blo(wc.x), bhi(wc.x), blo(wc.y), bhi(wc.y), blo(wc.z), bhi(wc.z), blo(wc.w), bhi(wc.w)};
#pragma unroll
                  for (int i = 0; i < 8; ++i) { if (p == 2) x2[i] = xu[i] * xc[i]; else x1[i] = xu[i] * xc[i]; } } }
#pragma unroll 4
          for (int r = 0; r < 16; ++r) { const size_t off = (size_t)(t0 + r) * DM + c0;
              const v4u wu = *(const GAS v4u*)(U + off), wc = *(const GAS v4u*)(Cg + off), wb = *(const GAS v4u*)(Bv + off);
              const float xu[8] = {blo(wu.x), bhi(wu.x), blo(wu.y), bhi(wu.y), blo(wu.z), bhi(wu.z), blo(wu.w), bhi(wu.w)}, xc[8] = {blo(wc.x), bhi(wc.x), blo(wc.y), bhi(wc.y), blo(wc.z), bhi(wc.z), blo(wc.w), bhi(wc.w)};
              const float xb[8] = {blo(wb.x), bhi(wb.x), blo(wb.y), bhi(wb.y), blo(wb.z), bhi(wb.z), blo(wb.w), bhi(wb.w)};
              float y[8];
#pragma unroll
              for (int i = 0; i < 8; ++i) { const float x0 = xu[i] * xc[i]; y[i] = xb[i] * (w0[i] * x2[i] + w1[i] * x1[i] + w2[i] * x0); x2[i] = x1[i]; x1[i] = x0; }
              v4u o; o.x = pk2(y[0], y[1]); o.y = pk2(y[2], y[3]); o.z = pk2(y[4], y[5]); o.w = pk2(y[6], y[7]);
              *(GAS v4u*)(Bv + off) = o; } } }
}

__device__ __forceinline__ void merge_conv_pass2(Frame& F, const Args& args) {
    const int gw = F.vcu * NWAVES + F.wave, NGW = F.G * NWAVES;
    bf16* OC = (bf16*)(F.ws + WS_Q); const float* LSE = (const float*)(F.ws + WS_LSE);
    const bf16* U = (const bf16*)(F.ws + WS_U); const bf16* Bv = (const bf16*)(F.ws + WS_B); const bf16* Cg = (const bf16*)(F.ws + WS_C); const float* cw = args.in[I_CONVW];
    for (int it = gw; it < M / 8; it += NGW) {
        const int t0 = it * 8;
        { const int h = F.lane >> 4, e = 8 * (F.lane & 15);
#pragma unroll 2
          for (int r = 0; r < 8; ++r) { const int t = t0 + r;
              const float l0 = LSE[(size_t)t * 12 + h], l1 = LSE[(size_t)t * 12 + 4 + h], l2 = LSE[(size_t)t * 12 + 8 + h];
              const float mx = fmaxf(l0, fmaxf(l1, l2)); const float e0 = __expf(l0 - mx), e1 = __expf(l1 - mx), e2 = __expf(l2 - mx); const float inv = 1.0f / (e0 + e1 + e2);
              const float wg[3] = {e0 * inv, e1 * inv, e2 * inv};
              f32x4 a0 = {0.f, 0.f, 0.f, 0.f}, a1 = {0.f, 0.f, 0.f, 0.f};
#pragma unroll
              for (int g = 0; g < 3; ++g) { const v4u w = *(const GAS v4u*)(OC + (size_t)t * AW + (g * 4 + h) * 128 + e);
                  a0 = a0 + (f32x4){blo(w.x), bhi(w.x), blo(w.y), bhi(w.y)} * wg[g]; a1 = a1 + (f32x4){blo(w.z), bhi(w.z), blo(w.w), bhi(w.w)} * wg[g]; }
              v4u o; o.x = pk2(a0.x, a0.y); o.y = pk2(a0.z, a0.w); o.z = pk2(a1.x, a1.y); o.w = pk2(a1.z, a1.w);
              *(GAS v4u*)(OC + (size_t)t * AW + 8 * F.lane) = o; } }
        asm volatile("s_waitcnt vmcnt(0)" ::: "memory");
#pragma unroll 1
        for (int hc = 0; hc < 2; ++hc) { const int c0 = 512 * hc + 8 * F.lane;
            float w0[8], w1[8], w2[8], x1[8], x2[8];
#pragma unroll
            for (int i = 0; i < 8; ++i) { w0[i] = cw[c0 + i]; w1[i] = cw[DM + c0 + i]; w2[i] = cw[2 * DM + c0 + i]; x1[i] = 0.f; x2[i] = 0.f; }
            if ((t0 & (SEQ - 1)) != 0) {
#pragma unroll
                for (int p = 2; p >= 1; --p) { const v4u wu = *(const GAS v4u*)(U + (size_t)(t0 - p) * DM + c0), wc = *(const GAS v4u*)(Cg + (size_t)(t0 - p) * DM + c0);
                    const float xu[8] = {blo(wu.x), bhi(wu.x), blo(wu.y), bhi(wu.y), blo(wu.z), bhi(wu.z), blo(wu.w), bhi(wu.w)}, xc[8] = {blo(wc.x), bhi(wc.x), blo(wc.y), bhi(wc.y), blo(wc.z), bhi(wc.z), blo(wc.w), bhi(wc.w)};
#pragma unroll
                    for (int i = 0; i < 8; ++i) { if (p == 2) x2[i] = xu[i] * xc[i]; else x1[i] = xu[i] * xc[i]; } } }
#pragma unroll 4
            for (int r = 0; r < 8; ++r) { const size_t off = (size_t)(t0 + r) * DM + c0;
                const v4u wu = *(const GAS v4u*)(U + off), wc = *(const GAS v4u*)(Cg + off), wb = *(const GAS v4u*)(Bv + off);
                const float xu[8] = {blo(wu.x), bhi(wu.x), blo(wu.y), bhi(wu.y), blo(wu.z), bhi(wu.z), blo(wu.w), bhi(wu.w)}, xc[8] = {blo(wc.x), bhi(wc.x), blo(wc.y), bhi(wc.y), blo(wc.z), bhi(wc.z), blo(wc.w), bhi(wc.w)};
                const float xb[8] = {blo(wb.x), bhi(wb.x), blo(wb.y), bhi(wb.y), blo(wb.z), bhi(wb.z), blo(wb.w), bhi(wb.w)};
                float y[8];
#pragma unroll
                for (int i = 0; i < 8; ++i) { const float x0 = xu[i] * xc[i]; y[i] = xb[i] * (w0[i] * x2[i] + w1[i] * x1[i] + w2[i] * x0); x2[i] = x1[i]; x1[i] = x0; }
                v4u o; o.x = pk2(y[0], y[1]); o.y = pk2(y[2], y[3]); o.z = pk2(y[4], y[5]); o.w = pk2(y[6], y[7]);
                *(GAS v4u*)(OC + (size_t)(t0 + r) * AW + 512 + c0) = o; } }
    }
}

#ifdef NAIVE
template <bool DUAL, class St>
__device__ __forceinline__ void naive_gemm(Frame& F, const bf16* A, int lda, const float* W, const float* W2, int ldw, int M_, int N_, int K_, St store) {
    LAS float* As = (LAS float*)(F.lds + RING_OFF);
    LAS float* Ws = As + 64 * 33;
    LAS float* Ws2 = Ws + 32 * 68;
    const int ty = F.tid >> 4, tx = F.tid & 15, ntn = N_ / 64, ntiles = (M_ / 64) * ntn;
    for (int tile = blockIdx.x; tile < ntiles; tile += F.G) {
        const int tm = tile / ntn, tn = tile - tm * ntn;
        float acc[2][4] = {{0.f, 0.f, 0.f, 0.f}, {0.f, 0.f, 0.f, 0.f}}, acc2[2][4] = {{0.f, 0.f, 0.f, 0.f}, {0.f, 0.f, 0.f, 0.f}};
        for (int k0 = 0; k0 < K_; k0 += 32) {
            __syncthreads();
#pragma unroll
            for (int i = 0; i < 4; ++i) { const int e = F.tid + 512 * i, r = e >> 5, c = e & 31; As[r * 33 + c] = __uint_as_float((unsigned)A[(size_t)(tm * 64 + r) * lda + k0 + c] << 16); }
#pragma unroll
            for (int i = 0; i < 4; ++i) { const int e = F.tid + 512 * i, r = e >> 6, c = e & 63; Ws[r * 68 + c] = W[(size_t)(k0 + r) * ldw + tn * 64 + c]; if (DUAL) Ws2[r * 68 + c] = W2[(size_t)(k0 + r) * ldw + tn * 64 + c]; }
            __syncthreads();
#pragma unroll 8
            for (int kk = 0; kk < 32; ++kk) { const float a0 = As[(ty * 2) * 33 + kk], a1 = As[(ty * 2 + 1) * 33 + kk];
#pragma unroll
                for (int j = 0; j < 4; ++j) { const float w = Ws[kk * 68 + tx * 4 + j]; acc[0][j] += a0 * w; acc[1][j] += a1 * w;
                    if (DUAL) { const float w2 = Ws2[kk * 68 + tx * 4 + j]; acc2[0][j] += a0 * w2; acc2[1][j] += a1 * w2; } } }
        }
#pragma unroll
        for (int i = 0; i < 2; ++i)
#pragma unroll
            for (int j = 0; j < 4; ++j) store(tm * 64 + ty * 2 + i, tn * 64 + tx * 4 + j, acc[i][j], acc2[i][j]);
    }
    __syncthreads();
}
__device__ __forceinline__ bf16 f2b(float v) { return (bf16)f2bf(v); }
__device__ __forceinline__ float b2f(bf16 v) { return __uint_as_float((unsigned)v << 16); }
__device__ __forceinline__ void naive_attn(Frame& F) {
    const int gw = F.vcu * NWAVES + F.wave, NGW = F.G * NWAVES;
    bf16* Qb = (bf16*)(F.ws + WS_Q); const bf16* Kb = (const bf16*)(F.ws + WS_K); const bf16* Vb = (const bf16*)(F.ws + WS_V); float* LSE = (float*)(F.ws + WS_LSE);
    for (int it = gw; it < M * 12; it += NGW) {
        const int t = it / 12, gh = it - t * 12, g = gh >> 2, d = 1 << (2 * g), tl = t & (SEQ - 1);
        const float q0 = b2f(Qb[(size_t)t * AW + gh * 128 + 2 * F.lane]), q1 = b2f(Qb[(size_t)t * AW + gh * 128 + 2 * F.lane + 1]);
        float s0 = -INFINITY, s1 = -INFINITY, s2 = -INFINITY;
        for (int j = 0; j <= 128; ++j) { if (tl - j * d < 0) break; const size_t kr = (size_t)(t - j * d) * AW + gh * 128 + 2 * F.lane;
            const float sc = wave_sum(q0 * b2f(Kb[kr]) + q1 * b2f(Kb[kr + 1])) * 0.08838834764831845f;
            if (j < 64) { if (F.lane == j) s0 = sc; } else if (j < 128) { if (F.lane == j - 64) s1 = sc; } else { if (F.lane == 0) s2 = sc; } }
        float mx = fmaxf(s0, fmaxf(s1, s2));
#pragma unroll
        for (int o = 1; o < 64; o <<= 1) mx = fmaxf(mx, __shfl_xor(mx, o));
        const float p0 = __expf(s0 - mx), p1 = __expf(s1 - mx), p2 = __expf(s2 - mx);
        const float l = wave_sum(p0 + p1 + p2);
        float o0 = 0.f, o1 = 0.f;
        for (int j = 0; j <= 128; ++j) { if (tl - j * d < 0) break; const size_t vr = (size_t)(t - j * d) * AW + gh * 128 + 2 * F.lane;
            const float p = (j < 64) ? __shfl(p0, j) : (j < 128) ? __shfl(p1, j - 64) : __shfl(p2, 0);
            o0 += p * b2f(Vb[vr]); o1 += p * b2f(Vb[vr + 1]); }
        const float inv = 1.0f / l;
        Qb[(size_t)t * AW + gh * 128 + 2 * F.lane] = f2b(o0 * inv); Qb[(size_t)t * AW + gh * 128 + 2 * F.lane + 1] = f2b(o1 * inv);
        if (F.lane == 0) LSE[(size_t)t * 12 + gh] = mx + __logf(l);
    }
}
#endif

constexpr int N_PHASES = 17;
__global__ void __launch_bounds__(NWAVES * 64, 2) mega_fwd(Args args) {
    extern __shared__ __attribute__((aligned(16))) unsigned char lds[];
    Frame F;
    F.lds = (LAS unsigned char*)lds;
    F.MISC = (volatile LAS unsigned*)(F.lds + MISC_OFF);
    F.tid = threadIdx.x; F.lane = F.tid & 63; F.wave = __builtin_amdgcn_readfirstlane(F.tid >> 6);
    F.G = gridDim.x; { const int bx = blockIdx.x; F.vcu = (F.G % 8 == 0) ? (bx % 8) * (F.G / 8) + bx / 8 : bx; }
    F.ws = args.ws; F.out = args.out;
    F.ctl = (gu32*)(args.ws + WS_CTL);
    for (int u = F.tid; u < (LDS_BYTES - LDSCTL_OFF) / 4; u += NWAVES * 64) ((LAS unsigned*)(F.lds + LDSCTL_OFF))[u] = 0u;
    __syncthreads();
    XcdBarrier bar = xcd_barrier_post((unsigned*)(F.ctl + CW_BAR), F.MISC + 8);
    const int lo = args.ph_lo, hi = args.ph_hi;
    typedef pg8::bf16_t pb;
#define mod ((const float*)(args.ws + WS_MOD))
#define XS ((const pb*)(args.ws + WS_XS))
    unsigned char* const ws = args.ws;
#define IN(k) (lo <= (k) && (k) < hi)
#define FRESH() do { F.tid = tid_opaque(); F.lane = F.tid & 63; } while (0)
#ifdef PROBE_TA
#define TSTAMP(slot) do { if (F.tid == 0) { const unsigned long long t_ = rt(); F.MISC[16 + 2 * (slot)] = (unsigned)t_; F.MISC[17 + 2 * (slot)] = (unsigned)(t_ >> 32); } } while (0)
#define SEAM(k) do { if (IN(k) && IN((k) + 1)) xcd_barrier(bar); if ((k) == PROBE_TA) TSTAMP(0); if ((k) == PROBE_TB) TSTAMP(1); } while (0)
    if (PROBE_TA == -1) TSTAMP(0);
#else
#define SEAM(k) do { if (IN(k) && IN((k) + 1)) xcd_barrier(bar); } while (0)
#endif
#ifdef NAIVE
#define FUSE_NORM 0
#else
#define FUSE_NORM 1
#endif
#define XL ((PG8_LAS float*)(F.lds + XL_OFF))
#define PS2 ((const float*)(args.ws + WS_PS2))
#define PS3 ((const float*)(args.ws + WS_PS3))
#define bias_in ((const float*)(args.ws + WS_BIAS_IN))
#define bias_f2 ((const float*)(args.ws + WS_BIAS_F2))
#define avec ((const float*)(args.ws + WS_AVEC))
#define GEMM_BX(SCHED_DECL, SCHED_T, A_, K_, BT, N_, MODE, NRM, QKN_, O_, LDC, SPC, SPS, I1, I2, PS_, BIAS_, BSTR) do { pg8::Gemm g{(const pb*)(A_), (const pb*)(BT), M, (N_), (K_)}; SCHED_DECL; \
        typedef pg8::EpiB<MODE, (NRM), (QKN_)> EpiT; EpiT E{(pb*)(O_), (LDC), (SPC), (SPS), (const pb*)(I1), (const pb*)(I2), (PS_), (BIAS_), (BSTR), args.in[I_QN], args.in[I_KN], 2 * AW, XL, 0}; \
        pg8::gemm_phase<EpiT, SCHED_T, true, true>(F.lds + RING_OFF, g, S, E); } while (0)
#define GEMM_B(A_, K_, BT, N_, MODE, NRM, QKN_, O_, LDC, SPC, SPS, I1, I2, PS_, BIAS_, BSTR) \
        GEMM_BX(pg8::StaticOrder S; S.init(M, (N_), F.G, (int)blockIdx.x), pg8::StaticOrder, A_, K_, BT, N_, MODE, NRM, QKN_, O_, LDC, SPC, SPS, I1, I2, PS_, BIAS_, BSTR)
#define GEMM_F(XSO, A_, K_, BT, BASE, COEF, SCALE, AVEC_, PS_) do { pg8::Gemm g{(const pb*)(A_), (const pb*)(BT), M, DM, (K_)}; pg8::StaticOrder S; S.init(M, DM, F.G, (int)blockIdx.x); \
        typedef pg8::EpiF<(XSO)> EpiT; EpiT E{(BASE), F.out, (COEF), (pb*)(ws + WS_XS), (AVEC_), (float*)(PS_), XL, (SCALE)}; pg8::gemm_phase<EpiT, pg8::StaticOrder, true, true>(F.lds + RING_OFF, g, S, E); } while (0)

    const bool p0_split = false;
#if FUSE_NORM
    FRESH();
    if (IN(0)) { for (int it = blockIdx.x; it < ADA_ITEMS; it += F.G) p0_adaln_item(F, args, it);
                 if (p0_split && (int)blockIdx.x >= ADA_ITEMS) p0_transposes(F, args, 0, ((int)blockIdx.x - ADA_ITEMS) * NWAVES + F.wave, (256 - ADA_ITEMS) * NWAVES); }
#else
    FRESH();
    if (IN(0)) { for (int it = blockIdx.x; it < ADA_ITEMS; it += F.G) p0_adaln_item(F, args, it); for (int st = 0; st < 3; ++st) p0_transposes(F, args, st, F.vcu * NWAVES + F.wave, F.G * NWAVES); }
#endif
    SEAM(0);
    FRESH();
    if (IN(1)) { norm_pass(F, args.in[I_X], args.in[I_NF1], MOD_SH1, MOD_SC1); if (FUSE_NORM) { aux_avec(F, args); if (!p0_split) p0_transposes(F, args, 0, F.vcu * NWAVES + F.wave, F.G * NWAVES); } }
    SEAM(1);
#ifdef PROBE_XBAR
    xcd_barrier(bar); xcd_barrier(bar); xcd_barrier(bar); xcd_barrier(bar);
#endif
#if defined(NAIVE) && (NAIVE & 1)
    if (IN(2)) { bf16* ACT = (bf16*)(ws + WS_ACT); naive_gemm<true>(F, (const bf16*)XS, DM, args.in[I_F1G], args.in[I_F1U], DFF, M, DFF, DM, [=](int r, int c, float g, float u) { ACT[(size_t)r * DFF + c] = f2b(silu_f(g) * u); }); }
#else
    if (IN(2)) GEMM_B(XS, DM, ws + WS_WGU1, 2 * DFF, pg8::EB_SWIGLU, false, false, ws + WS_ACT, DFF, 0, 0, nullptr, nullptr, nullptr, nullptr, 0);
    FRESH();
    if (FUSE_NORM && IN(2) && F.G == 256 && (int)blockIdx.x >= 128) p0_transposes(F, args, 1, ((int)blockIdx.x - 128) * NWAVES + F.wave, 128 * NWAVES);
    else if (FUSE_NORM && IN(2) && F.G != 256) p0_transposes(F, args, 1, F.vcu * NWAVES + F.wave, F.G * NWAVES);
#endif
    SEAM(2);
#if defined(NAIVE) && (NAIVE & 2)
    if (IN(3)) { const float* xb = args.in[I_X]; float* ob = F.out; naive_gemm<false>(F, (const bf16*)(ws + WS_ACT), DFF, args.in[I_F1D], nullptr, DM, M, DM, DFF, [=](int r, int c, float v, float) { ob[(size_t)r * DM + c] = xb[(size_t)r * DM + c] + 0.5f * mod[(r / SEQ) * NMOD + MOD_GT1 + c] * v; }); }
#else
    FRESH();
    if (FUSE_NORM && IN(3)) aux_bias(F, 0);
    if (IN(3)) GEMM_F(FUSE_NORM, ws + WS_ACT, DFF, ws + WS_WD1, args.in[I_X], mod + MOD_GT1, 0.5f, avec, ws + WS_PS2);
#endif
    SEAM(3);
#if !FUSE_NORM
    if (IN(4)) norm_pass(F, F.out, args.in[I_NMIX], MOD_SH2, MOD_SC2);
    SEAM(4);
#endif
#if defined(NAIVE) && (NAIVE & 4)
    if (IN(5)) { bf16* Qb = (bf16*)(ws + WS_Q); naive_gemm<false>(F, (const bf16*)XS, DM, args.in[I_WIN] + COL_Q, nullptr, INW, M, 3 * AW, DM, [=](int r, int c, float v, float) { const int t = c / AW; Qb[(size_t)t * M * AW + (size_t)r * AW + (c - t * AW)] = f2b(v); }); }
#else
    if (IN(5)) GEMM_B(XS, DM, ws + WS_WIN + (size_t)COL_Q * DM * 2, 3 * AW, pg8::EB_PLAIN, FUSE_NORM, FUSE_NORM, ws + WS_Q, AW, AW, (size_t)(WS_K - WS_Q) / 2, nullptr, nullptr, PS2, bias_in + COL_Q, INW);
    FRESH();
    if (FUSE_NORM && IN(5) && F.G == 256 && (int)blockIdx.x >= 128) p0_transposes(F, args, 2, ((int)blockIdx.x - 128) * NWAVES + F.wave, 128 * NWAVES);
    else if (FUSE_NORM && IN(5) && F.G != 256) p0_transposes(F, args, 2, F.vcu * NWAVES + F.wave, F.G * NWAVES);
#endif
    SEAM(5);
#if !FUSE_NORM
    if (IN(6)) qknorm_pass(F, args);
    SEAM(6);
#endif
#if defined(NAIVE) && (NAIVE & 8)
    if (IN(7)) naive_attn(F);
#else
    if (IN(7)) attn_phase(F, (char*)lds + RING_OFF);
#endif
    SEAM(7);
#if defined(NAIVE) && (NAIVE & 16)
    if (IN(8)) { bf16* Ub = (bf16*)(ws + WS_U); naive_gemm<false>(F, (const bf16*)XS, DM, args.in[I_WIN] + COL_U, nullptr, INW, M, 3 * DM, DM, [=](int r, int c, float v, float) { const int t = c / DM; Ub[(size_t)t * M * DM + (size_t)r * DM + (c - t * DM)] = f2b(v); }); }
#else
    if (IN(8)) GEMM_B(XS, DM, ws + WS_WIN + (size_t)COL_U * DM * 2, 3 * DM, pg8::EB_PLAIN, FUSE_NORM, false, ws + WS_U, DM, DM, (size_t)(WS_B - WS_U) / 2, nullptr, nullptr, PS2, bias_in + COL_U, INW);
#endif
    SEAM(8);
    FRESH();
#if FUSE_RS
    if (IN(9)) { merge_conv_pass2(F, args); aux_bias(F, 1); }
#else
    if (IN(9)) { merge_conv_pass(F, args); if (FUSE_NORM) aux_bias(F, 1); }
#endif
    SEAM(9);
#if FUSE_RS
#define WS_GA_ WS_U
#define WS_GC_ WS_C
#define WS_MG_ WS_B
#else
#define WS_GA_ WS_SGA
#define WS_GC_ WS_SGC
#define WS_MG_ WS_SGA
#endif
    { bf16* SGA = (bf16*)(ws + WS_SGA); bf16* SGC = (bf16*)(ws + WS_SGC); (void)SGA; (void)SGC;
#if defined(NAIVE) && (NAIVE & 32)
      if (IN(10)) naive_gemm<false>(F, (const bf16*)XS, DM, args.in[I_WIN] + COL_GA, nullptr, INW, M, DM, DM, [=](int r, int c, float v, float) { SGA[(size_t)r * DM + c] = f2b(1.0f / (1.0f + __expf(-v))); });
      if (IN(11)) naive_gemm<false>(F, (const bf16*)XS, DM, args.in[I_WIN] + COL_GC, nullptr, INW, M, DM, DM, [=](int r, int c, float v, float) { SGC[(size_t)r * DM + c] = f2b(1.0f / (1.0f + __expf(-v))); });
#else
    if (IN(10)) GEMM_BX(pg8::TwinOrder S; S.init(M, DM, F.G, (int)blockIdx.x); S.reps = 2, pg8::TwinOrder, XS, DM, ws + WS_WIN + (size_t)COL_GA * DM * 2, 2 * DM, pg8::EB_SIGMOID, FUSE_NORM, false,
                        ws + WS_GA_, DM, DM, (size_t)(WS_GC_ - WS_GA_) / 2, nullptr, nullptr, PS2, bias_in + COL_GA, INW);
#endif
#ifdef NAIVE
    if (IN(11) && IN(12)) xcd_barrier(bar);
#endif
#if defined(NAIVE) && (NAIVE & 512)
      if (IN(12)) naive_gemm<false>(F, (const bf16*)(ws + WS_O), 512, args.in[I_WAB], nullptr, DM, M, DM, 512, [=](int r, int c, float v, float) { SGA[(size_t)r * DM + c] = f2b(b2f(SGA[(size_t)r * DM + c]) * v); });
#else
#if FUSE_RS
    if (IN(12)) GEMM_B(ws + WS_Q, 1536, ws + WS_WA, DM, pg8::EB_RSMERGE, false, false, ws + WS_MG_, DM, 0, 0, ws + WS_GA_, ws + WS_GC_, nullptr, nullptr, 0);
#else
    if (IN(12)) GEMM_B(ws + WS_O, 512, ws + WS_WA, DM, pg8::EB_GATEMUL, false, false, ws + WS_SGA, DM, 0, 0, ws + WS_SGA, nullptr, nullptr, nullptr, 0);
#endif
#endif
#ifdef NAIVE
    if (IN(12) && IN(13)) xcd_barrier(bar);
#endif
#if defined(NAIVE) && (NAIVE & 1024)
      if (IN(13)) naive_gemm<false>(F, (const bf16*)(ws + WS_B), DM, args.in[I_WCB], nullptr, DM, M, DM, DM, [=](int r, int c, float v, float) { SGA[(size_t)r * DM + c] = f2b(b2f(SGA[(size_t)r * DM + c]) + b2f(SGC[(size_t)r * DM + c]) * v); });
#else
#if !FUSE_RS
    if (IN(13)) GEMM_B(ws + WS_B, DM, ws + WS_WC, DM, pg8::EB_MERGE, false, false, ws + WS_SGA, DM, 0, 0, ws + WS_SGA, ws + WS_SGC, nullptr, nullptr, 0);
#endif
#endif
    }
    SEAM(13);
#if defined(NAIVE) && (NAIVE & 64)
    if (IN(14)) { float* ob = F.out; naive_gemm<false>(F, (const bf16*)(ws + WS_SGA), DM, args.in[I_WOUT], nullptr, DM, M, DM, DM, [=](int r, int c, float v, float) { ob[(size_t)r * DM + c] += mod[(r / SEQ) * NMOD + MOD_GT2 + c] * v; }); }
#else
    if (IN(14)) GEMM_F(FUSE_NORM, ws + WS_MG_, DM, ws + WS_WO, F.out, mod + MOD_GT2, 1.0f, avec + 2 * DM, ws + WS_PS3);
#endif
    SEAM(14);
#if !FUSE_NORM
    if (IN(15)) norm_pass(F, F.out, args.in[I_NF2], MOD_SH3, MOD_SC3);
    SEAM(15);
#endif
#if defined(NAIVE) && (NAIVE & 128)
    if (IN(16)) { bf16* ACT = (bf16*)(ws + WS_ACT); naive_gemm<true>(F, (const bf16*)XS, DM, args.in[I_F2G], args.in[I_F2U], DFF, M, DFF, DM, [=](int r, int c, float g, float u) { ACT[(size_t)r * DFF + c] = f2b(silu_f(g) * u); }); }
#else
    if (IN(16)) GEMM_B(XS, DM, ws + WS_WGU2, 2 * DFF, pg8::EB_SWIGLU, FUSE_NORM, false, ws + WS_ACT, DFF, 0, 0, nullptr, nullptr, PS3, bias_f2, 2 * DFF);
#endif
    SEAM(16);
#if defined(NAIVE) && (NAIVE & 256)
    if (IN(17)) { float* ob = F.out; naive_gemm<false>(F, (const bf16*)(ws + WS_ACT), DFF, args.in[I_F2D], nullptr, DM, M, DM, DFF, [=](int r, int c, float v, float) { ob[(size_t)r * DM + c] += 0.5f * mod[(r / SEQ) * NMOD + MOD_GT3 + c] * v; }); }
#else
    if (IN(17)) GEMM_F(false, ws + WS_ACT, DFF, ws + WS_WD2, F.out, mod + MOD_GT3, 0.5f, nullptr, nullptr);
#endif
#ifdef PROBE_TA
    if (PROBE_TB == 17) TSTAMP(1);
    xcd_barrier(bar);
    if (blockIdx.x == 0 && F.tid == 0) { const unsigned long long t0_ = ((unsigned long long)F.MISC[17] << 32) | F.MISC[16], t1_ = ((unsigned long long)F.MISC[19] << 32) | F.MISC[18];
#ifdef PROBE_CONST
        F.out[0] += (float)(PROBE_CONST); (void)t0_; (void)t1_; }
#else
        F.out[0] += (float)(PROBE_SCALE) * 0.01f * (float)(t1_ - t0_); }
#endif
#endif
#undef IN
#undef SEAM
#undef XL
#undef PS2
#undef PS3
#undef bias_in
#undef bias_f2
#undef avec
#undef mod
#undef XS
}

extern "C" void kernel_launch(void* const* d_in, const int* in_sizes, int n_in, void* d_out, int out_size, void* d_ws, size_t ws_size, hipStream_t stream) {
    static int grid = 0;
    if (grid == 0) {
        if (n_in != 20 || in_sizes[0] != M * DM || out_size != M * DM || ws_size < WS_END) { fprintf(stderr, "kernel_launch: shape/workspace mismatch (n_in %d, in0 %d, out %d, ws %zu < %zu)\n", n_in, n_in > 0 ? in_sizes[0] : -1, out_size, ws_size, (size_t)WS_END); grid = -1; return; }
        int dev = 0, cus = 0, per_cu = 0;
        if (hipGetDevice(&dev) != hipSuccess || hipDeviceGetAttribute(&cus, hipDeviceAttributeMultiprocessorCount, dev) != hipSuccess) { grid = -1; return; }
        if (hipFuncSetAttribute((const void*)mega_fwd, hipFuncAttributeMaxDynamicSharedMemorySize, LDS_BYTES) != hipSuccess) { fprintf(stderr, "kernel_launch: hipFuncSetAttribute failed\n"); grid = -1; return; }
        if (hipOccupancyMaxActiveBlocksPerMultiprocessor(&per_cu, (const void*)mega_fwd, NWAVES * 64, LDS_BYTES) != hipSuccess || per_cu < 1) { fprintf(stderr, "kernel_launch: occupancy query reports %d workgroups per CU\n", per_cu); }
        (void)hipGetLastError();
        grid = cus;
    }
    if (grid < 0) return;
    (void)hipMemsetAsync((char*)d_ws + WS_CTL, 0, CTL_ZERO_BYTES, stream);
#ifdef PROBE_MEMSET2
    (void)hipMemsetAsync((char*)d_ws + WS_CTL + CTL_ZERO_BYTES, 0, CTL_ZERO_BYTES, stream);
#endif
    Args a{};
    for (int i = 0; i < 20; ++i) a.in[i] = (const float*)d_in[i];
    a.out = (float*)d_out; a.ws = (unsigned char*)d_ws;
#if defined(PROBE_DUP)
    a.ph_lo = 0; a.ph_hi = PROBE_DUP + 1; hipLaunchKernelGGL(mega_fwd, dim3(grid), dim3(NWAVES * 64), LDS_BYTES, stream, a);
    (void)hipMemsetAsync((char*)d_ws + WS_CTL, 0, CTL_ZERO_BYTES, stream);
    a.ph_lo = PROBE_DUP; a.ph_hi = N_PHASES + 1; hipLaunchKernelGGL(mega_fwd, dim3(grid), dim3(NWAVES * 64), LDS_BYTES, stream, a);
#elif defined(PROBE_RLO)
    a.ph_lo = 0; a.ph_hi = PROBE_RHI + 1; hipLaunchKernelGGL(mega_fwd, dim3(grid), dim3(NWAVES * 64), LDS_BYTES, stream, a);
    (void)hipMemsetAsync((char*)d_ws + WS_CTL, 0, CTL_ZERO_BYTES, stream);
    a.ph_lo = PROBE_RLO; a.ph_hi = N_PHASES + 1; hipLaunchKernelGGL(mega_fwd, dim3(grid), dim3(NWAVES * 64), LDS_BYTES, stream, a);
#elif defined(PROBE_SPLIT)
    a.ph_lo = 0; a.ph_hi = PROBE_SPLIT + 1; hipLaunchKernelGGL(mega_fwd, dim3(grid), dim3(NWAVES * 64), LDS_BYTES, stream, a);
    (void)hipMemsetAsync((char*)d_ws + WS_CTL, 0, CTL_ZERO_BYTES, stream);
    a.ph_lo = PROBE_SPLIT + 1; a.ph_hi = N_PHASES + 1; hipLaunchKernelGGL(mega_fwd, dim3(grid), dim3(NWAVES * 64), LDS_BYTES, stream, a);
#elif !defined(MK_PER_PHASE)
    a.ph_lo = 0; a.ph_hi = N_PHASES + 1;
    hipLaunchKernelGGL(mega_fwd, dim3(grid), dim3(NWAVES * 64), LDS_BYTES, stream, a);
#else
    for (int p = 0; p <= N_PHASES; ++p) { a.ph_lo = p; a.ph_hi = p + 1; hipLaunchKernelGGL(mega_fwd, dim3(grid), dim3(NWAVES * 64), LDS_BYTES, stream, a); }
#endif
}
```

```cpp
#include <hip/hip_runtime.h>
#include <hip/hip_bf16.h>
#include <cstdio>
#include <cstdint>
#include <type_traits>

constexpr int DM = 1024, BATCH = 2, SEQ = 8192, M = BATCH * SEQ;
constexpr int DFF = 2816, NMOD = 9 * DM;
constexpr int AW = 1536;
constexpr int INW = 9728;
constexpr int COL_Q = 0, COL_K = 1536, COL_V = 3072, COL_U = 4608, COL_B = 5632, COL_C = 6656, COL_GA = 7680, COL_GC = 8704;
constexpr float EPS = 1e-6f;

__device__ __forceinline__ int tid_opaque() { int t = (int)threadIdx.x; asm volatile("" : "+v"(t)); return t; }

namespace pg8 {
#define PG8_LAS __attribute__((address_space(3)))
typedef unsigned short bf16_t;
typedef short bf16x8 __attribute__((ext_vector_type(8)));
typedef float f32x4 __attribute__((ext_vector_type(4)));
typedef unsigned u32x4 __attribute__((ext_vector_type(4)));
typedef int i32x4 __attribute__((ext_vector_type(4)));
template <bool I8> __device__ __forceinline__ auto pg8_mma(bf16x8 b, bf16x8 a, typename std::conditional<I8, i32x4, f32x4>::type c) {
    if constexpr (I8) return __builtin_amdgcn_mfma_i32_16x16x64_i8(__builtin_bit_cast(i32x4, b), __builtin_bit_cast(i32x4, a), c, 0, 0, 0);
    else return __builtin_amdgcn_mfma_f32_16x16x32_bf16(b, a, c, 0, 0, 0);
}
constexpr int BM = 256, BK = 64, HALF = 128, HTB = HALF * BK * 2  , STAGE_BYTES = 8 * HTB, NXCD = 8, WGM = 8;

__host__ __device__ __forceinline__ int lds_byte(int r, int c) { const int st = (r >> 4) * 2 + (c >> 5), rr = r & 15, cc = c & 31, ob = rr * 64 + cc * 2; return st * 1024 + (ob ^ (((ob >> 9) & 1) << 5)); }
__host__ __device__ __forceinline__ void stage_rc(int b, int& R, int& C) { const int st = b / 1024, sb = b % 1024, swz = sb ^ (((sb >> 9) & 1) << 5); R = (st >> 1) * 16 + swz / 64; C = (st & 1) * 32 + (swz % 64) / 2; }
__host__ __device__ __forceinline__ int perm32(int rho) { const int n = rho >> 4, i = rho & 15; return 8 * (i >> 2) + 4 * n + (i & 3); }

struct Unit { int pm, pn; };
struct Gemm { const bf16_t* A; const bf16_t* Bt; int M, N, K; };

struct StaticOrder {
    int nM, nN, nwg, G, c;
    __host__ __device__ void init(int M, int N, int G_, int c_) { nM = M / BM; nN = N / BM; nwg = nM * nN; G = G_; c = c_; }
    __host__ __device__ bool next(int i, Unit& u) const {
        const long L = (long)i * G + c; if (L >= nwg) return false;
        int wgid = (int)L; { const int q = nwg / NXCD, r = nwg % NXCD, xcd = wgid % NXCD, off = wgid / NXCD; wgid = (xcd < r ? xcd * (q + 1) : r * (q + 1) + (xcd - r) * q) + off; }
        const int nig = WGM * nN, gid = wgid / nig, fm = gid * WGM, gsz = (nM - fm) < WGM ? (nM - fm) : WGM;
        u.pm = fm + ((wgid % nig) % gsz); u.pn = (wgid % nig) / gsz; return true;
    }
    __device__ __forceinline__ void a_ready(const Unit&) const {}
    __device__ __forceinline__ void done(const Unit&) const {}
};

typedef float f32x2_t __attribute__((ext_vector_type(2))); typedef __bf16 bf16x2_t __attribute__((ext_vector_type(2)));
__device__ __forceinline__ unsigned cvt_pk_bf16(float lo, float hi) { f32x2_t v = {lo, hi}; bf16x2_t b = __builtin_convertvector(v, bf16x2_t); return __builtin_bit_cast(unsigned, b); }
__device__ __forceinline__ float bf_lo(unsigned w) { return __uint_as_float(w << 16); }
__device__ __forceinline__ float bf_hi(unsigned w) { return __uint_as_float(w & 0xffff0000u); }
__device__ __forceinline__ float sigmoidf_(float x) { return __builtin_amdgcn_rcpf(1.0f + __builtin_amdgcn_exp2f(-1.4426950408889634f * x)); }
__device__ __forceinline__ void unpack8(const u32x4 w, f32x4& a, f32x4& b) { a = (f32x4){bf_lo(w.x), bf_hi(w.x), bf_lo(w.y), bf_hi(w.y)}; b = (f32x4){bf_lo(w.z), bf_hi(w.z), bf_lo(w.w), bf_hi(w.w)}; }
__device__ __forceinline__ u32x4 pack8(const f32x4 a, const f32x4 b) { u32x4 w; w.x = cvt_pk_bf16(a[0], a[1]); w.y = cvt_pk_bf16(a[2], a[3]); w.z = cvt_pk_bf16(b[0], b[1]); w.w = cvt_pk_bf16(b[2], b[3]); return w; }

enum { EB_PLAIN = 0, EB_SWIGLU = 1, EB_SIGMOID = 2, EB_GATEMUL = 3, EB_MERGE = 4 };
template <int mode, bool NORMED = false, bool QKN = false> struct EpiB {
    static constexpr bool PERM = true, AFTER_DRAIN = false, PREFETCH = NORMED, I8 = false; typedef f32x4 acc_t;
    bf16_t* O; int ldc; int split_cols; size_t split_stride; const bf16_t* In1; const bf16_t* In2;
    const float* PS; const float* bias; int bias_bstride; const float* gamma_q; const float* gamma_k; int qk_cols; PG8_LAS float* XL; int par;
    __device__ __forceinline__ void prefetch(const Unit& u, int wid, int buf) const {
        if (NORMED && wid < 4) { const int lane = threadIdx.x & 63; PG8_LAS unsigned char* X2 = (PG8_LAS unsigned char*)(XL + 2048) + buf * 5120;
            __builtin_amdgcn_global_load_lds((const unsigned*)(PS + (size_t)(u.pm * BM + wid * 64 + lane) * 4), (PG8_LAS unsigned*)(X2 + wid * 1024), 16, 0, 0);
            if (wid == 0) __builtin_amdgcn_global_load_lds((const unsigned*)(bias + (size_t)((u.pm * BM) / SEQ) * bias_bstride + u.pn * BM + lane * 4), (PG8_LAS unsigned*)(X2 + 4096), 16, 0, 0); }
    }
    __device__ __forceinline__ void operator()(f32x4 (&acc)[2][2][4][2], const Unit& u, int wr, int wc, int fr, int fq) const {
        const int row0 = u.pm * BM + wr * 64 + fr;
        if (NORMED) {
            const PG8_LAS float* X2 = XL + 2048 + par * 1280;
            f32x4 bv[2][2];
#pragma unroll
            for (int bj = 0; bj < 2; ++bj)
#pragma unroll
                for (int n = 0; n < 2; ++n) bv[bj][n] = *(const PG8_LAS f32x4*)(X2 + 1024 + bj * HALF + wc * 32 + 8 * fq + 4 * n);
#pragma unroll
            for (int ai = 0; ai < 2; ++ai)
#pragma unroll
                for (int m = 0; m < 4; ++m) { const f32x4 p = *(const PG8_LAS f32x4*)(X2 + (ai * HALF + wr * 64 + m * 16 + fr) * 4);
                    const float rstd = __builtin_amdgcn_rsqf(((p[0] + p[1]) + (p[2] + p[3])) * (1.0f / 1024.0f) + 1e-6f);
#pragma unroll
                    for (int bj = 0; bj < 2; ++bj)
#pragma unroll
                        for (int n = 0; n < 2; ++n) acc[ai][bj][m][n] = acc[ai][bj][m][n] * rstd + bv[bj][n]; }
        }
        if (mode == EB_SWIGLU) {
            const int col0 = u.pn * HALF + wc * 32 + 8 * fq;
#pragma unroll
            for (int ai = 0; ai < 2; ++ai)
#pragma unroll
                for (int m = 0; m < 4; ++m) { bf16_t* rowp = O + (size_t)(row0 + ai * HALF + m * 16) * ldc + col0;
                    f32x4 v0, v1;
#pragma unroll
                    for (int i = 0; i < 4; ++i) { const float g0 = acc[ai][0][m][0][i], g1 = acc[ai][0][m][1][i];
                        v0[i] = g0 * sigmoidf_(g0) * acc[ai][1][m][0][i]; v1[i] = g1 * sigmoidf_(g1) * acc[ai][1][m][1][i]; }
                    *(u32x4*)rowp = pack8(v0, v1); }
            return;
        }
        int colt = u.pn * BM; size_t boff = 0;
        if (QKN && colt < qk_cols) {
            PG8_LAS float* P = XL;
#pragma unroll
            for (int ai = 0; ai < 2; ++ai)
#pragma unroll
                for (int m = 0; m < 4; ++m)
#pragma unroll
                    for (int bj = 0; bj < 2; ++bj) { const f32x4 a = acc[ai][bj][m][0], b = acc[ai][bj][m][1];
                        float s = ((a[0] * a[0] + a[1] * a[1]) + (a[2] * a[2] + a[3] * a[3])) + ((b[0] * b[0] + b[1] * b[1]) + (b[2] * b[2] + b[3] * b[3]));
                        s += __shfl_xor(s, 16); s += __shfl_xor(s, 32);
                        if (fq == 0) P[((ai * HALF + wr * 64 + m * 16 + fr) * 2 + bj) * 4 + wc] = s; }
            asm volatile("s_waitcnt lgkmcnt(0)" ::: "memory"); __builtin_amdgcn_s_barrier(); asm volatile("" ::: "memory");
            const float* gm = (colt < (qk_cols >> 1) ? gamma_q : gamma_k) + wc * 32 + 8 * fq;
            const f32x4 g0 = *(const f32x4*)gm, g1 = *(const f32x4*)(gm + 4);
#pragma unroll
            for (int ai = 0; ai < 2; ++ai)
#pragma unroll
                for (int m = 0; m < 4; ++m)
#pragma unroll
                    for (int bj = 0; bj < 2; ++bj) { const f32x4 p = *(const PG8_LAS f32x4*)(P + ((ai * HALF + wr * 64 + m * 16 + fr) * 2 + bj) * 4);
                        const float r = __builtin_amdgcn_rsqf(((p[0] + p[1]) + (p[2] + p[3])) * (1.0f / 128.0f) + 1e-6f);
                        acc[ai][bj][m][0] = acc[ai][bj][m][0] * r * g0; acc[ai][bj][m][1] = acc[ai][bj][m][1] * r * g1; }
        }
        if (split_cols) { const int t = colt / split_cols; boff = (size_t)t * split_stride; colt -= t * split_cols; }
        const int col0 = colt + wc * 32 + 8 * fq;
#pragma unroll
        for (int ai = 0; ai < 2; ++ai)
#pragma unroll
            for (int m = 0; m < 4; ++m) { const size_t roff = boff + (size_t)(row0 + ai * HALF + m * 16) * ldc + col0;
#pragma unroll
                for (int bj = 0; bj < 2; ++bj) { const size_t off = roff + bj * HALF; f32x4 v0 = acc[ai][bj][m][0], v1 = acc[ai][bj][m][1];
                    if (mode == EB_SIGMOID) {
#pragma unroll
                        for (int i = 0; i < 4; ++i) { v0[i] = sigmoidf_(v0[i]); v1[i] = sigmoidf_(v1[i]); }
                    } else if (mode == EB_GATEMUL) { f32x4 a0, a1; unpack8(*(const u32x4*)(In1 + off), a0, a1); v0 = v0 * a0; v1 = v1 * a1; }
                    else if (mode == EB_MERGE) { f32x4 a0, a1, g0, g1; unpack8(*(const u32x4*)(In1 + off), a0, a1); unpack8(*(const u32x4*)(In2 + off), g0, g1); v0 = a0 + g0 * v0; v1 = a1 + g1 * v1; }
                    *(u32x4*)(O + off) = pack8(v0, v1); } }
    }
};
template <bool HASBIAS> struct EpiI8 {
    static constexpr bool PERM = true, AFTER_DRAIN = false, PREFETCH = true, I8 = true; typedef i32x4 acc_t;
    bf16_t* O; int ldc; const float* rowf; const float* sw; const float* bias; int bias_bstride; PG8_LAS float* XL; int par;
    __device__ __forceinline__ void prefetch(const Unit& u, int wid, int buf) const {
        if (wid < 3) { const int lane = threadIdx.x & 63; PG8_LAS unsigned char* X2 = (PG8_LAS unsigned char*)(XL + 2048) + buf * 5120;
            if (wid == 0) __builtin_amdgcn_global_load_lds((const unsigned*)(rowf + (size_t)u.pm * BM + lane * 4), (PG8_LAS unsigned*)(X2), 16, 0, 0);
            else if (wid == 1) __builtin_amdgcn_global_load_lds((const unsigned*)(sw + (size_t)u.pn * BM + lane * 4), (PG8_LAS unsigned*)(X2 + 1024), 16, 0, 0);
            else if (HASBIAS) __builtin_amdgcn_global_load_lds((const unsigned*)(bias + (size_t)((u.pm * BM) / SEQ) * bias_bstride + u.pn * BM + lane * 4), (PG8_LAS unsigned*)(X2 + 2048), 16, 0, 0); }
    }
    __device__ __forceinline__ void operator()(acc_t (&acc)[2][2][4][2], const Unit& u, int wr, int wc, int fr, int fq) const {
        const int row0 = u.pm * BM + wr * 64 + fr, col0 = u.pn * HALF + wc * 32 + 8 * fq;
        const PG8_LAS float* X2 = XL + 2048 + par * 1280;
        f32x4 sv[2][2], bv[2][2];
#pragma unroll
        for (int bj = 0; bj < 2; ++bj)
#pragma unroll
            for (int n = 0; n < 2; ++n) { sv[bj][n] = *(const PG8_LAS f32x4*)(X2 + 256 + bj * HALF + wc * 32 + 8 * fq + 4 * n);
                bv[bj][n] = HASBIAS ? *(const PG8_LAS f32x4*)(X2 + 512 + bj * HALF + wc * 32 + 8 * fq + 4 * n) : (f32x4){0.f, 0.f, 0.f, 0.f}; }
#pragma unroll
        for (int ai = 0; ai < 2; ++ai)
#pragma unroll
            for (int m = 0; m < 4; ++m) { const float rf = X2[ai * HALF + wr * 64 + m * 16 + fr]; bf16_t* rowp = O + (size_t)(row0 + ai * HALF + m * 16) * ldc + col0;
                f32x4 v0, v1;
#pragma unroll
                for (int i = 0; i < 4; ++i) {
                    const float g0 = (float)acc[ai][0][m][0][i] * rf * sv[0][0][i] + bv[0][0][i], g1 = (float)acc[ai][0][m][1][i] * rf * sv[0][1][i] + bv[0][1][i];
                    const float u0 = (float)acc[ai][1][m][0][i] * rf * sv[1][0][i] + bv[1][0][i], u1 = (float)acc[ai][1][m][1][i] * rf * sv[1][1][i] + bv[1][1][i];
                    v0[i] = g0 * sigmoidf_(g0) * u0; v1[i] = g1 * sigmoidf_(g1) * u1; }
                *(u32x4*)rowp = pack8(v0, v1); }
    }
};
template <bool XSOUT = false> struct EpiF {
    static constexpr bool I8 = false; typedef f32x4 acc_t;
    static constexpr bool PERM = true, AFTER_DRAIN = false, PREFETCH = false;
    const float* base; float* out; const float* coef; bf16_t* XS; const float* avec; float* PS; PG8_LAS float* XL; float scale;
    __device__ __forceinline__ void operator()(f32x4 (&acc)[2][2][4][2], const Unit& u, int wr, int wc, int fr, int fq) const {
        const int row0 = u.pm * BM + wr * 64 + fr, col0 = u.pn * BM + wc * 32 + 8 * fq, bt = (u.pm * BM) / SEQ;
        const float* cf = coef + (size_t)bt * NMOD + col0;
        f32x4 cv[2][2], av[2][2];
#pragma unroll
        for (int bj = 0; bj < 2; ++bj)
#pragma unroll
            for (int n = 0; n < 2; ++n) { cv[bj][n] = *(const f32x4*)(cf + bj * HALF + n * 4) * scale; if (XSOUT) av[bj][n] = *(const f32x4*)(avec + bt * DM + col0 + bj * HALF + n * 4); }
        PG8_LAS float* P = XL;
        f32x4 pre[2][2][2];
#define EPIF_LOAD(slot, q) do { const size_t off_ = (size_t)(row0 + ((q) >> 2) * HALF + ((q) & 3) * 16) * DM + col0; \
            _Pragma("unroll") for (int bj = 0; bj < 2; ++bj) _Pragma("unroll") for (int n = 0; n < 2; ++n) pre[slot][bj][n] = *(const f32x4*)(base + off_ + bj * HALF + n * 4); } while (0)
#define EPIF_DO(slot, q) do { const int ai = (q) >> 2, m = (q) & 3; const size_t off = (size_t)(row0 + ai * HALF + m * 16) * DM + col0; float ss = 0.f; \
            _Pragma("unroll") for (int bj = 0; bj < 2; ++bj) { const f32x4 o0 = pre[slot][bj][0] + cv[bj][0] * acc[ai][bj][m][0], o1 = pre[slot][bj][1] + cv[bj][1] * acc[ai][bj][m][1]; \
                *(f32x4*)(out + off + bj * HALF) = o0; *(f32x4*)(out + off + bj * HALF + 4) = o1; \
                if (XSOUT) { ss += ((o0[0] * o0[0] + o0[1] * o0[1]) + (o0[2] * o0[2] + o0[3] * o0[3])) + ((o1[0] * o1[0] + o1[1] * o1[1]) + (o1[2] * o1[2] + o1[3] * o1[3])); \
                    *(u32x4*)(XS + off + bj * HALF) = pack8(o0 * av[bj][0], o1 * av[bj][1]); } } \
            if (XSOUT) { ss += __shfl_xor(ss, 16); ss += __shfl_xor(ss, 32); if (fq == 0) P[(ai * HALF + wr * 64 + m * 16 + fr) * 4 + wc] = ss; } } while (0)
        EPIF_LOAD(0, 0); EPIF_LOAD(1, 1);
        EPIF_DO(0, 0); EPIF_LOAD(0, 2); EPIF_DO(1, 1); EPIF_LOAD(1, 3); EPIF_DO(0, 2); EPIF_LOAD(0, 4); EPIF_DO(1, 3); EPIF_LOAD(1, 5);
        EPIF_DO(0, 4); EPIF_LOAD(0, 6); EPIF_DO(1, 5); EPIF_LOAD(1, 7); EPIF_DO(0, 6); EPIF_DO(1, 7);
#undef EPIF_LOAD
#undef EPIF_DO
        if (XSOUT) {
            asm volatile("s_waitcnt lgkmcnt(0)" ::: "memory"); __builtin_amdgcn_s_barrier(); asm volatile("" ::: "memory");
            const int tid = threadIdx.x;
            if (tid < BM) { const f32x4 p = *(const PG8_LAS f32x4*)(P + tid * 4); PS[(size_t)(u.pm * BM + tid) * 4 + u.pn] = (p[0] + p[1]) + (p[2] + p[3]); }
        }
    }
};

struct TwinOrder : StaticOrder {
    int reps;
    __device__ bool next(int i, Unit& u) const { if (i >= reps) return false; if (!StaticOrder::next(0, u)) return false; u.pn += 4 * i; return true; }
};
template <class Epi, class Sched, bool ALIGN_EPI = false, bool SP2 = false>
__device__ __forceinline__ void gemm_phase(PG8_LAS unsigned char* lds, const Gemm g, const Sched& S, Epi E) {
    const int tid = tid_opaque(), wid = __builtin_amdgcn_readfirstlane(tid >> 6), lane = tid & 63, wr = wid >> 2, wc = wid & 3, fr = lane & 15, fq = lane >> 4;
    const int K = g.K, nt = K / BK;
    unsigned voffA[2], voffB[2];
#pragma unroll
    for (int i = 0; i < 2; ++i) { int R, C; stage_rc(tid * 16 + i * 8192, R, C); const int Rb = Epi::PERM ? ((R & ~31) + perm32(R & 31)) : R;
        voffA[i] = (unsigned)(R * K + C) * 2u; voffB[i] = (unsigned)(Rb * K + C) * 2u; }
    const size_t kstep = (size_t)(BK * 2);
    const size_t hstep = (size_t)HALF * K * 2;
    const size_t tstep = 2 * hstep;
    const unsigned ldsw = (unsigned)wid * 1024u;
    const int aoff = lds_byte(wr * 64 + fr, fq * 8), boff = lds_byte(wc * 32 + fr, fq * 8);
#define PG8_SA(b, h) (((b) * 2 + (h)) * HTB)
#define PG8_SB(b, h) ((4 + (b) * 2 + (h)) * HTB)
#define PG8_STAGE(bufoff, gbase, voff) do { _Pragma("unroll") for (int _i = 0; _i < 2; ++_i) \
        __builtin_amdgcn_global_load_lds((const unsigned*)((const char*)(gbase) + (voff)[_i]), (PG8_LAS unsigned*)(lds + (bufoff) + ldsw + _i * 8192), 16, 0, 0); } while (0)
#define PG8_LDA(dst, b, h) do { _Pragma("unroll") for (int m = 0; m < 4; ++m) _Pragma("unroll") for (int k = 0; k < 2; ++k) dst[m][k] = *(const PG8_LAS bf16x8*)(lds + PG8_SA(b, h) + aoff + m * 2048 + k * 1024); } while (0)
#define PG8_LDB(dst, b, h) do { _Pragma("unroll") for (int n = 0; n < 2; ++n) _Pragma("unroll") for (int k = 0; k < 2; ++k) dst[n][k] = *(const PG8_LAS bf16x8*)(lds + PG8_SB(b, h) + boff + n * 2048 + k * 1024); } while (0)
#define PG8_MMA(ai, bj, At, Bt) do { __builtin_amdgcn_s_setprio(1); _Pragma("unroll") for (int m = 0; m < 4; ++m) _Pragma("unroll") for (int n = 0; n < 2; ++n) _Pragma("unroll") for (int k = 0; k < 2; ++k) \
        acc[ai][bj][m][n] = pg8_mma<Epi::I8>(Bt[n][k], At[m][k], acc[ai][bj][m][n]); __builtin_amdgcn_s_setprio(0); } while (0)
#define PG8_WAIT_V(n) asm volatile("s_waitcnt vmcnt(" #n ")" ::: "memory")
#define PG8_WAIT_L(n) asm volatile("s_waitcnt lgkmcnt(" #n ")" ::: "memory")
#define PG8_BAR __builtin_amdgcn_s_barrier()
#define PG8_SCHED __builtin_amdgcn_sched_barrier(0)
    Unit cur, nxt; int ui = 0;
    if (!S.next(0, cur)) return;
    typedef typename Epi::acc_t acc_t;
    acc_t acc[2][2][4][2];
#pragma unroll
    for (int a = 0; a < 2; ++a)
#pragma unroll
        for (int b = 0; b < 2; ++b)
#pragma unroll
            for (int m = 0; m < 4; ++m)
#pragma unroll
                for (int n = 0; n < 2; ++n) acc[a][b][m][n] = acc_t{};
    bf16x8 At[4][2], B0[2][2], B1[2][2];
    const char* cA = (const char*)g.A + (size_t)cur.pm * tstep; const char* cB = (const char*)g.Bt + (size_t)cur.pn * tstep;
    S.a_ready(cur);
    if constexpr (Epi::PREFETCH) E.prefetch(cur, wid, 0);
    if constexpr (SP2) {
        PG8_STAGE(PG8_SB(0, 0), cB, voffB); PG8_STAGE(PG8_SB(0, 1), cB + hstep, voffB); PG8_STAGE(PG8_SA(0, 0), cA, voffA); PG8_STAGE(PG8_SA(0, 1), cA + hstep, voffA);
        if (wr == 1) PG8_BAR;
        PG8_WAIT_V(2); PG8_BAR;
        PG8_STAGE(PG8_SB(1, 0), cB + kstep, voffB); PG8_STAGE(PG8_SA(1, 0), cA + kstep, voffA); PG8_STAGE(PG8_SB(1, 1), cB + hstep + kstep, voffB);
        PG8_WAIT_V(6); PG8_BAR;
    } else {
        PG8_STAGE(PG8_SB(0, 0), cB, voffB); PG8_STAGE(PG8_SA(0, 0), cA, voffA); PG8_STAGE(PG8_SB(0, 1), cB + hstep, voffB); PG8_STAGE(PG8_SA(0, 1), cA + hstep, voffA);
        if (wr == 1) PG8_BAR;
        PG8_WAIT_V(4); PG8_BAR;
        PG8_STAGE(PG8_SB(1, 0), cB + kstep, voffB); PG8_STAGE(PG8_SA(1, 0), cA + kstep, voffA); PG8_STAGE(PG8_SB(1, 1), cB + hstep + kstep, voffB);
        PG8_WAIT_V(6); PG8_BAR;
    }
    for (;;) {
        const bool has_next = S.next(ui + 1, nxt);
        const char* nA = has_next ? (const char*)g.A + (size_t)nxt.pm * tstep : cA; const char* nB = has_next ? (const char*)g.Bt + (size_t)nxt.pn * tstep : cB;
        for (int t = 0; t < nt; t += 2) {
            const bool last = (t == nt - 2);
            const char* a1 = cA + (size_t)(t + 1) * kstep;
            const char* a2 = last ? nA : cA + (size_t)(t + 2) * kstep; const char* b2 = last ? nB : cB + (size_t)(t + 2) * kstep;
            const char* a3 = a2 + kstep; const char* b3 = b2 + kstep;
            if (last && has_next) S.a_ready(nxt);
            if constexpr (SP2) {
            PG8_LDB(B0, 0, 0); PG8_LDB(B1, 0, 1); PG8_SCHED; PG8_LDA(At, 0, 0); PG8_STAGE(PG8_SA(1, 1), a1 + hstep, voffA);
            PG8_WAIT_V(8); PG8_WAIT_L(0); PG8_BAR; PG8_MMA(0, 0, At, B0); PG8_MMA(0, 1, At, B1); PG8_BAR; PG8_SCHED;
            PG8_LDA(At, 0, 1); PG8_STAGE(PG8_SB(0, 0), b2, voffB); PG8_STAGE(PG8_SB(0, 1), b2 + hstep, voffB); PG8_STAGE(PG8_SA(0, 0), a2, voffA);
            PG8_WAIT_V(8); PG8_WAIT_L(0); PG8_BAR; PG8_MMA(1, 0, At, B0); PG8_MMA(1, 1, At, B1); PG8_BAR; PG8_SCHED;
            PG8_LDB(B0, 1, 0); PG8_LDB(B1, 1, 1); PG8_SCHED; PG8_LDA(At, 1, 0); PG8_STAGE(PG8_SA(0, 1), a2 + hstep, voffA);
            PG8_WAIT_V(8); PG8_WAIT_L(0); PG8_BAR; PG8_MMA(0, 0, At, B0); PG8_MMA(0, 1, At, B1); PG8_BAR; PG8_SCHED;
            PG8_LDA(At, 1, 1); PG8_STAGE(PG8_SB(1, 0), b3, voffB); PG8_STAGE(PG8_SB(1, 1), b3 + hstep, voffB); PG8_STAGE(PG8_SA(1, 0), a3, voffA);
            PG8_WAIT_V(8); PG8_WAIT_L(0); PG8_BAR; PG8_MMA(1, 0, At, B0); PG8_MMA(1, 1, At, B1); PG8_BAR; PG8_SCHED;
            } else {
            PG8_LDB(B0, 0, 0); PG8_SCHED; PG8_LDA(At, 0, 0); PG8_STAGE(PG8_SA(1, 1), a1 + hstep, voffA);
            PG8_WAIT_L(8); PG8_BAR; PG8_WAIT_L(0); PG8_MMA(0, 0, At, B0); PG8_BAR; PG8_SCHED;
            PG8_LDB(B1, 0, 1); PG8_STAGE(PG8_SB(0, 0), b2, voffB);
            PG8_BAR; PG8_WAIT_L(0); PG8_MMA(0, 1, At, B1); PG8_BAR;
            PG8_LDA(At, 0, 1); PG8_STAGE(PG8_SA(0, 0), a2, voffA);
            PG8_BAR; PG8_WAIT_L(0); PG8_MMA(1, 0, At, B0); PG8_BAR; PG8_SCHED;
            PG8_STAGE(PG8_SB(0, 1), b2 + hstep, voffB);
            PG8_WAIT_V(6); PG8_BAR; PG8_MMA(1, 1, At, B1); PG8_BAR;
            PG8_LDB(B0, 1, 0); PG8_SCHED; PG8_LDA(At, 1, 0); PG8_STAGE(PG8_SA(0, 1), a2 + hstep, voffA);
            PG8_WAIT_L(8); PG8_BAR; PG8_WAIT_L(0); PG8_MMA(0, 0, At, B0); PG8_BAR; PG8_SCHED;
            PG8_LDB(B1, 1, 1); PG8_STAGE(PG8_SB(1, 0), b3, voffB);
            PG8_BAR; PG8_WAIT_L(0); PG8_MMA(0, 1, At, B1); PG8_BAR;
            PG8_LDA(At, 1, 1); PG8_STAGE(PG8_SA(1, 0), a3, voffA);
            PG8_BAR; PG8_WAIT_L(0); PG8_MMA(1, 0, At, B0); PG8_BAR; PG8_SCHED;
            PG8_STAGE(PG8_SB(1, 1), b3 + hstep, voffB);
            PG8_WAIT_V(6); PG8_BAR; PG8_MMA(1, 1, At, B1); PG8_BAR;
            }
        }
        if constexpr (ALIGN_EPI) { if (wr == 0) PG8_BAR; }
        if constexpr (!Epi::AFTER_DRAIN) { if constexpr (Epi::PREFETCH) { E.par = ui & 1; } E(acc, cur, wr, wc, fr, fq); S.done(cur); }
        if (!has_next) break;
        if constexpr (Epi::PREFETCH) E.prefetch(nxt, wid, (ui + 1) & 1);
#pragma unroll
        for (int a = 0; a < 2; ++a)
#pragma unroll
            for (int b = 0; b < 2; ++b)
#pragma unroll
                for (int m = 0; m < 4; ++m)
#pragma unroll
                    for (int n = 0; n < 2; ++n) acc[a][b][m][n] = acc_t{};
        cur = nxt; cA = nA; cB = nB; ++ui;
        if constexpr (ALIGN_EPI) { if (wr == 1) PG8_BAR; }
    }
    PG8_WAIT_V(0);
    if constexpr (!ALIGN_EPI) { if (wr == 0) PG8_BAR; }
    PG8_BAR;
    if constexpr (Epi::AFTER_DRAIN) { E.fused(acc, cur, wr, wc, fr, fq, lds, wid, lane); S.done(cur); }
#undef PG8_SA
#undef PG8_SB
#undef PG8_STAGE
#undef PG8_LDA
#undef PG8_LDB
#undef PG8_MMA
#undef PG8_WAIT_V
#undef PG8_WAIT_L
#undef PG8_BAR
#undef PG8_SCHED
}
}

namespace attn {
constexpr int D = 128;
constexpr int WINDOW = 129;
constexpr float THR = 8.f;
constexpr bool WSKIP = true;
constexpr float SCALE = 0.08838834764831845f;
constexpr int NW = 8, QBLK = 32, KVBLK = 64, QB = NW * QBLK;
constexpr int SHM_V = KVBLK * D * 2, SHM_K = KVBLK * D * 2;
constexpr int LDS_BYTES = 2 * SHM_V + 2 * SHM_K + NW * 64 * 4;
using bf16 = __hip_bfloat16;
typedef short bf16x8 __attribute__((ext_vector_type(8)));
typedef short s16x4 __attribute__((ext_vector_type(4)));
typedef float f32x16 __attribute__((ext_vector_type(16)));
typedef float f32x4 __attribute__((ext_vector_type(4)));
typedef unsigned u32x4 __attribute__((ext_vector_type(4)));
template <class A, class Bt> struct same_t { static constexpr bool v = false; };
template <class A> struct same_t<A, A> { static constexpr bool v = true; };

#define KSWZ(row, colB) ((row) * 256 + ((colB) ^ (((row) & 7) << 4)))
#define SBAR() __builtin_amdgcn_sched_barrier(0)
__device__ __forceinline__ int v_st(int k, int c) { const int kk = (k & ~0xC) | ((k & 4) << 1) | ((k & 8) >> 1); return ((kk >> 3) * 4 + (c >> 5)) * 512 + ((kk & 7) * 32 + (c & 31)) * 2; }
__device__ __forceinline__ int v_rd_base(int lane) { return ((lane & 3) << 3) | (((lane >> 2) & 3) << 6) | (((lane >> 4) & 1) << 5) | (((lane >> 5) & 1) << 8); }
constexpr int v_rd_off(int d0, int ks, int half) { return d0 * 512 + ks * 4096 + half * 2048; }
__device__ __forceinline__ int crow(int r, int hi) { return (r & 3) + 8 * (r >> 2) + 4 * hi; }
__device__ __forceinline__ unsigned cvtpk(float lo, float hi) {
    unsigned r; asm volatile("v_cvt_pk_bf16_f32 %0, %1, %2" : "=v"(r) : "v"(lo), "v"(hi)); return r;
}
__device__ __forceinline__ bf16x8 pack8(f32x4 a, f32x4 b) {
    u32x4 w = {cvtpk(a[0], a[1]), cvtpk(a[2], a[3]), cvtpk(b[0], b[1]), cvtpk(b[2], b[3])};
    return *reinterpret_cast<bf16x8*>(&w);
}
template <class T> __device__ __forceinline__ bf16x8 load8(const T* p) {
    if constexpr (same_t<T, float>::v) { return pack8(*(const f32x4*)p, *(const f32x4*)(p + 4)); }
    else { return *reinterpret_cast<const bf16x8*>(p); }
}
__device__ __forceinline__ void mask_tile(f32x16& p0, f32x16& p1, int dq, unsigned W) {
    const float NEG = -__builtin_inff();
#pragma unroll
    for (int r = 0; r < 16; ++r) {
        const int c = (r & 3) + 8 * (r >> 2);
        if ((unsigned)(dq - c) >= W) p0[r] = NEG;
        if ((unsigned)(dq - c - 32) >= W) p1[r] = NEG;
    }
}
__device__ __forceinline__ void partialSM(f32x16& p0, f32x16& p1, float& m_reg, float& mn, float& alpha) {
    float pmax = p0[0]; for (int r = 1; r < 16; ++r) pmax = fmaxf(pmax, p0[r]); for (int r = 0; r < 16; ++r) pmax = fmaxf(pmax, p1[r]);
    { auto rr = __builtin_amdgcn_permlane32_swap(__float_as_uint(pmax), __float_as_uint(pmax), false, false);
      pmax = fmaxf(__uint_as_float(rr[0]), __uint_as_float(rr[1])); }
    constexpr float C2 = 1.4426950408889634f * SCALE;
    if (__builtin_expect(__all((pmax - m_reg) * SCALE <= THR), 1)) { mn = m_reg; alpha = 1.f; }
    else { mn = fmaxf(m_reg, pmax); alpha = __builtin_amdgcn_exp2f((m_reg - mn) * C2); m_reg = mn; }
    const float mnL = -mn * C2;
    for (int r = 0; r < 16; ++r) p0[r] = fmaf(p0[r], C2, mnL); for (int r = 0; r < 16; ++r) p1[r] = fmaf(p1[r], C2, mnL);
    for (int r = 0; r < 16; ++r) p0[r] = __builtin_amdgcn_exp2f(p0[r]);
}
__device__ __forceinline__ void finishSM(f32x16& p0, f32x16& p1, float alpha, float& l_reg, bf16x8& pa0, bf16x8& pa1, bf16x8& pa2, bf16x8& pa3) {
    for (int r = 0; r < 16; ++r) p1[r] = __builtin_amdgcn_exp2f(p1[r]);
    float ps = 0; for (int r = 0; r < 16; ++r) ps += p0[r]; for (int r = 0; r < 16; ++r) ps += p1[r];
    { auto rr = __builtin_amdgcn_permlane32_swap(__float_as_uint(ps), __float_as_uint(ps), false, false);
      ps = __uint_as_float(rr[0]) + __uint_as_float(rr[1]); }
    l_reg = l_reg * alpha + ps;
#define PK4(P, B_, OUT) do { unsigned a0 = cvtpk(P[B_+0], P[B_+1]), a1 = cvtpk(P[B_+2], P[B_+3]);                          \
        unsigned b0 = cvtpk(P[B_+4], P[B_+5]), b1 = cvtpk(P[B_+6], P[B_+7]);                                             \
        auto r0 = __builtin_amdgcn_permlane32_swap(a0, b0, false, false); auto r1 = __builtin_amdgcn_permlane32_swap(a1, b1, false, false); \
        u32x4 w = {r0[0], r1[0], r0[1], r1[1]}; OUT = *reinterpret_cast<bf16x8*>(&w); } while (0)
    PK4(p0, 0, pa0); PK4(p0, 8, pa1); PK4(p1, 0, pa2); PK4(p1, 8, pa3);
#undef PK4
}
template <int KB, bool SK>
__device__ __forceinline__ void qkt(f32x16& p0, f32x16& p1, const char* K_lds, int r32, int hi, const bf16x8* qr, bool act) {
    if (SK && !act) { const float NEG = -__builtin_inff();
#pragma unroll
        for (int r = 0; r < 16; ++r) { p0[r] = NEG; p1[r] = NEG; } return; }
    p0 = f32x16{}; p1 = f32x16{};
    const char* kb[4];
#pragma unroll
    for (int dd = 0; dd < 4; ++dd) kb[dd] = K_lds + KB * SHM_K + KSWZ(r32, (dd * 16 + hi * 8) * 2);
#pragma unroll
    for (int d0 = 0; d0 < 8; ++d0) { const char* a = kb[d0 & 3] + (d0 >> 2) * 128;
        bf16x8 b0 = *reinterpret_cast<const bf16x8*>(a);
        bf16x8 b1 = *reinterpret_cast<const bf16x8*>(a + 32 * 256);
        p0 = __builtin_amdgcn_mfma_f32_32x32x16_bf16(b0, qr[d0], p0, 0, 0, 0);
        p1 = __builtin_amdgcn_mfma_f32_32x32x16_bf16(b1, qr[d0], p1, 0, 0, 0); }
}
template <int VB, bool SK>
__device__ __forceinline__ void pv_tile(f32x16* o, int vb0, bf16x8 pa0, bf16x8 pa1, bf16x8 pa2, bf16x8 pa3, bool act) {
    if (SK && !act) return;
#define TRRD(dst, off) asm volatile("ds_read_b64_tr_b16 %0, %1 offset:%2" : "=&v"(dst) : "v"(vb0), "i"(off) : "memory")
#define PV_D0(d0) do { s16x4 l0, l1, l2, l3, h0, h1, h2, h3; constexpr int b_ = VB * SHM_V + v_rd_off(d0, 0, 0);     \
        TRRD(l0, b_); TRRD(h0, b_ + 2048); TRRD(l1, b_ + 4096); TRRD(h1, b_ + 6144); TRRD(l2, b_ + 8192); TRRD(h2, b_ + 10240); TRRD(l3, b_ + 12288); TRRD(h3, b_ + 14336); \
        asm volatile("s_waitcnt lgkmcnt(0)" ::: "memory"); SBAR();                 \
        o[d0] = __builtin_amdgcn_mfma_f32_32x32x16_bf16(pa0, (bf16x8){l0[0], l0[1], l0[2], l0[3], h0[0], h0[1], h0[2], h0[3]}, o[d0], 0, 0, 0);   \
        o[d0] = __builtin_amdgcn_mfma_f32_32x32x16_bf16(pa1, (bf16x8){l1[0], l1[1], l1[2], l1[3], h1[0], h1[1], h1[2], h1[3]}, o[d0], 0, 0, 0);   \
        o[d0] = __builtin_amdgcn_mfma_f32_32x32x16_bf16(pa2, (bf16x8){l2[0], l2[1], l2[2], l2[3], h2[0], h2[1], h2[2], h2[3]}, o[d0], 0, 0, 0);   \
        o[d0] = __builtin_amdgcn_mfma_f32_32x32x16_bf16(pa3, (bf16x8){l3[0], l3[1], l3[2], l3[3], h3[0], h3[1], h3[2], h3[3]}, o[d0], 0, 0, 0); } while (0)
    PV_D0(0); PV_D0(1); PV_D0(2); PV_D0(3);
#undef PV_D0
#undef TRRD
}

template <class TIn, class TOut> struct BlockRef { const TIn* Q; const TIn* K; const TIn* V; TOut* O; float* LSE; int P0; int rs; int ls; };
template <class TIn> struct Seam {
    bf16x8 qr[8];
    bf16x8 st_v0, st_v1, st_k0, st_k1; f32x4 sf0, sf1, sf2, sf3;
    f32x4 tq[16];
};
__device__ __forceinline__ int swa_jlo(int P0, int W) { const int lowk = P0 - W + 1; return lowk > 0 ? lowk / KVBLK : 0; }
#define ROW(p, k0, rr, rs_) ((p) + (size_t)((k0) + (rr)) * (size_t)(rs_) + sc)
#define VMW() asm volatile("s_waitcnt vmcnt(0)" ::: "memory")
#define VMWN(n) asm volatile("s_waitcnt vmcnt(%0)" :: "i"(n) : "memory")
#define SLOAD_H(Kp, Vp, k0, rs_) do { S.st_v0 = load8<TIn>(ROW(Vp, k0, sr, rs_)); S.st_v1 = load8<TIn>(ROW(Vp, k0, 32 + sr, rs_));              \
                         S.st_k0 = load8<TIn>(ROW(Kp, k0, sr, rs_)); S.st_k1 = load8<TIn>(ROW(Kp, k0, 32 + sr, rs_)); } while (0)
#define SWRITE_HK(bf) do { *(bf16x8*)(K_lds + (bf) * SHM_K + kws) = S.st_k0; *(bf16x8*)(K_lds + (bf) * SHM_K + kws + 32 * 256) = S.st_k1; } while (0)
#define SWRITE_HV(bf) do { *(bf16x8*)(V_lds + (bf) * SHM_V + vst0) = S.st_v0; *(bf16x8*)(V_lds + (bf) * SHM_V + vst1) = S.st_v1; } while (0)
#define SWRITE_H(bf) do { SWRITE_HV(bf); SWRITE_HK(bf); } while (0)
#define SLOAD_F(p, k0) do { } while (0)
#define SWRITE_KF(bf) do { *(bf16x8*)(K_lds + (bf) * SHM_K + kws) = pack8(S.sf0, S.sf1); *(bf16x8*)(K_lds + (bf) * SHM_K + kws + 32 * 256) = pack8(S.sf2, S.sf3); } while (0)
#define SWRITE_VF(bf) do { *(bf16x8*)(V_lds + (bf) * SHM_V + vst0) = pack8(S.sf0, S.sf1); *(bf16x8*)(V_lds + (bf) * SHM_V + vst1) = pack8(S.sf2, S.sf3); } while (0)
template <class TIn, class TOut>
__device__ __forceinline__ void causal_swa_prime(const BlockRef<TIn, TOut>& cur, int W, char* lds, Seam<TIn>& S) {
    constexpr bool F32 = same_t<TIn, float>::v;
    const int tid = tid_opaque(), wid = __builtin_amdgcn_readfirstlane(tid >> 6), lane = tid & 63, r32 = lane & 31, hi = lane >> 5;
    const int sr = tid >> 4, sc = (tid & 15) * 8, kws = KSWZ(sr, sc * 2); char* K_lds = lds + 2 * SHM_V;
    const int kb0 = swa_jlo(cur.P0, W) * KVBLK;
    for (int d0 = 0; d0 < 8; ++d0) S.qr[d0] = load8<TIn>(cur.Q + (size_t)(wid * QBLK + r32) * (size_t)cur.rs + d0 * 16 + hi * 8);
    if constexpr (F32) { SLOAD_F((const float*)cur.K, kb0); VMW(); SWRITE_KF(0); SBAR(); SLOAD_F((const float*)cur.V, kb0); }
    else { SLOAD_H(cur.K, cur.V, kb0, cur.rs); VMW(); SWRITE_HK(0); }
    __syncthreads();
}
template <class TIn, class TOut>
__device__ __forceinline__ void causal_swa_block(const BlockRef<TIn, TOut>& cur, const BlockRef<TIn, TOut>& nxt, int skv, int W, char* lds, Seam<TIn>& S) {
    constexpr bool F32 = same_t<TIn, float>::v;
    const int tid = tid_opaque(), wid = __builtin_amdgcn_readfirstlane(tid >> 6), lane = tid & 63, r32 = lane & 31, hi = lane >> 5;
    const int j_lo = swa_jlo(cur.P0, W);
    int j_hi = (cur.P0 + QB - 1) / KVBLK + 1; if (j_hi > skv / KVBLK) j_hi = skv / KVBLK;
    const int NT = j_hi - j_lo;
    const int kbn = swa_jlo(nxt.P0, W) * KVBLK;
    const int qlo = cur.P0 + wid * QBLK, qm = qlo + r32 - 4 * hi;
    char* V_lds = lds; char* K_lds = lds + 2 * SHM_V;
    float* ws = (float*)(lds + 2 * SHM_V + 2 * SHM_K) + wid * 64; float* li_l = ws, * al_l = ws + 32;
    float m_reg = -1e30f, l_reg = 0; f32x16 o[4] = {};
    const int sr = tid >> 4, sc = (tid & 15) * 8, vst0 = v_st(sr, sc), vst1 = v_st(32 + sr, sc), kws = KSWZ(sr, sc * 2);
    const int vb0 = (int)(uintptr_t)V_lds + v_rd_base(lane);
    const TIn* Kh = cur.K; const TIn* Vh = cur.V;
#define RESC(a) do { if (__any((a) < 1.f)) { if (hi == 0) al_l[r32] = (a); asm volatile("s_waitcnt lgkmcnt(0)" ::: "memory");              \
                     for (int d_ = 0; d_ < 4; ++d_) for (int r = 0; r < 16; ++r) o[d_][r] *= al_l[crow(r, hi)]; } } while (0)
#define KBASE(t) ((j_lo + (t)) * KVBLK)
#define ACT(t) (KBASE(t) <= qlo + QBLK - 1 && KBASE(t) + KVBLK - 1 >= qlo - W + 1)
#define MASKT(P0_, P1_, t) do { const int kb_ = KBASE(t); if ((!SK || ACT(t)) && (kb_ + KVBLK - 1 > qlo || kb_ <= qlo + QBLK - 1 - W)) mask_tile(P0_, P1_, qm - kb_, (unsigned)W); } while (0)
    constexpr int NQL = F32 ? 16 : 8;
    constexpr bool SK = WSKIP && !F32;
#define SEAM_K0() do { VMWN(NQL); if constexpr (F32) { SWRITE_KF(0); SBAR(); SLOAD_F((const float*)nxt.V, kbn); } else { SWRITE_HK(0); } SBAR(); } while (0)
    f32x16 pA0, pA1, pB0, pB1; float mnA, mnB, alA, alB; bf16x8 pa0, pa1, pa2, pa3;
    if constexpr (F32) { VMW(); SWRITE_VF(0); SBAR(); } else { SWRITE_HV(0); SBAR(); }
    if (NT > 1) { if constexpr (F32) SLOAD_F((const float*)Kh, KBASE(1)); else SLOAD_H(Kh, Vh, KBASE(1), cur.rs); }
    SBAR(); qkt<0, SK>(pA0, pA1, K_lds, r32, hi, S.qr, ACT(0));
    if constexpr (F32) { if (NT > 1) { VMW(); SWRITE_KF(1); SBAR(); SLOAD_F((const float*)Vh, KBASE(1)); } }
    MASKT(pA0, pA1, 0); partialSM(pA0, pA1, m_reg, mnA, alA);
    if (NT > 1) { VMW(); if constexpr (F32) { SWRITE_VF(1); SBAR(); if (NT > 2) SLOAD_F((const float*)Kh, KBASE(2)); } else SWRITE_H(1); }
    __syncthreads();
#define HALF_STEP(PX0, PX1, mnX, alX, PY0, PY1, alY, t, KB, VB, SB) do {                                                      \
        SBAR(); qkt<KB, SK>(PX0, PX1, K_lds, r32, hi, S.qr, ACT(t));                                             \
        finishSM(PY0, PY1, alY, l_reg, pa0, pa1, pa2, pa3); SBAR();                                                           \
        if ((t) + 1 < NT) { if constexpr (F32) { VMW(); SWRITE_KF(SB); SBAR(); SLOAD_F((const float*)Vh, KBASE((t) + 1)); }  \
                            else { SLOAD_H(Kh, Vh, KBASE((t) + 1), cur.rs); } SBAR(); }                                               \
        pv_tile<VB, SK>(o, vb0, pa0, pa1, pa2, pa3, ACT((t) - 1)); MASKT(PX0, PX1, (t)); partialSM(PX0, PX1, m_reg, mnX, alX);                                        \
        __syncthreads();                                                                                                      \
        if ((t) + 1 < NT) { VMW(); if constexpr (F32) { SWRITE_VF(SB); SBAR(); if ((t) + 2 < NT) SLOAD_F((const float*)Kh, KBASE((t) + 2)); } \
                            else { SWRITE_H(SB); } }                                                                          \
        RESC(alX); __syncthreads(); } while (0)
    for (int t = 1; t + 1 < NT; t += 2) {
        HALF_STEP(pB0, pB1, mnB, alB, pA0, pA1, alA, t, 1, 0, 0);
        HALF_STEP(pA0, pA1, mnA, alA, pB0, pB1, alB, t + 1, 0, 1, 1);
    }
    const bool even = (NT & 1) == 0;
    if (even) { SBAR(); qkt<1, SK>(pB0, pB1, K_lds, r32, hi, S.qr, ACT(NT - 1)); SBAR(); }
#define QROW(e) (nxt.Q + (size_t)(wid * QBLK + r32) * (size_t)nxt.rs + ((e) >> 1) * 16 + hi * 8 + ((e) & 1) * 4)
    if constexpr (F32) { SLOAD_F((const float*)nxt.K, kbn); SBAR();
#pragma unroll
        for (int e = 0; e < 8; ++e) S.tq[e] = *(const f32x4*)QROW(e); }
    else { SLOAD_H(nxt.K, nxt.V, kbn, nxt.rs); SBAR();
#pragma unroll
        for (int d0 = 0; d0 < 8; ++d0) S.qr[d0] = load8<TIn>(nxt.Q + (size_t)(wid * QBLK + r32) * (size_t)nxt.rs + d0 * 16 + hi * 8); }
    SBAR();
    finishSM(pA0, pA1, alA, l_reg, pa0, pa1, pa2, pa3); SBAR();
    if constexpr (F32) {
#pragma unroll
        for (int e = 8; e < 16; ++e) S.tq[e] = *(const f32x4*)QROW(e); SBAR(); }
#undef QROW
    pv_tile<0, SK>(o, vb0, pa0, pa1, pa2, pa3, ACT(even ? NT - 2 : NT - 1));
    if (even) { MASKT(pB0, pB1, NT - 1); partialSM(pB0, pB1, m_reg, mnB, alB); __syncthreads(); RESC(alB);
        finishSM(pB0, pB1, alB, l_reg, pa0, pa1, pa2, pa3); SBAR(); pv_tile<1, SK>(o, vb0, pa0, pa1, pa2, pa3, ACT(NT - 1)); }
    SBAR(); SEAM_K0();
    if (hi == 0) li_l[r32] = l_reg; asm volatile("s_waitcnt lgkmcnt(0)" ::: "memory");
    float rli[16];
#pragma unroll
    for (int r = 0; r < 16; ++r) rli[r] = __builtin_amdgcn_rcpf(li_l[crow(r, hi)]);
    TOut* Ow = cur.O + (size_t)(wid * QBLK) * (size_t)cur.rs;
    if (hi == 0) cur.LSE[(size_t)(wid * QBLK + r32) * (size_t)cur.ls] = m_reg * SCALE + __logf(l_reg);
#pragma unroll
    for (int r = 0; r < 16; ++r) { const int orow = crow(r, hi);
#pragma unroll
        for (int d0 = 0; d0 < 4; ++d0) { const float v = o[d0][r] * rli[r];
            if constexpr (same_t<TOut, float>::v) { Ow[(size_t)orow * (size_t)cur.rs + d0 * 32 + r32] = v; }
            else { const float vn = __shfl_xor(v, 1);
                   if ((r32 & 1) == 0) *(unsigned*)(Ow + (size_t)orow * (size_t)cur.rs + d0 * 32 + r32) = cvtpk(v, vn); } } }
    if constexpr (F32) {
#pragma unroll
        for (int d0 = 0; d0 < 8; ++d0) S.qr[d0] = pack8(S.tq[2 * d0], S.tq[2 * d0 + 1]); }
    __syncthreads();
#undef RESC
#undef KBASE
#undef ACT
#undef MASKT
#undef SEAM_K0
#undef HALF_STEP
}
#undef ROW
#undef VMW
#undef VMWN
#undef SLOAD_H
#undef SWRITE_HK
#undef SWRITE_HV
#undef SWRITE_H
#undef SLOAD_F
#undef SWRITE_KF
#undef SWRITE_VF

#undef SBAR
}
#define GAS __attribute__((address_space(1)))
#define LAS __attribute__((address_space(3)))
typedef unsigned short bf16;
typedef unsigned v4u __attribute__((ext_vector_type(4)));
typedef float f32x4 __attribute__((ext_vector_type(4)));
typedef short bf16x8 __attribute__((ext_vector_type(8)));
typedef GAS unsigned gu32;
typedef GAS unsigned long long gu64;
#define RLX_AGENT __ATOMIC_RELAXED, __HIP_MEMORY_SCOPE_AGENT
#define LDS_WAIT() asm volatile("s_waitcnt lgkmcnt(0)" ::: "memory")
#define VM_WAIT() asm volatile("s_waitcnt vmcnt(0)" ::: "memory")
__device__ __forceinline__ unsigned long long rt() { return __builtin_amdgcn_s_memrealtime(); }
__device__ __forceinline__ unsigned f2bf(float f) { unsigned u = __builtin_bit_cast(unsigned, f); return (u + 0x7fffu + ((u >> 16) & 1u)) >> 16; }
__device__ __forceinline__ unsigned pk2(float lo, float hi) { return f2bf(lo) | (f2bf(hi) << 16); }

#define XB_TMO      128
#define XB_XCNT(j)  (256  + 64 * (j))
#define XB_XSUB(j)  (1280 + 64 * (j))
#define XB_XGEN(j)  (2304 + 64 * (j))
#define XB_TOP      3328
#define XB_TOPGEN   3392
#define XCD_BAR_WORDS 3456
#define XB_SPIN_CAP (1u << 18)

__device__ __forceinline__ unsigned xb_ld(unsigned* p)              { return __hip_atomic_load(p, __ATOMIC_RELAXED, __HIP_MEMORY_SCOPE_AGENT); }
__device__ __forceinline__ unsigned xb_add(unsigned* p, unsigned v) { return __hip_atomic_fetch_add(p, v, __ATOMIC_RELAXED, __HIP_MEMORY_SCOPE_AGENT); }
__device__ __forceinline__ unsigned xb_xcc_id() { return (unsigned)__builtin_amdgcn_s_getreg((3 << 11) | 20) & 0xFu; }
#define XB_SPIN(cond, bar) do { unsigned _sp = 0; while (cond) { __builtin_amdgcn_s_sleep(1); \
    if ((++_sp & 255u) == 0u) { if (xb_ld(&(bar)[XB_TMO])) break; if (_sp > XB_SPIN_CAP) { atomicAdd(&(bar)[XB_TMO], 1u); break; } } } } while (0)

struct XcdBarrier {
    unsigned* bar; unsigned x;
    volatile LAS unsigned* st;
};

__device__ __forceinline__ XcdBarrier xcd_barrier_post(unsigned* bar, volatile LAS unsigned* st) {
    XcdBarrier b; b.bar = bar; b.x = xb_xcc_id(); b.st = st;
    if (threadIdx.x == 0) (void)xb_add(&bar[XB_XCNT(b.x)], 1u);
    return b;
}
__device__ __forceinline__ void xcd_barrier_complete(unsigned* bar, unsigned x, unsigned& nloc, unsigned& nx) {
    const unsigned G = gridDim.x * gridDim.y * gridDim.z;
    unsigned sum, cnt, mine, sp = 0u;
    for (;;) {
        sum = 0u; cnt = 0u; mine = 0u;
#pragma unroll
        for (unsigned j = 0; j < 16; ++j) { const unsigned c = xb_ld(&bar[XB_XCNT(j)]); sum += c; cnt += (c > 0u) ? 1u : 0u; mine = (j == x) ? c : mine; }
        if (sum == G) break;
        __builtin_amdgcn_s_sleep(1);
        if ((++sp & 255u) == 0u) { if (xb_ld(&bar[XB_TMO])) break; if (sp > XB_SPIN_CAP) { atomicAdd(&bar[XB_TMO], 1u); break; } }
    }
    nloc = mine > 0u ? mine : 1u; nx = cnt > 0u ? cnt : 1u;
}

__device__ __forceinline__ void xcd_barrier(const XcdBarrier& b) {
    asm volatile("s_waitcnt vmcnt(0)" ::: "memory");
    __syncthreads();
    if (threadIdx.x == 0) {
        unsigned* bar = b.bar;
        __builtin_amdgcn_s_waitcnt(0);
        unsigned nloc = b.st[0], nx = b.st[1];
        if (nloc == 0u) { xcd_barrier_complete(bar, b.x, nloc, nx); b.st[0] = nloc; b.st[1] = nx; }
        const unsigned old = xb_add(&bar[XB_XSUB(b.x)], 1u);
        const unsigned gen = old / nloc;
        if (old + 1u == (gen + 1u) * nloc) {
            __builtin_amdgcn_fence(__ATOMIC_RELEASE, "agent");
            asm volatile("s_waitcnt vmcnt(0)" ::: "memory");
            const unsigned og = xb_add(&bar[XB_TOP], 1u);
            const unsigned tg = og / nx;
            if (og + 1u == (tg + 1u) * nx) xb_add(&bar[XB_TOPGEN], 1u);
            else XB_SPIN(xb_ld(&bar[XB_TOPGEN]) == tg, bar);
            __builtin_amdgcn_fence(__ATOMIC_ACQUIRE, "agent");
            xb_add(&bar[XB_XGEN(b.x)], 1u);
            asm volatile("s_waitcnt vmcnt(0)" ::: "memory");
        } else {
            XB_SPIN(xb_ld(&bar[XB_XGEN(b.x)]) == gen, bar);
            __builtin_amdgcn_fence(__ATOMIC_ACQUIRE, "agent");
            asm volatile("s_waitcnt vmcnt(0)" ::: "memory");
        }
    }
    __syncthreads();
}

constexpr int NWAVES = 8;

constexpr size_t MiB = 1u << 20, HMiB = 1u << 19;
constexpr size_t WS_CTL = 0, CTL_ZERO_BYTES = 128 * 1024;
constexpr size_t WS_COLMAX = 64 * 1024;
constexpr size_t WS_MOD = 1 * MiB;
constexpr size_t WS_AVEC = WS_MOD + 80 * 1024;
constexpr size_t WS_BIAS_IN = WS_MOD + 96 * 1024;
constexpr size_t WS_BIAS_F2 = WS_MOD + 176 * 1024;
constexpr size_t WS_PS2 = WS_MOD + 256 * 1024, WS_PS3 = WS_MOD + 512 * 1024;
constexpr size_t WS_SW1 = WS_MOD + 768 * 1024, WS_SW2 = WS_MOD + 800 * 1024;
constexpr size_t WS_SA1 = WS_MOD + 832 * 1024, WS_RF3 = WS_MOD + 896 * 1024;
constexpr size_t WS_WGU1 = 2 * MiB;
constexpr size_t WS_WD1 = WS_WGU1 + 11 * MiB;
constexpr size_t WS_WIN = WS_WD1 + 11 * HMiB;
constexpr size_t WS_WA = WS_WIN + 19 * MiB;
constexpr size_t WS_WC = WS_WA + 1 * MiB;
constexpr size_t WS_WO = WS_WC + 2 * MiB;
constexpr size_t WS_WGU2 = WS_WO + 2 * MiB;
constexpr size_t WS_WD2 = WS_WGU2 + 11 * MiB;
constexpr size_t WS_XS = WS_WD2 + 11 * HMiB;
constexpr size_t WS_R = WS_XS + 32 * MiB;
constexpr size_t WS_ACT = WS_R;
constexpr size_t WS_Q = WS_R, WS_K = WS_R + 48 * MiB, WS_V = WS_R + 96 * MiB;
constexpr size_t WS_LSE = WS_R + 144 * MiB;
constexpr size_t WS_O = WS_R + 145 * MiB;
constexpr size_t WS_U = WS_R + 48 * MiB, WS_B = WS_R + 80 * MiB, WS_C = WS_R + 112 * MiB;
constexpr size_t WS_SGA = WS_R, WS_SGC = WS_R + 48 * MiB;
constexpr size_t WS_END = WS_O + 16 * MiB;
static_assert(WS_XS == 59 * MiB && WS_END <= 256 * MiB, "d_ws map");
constexpr size_t WS_XQ1 = WS_XS, WS_XQ3 = WS_O;
constexpr int CW_BAR = 4096;

constexpr int RING_OFF = 0, RING_BYTES = 131072;
constexpr int LDSCTL_OFF = RING_BYTES, MISC_OFF = LDSCTL_OFF + 320, XL_OFF = RING_BYTES + 1024;
constexpr int LDS_BYTES = 151552;


#ifdef NAIVE
#define FFN_I8 0
#else
#define FFN_I8 1
#endif
struct Args { const float* in[20]; float* out; unsigned char* ws; int ph_lo, ph_hi; };
struct Frame {
    LAS unsigned char* lds;
    volatile LAS unsigned* MISC;
    gu32* ctl;
    int tid, lane, wave;
    int vcu, G;
    float* out; unsigned char* ws;
};
enum { I_X = 0, I_C, I_WADA, I_BADA, I_NF1, I_F1G, I_F1U, I_F1D, I_NMIX, I_WIN, I_QN, I_KN, I_CONVW, I_WAB, I_WCB, I_WOUT, I_NF2, I_F2G, I_F2U, I_F2D };
enum { MOD_SH1 = 0, MOD_SC1 = 1024, MOD_GT1 = 2048, MOD_SH2 = 3072, MOD_SC2 = 4096, MOD_GT2 = 5120, MOD_SH3 = 6144, MOD_SC3 = 7168, MOD_GT3 = 8192 };

__device__ __forceinline__ float silu_f(float x) { return x * __builtin_amdgcn_rcpf(1.0f + __builtin_amdgcn_exp2f(-1.4426950408889634f * x)); }
__device__ __forceinline__ float wave_sum(float v) {
#pragma unroll
    for (int o = 1; o < 64; o <<= 1) v += __shfl_xor(v, o);
    return v;
}
__device__ __forceinline__ float blo(unsigned w) { return __uint_as_float(w << 16); }
__device__ __forceinline__ float bhi(unsigned w) { return __uint_as_float(w & 0xffff0000u); }

constexpr int ADA_ITEMS = NMOD / 64;
__device__ __forceinline__ void p0_adaln_item(Frame& F, const Args& args, int item) {
    LAS float* sc = (LAS float*)(F.lds + RING_OFF);
    LAS float* red = sc + 2048;
    const float* c = args.in[I_C]; const float* wada = args.in[I_WADA]; const float* bada = args.in[I_BADA];
    for (int i = F.tid; i < 2 * DM; i += NWAVES * 64) sc[i] = silu_f(c[i]);
    __syncthreads();
    const int j0 = item * 64, cg = F.lane & 15, rs = F.lane >> 4;
    f32x4 a0 = {0.f, 0.f, 0.f, 0.f}, a1 = {0.f, 0.f, 0.f, 0.f};
    const GAS f32x4* wp = (const GAS f32x4*)(wada + (size_t)(F.wave * 128 + rs) * NMOD + j0 + 4 * cg);
#pragma unroll 16
    for (int it = 0; it < 32; ++it) { const int k = F.wave * 128 + 4 * it + rs; const f32x4 w = __builtin_nontemporal_load(&wp[(size_t)it * 4 * (NMOD / 4)]);
        a0 = a0 + w * sc[k]; a1 = a1 + w * sc[DM + k]; }
#pragma unroll
    for (int i = 0; i < 4; ++i) { a0[i] += __shfl_xor(a0[i], 16); a0[i] += __shfl_xor(a0[i], 32); a1[i] += __shfl_xor(a1[i], 16); a1[i] += __shfl_xor(a1[i], 32); }
    if (F.lane < 16) {
#pragma unroll
        for (int i = 0; i < 4; ++i) { red[(F.wave * 2 + 0) * 64 + 4 * cg + i] = a0[i]; red[(F.wave * 2 + 1) * 64 + 4 * cg + i] = a1[i]; } }
    __syncthreads();
    if (F.tid < 128) { const int b = F.tid >> 6, j = F.tid & 63; float s = bada[j0 + j];
#pragma unroll
        for (int w = 0; w < NWAVES; ++w) s += red[(w * 2 + b) * 64 + j];
        ((float*)(F.ws + WS_MOD))[b * NMOD + j0 + j] = s; }
    __syncthreads();
}
__device__ __forceinline__ void p0_transpose_item(const float* W, int K, int N, bf16* WT, int rmode, LAS float* scr, int item, int lane) {
    const int nblk = N / 32, kb = item / nblk, nb = item % nblk, k0 = 64 * kb, n0 = 32 * nb;
    const int r0 = rmode == 0 ? n0 : 256 * (n0 >> 7) + 128 * (rmode - 1) + (n0 & 127);
#pragma unroll 16
    for (int i = 0; i < 32; ++i) { const int kk = 2 * i + (lane >> 5); scr[kk * 33 + (lane & 31)] = __builtin_nontemporal_load(&W[(size_t)(k0 + kk) * N + n0 + (lane & 31)]); }
    LDS_WAIT(); asm volatile("" ::: "memory");
    const int c = lane & 7;
#pragma unroll
    for (int j = 0; j < 4; ++j) { const int n = (lane >> 3) + 8 * j; const LAS float* s = scr + (8 * c) * 33 + n;
        v4u o; o.x = pk2(s[0 * 33], s[1 * 33]); o.y = pk2(s[2 * 33], s[3 * 33]); o.z = pk2(s[4 * 33], s[5 * 33]); o.w = pk2(s[6 * 33], s[7 * 33]);
        *(GAS v4u*)(WT + (size_t)(r0 + n) * K + k0 + 8 * c) = o; }
    LDS_WAIT(); asm volatile("" ::: "memory");
}
__device__ __forceinline__ int q8(float v) { return (int)fminf(fmaxf(rintf(v), -127.f), 127.f); }
__device__ __forceinline__ unsigned pk4q(float a, float b, float c, float d) { return (unsigned)(q8(a) & 255) | ((unsigned)(q8(b) & 255) << 8) | ((unsigned)(q8(c) & 255) << 16) | ((unsigned)(q8(d) & 255) << 24); }
__device__ __forceinline__ void wq_absmax(Frame& F, const Args& args, int worker, int nworkers) {
    unsigned* cm = (unsigned*)(F.ws + WS_COLMAX);
    for (int it = worker; it < 4 * 44 * 8; it += nworkers) {
        const int mat = it / 352, r = it - mat * 352, nch = r >> 3, kch = r & 7, n = nch * 64 + F.lane;
        const float* W = (mat == 0 ? args.in[I_F1G] : mat == 1 ? args.in[I_F1U] : mat == 2 ? args.in[I_F2G] : args.in[I_F2U]) + (size_t)(kch * 128) * DFF + n;
        float mx = 0.f;
#pragma unroll 16
        for (int i = 0; i < 128; ++i) mx = fmaxf(mx, fabsf(__builtin_nontemporal_load(&W[(size_t)i * DFF])));
        atomicMax(cm + mat * DFF + n, __float_as_uint(mx));
    }
}
__device__ __forceinline__ void p0_transpose_item_i8(const float* W, int N, signed char* WQ, int rmode, LAS float* scr, int item, int lane, const float* colmax, float* SW) {
    const int nblk = N / 32, kb = item / nblk, nb = item % nblk, k0 = 64 * kb, n0 = 32 * nb;
    const int r0 = 256 * (n0 >> 7) + 128 * (rmode - 1) + (n0 & 127);
#pragma unroll 16
    for (int i = 0; i < 32; ++i) { const int kk = 2 * i + (lane >> 5); scr[kk * 33 + (lane & 31)] = __builtin_nontemporal_load(&W[(size_t)(k0 + kk) * N + n0 + (lane & 31)]); }
    LDS_WAIT(); asm volatile("" ::: "memory");
    const int n = lane >> 1, hh = lane & 1; const float cmx = colmax[n0 + n], inv = cmx > 0.f ? 127.0f / cmx : 0.f;
    const LAS float* s = scr + (32 * hh) * 33 + n;
    v4u o0, o1;
    o0.x = pk4q(s[0 * 33] * inv, s[1 * 33] * inv, s[2 * 33] * inv, s[3 * 33] * inv);     o0.y = pk4q(s[4 * 33] * inv, s[5 * 33] * inv, s[6 * 33] * inv, s[7 * 33] * inv);
    o0.z = pk4q(s[8 * 33] * inv, s[9 * 33] * inv, s[10 * 33] * inv, s[11 * 33] * inv);   o0.w = pk4q(s[12 * 33] * inv, s[13 * 33] * inv, s[14 * 33] * inv, s[15 * 33] * inv);
    o1.x = pk4q(s[16 * 33] * inv, s[17 * 33] * inv, s[18 * 33] * inv, s[19 * 33] * inv); o1.y = pk4q(s[20 * 33] * inv, s[21 * 33] * inv, s[22 * 33] * inv, s[23 * 33] * inv);
    o1.z = pk4q(s[24 * 33] * inv, s[25 * 33] * inv, s[26 * 33] * inv, s[27 * 33] * inv); o1.w = pk4q(s[28 * 33] * inv, s[29 * 33] * inv, s[30 * 33] * inv, s[31 * 33] * inv);
    GAS v4u* dst = (GAS v4u*)(WQ + (size_t)(r0 + n) * DM + k0 + 32 * hh); dst[0] = o0; dst[1] = o1;
    if (kb == 0 && hh == 0) SW[r0 + n] = cmx * (1.0f / 127.0f);
    LDS_WAIT(); asm volatile("" ::: "memory");
}
__device__ __forceinline__ void p0_transposes(Frame& F, const Args& args, int set, int gw, int NGW) {
    LAS float* scr = (LAS float*)(F.lds + RING_OFF + F.wave * 16384);
    int base = 0;
#define TR_JOB8(SRC, N_, RMODE, DST, MAT, SWO) do { const int n_it = (DM / 64) * ((N_) / 32); int it = gw - (base % NGW); if (it < 0) it += NGW; \
        const float* W_ = args.in[SRC]; signed char* WQ_ = (signed char*)(F.ws + (DST)); const float* cm_ = (const float*)(F.ws + WS_COLMAX) + (MAT) * DFF; float* sw_ = (float*)(F.ws + (SWO)); \
        for (; it < n_it; it += NGW) p0_transpose_item_i8(W_, (N_), WQ_, (RMODE), scr, it, F.lane, cm_, sw_); base += n_it; } while (0)
#define TR_JOB(SRC, K_, N_, RMODE, DST) do { const int n_it = ((K_) / 64) * ((N_) / 32); int it = gw - (base % NGW); if (it < 0) it += NGW;     \
        const float* W_ = args.in[SRC]; bf16* WT_ = (bf16*)(F.ws + (DST)); \
        for (; it < n_it; it += NGW) p0_transpose_item(W_, (K_), (N_), WT_, (RMODE), scr, it, F.lane); base += n_it; } while (0)
#if FFN_I8
    if (set == 0) { TR_JOB8(I_F1G, DFF, 1, WS_WGU1, 0, WS_SW1); TR_JOB8(I_F1U, DFF, 2, WS_WGU1, 1, WS_SW1); TR_JOB(I_F1D, DFF, DM, 0, WS_WD1); }
#else
    if (set == 0) { TR_JOB(I_F1G, DM, DFF, 1, WS_WGU1); TR_JOB(I_F1U, DM, DFF, 2, WS_WGU1); TR_JOB(I_F1D, DFF, DM, 0, WS_WD1); }
#endif
    else if (set == 1) { TR_JOB(I_WIN, DM, INW, 0, WS_WIN); TR_JOB(I_WAB, 512, DM, 0, WS_WA); TR_JOB(I_WCB, DM, DM, 0, WS_WC); TR_JOB(I_WOUT, DM, DM, 0, WS_WO); }
#if FFN_I8
    else { TR_JOB8(I_F2G, DFF, 1, WS_WGU2, 2, WS_SW2); TR_JOB8(I_F2U, DFF, 2, WS_WGU2, 3, WS_SW2); TR_JOB(I_F2D, DFF, DM, 0, WS_WD2); }
#else
    else { TR_JOB(I_F2G, DM, DFF, 1, WS_WGU2); TR_JOB(I_F2U, DM, DFF, 2, WS_WGU2); TR_JOB(I_F2D, DFF, DM, 0, WS_WD2); }
#endif
#undef TR_JOB
#undef TR_JOB8
}
__device__ __forceinline__ void norm_pass(Frame& F, const float* X, const float* g, int mod_sh, int mod_sc, bool q8out = false) {
    const int gw = F.vcu * NWAVES + F.wave, NGW = F.G * NWAVES;
    const float* mod = (const float*)(F.ws + WS_MOD); bf16* XS = (bf16*)(F.ws + WS_XS);
    for (int r0 = gw * 8; r0 < M; r0 += NGW * 8) {
        const int b = r0 / SEQ;
        f32x4 a[4], s[4];
#pragma unroll
        for (int j = 0; j < 4; ++j) { const int c = 4 * F.lane + 256 * j;
            a[j] = *(const f32x4*)(g + c) * (*(const f32x4*)(mod + b * NMOD + mod_sc + c) + 1.0f); s[j] = *(const f32x4*)(mod + b * NMOD + mod_sh + c); }
#pragma unroll 4
        for (int r = 0; r < 8; ++r) {
            const GAS f32x4* xr = (const GAS f32x4*)(X + (size_t)(r0 + r) * DM) + F.lane;
            f32x4 v[4]; float ss = 0.f;
#pragma unroll
            for (int j = 0; j < 4; ++j) { v[j] = xr[64 * j]; ss += (v[j].x * v[j].x + v[j].y * v[j].y) + (v[j].z * v[j].z + v[j].w * v[j].w); }
            const float rstd = 1.0f / sqrtf(wave_sum(ss) * (1.f / DM) + EPS);
            if (q8out) {
                f32x4 y[4]; float am = 0.f;
#pragma unroll
                for (int j = 0; j < 4; ++j) { y[j] = v[j] * rstd * a[j] + s[j]; am = fmaxf(am, fmaxf(fmaxf(fabsf(y[j].x), fabsf(y[j].y)), fmaxf(fabsf(y[j].z), fabsf(y[j].w)))); }
#pragma unroll
                for (int o = 1; o < 64; o <<= 1) am = fmaxf(am, __shfl_xor(am, o));
                const float inv = am > 0.f ? 127.0f / am : 0.f;
                GAS unsigned* o4 = (GAS unsigned*)((signed char*)(F.ws + WS_XQ1) + (size_t)(r0 + r) * DM) + F.lane;
#pragma unroll
                for (int j = 0; j < 4; ++j) o4[64 * j] = pk4q(y[j].x * inv, y[j].y * inv, y[j].z * inv, y[j].w * inv);
                if (F.lane == 0) ((float*)(F.ws + WS_SA1))[r0 + r] = am * (1.0f / 127.0f);
            } else {
            GAS unsigned long long* o8 = (GAS unsigned long long*)(XS + (size_t)(r0 + r) * DM) + F.lane;
#pragma unroll
            for (int j = 0; j < 4; ++j) { const f32x4 y = v[j] * rstd * a[j] + s[j];
                o8[64 * j] = (unsigned long long)pk2(y.x, y.y) | ((unsigned long long)pk2(y.z, y.w) << 32); }
            }
        }
    }
}
__device__ __forceinline__ void qknorm_pass(Frame& F, const Args& args) {
    const int gw = F.vcu * NWAVES + F.wave, NGW = F.G * NWAVES;
    const float* gq_ = args.in[I_QN]; const float* gk_ = args.in[I_KN];
    for (int it = gw; it < 2 * M; it += NGW) {
        const int which = it >= M, row = which ? it - M : it;
        bf16* buf = (bf16*)(F.ws + (which ? WS_K : WS_Q)) + (size_t)row * AW; const float* gm = (which ? gk_ : gq_) + 8 * (F.lane & 15);
        const f32x4 g0 = *(const f32x4*)gm, g1 = *(const f32x4*)(gm + 4);
#pragma unroll
        for (int j = 0; j < 3; ++j) { GAS v4u* p = (GAS v4u*)(buf + 512 * j + 8 * F.lane); const v4u w = *p;
            f32x4 v0 = {blo(w.x), bhi(w.x), blo(w.y), bhi(w.y)}, v1 = {blo(w.z), bhi(w.z), blo(w.w), bhi(w.w)};
            float ss = (v0.x * v0.x + v0.y * v0.y) + (v0.z * v0.z + v0.w * v0.w) + (v1.x * v1.x + v1.y * v1.y) + (v1.z * v1.z + v1.w * v1.w);
            ss += __shfl_xor(ss, 1); ss += __shfl_xor(ss, 2); ss += __shfl_xor(ss, 4); ss += __shfl_xor(ss, 8);
            const float r = 1.0f / sqrtf(ss * (1.f / 128.f) + EPS);
            v0 = v0 * r * g0; v1 = v1 * r * g1;
            v4u o; o.x = pk2(v0.x, v0.y); o.y = pk2(v0.z, v0.w); o.z = pk2(v1.x, v1.y); o.w = pk2(v1.z, v1.w); *p = o; }
    }
}
__device__ __forceinline__ void aux_avec(Frame& F, const Args& args) {
    const int gw = F.vcu * NWAVES + F.wave, NGW = F.G * NWAVES;
    const float* mod = (const float*)(F.ws + WS_MOD); float* avec = (float*)(F.ws + WS_AVEC);
    const float* g2 = args.in[I_NMIX]; const float* g3 = args.in[I_NF2];
    for (int idx = gw * 64 + F.lane; idx < 4 * DM; idx += NGW * 64) { const int which = idx >> 11, b = (idx >> 10) & 1, c = idx & (DM - 1);
        avec[idx] = (which ? g3[c] : g2[c]) * (1.0f + mod[b * NMOD + (which ? MOD_SC3 : MOD_SC2) + c]); }
}
__device__ __forceinline__ void aux_bias(Frame& F, int which) {
    const int gw = F.vcu * NWAVES + F.wave, NGW = F.G * NWAVES;
    const float* mod = (const float*)(F.ws + WS_MOD);
    const int nrows = which ? 2 * DFF : INW;
    const float* sh = mod + (which ? MOD_SH3 : MOD_SH2) + 16 * F.lane;
    f32x4 s0[4], s1[4];
#pragma unroll
    for (int q = 0; q < 4; ++q) { s0[q] = *(const f32x4*)(sh + 4 * q); s1[q] = *(const f32x4*)(sh + NMOD + 4 * q); }
    float* bo = (float*)(F.ws + (which ? WS_BIAS_F2 : WS_BIAS_IN));
    for (int n = gw; n < nrows; n += NGW) {
        const bf16* wrow = (const bf16*)(F.ws + (which ? WS_WGU2 : WS_WIN)) + (size_t)n * DM + 16 * F.lane;
        const v4u w0 = *(const GAS v4u*)wrow, w1 = *(const GAS v4u*)(wrow + 8);
        const float wv[16] = {blo(w0.x), bhi(w0.x), blo(w0.y), bhi(w0.y), blo(w0.z), bhi(w0.z), blo(w0.w), bhi(w0.w), blo(w1.x), bhi(w1.x), blo(w1.y), bhi(w1.y), blo(w1.z), bhi(w1.z), blo(w1.w), bhi(w1.w)};
        float d0 = 0.f, d1 = 0.f;
#pragma unroll
        for (int q = 0; q < 4; ++q)
#pragma unroll
            for (int i = 0; i < 4; ++i) { d0 += s0[q][i] * wv[4 * q + i]; d1 += s1[q][i] * wv[4 * q + i]; }
        d0 = wave_sum(d0); d1 = wave_sum(d1);
        if (F.lane == 0) { bo[n] = d0; bo[nrows + n] = d1; }
    }
}
__device__ __forceinline__ void xs_quant_pass(Frame& F) {
    const int gw = F.vcu * NWAVES + F.wave, NGW = F.G * NWAVES; const bf16* XSb = (const bf16*)(F.ws + WS_XS); const float* PS = (const float*)(F.ws + WS_PS3);
    for (int r = gw; r < M; r += NGW) { const GAS v4u* p = (const GAS v4u*)(XSb + (size_t)r * DM) + F.lane;
        const v4u w0 = p[0], w1 = p[64]; const f32x4 ps = *(const f32x4*)(PS + (size_t)r * 4);
        const float v[16] = {blo(w0.x), bhi(w0.x), blo(w0.y), bhi(w0.y), blo(w0.z), bhi(w0.z), blo(w0.w), bhi(w0.w), blo(w1.x), bhi(w1.x), blo(w1.y), bhi(w1.y), blo(w1.z), bhi(w1.z), blo(w1.w), bhi(w1.w)};
        float am = 0.f;
#pragma unroll
        for (int i = 0; i < 16; ++i) am = fmaxf(am, fabsf(v[i]));
#pragma unroll
        for (int o = 1; o < 64; o <<= 1) am = fmaxf(am, __shfl_xor(am, o));
        const float inv = am > 0.f ? 127.0f / am : 0.f;
        GAS unsigned long long* q = (GAS unsigned long long*)((signed char*)(F.ws + WS_XQ3) + (size_t)r * DM) + F.lane;
        q[0] = (unsigned long long)pk4q(v[0] * inv, v[1] * inv, v[2] * inv, v[3] * inv) | ((unsigned long long)pk4q(v[4] * inv, v[5] * inv, v[6] * inv, v[7] * inv) << 32);
        q[64] = (unsigned long long)pk4q(v[8] * inv, v[9] * inv, v[10] * inv, v[11] * inv) | ((unsigned long long)pk4q(v[12] * inv, v[13] * inv, v[14] * inv, v[15] * inv) << 32);
        if (F.lane == 0) ((float*)(F.ws + WS_RF3))[r] = __builtin_amdgcn_rsqf(((ps[0] + ps[1]) + (ps[2] + ps[3])) * (1.0f / 1024.0f) + 1e-6f) * am * (1.0f / 127.0f);
    }
}
__device__ __forceinline__ void aux_bias_i8(Frame& F) {
    const int gw = F.vcu * NWAVES + F.wave, NGW = F.G * NWAVES;
    const float* mod = (const float*)(F.ws + WS_MOD); const float* sh = mod + MOD_SH3 + 16 * F.lane; const float* SW = (const float*)(F.ws + WS_SW2);
    f32x4 s0[4], s1[4];
#pragma unroll
    for (int q = 0; q < 4; ++q) { s0[q] = *(const f32x4*)(sh + 4 * q); s1[q] = *(const f32x4*)(sh + NMOD + 4 * q); }
    float* bo = (float*)(F.ws + WS_BIAS_F2);
    for (int n = gw; n < 2 * DFF; n += NGW) {
        const v4u w = *(const GAS v4u*)((const signed char*)(F.ws + WS_WGU2) + (size_t)n * DM + 16 * F.lane);
        const unsigned ww[4] = {w.x, w.y, w.z, w.w}; float d0 = 0.f, d1 = 0.f;
#pragma unroll
        for (int q = 0; q < 4; ++q)
#pragma unroll
            for (int i = 0; i < 4; ++i) { const float wv = (float)(int)(signed char)((ww[q] >> (8 * i)) & 255u); d0 += s0[q][i] * wv; d1 += s1[q][i] * wv; }
        d0 = wave_sum(d0); d1 = wave_sum(d1);
        if (F.lane == 0) { const float sc = SW[n]; bo[n] = d0 * sc; bo[2 * DFF + n] = d1 * sc; }
    }
}
typedef attn::BlockRef<attn::bf16, attn::bf16> ABlock;
__device__ __forceinline__ ABlock attn_ref(Frame& F, int id, int& skv) {
    const int bgh = id >> 5, x = id & 31, b = bgh / 12, gh = bgh - b * 12, g = gh >> 2, d = 1 << (2 * g), nqb = 32 >> (2 * g), r = x / nqb, qb = x - r * nqb;
    ABlock R; const size_t e0 = (size_t)(b * SEQ + r) * AW + gh * 128;
    R.rs = d * AW; R.ls = d * 12; R.P0 = qb * 256; skv = SEQ / d;
    R.K = (const attn::bf16*)(F.ws + WS_K) + e0; R.V = (const attn::bf16*)(F.ws + WS_V) + e0;
    attn::bf16* q = (attn::bf16*)(F.ws + WS_Q) + e0 + (size_t)(qb * 256) * R.rs; R.Q = q; R.O = q;
    R.LSE = (float*)(F.ws + WS_LSE) + (size_t)(b * SEQ + r + qb * 256 * d) * 12 + gh;
    return R;
}
__device__ __forceinline__ void attn_phase(Frame& F, char* lds) {
    constexpr int NITEMS = 768;
    const int per = (NITEMS + F.G - 1) / F.G; int id = F.vcu * per; const int end = (id + per < NITEMS) ? id + per : NITEMS;
    if (id >= end) return;
    int skv, skvn; ABlock cur = attn_ref(F, id, skv);
    attn::Seam<attn::bf16> S;
    attn::causal_swa_prime<attn::bf16, attn::bf16>(cur, attn::WINDOW, lds, S);
    for (;;) {
        const bool last = id + 1 >= end; skvn = skv;
        const ABlock nxt = last ? cur : attn_ref(F, id + 1, skvn);
        attn::causal_swa_block<attn::bf16, attn::bf16>(cur, nxt, skv, attn::WINDOW, lds, S);
        if (last) break;
        cur = nxt; skv = skvn; ++id;
    }
}
__device__ __forceinline__ void merge_conv_pass(Frame& F, const Args& args) {
    const int gw = F.vcu * NWAVES + F.wave, NGW = F.G * NWAVES;
    { const bf16* OG = (const bf16*)(F.ws + WS_Q); const float* LSE = (const float*)(F.ws + WS_LSE); bf16* O = (bf16*)(F.ws + WS_O);
      const int h = F.lane >> 4, e = 8 * (F.lane & 15);
      for (int t = gw; t < M; t += NGW) {
          const float l0 = LSE[(size_t)t * 12 + h], l1 = LSE[(size_t)t * 12 + 4 + h], l2 = LSE[(size_t)t * 12 + 8 + h];
          const float mx = fmaxf(l0, fmaxf(l1, l2)); const float e0 = __expf(l0 - mx), e1 = __expf(l1 - mx), e2 = __expf(l2 - mx); const float inv = 1.0f / (e0 + e1 + e2);
          const float wg[3] = {e0 * inv, e1 * inv, e2 * inv};
          f32x4 a0 = {0.f, 0.f, 0.f, 0.f}, a1 = {0.f, 0.f, 0.f, 0.f};
#pragma unroll
          for (int g = 0; g < 3; ++g) { const v4u w = *(const GAS v4u*)(OG + (size_t)t * AW + (g * 4 + h) * 128 + e);
              a0 = a0 + (f32x4){blo(w.x), bhi(w.x), blo(w.y), bhi(w.y)} * wg[g]; a1 = a1 + (f32x4){blo(w.z), bhi(w.z), blo(w.w), bhi(w.w)} * wg[g]; }
          v4u o; o.x = pk2(a0.x, a0.y); o.y = pk2(a0.z, a0.w); o.z = pk2(a1.x, a1.y); o.w = pk2(a1.z, a1.w);
          *(GAS v4u*)(O + (size_t)t * 512 + 8 * F.lane) = o; } }
    { const bf16* U = (const bf16*)(F.ws + WS_U); bf16* Bv = (bf16*)(F.ws + WS_B); const bf16* Cg = (const bf16*)(F.ws + WS_C); const float* cw = args.in[I_CONVW];
      for (int it = gw; it < 2 * (M / 16); it += NGW) {
          const int ch = it & 1, t0 = (it >> 1) * 16, c0 = 512 * ch + 8 * F.lane;
          float w0[8], w1[8], w2[8], x1[8], x2[8];
#pragma unroll
          for (int i = 0; i < 8; ++i) { w0[i] = cw[c0 + i]; w1[i] = cw[DM + c0 + i]; w2[i] = cw[2 * DM + c0 + i]; x1[i] = 0.f; x2[i] = 0.f; }
          if ((t0 & (SEQ - 1)) != 0) {
#pragma unroll
              for (int p = 2; p >= 1; --p) { const v4u wu = *(const GAS v4u*)(U + (size_t)(t0 - p) * DM + c0), wc = *(const GAS v4u*)(Cg + (size_t)(t0 - p) * DM + c0);
                  const float xu[8] = {blo(wu.x), bhi(wu.x), blo(wu.y), bhi(wu.y), blo(wu.z), bhi(wu.z), blo(wu.w), bhi(wu.w)}, xc[8] = {blo(wc.x), bhi(wc.x), blo(wc.y), bhi(wc.y), blo(wc.z), bhi(wc.z), blo(wc.w), bhi(wc.w)};
#pragma unroll
                  for (int i = 0; i < 8; ++i) { if (p == 2) x2[i] = xu[i] * xc[i]; else x1[i] = xu[i] * xc[i]; } } }
#pragma unroll 4
          for (int r = 0; r < 16; ++r) { const size_t off = (size_t)(t0 + r) * DM + c0;
              const v4u wu = *(const GAS v4u*)(U + off), wc = *(const GAS v4u*)(Cg + off), wb = *(const GAS v4u*)(Bv + off);
              const float xu[8] = {blo(wu.x), bhi(wu.x), blo(wu.y), bhi(wu.y), blo(wu.z), bhi(wu.z), blo(wu.w), bhi(wu.w)}, xc[8] = {blo(wc.x), bhi(wc.x), blo(wc.y), bhi(wc.y), blo(wc.z), bhi(wc.z), blo(wc.w), bhi(wc.w)};
              const float xb[8] = {blo(wb.x), bhi(wb.x), blo(wb.y), bhi(wb.y), blo(wb.z), bhi(wb.z), blo(wb.w), bhi(wb.w)};
              float y[8];
#pragma unroll
              for (int i = 0; i < 8; ++i) { const float x0 = xu[i] * xc[i]; y[i] = xb[i] * (w0[i] * x2[i] + w1[i] * x1[i] + w2[i] * x0); x2[i] = x1[i]; x1[i] = x0; }
              v4u o; o.x = pk2(y[0], y[1]); o.y = pk2(y[2], y[3]); o.z = pk2(y[4], y[5]); o.w = pk2(y[6], y[7]);
              *(GAS v4u*)(Bv + off) = o; } } }
}


#ifdef NAIVE
template <bool DUAL, class St>
__device__ __forceinline__ void naive_gemm(Frame& F, const bf16* A, int lda, const float* W, const float* W2, int ldw, int M_, int N_, int K_, St store) {
    LAS float* As = (LAS float*)(F.lds + RING_OFF);
    LAS float* Ws = As + 64 * 33;
    LAS float* Ws2 = Ws + 32 * 68;
    const int ty = F.tid >> 4, tx = F.tid & 15, ntn = N_ / 64, ntiles = (M_ / 64) * ntn;
    for (int tile = blockIdx.x; tile < ntiles; tile += F.G) {
        const int tm = tile / ntn, tn = tile - tm * ntn;
        float acc[2][4] = {{0.f, 0.f, 0.f, 0.f}, {0.f, 0.f, 0.f, 0.f}}, acc2[2][4] = {{0.f, 0.f, 0.f, 0.f}, {0.f, 0.f, 0.f, 0.f}};
        for (int k0 = 0; k0 < K_; k0 += 32) {
            __syncthreads();
#pragma unroll
            for (int i = 0; i < 4; ++i) { const int e = F.tid + 512 * i, r = e >> 5, c = e & 31; As[r * 33 + c] = __uint_as_float((unsigned)A[(size_t)(tm * 64 + r) * lda + k0 + c] << 16); }
#pragma unroll
            for (int i = 0; i < 4; ++i) { const int e = F.tid + 512 * i, r = e >> 6, c = e & 63; Ws[r * 68 + c] = W[(size_t)(k0 + r) * ldw + tn * 64 + c]; if (DUAL) Ws2[r * 68 + c] = W2[(size_t)(k0 + r) * ldw + tn * 64 + c]; }
            __syncthreads();
#pragma unroll 8
            for (int kk = 0; kk < 32; ++kk) { const float a0 = As[(ty * 2) * 33 + kk], a1 = As[(ty * 2 + 1) * 33 + kk];
#pragma unroll
                for (int j = 0; j < 4; ++j) { const float w = Ws[kk * 68 + tx * 4 + j]; acc[0][j] += a0 * w; acc[1][j] += a1 * w;
                    if (DUAL) { const float w2 = Ws2[kk * 68 + tx * 4 + j]; acc2[0][j] += a0 * w2; acc2[1][j] += a1 * w2; } } }
        }
#pragma unroll
        for (int i = 0; i < 2; ++i)
#pragma unroll
            for (int j = 0; j < 4; ++j) store(tm * 64 + ty * 2 + i, tn * 64 + tx * 4 + j, acc[i][j], acc2[i][j]);
    }
    __syncthreads();
}
__device__ __forceinline__ bf16 f2b(float v) { return (bf16)f2bf(v); }
__device__ __forceinline__ float b2f(bf16 v) { return __uint_as_float((unsigned)v << 16); }
__device__ __forceinline__ void naive_attn(Frame& F) {
    const int gw = F.vcu * NWAVES + F.wave, NGW = F.G * NWAVES;
    bf16* Qb = (bf16*)(F.ws + WS_Q); const bf16* Kb = (const bf16*)(F.ws + WS_K); const bf16* Vb = (const bf16*)(F.ws + WS_V); float* LSE = (float*)(F.ws + WS_LSE);
    for (int it = gw; it < M * 12; it += NGW) {
        const int t = it / 12, gh = it - t * 12, g = gh >> 2, d = 1 << (2 * g), tl = t & (SEQ - 1);
        const float q0 = b2f(Qb[(size_t)t * AW + gh * 128 + 2 * F.lane]), q1 = b2f(Qb[(size_t)t * AW + gh * 128 + 2 * F.lane + 1]);
        float s0 = -INFINITY, s1 = -INFINITY, s2 = -INFINITY;
        for (int j = 0; j <= 128; ++j) { if (tl - j * d < 0) break; const size_t kr = (size_t)(t - j * d) * AW + gh * 128 + 2 * F.lane;
            const float sc = wave_sum(q0 * b2f(Kb[kr]) + q1 * b2f(Kb[kr + 1])) * 0.08838834764831845f;
            if (j < 64) { if (F.lane == j) s0 = sc; } else if (j < 128) { if (F.lane == j - 64) s1 = sc; } else { if (F.lane == 0) s2 = sc; } }
        float mx = fmaxf(s0, fmaxf(s1, s2));
#pragma unroll
        for (int o = 1; o < 64; o <<= 1) mx = fmaxf(mx, __shfl_xor(mx, o));
        const float p0 = __expf(s0 - mx), p1 = __expf(s1 - mx), p2 = __expf(s2 - mx);
        const float l = wave_sum(p0 + p1 + p2);
        float o0 = 0.f, o1 = 0.f;
        for (int j = 0; j <= 128; ++j) { if (tl - j * d < 0) break; const size_t vr = (size_t)(t - j * d) * AW + gh * 128 + 2 * F.lane;
            const float p = (j < 64) ? __shfl(p0, j) : (j < 128) ? __shfl(p1, j - 64) : __shfl(p2, 0);
            o0 += p * b2f(Vb[vr]); o1 += p * b2f(Vb[vr + 1]); }
        const float inv = 1.0f / l;
        Qb[(size_t)t * AW + gh * 128 + 2 * F.lane] = f2b(o0 * inv); Qb[(size_t)t * AW + gh * 128 + 2 * F.lane + 1] = f2b(o1 * inv);
        if (F.lane == 0) LSE[(size_t)t * 12 + gh] = mx + __logf(l);
    }
}
#endif

constexpr int N_PHASES = 17;
__global__ void __launch_bounds__(NWAVES * 64, 2) mega_fwd(Args args) {
    extern __shared__ __attribute__((aligned(16))) unsigned char lds[];
    Frame F;
    F.lds = (LAS unsigned char*)lds;
    F.MISC = (volatile LAS unsigned*)(F.lds + MISC_OFF);
    F.tid = threadIdx.x; F.lane = F.tid & 63; F.wave = __builtin_amdgcn_readfirstlane(F.tid >> 6);
    F.G = gridDim.x; { const int bx = blockIdx.x; F.vcu = (F.G % 8 == 0) ? (bx % 8) * (F.G / 8) + bx / 8 : bx; }
    F.ws = args.ws; F.out = args.out;
    F.ctl = (gu32*)(args.ws + WS_CTL);
    for (int u = F.tid; u < (LDS_BYTES - LDSCTL_OFF) / 4; u += NWAVES * 64) ((LAS unsigned*)(F.lds + LDSCTL_OFF))[u] = 0u;
    __syncthreads();
    XcdBarrier bar = xcd_barrier_post((unsigned*)(F.ctl + CW_BAR), F.MISC + 8);
    const int lo = args.ph_lo, hi = args.ph_hi;
    typedef pg8::bf16_t pb;
#define mod ((const float*)(args.ws + WS_MOD))
#define XS ((const pb*)(args.ws + WS_XS))
    unsigned char* const ws = args.ws;
#define IN(k) (lo <= (k) && (k) < hi)
#define FRESH() do { F.tid = tid_opaque(); F.lane = F.tid & 63; } while (0)
#ifdef PROBE_TA
#define TSTAMP(slot) do { if (F.tid == 0) { const unsigned long long t_ = rt(); F.MISC[16 + 2 * (slot)] = (unsigned)t_; F.MISC[17 + 2 * (slot)] = (unsigned)(t_ >> 32); } } while (0)
#define SEAM(k) do { if (IN(k) && IN((k) + 1)) xcd_barrier(bar); if ((k) == PROBE_TA) TSTAMP(0); if ((k) == PROBE_TB) TSTAMP(1); } while (0)
    if (PROBE_TA == -1) TSTAMP(0);
#else
#define SEAM(k) do { if (IN(k) && IN((k) + 1)) xcd_barrier(bar); } while (0)
#endif
#ifdef NAIVE
#define FUSE_NORM 0
#else
#define FUSE_NORM 1
#endif
#define XL ((PG8_LAS float*)(F.lds + XL_OFF))
#define PS2 ((const float*)(args.ws + WS_PS2))
#define PS3 ((const float*)(args.ws + WS_PS3))
#define bias_in ((const float*)(args.ws + WS_BIAS_IN))
#define bias_f2 ((const float*)(args.ws + WS_BIAS_F2))
#define avec ((const float*)(args.ws + WS_AVEC))
#define GEMM_BX(SCHED_DECL, SCHED_T, A_, K_, BT, N_, MODE, NRM, QKN_, O_, LDC, SPC, SPS, I1, I2, PS_, BIAS_, BSTR) do { pg8::Gemm g{(const pb*)(A_), (const pb*)(BT), M, (N_), (K_)}; SCHED_DECL; \
        typedef pg8::EpiB<MODE, (NRM), (QKN_)> EpiT; EpiT E{(pb*)(O_), (LDC), (SPC), (SPS), (const pb*)(I1), (const pb*)(I2), (PS_), (BIAS_), (BSTR), args.in[I_QN], args.in[I_KN], 2 * AW, XL, 0}; \
        pg8::gemm_phase<EpiT, SCHED_T, true, true>(F.lds + RING_OFF, g, S, E); } while (0)
#define GEMM_B(A_, K_, BT, N_, MODE, NRM, QKN_, O_, LDC, SPC, SPS, I1, I2, PS_, BIAS_, BSTR) \
        GEMM_BX(pg8::StaticOrder S; S.init(M, (N_), F.G, (int)blockIdx.x), pg8::StaticOrder, A_, K_, BT, N_, MODE, NRM, QKN_, O_, LDC, SPC, SPS, I1, I2, PS_, BIAS_, BSTR)
#define GEMM_F(XSO, A_, K_, BT, BASE, COEF, SCALE, AVEC_, PS_) do { pg8::Gemm g{(const pb*)(A_), (const pb*)(BT), M, DM, (K_)}; pg8::StaticOrder S; S.init(M, DM, F.G, (int)blockIdx.x); \
        typedef pg8::EpiF<(XSO)> EpiT; EpiT E{(BASE), F.out, (COEF), (pb*)(ws + WS_XS), (AVEC_), (float*)(PS_), XL, (SCALE)}; pg8::gemm_phase<EpiT, pg8::StaticOrder, true, true>(F.lds + RING_OFF, g, S, E); } while (0)

#define GEMM_I8(XQ_, WQ_, HASB, ROWF_, SW_, BIAS_) do { pg8::Gemm g{(const pb*)(XQ_), (const pb*)(WQ_), M, 2 * DFF, DM / 2}; pg8::StaticOrder S; S.init(M, 2 * DFF, F.G, (int)blockIdx.x);     \
        typedef pg8::EpiI8<(HASB)> EpiT; EpiT E{(pb*)(ws + WS_ACT), DFF, (ROWF_), (SW_), (BIAS_), 2 * DFF, XL, 0}; pg8::gemm_phase<EpiT, pg8::StaticOrder, true, true>(F.lds + RING_OFF, g, S, E); } while (0)
    const bool p0_split = false;
#if FUSE_NORM
    FRESH();
    if (IN(0)) { for (int it = blockIdx.x; it < ADA_ITEMS; it += F.G) p0_adaln_item(F, args, it);
                 if (p0_split && (int)blockIdx.x >= ADA_ITEMS) p0_transposes(F, args, 0, ((int)blockIdx.x - ADA_ITEMS) * NWAVES + F.wave, (256 - ADA_ITEMS) * NWAVES);
#if FFN_I8
                 if (F.G == 256 && (int)blockIdx.x >= ADA_ITEMS) wq_absmax(F, args, ((int)blockIdx.x - ADA_ITEMS) * NWAVES + F.wave, (256 - ADA_ITEMS) * NWAVES);
                 else if (F.G != 256) wq_absmax(F, args, F.vcu * NWAVES + F.wave, F.G * NWAVES);
#endif
    }
#else
    FRESH();
    if (IN(0)) { for (int it = blockIdx.x; it < ADA_ITEMS; it += F.G) p0_adaln_item(F, args, it); for (int st = 0; st < 3; ++st) p0_transposes(F, args, st, F.vcu * NWAVES + F.wave, F.G * NWAVES); }
#endif
    SEAM(0);
    FRESH();
    if (IN(1)) { norm_pass(F, args.in[I_X], args.in[I_NF1], MOD_SH1, MOD_SC1, FFN_I8 != 0); if (FUSE_NORM) { aux_avec(F, args); if (!p0_split) p0_transposes(F, args, 0, F.vcu * NWAVES + F.wave, F.G * NWAVES); } }
    SEAM(1);
#ifdef PROBE_XBAR
    xcd_barrier(bar); xcd_barrier(bar); xcd_barrier(bar); xcd_barrier(bar);
#endif
#if defined(NAIVE) && (NAIVE & 1)
    if (IN(2)) { bf16* ACT = (bf16*)(ws + WS_ACT); naive_gemm<true>(F, (const bf16*)XS, DM, args.in[I_F1G], args.in[I_F1U], DFF, M, DFF, DM, [=](int r, int c, float g, float u) { ACT[(size_t)r * DFF + c] = f2b(silu_f(g) * u); }); }
#else
#if FFN_I8
    if (IN(2)) GEMM_I8(ws + WS_XQ1, ws + WS_WGU1, false, (const float*)(ws + WS_SA1), (const float*)(ws + WS_SW1), nullptr);
#else
    if (IN(2)) GEMM_B(XS, DM, ws + WS_WGU1, 2 * DFF, pg8::EB_SWIGLU, false, false, ws + WS_ACT, DFF, 0, 0, nullptr, nullptr, nullptr, nullptr, 0);
#endif
    FRESH();
    if (FUSE_NORM && IN(2) && F.G == 256 && (int)blockIdx.x >= 128) p0_transposes(F, args, 1, ((int)blockIdx.x - 128) * NWAVES + F.wave, 128 * NWAVES);
    else if (FUSE_NORM && IN(2) && F.G != 256) p0_transposes(F, args, 1, F.vcu * NWAVES + F.wave, F.G * NWAVES);
#endif
    SEAM(2);
#if defined(NAIVE) && (NAIVE & 2)
    if (IN(3)) { const float* xb = args.in[I_X]; float* ob = F.out; naive_gemm<false>(F, (const bf16*)(ws + WS_ACT), DFF, args.in[I_F1D], nullptr, DM, M, DM, DFF, [=](int r, int c, float v, float) { ob[(size_t)r * DM + c] = xb[(size_t)r * DM + c] + 0.5f * mod[(r / SEQ) * NMOD + MOD_GT1 + c] * v; }); }
#else
    FRESH();
    if (FUSE_NORM && IN(3)) aux_bias(F, 0);
    if (IN(3)) GEMM_F(FUSE_NORM, ws + WS_ACT, DFF, ws + WS_WD1, args.in[I_X], mod + MOD_GT1, 0.5f, avec, ws + WS_PS2);
#endif
    SEAM(3);
#if !FUSE_NORM
    if (IN(4)) norm_pass(F, F.out, args.in[I_NMIX], MOD_SH2, MOD_SC2);
    SEAM(4);
#endif
#if defined(NAIVE) && (NAIVE & 4)
    if (IN(5)) { bf16* Qb = (bf16*)(ws + WS_Q); naive_gemm<false>(F, (const bf16*)XS, DM, args.in[I_WIN] + COL_Q, nullptr, INW, M, 3 * AW, DM, [=](int r, int c, float v, float) { const int t = c / AW; Qb[(size_t)t * M * AW + (size_t)r * AW + (c - t * AW)] = f2b(v); }); }
#else
    if (IN(5)) GEMM_B(XS, DM, ws + WS_WIN + (size_t)COL_Q * DM * 2, 3 * AW, pg8::EB_PLAIN, FUSE_NORM, FUSE_NORM, ws + WS_Q, AW, AW, (size_t)(WS_K - WS_Q) / 2, nullptr, nullptr, PS2, bias_in + COL_Q, INW);
    FRESH();
    if (FUSE_NORM && IN(5) && F.G == 256 && (int)blockIdx.x >= 128) p0_transposes(F, args, 2, ((int)blockIdx.x - 128) * NWAVES + F.wave, 128 * NWAVES);
    else if (FUSE_NORM && IN(5) && F.G != 256) p0_transposes(F, args, 2, F.vcu * NWAVES + F.wave, F.G * NWAVES);
#endif
    SEAM(5);
#if !FUSE_NORM
    if (IN(6)) qknorm_pass(F, args);
    SEAM(6);
#endif
#if defined(NAIVE) && (NAIVE & 8)
    if (IN(7)) naive_attn(F);
#else
    if (IN(7)) attn_phase(F, (char*)lds + RING_OFF);
#endif
    SEAM(7);
#if defined(NAIVE) && (NAIVE & 16)
    if (IN(8)) { bf16* Ub = (bf16*)(ws + WS_U); naive_gemm<false>(F, (const bf16*)XS, DM, args.in[I_WIN] + COL_U, nullptr, INW, M, 3 * DM, DM, [=](int r, int c, float v, float) { const int t = c / DM; Ub[(size_t)t * M * DM + (size_t)r * DM + (c - t * DM)] = f2b(v); }); }
#else
    if (IN(8)) GEMM_B(XS, DM, ws + WS_WIN + (size_t)COL_U * DM * 2, 3 * DM, pg8::EB_PLAIN, FUSE_NORM, false, ws + WS_U, DM, DM, (size_t)(WS_B - WS_U) / 2, nullptr, nullptr, PS2, bias_in + COL_U, INW);
#endif
    SEAM(8);
    FRESH();
    if (IN(9)) { merge_conv_pass(F, args);
#if FFN_I8
        aux_bias_i8(F);
#else
        if (FUSE_NORM) aux_bias(F, 1);
#endif
    }
    SEAM(9);
    { bf16* SGA = (bf16*)(ws + WS_SGA); bf16* SGC = (bf16*)(ws + WS_SGC); (void)SGA; (void)SGC;
#if defined(NAIVE) && (NAIVE & 32)
      if (IN(10)) naive_gemm<false>(F, (const bf16*)XS, DM, args.in[I_WIN] + COL_GA, nullptr, INW, M, DM, DM, [=](int r, int c, float v, float) { SGA[(size_t)r * DM + c] = f2b(1.0f / (1.0f + __expf(-v))); });
      if (IN(11)) naive_gemm<false>(F, (const bf16*)XS, DM, args.in[I_WIN] + COL_GC, nullptr, INW, M, DM, DM, [=](int r, int c, float v, float) { SGC[(size_t)r * DM + c] = f2b(1.0f / (1.0f + __expf(-v))); });
#else
    if (IN(10)) GEMM_BX(pg8::TwinOrder S; S.init(M, DM, F.G, (int)blockIdx.x); S.reps = 2, pg8::TwinOrder, XS, DM, ws + WS_WIN + (size_t)COL_GA * DM * 2, 2 * DM, pg8::EB_SIGMOID, FUSE_NORM, false,
                        ws + WS_SGA, DM, DM, (size_t)(WS_SGC - WS_SGA) / 2, nullptr, nullptr, PS2, bias_in + COL_GA, INW);
#endif
#ifdef NAIVE
    if (IN(11) && IN(12)) xcd_barrier(bar);
#endif
#if defined(NAIVE) && (NAIVE & 512)
      if (IN(12)) naive_gemm<false>(F, (const bf16*)(ws + WS_O), 512, args.in[I_WAB], nullptr, DM, M, DM, 512, [=](int r, int c, float v, float) { SGA[(size_t)r * DM + c] = f2b(b2f(SGA[(size_t)r * DM + c]) * v); });
#else
    if (IN(12)) GEMM_B(ws + WS_O, 512, ws + WS_WA, DM, pg8::EB_GATEMUL, false, false, ws + WS_SGA, DM, 0, 0, ws + WS_SGA, nullptr, nullptr, nullptr, 0);
#endif
#ifdef NAIVE
    if (IN(12) && IN(13)) xcd_barrier(bar);
#endif
#if defined(NAIVE) && (NAIVE & 1024)
      if (IN(13)) naive_gemm<false>(F, (const bf16*)(ws + WS_B), DM, args.in[I_WCB], nullptr, DM, M, DM, DM, [=](int r, int c, float v, float) { SGA[(size_t)r * DM + c] = f2b(b2f(SGA[(size_t)r * DM + c]) + b2f(SGC[(size_t)r * DM + c]) * v); });
#else
    if (IN(13)) GEMM_B(ws + WS_B, DM, ws + WS_WC, DM, pg8::EB_MERGE, false, false, ws + WS_SGA, DM, 0, 0, ws + WS_SGA, ws + WS_SGC, nullptr, nullptr, 0);
#endif
    }
    SEAM(13);
#if defined(NAIVE) && (NAIVE & 64)
    if (IN(14)) { float* ob = F.out; naive_gemm<false>(F, (const bf16*)(ws + WS_SGA), DM, args.in[I_WOUT], nullptr, DM, M, DM, DM, [=](int r, int c, float v, float) { ob[(size_t)r * DM + c] += mod[(r / SEQ) * NMOD + MOD_GT2 + c] * v; }); }
#else
    if (IN(14)) GEMM_F(FUSE_NORM, ws + WS_SGA, DM, ws + WS_WO, F.out, mod + MOD_GT2, 1.0f, avec + 2 * DM, ws + WS_PS3);
#endif
    SEAM(14);
#if FFN_I8
    FRESH();
    if (IN(14) && IN(16)) { xs_quant_pass(F); xcd_barrier(bar); }
#endif
#if !FUSE_NORM
    if (IN(15)) norm_pass(F, F.out, args.in[I_NF2], MOD_SH3, MOD_SC3);
    SEAM(15);
#endif
#if defined(NAIVE) && (NAIVE & 128)
    if (IN(16)) { bf16* ACT = (bf16*)(ws + WS_ACT); naive_gemm<true>(F, (const bf16*)XS, DM, args.in[I_F2G], args.in[I_F2U], DFF, M, DFF, DM, [=](int r, int c, float g, float u) { ACT[(size_t)r * DFF + c] = f2b(silu_f(g) * u); }); }
#else
#if FFN_I8
    if (IN(16)) GEMM_I8(ws + WS_XQ3, ws + WS_WGU2, true, (const float*)(ws + WS_RF3), (const float*)(ws + WS_SW2), bias_f2);
#else
    if (IN(16)) GEMM_B(XS, DM, ws + WS_WGU2, 2 * DFF, pg8::EB_SWIGLU, FUSE_NORM, false, ws + WS_ACT, DFF, 0, 0, nullptr, nullptr, PS3, bias_f2, 2 * DFF);
#endif
#endif
    SEAM(16);
#if defined(NAIVE) && (NAIVE & 256)
    if (IN(17)) { float* ob = F.out; naive_gemm<false>(F, (const bf16*)(ws + WS_ACT), DFF, args.in[I_F2D], nullptr, DM, M, DM, DFF, [=](int r, int c, float v, float) { ob[(size_t)r * DM + c] += 0.5f * mod[(r / SEQ) * NMOD + MOD_GT3 + c] * v; }); }
#else
    if (IN(17)) GEMM_F(false, ws + WS_ACT, DFF, ws + WS_WD2, F.out, mod + MOD_GT3, 0.5f, nullptr, nullptr);
#endif
#ifdef PROBE_TA
    if (PROBE_TB == 17) TSTAMP(1);
    xcd_barrier(bar);
    if (blockIdx.x == 0 && F.tid == 0) { const unsigned long long t0_ = ((unsigned long long)F.MISC[17] << 32) | F.MISC[16], t1_ = ((unsigned long long)F.MISC[19] << 32) | F.MISC[18];
#ifdef PROBE_CONST
        F.out[0] += (float)(PROBE_CONST); (void)t0_; (void)t1_; }
#else
        F.out[0] += (float)(PROBE_SCALE) * 0.01f * (float)(t1_ - t0_); }
#endif
#endif
#undef IN
#undef SEAM
#undef XL
#undef PS2
#undef PS3
#undef bias_in
#undef bias_f2
#undef avec
#undef mod
#undef XS
}

extern "C" void kernel_launch(void* const* d_in, const int* in_sizes, int n_in, void* d_out, int out_size, void* d_ws, size_t ws_size, hipStream_t stream) {
    static int grid = 0;
    if (grid == 0) {
        if (n_in != 20 || in_sizes[0] != M * DM || out_size != M * DM || ws_size < WS_END) { fprintf(stderr, "kernel_launch: shape/workspace mismatch (n_in %d, in0 %d, out %d, ws %zu < %zu)\n", n_in, n_in > 0 ? in_sizes[0] : -1, out_size, ws_size, (size_t)WS_END); grid = -1; return; }
        int dev = 0, cus = 0, per_cu = 0;
        if (hipGetDevice(&dev) != hipSuccess || hipDeviceGetAttribute(&cus, hipDeviceAttributeMultiprocessorCount, dev) != hipSuccess) { grid = -1; return; }
        if (hipFuncSetAttribute((const void*)mega_fwd, hipFuncAttributeMaxDynamicSharedMemorySize, LDS_BYTES) != hipSuccess) { fprintf(stderr, "kernel_launch: hipFuncSetAttribute failed\n"); grid = -1; return; }
        if (hipOccupancyMaxActiveBlocksPerMultiprocessor(&per_cu, (const void*)mega_fwd, NWAVES * 64, LDS_BYTES) != hipSuccess || per_cu < 1) { fprintf(stderr, "kernel_launch: occupancy query reports %d workgroups per CU\n", per_cu); }
        (void)hipGetLastError();
        grid = cus;
    }
    if (grid < 0) return;
    (void)hipMemsetAsync((char*)d_ws + WS_CTL, 0, CTL_ZERO_BYTES, stream);
#ifdef PROBE_MEMSET2
    (void)hipMemsetAsync((char*)d_ws + WS_CTL + CTL_ZERO_BYTES, 0, CTL_ZERO_BYTES, stream);
#endif
    Args a{};
    for (int i = 0; i < 20; ++i) a.in[i] = (const float*)d_in[i];
    a.out = (float*)d_out; a.ws = (unsigned char*)d_ws;
#if defined(PROBE_DUP)
    a.ph_lo = 0; a.ph_hi = PROBE_DUP + 1; hipLaunchKernelGGL(mega_fwd, dim3(grid), dim3(NWAVES * 64), LDS_BYTES, stream, a);
    (void)hipMemsetAsync((char*)d_ws + WS_CTL, 0, CTL_ZERO_BYTES, stream);
    a.ph_lo = PROBE_DUP; a.ph_hi = N_PHASES + 1; hipLaunchKernelGGL(mega_fwd, dim3(grid), dim3(NWAVES * 64), LDS_BYTES, stream, a);
#elif defined(PROBE_RLO)
    a.ph_lo = 0; a.ph_hi = PROBE_RHI + 1; hipLaunchKernelGGL(mega_fwd, dim3(grid), dim3(NWAVES * 64), LDS_BYTES, stream, a);
    (void)hipMemsetAsync((char*)d_ws + WS_CTL, 0, CTL_ZERO_BYTES, stream);
    a.ph_lo = PROBE_RLO; a.ph_hi = N_PHASES + 1; hipLaunchKernelGGL(mega_fwd, dim3(grid), dim3(NWAVES * 64), LDS_BYTES, stream, a);
#elif defined(PROBE_SPLIT)
    a.ph_lo = 0; a.ph_hi = PROBE_SPLIT + 1; hipLaunchKernelGGL(mega_fwd, dim3(grid), dim3(NWAVES * 64), LDS_BYTES, stream, a);
    (void)hipMemsetAsync((char*)d_ws + WS_CTL, 0, CTL_ZERO_BYTES, stream);
    a.ph_lo = PROBE_SPLIT + 1; a.ph_hi = N_PHASES + 1; hipLaunchKernelGGL(mega_fwd, dim3(grid), dim3(NWAVES * 64), LDS_BYTES, stream, a);
#elif !defined(MK_PER_PHASE)
    a.ph_lo = 0; a.ph_hi = N_PHASES + 1;
    hipLaunchKernelGGL(mega_fwd, dim3(grid), dim3(NWAVES * 64), LDS_BYTES, stream, a);
#else
    for (int p = 0; p <= N_PHASES; ++p) { a.ph_lo = p; a.ph_hi = p + 1; hipLaunchKernelGGL(mega_fwd, dim3(grid), dim3(NWAVES * 64), LDS_BYTES, stream, a); }
#endif
}
```

```cpp
#include <hip/hip_runtime.h>
#include <hip/hip_bf16.h>
#include <cstdio>
#include <cstdint>
#include <type_traits>

constexpr int DM = 1024, BATCH = 2, SEQ = 8192, M = BATCH * SEQ;
constexpr int DFF = 2816, NMOD = 9 * DM;
constexpr int AW = 1536;
constexpr int INW = 9728;
constexpr int COL_Q = 0, COL_K = 1536, COL_V = 3072, COL_U = 4608, COL_B = 5632, COL_C = 6656, COL_GA = 7680, COL_GC = 8704;
constexpr float EPS = 1e-6f;

__device__ __forceinline__ int tid_opaque() { int t = (int)threadIdx.x; asm volatile("" : "+v"(t)); return t; }

namespace pg8 {
#define PG8_LAS __attribute__((address_space(3)))
typedef unsigned short bf16_t;
typedef short bf16x8 __attribute__((ext_vector_type(8)));
typedef float f32x4 __attribute__((ext_vector_type(4)));
typedef unsigned u32x4 __attribute__((ext_vector_type(4)));
typedef int i32x4 __attribute__((ext_vector_type(4)));
template <bool I8> __device__ __forceinline__ auto pg8_mma(bf16x8 b, bf16x8 a, typename std::conditional<I8, i32x4, f32x4>::type c) {
    if constexpr (I8) return __builtin_amdgcn_mfma_i32_16x16x64_i8(__builtin_bit_cast(i32x4, b), __builtin_bit_cast(i32x4, a), c, 0, 0, 0);
    else return __builtin_amdgcn_mfma_f32_16x16x32_bf16(b, a, c, 0, 0, 0);
}
constexpr int BM = 256, BK = 64, HALF = 128, HTB = HALF * BK * 2  , STAGE_BYTES = 8 * HTB, NXCD = 8, WGM = 8;

__host__ __device__ __forceinline__ int lds_byte(int r, int c) { const int st = (r >> 4) * 2 + (c >> 5), rr = r & 15, cc = c & 31, ob = rr * 64 + cc * 2; return st * 1024 + (ob ^ (((ob >> 9) & 1) << 5)); }
__host__ __device__ __forceinline__ void stage_rc(int b, int& R, int& C) { const int st = b / 1024, sb = b % 1024, swz = sb ^ (((sb >> 9) & 1) << 5); R = (st >> 1) * 16 + swz / 64; C = (st & 1) * 32 + (swz % 64) / 2; }
__host__ __device__ __forceinline__ int perm32(int rho) { const int n = rho >> 4, i = rho & 15; return 8 * (i >> 2) + 4 * n + (i & 3); }

struct Unit { int pm, pn; };
struct Gemm { const bf16_t* A; const bf16_t* Bt; int M, N, K; };

struct StaticOrder {
    int nM, nN, nwg, G, c;
    __host__ __device__ void init(int M, int N, int G_, int c_) { nM = M / BM; nN = N / BM; nwg = nM * nN; G = G_; c = c_; }
    __host__ __device__ bool next(int i, Unit& u) const {
        const long L = (long)i * G + c; if (L >= nwg) return false;
        int wgid = (int)L; { const int q = nwg / NXCD, r = nwg % NXCD, xcd = wgid % NXCD, off = wgid / NXCD; wgid = (xcd < r ? xcd * (q + 1) : r * (q + 1) + (xcd - r) * q) + off; }
        const int nig = WGM * nN, gid = wgid / nig, fm = gid * WGM, gsz = (nM - fm) < WGM ? (nM - fm) : WGM;
        u.pm = fm + ((wgid % nig) % gsz); u.pn = (wgid % nig) / gsz; return true;
    }
    __device__ __forceinline__ void a_ready(const Unit&) const {}
    __device__ __forceinline__ void done(const Unit&) const {}
};

typedef float f32x2_t __attribute__((ext_vector_type(2))); typedef __bf16 bf16x2_t __attribute__((ext_vector_type(2)));
__device__ __forceinline__ unsigned cvt_pk_bf16(float lo, float hi) { f32x2_t v = {lo, hi}; bf16x2_t b = __builtin_convertvector(v, bf16x2_t); return __builtin_bit_cast(unsigned, b); }
__device__ __forceinline__ float bf_lo(unsigned w) { return __uint_as_float(w << 16); }
__device__ __forceinline__ float bf_hi(unsigned w) { return __uint_as_float(w & 0xffff0000u); }
__device__ __forceinline__ float sigmoidf_(float x) { return __builtin_amdgcn_rcpf(1.0f + __builtin_amdgcn_exp2f(-1.4426950408889634f * x)); }
__device__ __forceinline__ void unpack8(const u32x4 w, f32x4& a, f32x4& b) { a = (f32x4){bf_lo(w.x), bf_hi(w.x), bf_lo(w.y), bf_hi(w.y)}; b = (f32x4){bf_lo(w.z), bf_hi(w.z), bf_lo(w.w), bf_hi(w.w)}; }
__device__ __forceinline__ u32x4 pack8(const f32x4 a, const f32x4 b) { u32x4 w; w.x = cvt_pk_bf16(a[0], a[1]); w.y = cvt_pk_bf16(a[2], a[3]); w.z = cvt_pk_bf16(b[0], b[1]); w.w = cvt_pk_bf16(b[2], b[3]); return w; }

enum { EB_PLAIN = 0, EB_SWIGLU = 1, EB_SIGMOID = 2, EB_GATEMUL = 3, EB_MERGE = 4 };
template <int mode, bool NORMED = false, bool QKN = false> struct EpiB {
    static constexpr bool PERM = true, AFTER_DRAIN = false, PREFETCH = NORMED, I8 = false; typedef f32x4 acc_t;
    bf16_t* O; int ldc; int split_cols; size_t split_stride; const bf16_t* In1; const bf16_t* In2;
    const float* PS; const float* bias; int bias_bstride; const float* gamma_q; const float* gamma_k; int qk_cols; PG8_LAS float* XL; int par;
    __device__ __forceinline__ void prefetch(const Unit& u, int wid, int buf) const {
        if (NORMED && wid < 4) { const int lane = threadIdx.x & 63; PG8_LAS unsigned char* X2 = (PG8_LAS unsigned char*)(XL + 2048) + buf * 5120;
            __builtin_amdgcn_global_load_lds((const unsigned*)(PS + (size_t)(u.pm * BM + wid * 64 + lane) * 4), (PG8_LAS unsigned*)(X2 + wid * 1024), 16, 0, 0);
            if (wid == 0) __builtin_amdgcn_global_load_lds((const unsigned*)(bias + (size_t)((u.pm * BM) / SEQ) * bias_bstride + u.pn * BM + lane * 4), (PG8_LAS unsigned*)(X2 + 4096), 16, 0, 0); }
    }
    __device__ __forceinline__ void operator()(f32x4 (&acc)[2][2][4][2], const Unit& u, int wr, int wc, int fr, int fq) const {
        const int row0 = u.pm * BM + wr * 64 + fr;
        if (NORMED) {
            const PG8_LAS float* X2 = XL + 2048 + par * 1280;
            f32x4 bv[2][2];
#pragma unroll
            for (int bj = 0; bj < 2; ++bj)
#pragma unroll
                for (int n = 0; n < 2; ++n) bv[bj][n] = *(const PG8_LAS f32x4*)(X2 + 1024 + bj * HALF + wc * 32 + 8 * fq + 4 * n);
#pragma unroll
            for (int ai = 0; ai < 2; ++ai)
#pragma unroll
                for (int m = 0; m < 4; ++m) { const f32x4 p = *(const PG8_LAS f32x4*)(X2 + (ai * HALF + wr * 64 + m * 16 + fr) * 4);
                    const float rstd = __builtin_amdgcn_rsqf(((p[0] + p[1]) + (p[2] + p[3])) * (1.0f / 1024.0f) + 1e-6f);
#pragma unroll
                    for (int bj = 0; bj < 2; ++bj)
#pragma unroll
                        for (int n = 0; n < 2; ++n) acc[ai][bj][m][n] = acc[ai][bj][m][n] * rstd + bv[bj][n]; }
        }
        if (mode == EB_SWIGLU) {
            const int col0 = u.pn * HALF + wc * 32 + 8 * fq;
#pragma unroll
            for (int ai = 0; ai < 2; ++ai)
#pragma unroll
                for (int m = 0; m < 4; ++m) { bf16_t* rowp = O + (size_t)(row0 + ai * HALF + m * 16) * ldc + col0;
                    f32x4 v0, v1;
#pragma unroll
                    for (int i = 0; i < 4; ++i) { const float g0 = acc[ai][0][m][0][i], g1 = acc[ai][0][m][1][i];
                        v0[i] = g0 * sigmoidf_(g0) * acc[ai][1][m][0][i]; v1[i] = g1 * sigmoidf_(g1) * acc[ai][1][m][1][i]; }
                    *(u32x4*)rowp = pack8(v0, v1); }
            return;
        }
        int colt = u.pn * BM; size_t boff = 0;
        if (QKN && colt < qk_cols) {
            PG8_LAS float* P = XL;
#pragma unroll
            for (int ai = 0; ai < 2; ++ai)
#pragma unroll
                for (int m = 0; m < 4; ++m)
#pragma unroll
                    for (int bj = 0; bj < 2; ++bj) { const f32x4 a = acc[ai][bj][m][0], b = acc[ai][bj][m][1];
                        float s = ((a[0] * a[0] + a[1] * a[1]) + (a[2] * a[2] + a[3] * a[3])) + ((b[0] * b[0] + b[1] * b[1]) + (b[2] * b[2] + b[3] * b[3]));
                        s += __shfl_xor(s, 16); s += __shfl_xor(s, 32);
                        if (fq == 0) P[((ai * HALF + wr * 64 + m * 16 + fr) * 2 + bj) * 4 + wc] = s; }
            asm volatile("s_waitcnt lgkmcnt(0)" ::: "memory"); __builtin_amdgcn_s_barrier(); asm volatile("" ::: "memory");
            const float* gm = (colt < (qk_cols >> 1) ? gamma_q : gamma_k) + wc * 32 + 8 * fq;
            const f32x4 g0 = *(const f32x4*)gm, g1 = *(const f32x4*)(gm + 4);
#pragma unroll
            for (int ai = 0; ai < 2; ++ai)
#pragma unroll
                for (int m = 0; m < 4; ++m)
#pragma unroll
                    for (int bj = 0; bj < 2; ++bj) { const f32x4 p = *(const PG8_LAS f32x4*)(P + ((ai * HALF + wr * 64 + m * 16 + fr) * 2 + bj) * 4);
                        const float r = __builtin_amdgcn_rsqf(((p[0] + p[1]) + (p[2] + p[3])) * (1.0f / 128.0f) + 1e-6f);
                        acc[ai][bj][m][0] = acc[ai][bj][m][0] * r * g0; acc[ai][bj][m][1] = acc[ai][bj][m][1] * r * g1; }
        }
        if (split_cols) { const int t = colt / split_cols; boff = (size_t)t * split_stride; colt -= t * split_cols; }
        const int col0 = colt + wc * 32 + 8 * fq;
#pragma unroll
        for (int ai = 0; ai < 2; ++ai)
#pragma unroll
            for (int m = 0; m < 4; ++m) { const size_t roff = boff + (size_t)(row0 + ai * HALF + m * 16) * ldc + col0;
#pragma unroll
                for (int bj = 0; bj < 2; ++bj) { const size_t off = roff + bj * HALF; f32x4 v0 = acc[ai][bj][m][0], v1 = acc[ai][bj][m][1];
                    if (mode == EB_SIGMOID) {
#pragma unroll
                        for (int i = 0; i < 4; ++i) { v0[i] = sigmoidf_(v0[i]); v1[i] = sigmoidf_(v1[i]); }
                    } else if (mode == EB_GATEMUL) { f32x4 a0, a1; unpack8(*(const u32x4*)(In1 + off), a0, a1); v0 = v0 * a0; v1 = v1 * a1; }
                    else if (mode == EB_MERGE) { f32x4 a0, a1, g0, g1; unpack8(*(const u32x4*)(In1 + off), a0, a1); unpack8(*(const u32x4*)(In2 + off), g0, g1); v0 = a0 + g0 * v0; v1 = a1 + g1 * v1; }
                    *(u32x4*)(O + off) = pack8(v0, v1); } }
    }
};
template <bool HASBIAS> struct EpiI8 {
    static constexpr bool PERM = true, AFTER_DRAIN = false, PREFETCH = true, I8 = true; typedef i32x4 acc_t;
    bf16_t* O; int ldc; const float* rowf; const float* sw; const float* bias; int bias_bstride; PG8_LAS float* XL; int par;
    __device__ __forceinline__ void prefetch(const Unit& u, int wid, int buf) const {
        if (wid < 3) { const int lane = threadIdx.x & 63; PG8_LAS unsigned char* X2 = (PG8_LAS unsigned char*)(XL + 2048) + buf * 5120;
            if (wid == 0) __builtin_amdgcn_global_load_lds((const unsigned*)(rowf + (size_t)u.pm * BM + lane * 4), (PG8_LAS unsigned*)(X2), 16, 0, 0);
            else if (wid == 1) __builtin_amdgcn_global_load_lds((const unsigned*)(sw + (size_t)u.pn * BM + lane * 4), (PG8_LAS unsigned*)(X2 + 1024), 16, 0, 0);
            else if (HASBIAS) __builtin_amdgcn_global_load_lds((const unsigned*)(bias + (size_t)((u.pm * BM) / SEQ) * bias_bstride + u.pn * BM + lane * 4), (PG8_LAS unsigned*)(X2 + 2048), 16, 0, 0); }
    }
    __device__ __forceinline__ void operator()(acc_t (&acc)[2][2][4][2], const Unit& u, int wr, int wc, int fr, int fq) const {
        const int row0 = u.pm * BM + wr * 64 + fr, col0 = u.pn * HALF + wc * 32 + 8 * fq;
        const PG8_LAS float* X2 = XL + 2048 + par * 1280;
        f32x4 sv[2][2], bv[2][2];
#pragma unroll
        for (int bj = 0; bj < 2; ++bj)
#pragma unroll
            for (int n = 0; n < 2; ++n) { sv[bj][n] = *(const PG8_LAS f32x4*)(X2 + 256 + bj * HALF + wc * 32 + 8 * fq + 4 * n);
                bv[bj][n] = HASBIAS ? *(const PG8_LAS f32x4*)(X2 + 512 + bj * HALF + wc * 32 + 8 * fq + 4 * n) : (f32x4){0.f, 0.f, 0.f, 0.f}; }
#pragma unroll
        for (int ai = 0; ai < 2; ++ai)
#pragma unroll
            for (int m = 0; m < 4; ++m) { const float rf = X2[ai * HALF + wr * 64 + m * 16 + fr]; bf16_t* rowp = O + (size_t)(row0 + ai * HALF + m * 16) * ldc + col0;
                f32x4 v0, v1;
#pragma unroll
                for (int i = 0; i < 4; ++i) {
                    const float g0 = (float)acc[ai][0][m][0][i] * rf * sv[0][0][i] + bv[0][0][i], g1 = (float)acc[ai][0][m][1][i] * rf * sv[0][1][i] + bv[0][1][i];
                    const float u0 = (float)acc[ai][1][m][0][i] * rf * sv[1][0][i] + bv[1][0][i], u1 = (float)acc[ai][1][m][1][i] * rf * sv[1][1][i] + bv[1][1][i];
                    v0[i] = g0 * sigmoidf_(g0) * u0; v1[i] = g1 * sigmoidf_(g1) * u1; }
                *(u32x4*)rowp = pack8(v0, v1); }
    }
};
struct EpiQ8 {
    static constexpr bool PERM = true, AFTER_DRAIN = false, PREFETCH = true, I8 = true; typedef i32x4 acc_t;
    bf16_t* O; int ldc; int split_cols; size_t split_stride; const float* rowf; const float* sw; const float* bias; int bias_bstride; const float* gamma_q; const float* gamma_k; int qk_cols; PG8_LAS float* XL; int par;
    __device__ __forceinline__ void prefetch(const Unit& u, int wid, int buf) const {
        if (wid < 3) { const int lane = threadIdx.x & 63; PG8_LAS unsigned char* X2 = (PG8_LAS unsigned char*)(XL + 2048) + buf * 5120;
            if (wid == 0) __builtin_amdgcn_global_load_lds((const unsigned*)(rowf + (size_t)u.pm * BM + lane * 4), (PG8_LAS unsigned*)(X2), 16, 0, 0);
            else if (wid == 1) __builtin_amdgcn_global_load_lds((const unsigned*)(sw + (size_t)u.pn * BM + lane * 4), (PG8_LAS unsigned*)(X2 + 1024), 16, 0, 0);
            else __builtin_amdgcn_global_load_lds((const unsigned*)(bias + (size_t)((u.pm * BM) / SEQ) * bias_bstride + u.pn * BM + lane * 4), (PG8_LAS unsigned*)(X2 + 2048), 16, 0, 0); }
    }
    __device__ __forceinline__ void operator()(acc_t (&acc)[2][2][4][2], const Unit& u, int wr, int wc, int fr, int fq) const {
        const int row0 = u.pm * BM + wr * 64 + fr;
        const PG8_LAS float* X2 = XL + 2048 + par * 1280;
        f32x4 sv[2][2], bv[2][2], v[2][2][4][2];
#pragma unroll
        for (int bj = 0; bj < 2; ++bj)
#pragma unroll
            for (int n = 0; n < 2; ++n) { sv[bj][n] = *(const PG8_LAS f32x4*)(X2 + 256 + bj * HALF + wc * 32 + 8 * fq + 4 * n); bv[bj][n] = *(const PG8_LAS f32x4*)(X2 + 512 + bj * HALF + wc * 32 + 8 * fq + 4 * n); }
#pragma unroll
        for (int ai = 0; ai < 2; ++ai)
#pragma unroll
            for (int m = 0; m < 4; ++m) { const float rf = X2[ai * HALF + wr * 64 + m * 16 + fr];
#pragma unroll
                for (int bj = 0; bj < 2; ++bj)
#pragma unroll
                    for (int n = 0; n < 2; ++n)
#pragma unroll
                        for (int i = 0; i < 4; ++i) v[ai][bj][m][n][i] = (float)acc[ai][bj][m][n][i] * rf * sv[bj][n][i] + bv[bj][n][i]; }
        int colt = u.pn * BM; size_t boff = 0;
        if (colt < qk_cols) {
            PG8_LAS float* P = XL;
#pragma unroll
            for (int ai = 0; ai < 2; ++ai)
#pragma unroll
                for (int m = 0; m < 4; ++m)
#pragma unroll
                    for (int bj = 0; bj < 2; ++bj) { const f32x4 a = v[ai][bj][m][0], b = v[ai][bj][m][1];
                        float s = ((a[0] * a[0] + a[1] * a[1]) + (a[2] * a[2] + a[3] * a[3])) + ((b[0] * b[0] + b[1] * b[1]) + (b[2] * b[2] + b[3] * b[3]));
                        s += __shfl_xor(s, 16); s += __shfl_xor(s, 32);
                        if (fq == 0) P[((ai * HALF + wr * 64 + m * 16 + fr) * 2 + bj) * 4 + wc] = s; }
            asm volatile("s_waitcnt lgkmcnt(0)" ::: "memory"); __builtin_amdgcn_s_barrier(); asm volatile("" ::: "memory");
            const float* gm = (colt < (qk_cols >> 1) ? gamma_q : gamma_k) + wc * 32 + 8 * fq;
            const f32x4 g0 = *(const f32x4*)gm, g1 = *(const f32x4*)(gm + 4);
#pragma unroll
            for (int ai = 0; ai < 2; ++ai)
#pragma unroll
                for (int m = 0; m < 4; ++m)
#pragma unroll
                    for (int bj = 0; bj < 2; ++bj) { const f32x4 p = *(const PG8_LAS f32x4*)(P + ((ai * HALF + wr * 64 + m * 16 + fr) * 2 + bj) * 4);
                        const float r = __builtin_amdgcn_rsqf(((p[0] + p[1]) + (p[2] + p[3])) * (1.0f / 128.0f) + 1e-6f);
                        v[ai][bj][m][0] = v[ai][bj][m][0] * r * g0; v[ai][bj][m][1] = v[ai][bj][m][1] * r * g1; }
        }
        if (split_cols) { const int t = colt / split_cols; boff = (size_t)t * split_stride; colt -= t * split_cols; }
        const int col0 = colt + wc * 32 + 8 * fq;
#pragma unroll
        for (int ai = 0; ai < 2; ++ai)
#pragma unroll
            for (int m = 0; m < 4; ++m) { const size_t roff = boff + (size_t)(row0 + ai * HALF + m * 16) * ldc + col0;
#pragma unroll
                for (int bj = 0; bj < 2; ++bj) *(u32x4*)(O + roff + bj * HALF) = pack8(v[ai][bj][m][0], v[ai][bj][m][1]); }
    }
};
template <bool XSOUT = false> struct EpiF {
    static constexpr bool I8 = false; typedef f32x4 acc_t;
    static constexpr bool PERM = true, AFTER_DRAIN = false, PREFETCH = false;
    const float* base; float* out; const float* coef; bf16_t* XS; const float* avec; float* PS; PG8_LAS float* XL; float scale;
    __device__ __forceinline__ void operator()(f32x4 (&acc)[2][2][4][2], const Unit& u, int wr, int wc, int fr, int fq) const {
        const int row0 = u.pm * BM + wr * 64 + fr, col0 = u.pn * BM + wc * 32 + 8 * fq, bt = (u.pm * BM) / SEQ;
        const float* cf = coef + (size_t)bt * NMOD + col0;
        f32x4 cv[2][2], av[2][2];
#pragma unroll
        for (int bj = 0; bj < 2; ++bj)
#pragma unroll
            for (int n = 0; n < 2; ++n) { cv[bj][n] = *(const f32x4*)(cf + bj * HALF + n * 4) * scale; if (XSOUT) av[bj][n] = *(const f32x4*)(avec + bt * DM + col0 + bj * HALF + n * 4); }
        PG8_LAS float* P = XL;
        f32x4 pre[2][2][2];
#define EPIF_LOAD(slot, q) do { const size_t off_ = (size_t)(row0 + ((q) >> 2) * HALF + ((q) & 3) * 16) * DM + col0; \
            _Pragma("unroll") for (int bj = 0; bj < 2; ++bj) _Pragma("unroll") for (int n = 0; n < 2; ++n) pre[slot][bj][n] = *(const f32x4*)(base + off_ + bj * HALF + n * 4); } while (0)
#define EPIF_DO(slot, q) do { const int ai = (q) >> 2, m = (q) & 3; const size_t off = (size_t)(row0 + ai * HALF + m * 16) * DM + col0; float ss = 0.f; \
            _Pragma("unroll") for (int bj = 0; bj < 2; ++bj) { const f32x4 o0 = pre[slot][bj][0] + cv[bj][0] * acc[ai][bj][m][0], o1 = pre[slot][bj][1] + cv[bj][1] * acc[ai][bj][m][1]; \
                *(f32x4*)(out + off + bj * HALF) = o0; *(f32x4*)(out + off + bj * HALF + 4) = o1; \
                if (XSOUT) { ss += ((o0[0] * o0[0] + o0[1] * o0[1]) + (o0[2] * o0[2] + o0[3] * o0[3])) + ((o1[0] * o1[0] + o1[1] * o1[1]) + (o1[2] * o1[2] + o1[3] * o1[3])); \
                    *(u32x4*)(XS + off + bj * HALF) = pack8(o0 * av[bj][0], o1 * av[bj][1]); } } \
            if (XSOUT) { ss += __shfl_xor(ss, 16); ss += __shfl_xor(ss, 32); if (fq == 0) P[(ai * HALF + wr * 64 + m * 16 + fr) * 4 + wc] = ss; } } while (0)
        EPIF_LOAD(0, 0); EPIF_LOAD(1, 1);
        EPIF_DO(0, 0); EPIF_LOAD(0, 2); EPIF_DO(1, 1); EPIF_LOAD(1, 3); EPIF_DO(0, 2); EPIF_LOAD(0, 4); EPIF_DO(1, 3); EPIF_LOAD(1, 5);
        EPIF_DO(0, 4); EPIF_LOAD(0, 6); EPIF_DO(1, 5); EPIF_LOAD(1, 7); EPIF_DO(0, 6); EPIF_DO(1, 7);
#undef EPIF_LOAD
#undef EPIF_DO
        if (XSOUT) {
            asm volatile("s_waitcnt lgkmcnt(0)" ::: "memory"); __builtin_amdgcn_s_barrier(); asm volatile("" ::: "memory");
            const int tid = threadIdx.x;
            if (tid < BM) { const f32x4 p = *(const PG8_LAS f32x4*)(P + tid * 4); PS[(size_t)(u.pm * BM + tid) * 4 + u.pn] = (p[0] + p[1]) + (p[2] + p[3]); }
        }
    }
};

struct TwinOrder : StaticOrder {
    int reps;
    __device__ bool next(int i, Unit& u) const { if (i >= reps) return false; if (!StaticOrder::next(0, u)) return false; u.pn += 4 * i; return true; }
};
template <class Epi, class Sched, bool ALIGN_EPI = false, bool SP2 = false>
__device__ __forceinline__ void gemm_phase(PG8_LAS unsigned char* lds, const Gemm g, const Sched& S, Epi E) {
    const int tid = tid_opaque(), wid = __builtin_amdgcn_readfirstlane(tid >> 6), lane = tid & 63, wr = wid >> 2, wc = wid & 3, fr = lane & 15, fq = lane >> 4;
    const int K = g.K, nt = K / BK;
    unsigned voffA[2], voffB[2];
#pragma unroll
    for (int i = 0; i < 2; ++i) { int R, C; stage_rc(tid * 16 + i * 8192, R, C); const int Rb = Epi::PERM ? ((R & ~31) + perm32(R & 31)) : R;
        voffA[i] = (unsigned)(R * K + C) * 2u; voffB[i] = (unsigned)(Rb * K + C) * 2u; }
    const size_t kstep = (size_t)(BK * 2);
    const size_t hstep = (size_t)HALF * K * 2;
    const size_t tstep = 2 * hstep;
    const unsigned ldsw = (unsigned)wid * 1024u;
    const int aoff = lds_byte(wr * 64 + fr, fq * 8), boff = lds_byte(wc * 32 + fr, fq * 8);
#define PG8_SA(b, h) (((b) * 2 + (h)) * HTB)
#define PG8_SB(b, h) ((4 + (b) * 2 + (h)) * HTB)
#define PG8_STAGE(bufoff, gbase, voff) do { _Pragma("unroll") for (int _i = 0; _i < 2; ++_i) \
        __builtin_amdgcn_global_load_lds((const unsigned*)((const char*)(gbase) + (voff)[_i]), (PG8_LAS unsigned*)(lds + (bufoff) + ldsw + _i * 8192), 16, 0, 0); } while (0)
#define PG8_LDA(dst, b, h) do { _Pragma("unroll") for (int m = 0; m < 4; ++m) _Pragma("unroll") for (int k = 0; k < 2; ++k) dst[m][k] = *(const PG8_LAS bf16x8*)(lds + PG8_SA(b, h) + aoff + m * 2048 + k * 1024); } while (0)
#define PG8_LDB(dst, b, h) do { _Pragma("unroll") for (int n = 0; n < 2; ++n) _Pragma("unroll") for (int k = 0; k < 2; ++k) dst[n][k] = *(const PG8_LAS bf16x8*)(lds + PG8_SB(b, h) + boff + n * 2048 + k * 1024); } while (0)
#define PG8_MMA(ai, bj, At, Bt) do { __builtin_amdgcn_s_setprio(1); _Pragma("unroll") for (int m = 0; m < 4; ++m) _Pragma("unroll") for (int n = 0; n < 2; ++n) _Pragma("unroll") for (int k = 0; k < 2; ++k) \
        acc[ai][bj][m][n] = pg8_mma<Epi::I8>(Bt[n][k], At[m][k], acc[ai][bj][m][n]); __builtin_amdgcn_s_setprio(0); } while (0)
#define PG8_WAIT_V(n) asm volatile("s_waitcnt vmcnt(" #n ")" ::: "memory")
#define PG8_WAIT_L(n) asm volatile("s_waitcnt lgkmcnt(" #n ")" ::: "memory")
#define PG8_BAR __builtin_amdgcn_s_barrier()
#define PG8_SCHED __builtin_amdgcn_sched_barrier(0)
    Unit cur, nxt; int ui = 0;
    if (!S.next(0, cur)) return;
    typedef typename Epi::acc_t acc_t;
    acc_t acc[2][2][4][2];
#pragma unroll
    for (int a = 0; a < 2; ++a)
#pragma unroll
        for (int b = 0; b < 2; ++b)
#pragma unroll
            for (int m = 0; m < 4; ++m)
#pragma unroll
                for (int n = 0; n < 2; ++n) acc[a][b][m][n] = acc_t{};
    bf16x8 At[4][2], B0[2][2], B1[2][2];
    const char* cA = (const char*)g.A + (size_t)cur.pm * tstep; const char* cB = (const char*)g.Bt + (size_t)cur.pn * tstep;
    S.a_ready(cur);
    if constexpr (Epi::PREFETCH) E.prefetch(cur, wid, 0);
    if constexpr (SP2) {
        PG8_STAGE(PG8_SB(0, 0), cB, voffB); PG8_STAGE(PG8_SB(0, 1), cB + hstep, voffB); PG8_STAGE(PG8_SA(0, 0), cA, voffA); PG8_STAGE(PG8_SA(0, 1), cA + hstep, voffA);
        if (wr == 1) PG8_BAR;
        PG8_WAIT_V(2); PG8_BAR;
        PG8_STAGE(PG8_SB(1, 0), cB + kstep, voffB); PG8_STAGE(PG8_SA(1, 0), cA + kstep, voffA); PG8_STAGE(PG8_SB(1, 1), cB + hstep + kstep, voffB);
        PG8_WAIT_V(6); PG8_BAR;
    } else {
        PG8_STAGE(PG8_SB(0, 0), cB, voffB); PG8_STAGE(PG8_SA(0, 0), cA, voffA); PG8_STAGE(PG8_SB(0, 1), cB + hstep, voffB); PG8_STAGE(PG8_SA(0, 1), cA + hstep, voffA);
        if (wr == 1) PG8_BAR;
        PG8_WAIT_V(4); PG8_BAR;
        PG8_STAGE(PG8_SB(1, 0), cB + kstep, voffB); PG8_STAGE(PG8_SA(1, 0), cA + kstep, voffA); PG8_STAGE(PG8_SB(1, 1), cB + hstep + kstep, voffB);
        PG8_WAIT_V(6); PG8_BAR;
    }
    for (;;) {
        const bool has_next = S.next(ui + 1, nxt);
        const char* nA = has_next ? (const char*)g.A + (size_t)nxt.pm * tstep : cA; const char* nB = has_next ? (const char*)g.Bt + (size_t)nxt.pn * tstep : cB;
        for (int t = 0; t < nt; t += 2) {
            const bool last = (t == nt - 2);
            const char* a1 = cA + (size_t)(t + 1) * kstep;
            const char* a2 = last ? nA : cA + (size_t)(t + 2) * kstep; const char* b2 = last ? nB : cB + (size_t)(t + 2) * kstep;
            const char* a3 = a2 + kstep; const char* b3 = b2 + kstep;
            if (last && has_next) S.a_ready(nxt);
            if constexpr (SP2) {
            PG8_LDB(B0, 0, 0); PG8_LDB(B1, 0, 1); PG8_SCHED; PG8_LDA(At, 0, 0); PG8_STAGE(PG8_SA(1, 1), a1 + hstep, voffA);
            PG8_WAIT_V(8); PG8_WAIT_L(0); PG8_BAR; PG8_MMA(0, 0, At, B0); PG8_MMA(0, 1, At, B1); PG8_BAR; PG8_SCHED;
            PG8_LDA(At, 0, 1); PG8_STAGE(PG8_SB(0, 0), b2, voffB); PG8_STAGE(PG8_SB(0, 1), b2 + hstep, voffB); PG8_STAGE(PG8_SA(0, 0), a2, voffA);
            PG8_WAIT_V(8); PG8_WAIT_L(0); PG8_BAR; PG8_MMA(1, 0, At, B0); PG8_MMA(1, 1, At, B1); PG8_BAR; PG8_SCHED;
            PG8_LDB(B0, 1, 0); PG8_LDB(B1, 1, 1); PG8_SCHED; PG8_LDA(At, 1, 0); PG8_STAGE(PG8_SA(0, 1), a2 + hstep, voffA);
            PG8_WAIT_V(8); PG8_WAIT_L(0); PG8_BAR; PG8_MMA(0, 0, At, B0); PG8_MMA(0, 1, At, B1); PG8_BAR; PG8_SCHED;
            PG8_LDA(At, 1, 1); PG8_STAGE(PG8_SB(1, 0), b3, voffB); PG8_STAGE(PG8_SB(1, 1), b3 + hstep, voffB); PG8_STAGE(PG8_SA(1, 0), a3, voffA);
            PG8_WAIT_V(8); PG8_WAIT_L(0); PG8_BAR; PG8_MMA(1, 0, At, B0); PG8_MMA(1, 1, At, B1); PG8_BAR; PG8_SCHED;
            } else {
            PG8_LDB(B0, 0, 0); PG8_SCHED; PG8_LDA(At, 0, 0); PG8_STAGE(PG8_SA(1, 1), a1 + hstep, voffA);
            PG8_WAIT_L(8); PG8_BAR; PG8_WAIT_L(0); PG8_MMA(0, 0, At, B0); PG8_BAR; PG8_SCHED;
            PG8_LDB(B1, 0, 1); PG8_STAGE(PG8_SB(0, 0), b2, voffB);
            PG8_BAR; PG8_WAIT_L(0); PG8_MMA(0, 1, At, B1); PG8_BAR;
            PG8_LDA(At, 0, 1); PG8_STAGE(PG8_SA(0, 0), a2, voffA);
            PG8_BAR; PG8_WAIT_L(0); PG8_MMA(1, 0, At, B0); PG8_BAR; PG8_SCHED;
            PG8_STAGE(PG8_SB(0, 1), b2 + hstep, voffB);
            PG8_WAIT_V(6); PG8_BAR; PG8_MMA(1, 1, At, B1); PG8_BAR;
            PG8_LDB(B0, 1, 0); PG8_SCHED; PG8_LDA(At, 1, 0); PG8_STAGE(PG8_SA(0, 1), a2 + hstep, voffA);
            PG8_WAIT_L(8); PG8_BAR; PG8_WAIT_L(0); PG8_MMA(0, 0, At, B0); PG8_BAR; PG8_SCHED;
            PG8_LDB(B1, 1, 1); PG8_STAGE(PG8_SB(1, 0), b3, voffB);
            PG8_BAR; PG8_WAIT_L(0); PG8_MMA(0, 1, At, B1); PG8_BAR;
            PG8_LDA(At, 1, 1); PG8_STAGE(PG8_SA(1, 0), a3, voffA);
            PG8_BAR; PG8_WAIT_L(0); PG8_MMA(1, 0, At, B0); PG8_BAR; PG8_SCHED;
            PG8_STAGE(PG8_SB(1, 1), b3 + hstep, voffB);
            PG8_WAIT_V(6); PG8_BAR; PG8_MMA(1, 1, At, B1); PG8_BAR;
            }
        }
        if constexpr (ALIGN_EPI) { if (wr == 0) PG8_BAR; }
        if constexpr (!Epi::AFTER_DRAIN) { if constexpr (Epi::PREFETCH) { E.par = ui & 1; } E(acc, cur, wr, wc, fr, fq); S.done(cur); }
        if (!has_next) break;
        if constexpr (Epi::PREFETCH) E.prefetch(nxt, wid, (ui + 1) & 1);
#pragma unroll
        for (int a = 0; a < 2; ++a)
#pragma unroll
            for (int b = 0; b < 2; ++b)
#pragma unroll
                for (int m = 0; m < 4; ++m)
#pragma unroll
                    for (int n = 0; n < 2; ++n) acc[a][b][m][n] = acc_t{};
        cur = nxt; cA = nA; cB = nB; ++ui;
        if constexpr (ALIGN_EPI) { if (wr == 1) PG8_BAR; }
    }
    PG8_WAIT_V(0);
    if constexpr (!ALIGN_EPI) { if (wr == 0) PG8_BAR; }
    PG8_BAR;
    if constexpr (Epi::AFTER_DRAIN) { E.fused(acc, cur, wr, wc, fr, fq, lds, wid, lane); S.done(cur); }
#undef PG8_SA
#undef PG8_SB
#undef PG8_STAGE
#undef PG8_LDA
#undef PG8_LDB
#undef PG8_MMA
#undef PG8_WAIT_V
#undef PG8_WAIT_L
#undef PG8_BAR
#undef PG8_SCHED
}
}

namespace attn {
constexpr int D = 128;
constexpr int WINDOW = 129;
constexpr float THR = 8.f;
constexpr bool WSKIP = true;
constexpr float SCALE = 0.08838834764831845f;
constexpr int NW = 8, QBLK = 32, KVBLK = 64, QB = NW * QBLK;
constexpr int SHM_V = KVBLK * D * 2, SHM_K = KVBLK * D * 2;
constexpr int LDS_BYTES = 2 * SHM_V + 2 * SHM_K + NW * 64 * 4;
using bf16 = __hip_bfloat16;
typedef short bf16x8 __attribute__((ext_vector_type(8)));
typedef short s16x4 __attribute__((ext_vector_type(4)));
typedef float f32x16 __attribute__((ext_vector_type(16)));
typedef float f32x4 __attribute__((ext_vector_type(4)));
typedef unsigned u32x4 __attribute__((ext_vector_type(4)));
template <class A, class Bt> struct same_t { static constexpr bool v = false; };
template <class A> struct same_t<A, A> { static constexpr bool v = true; };

#define KSWZ(row, colB) ((row) * 256 + ((colB) ^ (((row) & 7) << 4)))
#define SBAR() __builtin_amdgcn_sched_barrier(0)
__device__ __forceinline__ int v_st(int k, int c) { const int kk = (k & ~0xC) | ((k & 4) << 1) | ((k & 8) >> 1); return ((kk >> 3) * 4 + (c >> 5)) * 512 + ((kk & 7) * 32 + (c & 31)) * 2; }
__device__ __forceinline__ int v_rd_base(int lane) { return ((lane & 3) << 3) | (((lane >> 2) & 3) << 6) | (((lane >> 4) & 1) << 5) | (((lane >> 5) & 1) << 8); }
constexpr int v_rd_off(int d0, int ks, int half) { return d0 * 512 + ks * 4096 + half * 2048; }
__device__ __forceinline__ int crow(int r, int hi) { return (r & 3) + 8 * (r >> 2) + 4 * hi; }
__device__ __forceinline__ unsigned cvtpk(float lo, float hi) {
    unsigned r; asm volatile("v_cvt_pk_bf16_f32 %0, %1, %2" : "=v"(r) : "v"(lo), "v"(hi)); return r;
}
__device__ __forceinline__ bf16x8 pack8(f32x4 a, f32x4 b) {
    u32x4 w = {cvtpk(a[0], a[1]), cvtpk(a[2], a[3]), cvtpk(b[0], b[1]), cvtpk(b[2], b[3])};
    return *reinterpret_cast<bf16x8*>(&w);
}
template <class T> __device__ __forceinline__ bf16x8 load8(const T* p) {
    if constexpr (same_t<T, float>::v) { return pack8(*(const f32x4*)p, *(const f32x4*)(p + 4)); }
    else { return *reinterpret_cast<const bf16x8*>(p); }
}
__device__ __forceinline__ void mask_tile(f32x16& p0, f32x16& p1, int dq, unsigned W) {
    const float NEG = -__builtin_inff();
#pragma unroll
    for (int r = 0; r < 16; ++r) {
        const int c = (r & 3) + 8 * (r >> 2);
        if ((unsigned)(dq - c) >= W) p0[r] = NEG;
        if ((unsigned)(dq - c - 32) >= W) p1[r] = NEG;
    }
}
__device__ __forceinline__ void partialSM(f32x16& p0, f32x16& p1, float& m_reg, float& mn, float& alpha) {
    float pmax = p0[0]; for (int r = 1; r < 16; ++r) pmax = fmaxf(pmax, p0[r]); for (int r = 0; r < 16; ++r) pmax = fmaxf(pmax, p1[r]);
    { auto rr = __builtin_amdgcn_permlane32_swap(__float_as_uint(pmax), __float_as_uint(pmax), false, false);
      pmax = fmaxf(__uint_as_float(rr[0]), __uint_as_float(rr[1])); }
    constexpr float C2 = 1.4426950408889634f * SCALE;
    if (__builtin_expect(__all((pmax - m_reg) * SCALE <= THR), 1)) { mn = m_reg; alpha = 1.f; }
    else { mn = fmaxf(m_reg, pmax); alpha = __builtin_amdgcn_exp2f((m_reg - mn) * C2); m_reg = mn; }
    const float mnL = -mn * C2;
    for (int r = 0; r < 16; ++r) p0[r] = fmaf(p0[r], C2, mnL); for (int r = 0; r < 16; ++r) p1[r] = fmaf(p1[r], C2, mnL);
    for (int r = 0; r < 16; ++r) p0[r] = __builtin_amdgcn_exp2f(p0[r]);
}
__device__ __forceinline__ void finishSM(f32x16& p0, f32x16& p1, float alpha, float& l_reg, bf16x8& pa0, bf16x8& pa1, bf16x8& pa2, bf16x8& pa3) {
    for (int r = 0; r < 16; ++r) p1[r] = __builtin_amdgcn_exp2f(p1[r]);
    float ps = 0; for (int r = 0; r < 16; ++r) ps += p0[r]; for (int r = 0; r < 16; ++r) ps += p1[r];
    { auto rr = __builtin_amdgcn_permlane32_swap(__float_as_uint(ps), __float_as_uint(ps), false, false);
      ps = __uint_as_float(rr[0]) + __uint_as_float(rr[1]); }
    l_reg = l_reg * alpha + ps;
#define PK4(P, B_, OUT) do { unsigned a0 = cvtpk(P[B_+0], P[B_+1]), a1 = cvtpk(P[B_+2], P[B_+3]);                          \
        unsigned b0 = cvtpk(P[B_+4], P[B_+5]), b1 = cvtpk(P[B_+6], P[B_+7]);                                             \
        auto r0 = __builtin_amdgcn_permlane32_swap(a0, b0, false, false); auto r1 = __builtin_amdgcn_permlane32_swap(a1, b1, false, false); \
        u32x4 w = {r0[0], r1[0], r0[1], r1[1]}; OUT = *reinterpret_cast<bf16x8*>(&w); } while (0)
    PK4(p0, 0, pa0); PK4(p0, 8, pa1); PK4(p1, 0, pa2); PK4(p1, 8, pa3);
#undef PK4
}
template <int KB, bool SK>
__device__ __forceinline__ void qkt(f32x16& p0, f32x16& p1, const char* K_lds, int r32, int hi, const bf16x8* qr, bool act) {
    if (SK && !act) { const float NEG = -__builtin_inff();
#pragma unroll
        for (int r = 0; r < 16; ++r) { p0[r] = NEG; p1[r] = NEG; } return; }
    p0 = f32x16{}; p1 = f32x16{};
    const char* kb[4];
#pragma unroll
    for (int dd = 0; dd < 4; ++dd) kb[dd] = K_lds + KB * SHM_K + KSWZ(r32, (dd * 16 + hi * 8) * 2);
#pragma unroll
    for (int d0 = 0; d0 < 8; ++d0) { const char* a = kb[d0 & 3] + (d0 >> 2) * 128;
        bf16x8 b0 = *reinterpret_cast<const bf16x8*>(a);
        bf16x8 b1 = *reinterpret_cast<const bf16x8*>(a + 32 * 256);
        p0 = __builtin_amdgcn_mfma_f32_32x32x16_bf16(b0, qr[d0], p0, 0, 0, 0);
        p1 = __builtin_amdgcn_mfma_f32_32x32x16_bf16(b1, qr[d0], p1, 0, 0, 0); }
}
template <int VB, bool SK>
__device__ __forceinline__ void pv_tile(f32x16* o, int vb0, bf16x8 pa0, bf16x8 pa1, bf16x8 pa2, bf16x8 pa3, bool act) {
    if (SK && !act) return;
#define TRRD(dst, off) asm volatile("ds_read_b64_tr_b16 %0, %1 offset:%2" : "=&v"(dst) : "v"(vb0), "i"(off) : "memory")
#define PV_D0(d0) do { s16x4 l0, l1, l2, l3, h0, h1, h2, h3; constexpr int b_ = VB * SHM_V + v_rd_off(d0, 0, 0);     \
        TRRD(l0, b_); TRRD(h0, b_ + 2048); TRRD(l1, b_ + 4096); TRRD(h1, b_ + 6144); TRRD(l2, b_ + 8192); TRRD(h2, b_ + 10240); TRRD(l3, b_ + 12288); TRRD(h3, b_ + 14336); \
        asm volatile("s_waitcnt lgkmcnt(0)" ::: "memory"); SBAR();                 \
        o[d0] = __builtin_amdgcn_mfma_f32_32x32x16_bf16(pa0, (bf16x8){l0[0], l0[1], l0[2], l0[3], h0[0], h0[1], h0[2], h0[3]}, o[d0], 0, 0, 0);   \
        o[d0] = __builtin_amdgcn_mfma_f32_32x32x16_bf16(pa1, (bf16x8){l1[0], l1[1], l1[2], l1[3], h1[0], h1[1], h1[2], h1[3]}, o[d0], 0, 0, 0);   \
        o[d0] = __builtin_amdgcn_mfma_f32_32x32x16_bf16(pa2, (bf16x8){l2[0], l2[1], l2[2], l2[3], h2[0], h2[1], h2[2], h2[3]}, o[d0], 0, 0, 0);   \
        o[d0] = __builtin_amdgcn_mfma_f32_32x32x16_bf16(pa3, (bf16x8){l3[0], l3[1], l3[2], l3[3], h3[0], h3[1], h3[2], h3[3]}, o[d0], 0, 0, 0); } while (0)
    PV_D0(0); PV_D0(1); PV_D0(2); PV_D0(3);
#undef PV_D0
#undef TRRD
}

template <class TIn, class TOut> struct BlockRef { const TIn* Q; const TIn* K; const TIn* V; TOut* O; float* LSE; int P0; int rs; int ls; };
template <class TIn> struct Seam {
    bf16x8 qr[8];
    bf16x8 st_v0, st_v1, st_k0, st_k1; f32x4 sf0, sf1, sf2, sf3;
    f32x4 tq[16];
};
__device__ __forceinline__ int swa_jlo(int P0, int W) { const int lowk = P0 - W + 1; return lowk > 0 ? lowk / KVBLK : 0; }
#define ROW(p, k0, rr, rs_) ((p) + (size_t)((k0) + (rr)) * (size_t)(rs_) + sc)
#define VMW() asm volatile("s_waitcnt vmcnt(0)" ::: "memory")
#define VMWN(n) asm volatile("s_waitcnt vmcnt(%0)" :: "i"(n) : "memory")
#define SLOAD_H(Kp, Vp, k0, rs_) do { S.st_v0 = load8<TIn>(ROW(Vp, k0, sr, rs_)); S.st_v1 = load8<TIn>(ROW(Vp, k0, 32 + sr, rs_));              \
                         S.st_k0 = load8<TIn>(ROW(Kp, k0, sr, rs_)); S.st_k1 = load8<TIn>(ROW(Kp, k0, 32 + sr, rs_)); } while (0)
#define SWRITE_HK(bf) do { *(bf16x8*)(K_lds + (bf) * SHM_K + kws) = S.st_k0; *(bf16x8*)(K_lds + (bf) * SHM_K + kws + 32 * 256) = S.st_k1; } while (0)
#define SWRITE_HV(bf) do { *(bf16x8*)(V_lds + (bf) * SHM_V + vst0) = S.st_v0; *(bf16x8*)(V_lds + (bf) * SHM_V + vst1) = S.st_v1; } while (0)
#define SWRITE_H(bf) do { SWRITE_HV(bf); SWRITE_HK(bf); } while (0)
#define SLOAD_F(p, k0) do { } while (0)
#define SWRITE_KF(bf) do { *(bf16x8*)(K_lds + (bf) * SHM_K + kws) = pack8(S.sf0, S.sf1); *(bf16x8*)(K_lds + (bf) * SHM_K + kws + 32 * 256) = pack8(S.sf2, S.sf3); } while (0)
#define SWRITE_VF(bf) do { *(bf16x8*)(V_lds + (bf) * SHM_V + vst0) = pack8(S.sf0, S.sf1); *(bf16x8*)(V_lds + (bf) * SHM_V + vst1) = pack8(S.sf2, S.sf3); } while (0)
template <class TIn, class TOut>
__device__ __forceinline__ void causal_swa_prime(const BlockRef<TIn, TOut>& cur, int W, char* lds, Seam<TIn>& S) {
    constexpr bool F32 = same_t<TIn, float>::v;
    const int tid = tid_opaque(), wid = __builtin_amdgcn_readfirstlane(tid >> 6), lane = tid & 63, r32 = lane & 31, hi = lane >> 5;
    const int sr = tid >> 4, sc = (tid & 15) * 8, kws = KSWZ(sr, sc * 2); char* K_lds = lds + 2 * SHM_V;
    const int kb0 = swa_jlo(cur.P0, W) * KVBLK;
    for (int d0 = 0; d0 < 8; ++d0) S.qr[d0] = load8<TIn>(cur.Q + (size_t)(wid * QBLK + r32) * (size_t)cur.rs + d0 * 16 + hi * 8);
    if constexpr (F32) { SLOAD_F((const float*)cur.K, kb0); VMW(); SWRITE_KF(0); SBAR(); SLOAD_F((const float*)cur.V, kb0); }
    else { SLOAD_H(cur.K, cur.V, kb0, cur.rs); VMW(); SWRITE_HK(0); }
    __syncthreads();
}
template <class TIn, class TOut>
__device__ __forceinline__ void causal_swa_block(const BlockRef<TIn, TOut>& cur, const BlockRef<TIn, TOut>& nxt, int skv, int W, char* lds, Seam<TIn>& S) {
    constexpr bool F32 = same_t<TIn, float>::v;
    const int tid = tid_opaque(), wid = __builtin_amdgcn_readfirstlane(tid >> 6), lane = tid & 63, r32 = lane & 31, hi = lane >> 5;
    const int j_lo = swa_jlo(cur.P0, W);
    int j_hi = (cur.P0 + QB - 1) / KVBLK + 1; if (j_hi > skv / KVBLK) j_hi = skv / KVBLK;
    const int NT = j_hi - j_lo;
    const int kbn = swa_jlo(nxt.P0, W) * KVBLK;
    const int qlo = cur.P0 + wid * QBLK, qm = qlo + r32 - 4 * hi;
    char* V_lds = lds; char* K_lds = lds + 2 * SHM_V;
    float* ws = (float*)(lds + 2 * SHM_V + 2 * SHM_K) + wid * 64; float* li_l = ws, * al_l = ws + 32;
    float m_reg = -1e30f, l_reg = 0; f32x16 o[4] = {};
    const int sr = tid >> 4, sc = (tid & 15) * 8, vst0 = v_st(sr, sc), vst1 = v_st(32 + sr, sc), kws = KSWZ(sr, sc * 2);
    const int vb0 = (int)(uintptr_t)V_lds + v_rd_base(lane);
    const TIn* Kh = cur.K; const TIn* Vh = cur.V;
#define RESC(a) do { if (__any((a) < 1.f)) { if (hi == 0) al_l[r32] = (a); asm volatile("s_waitcnt lgkmcnt(0)" ::: "memory");              \
                     for (int d_ = 0; d_ < 4; ++d_) for (int r = 0; r < 16; ++r) o[d_][r] *= al_l[crow(r, hi)]; } } while (0)
#define KBASE(t) ((j_lo + (t)) * KVBLK)
#define ACT(t) (KBASE(t) <= qlo + QBLK - 1 && KBASE(t) + KVBLK - 1 >= qlo - W + 1)
#define MASKT(P0_, P1_, t) do { const int kb_ = KBASE(t); if ((!SK || ACT(t)) && (kb_ + KVBLK - 1 > qlo || kb_ <= qlo + QBLK - 1 - W)) mask_tile(P0_, P1_, qm - kb_, (unsigned)W); } while (0)
    constexpr int NQL = F32 ? 16 : 8;
    constexpr bool SK = WSKIP && !F32;
#define SEAM_K0() do { VMWN(NQL); if constexpr (F32) { SWRITE_KF(0); SBAR(); SLOAD_F((const float*)nxt.V, kbn); } else { SWRITE_HK(0); } SBAR(); } while (0)
    f32x16 pA0, pA1, pB0, pB1; float mnA, mnB, alA, alB; bf16x8 pa0, pa1, pa2, pa3;
    if constexpr (F32) { VMW(); SWRITE_VF(0); SBAR(); } else { SWRITE_HV(0); SBAR(); }
    if (NT > 1) { if constexpr (F32) SLOAD_F((const float*)Kh, KBASE(1)); else SLOAD_H(Kh, Vh, KBASE(1), cur.rs); }
    SBAR(); qkt<0, SK>(pA0, pA1, K_lds, r32, hi, S.qr, ACT(0));
    if constexpr (F32) { if (NT > 1) { VMW(); SWRITE_KF(1); SBAR(); SLOAD_F((const float*)Vh, KBASE(1)); } }
    MASKT(pA0, pA1, 0); partialSM(pA0, pA1, m_reg, mnA, alA);
    if (NT > 1) { VMW(); if constexpr (F32) { SWRITE_VF(1); SBAR(); if (NT > 2) SLOAD_F((const float*)Kh, KBASE(2)); } else SWRITE_H(1); }
    __syncthreads();
#define HALF_STEP(PX0, PX1, mnX, alX, PY0, PY1, alY, t, KB, VB, SB) do {                                                      \
        SBAR(); qkt<KB, SK>(PX0, PX1, K_lds, r32, hi, S.qr, ACT(t));                                             \
        finishSM(PY0, PY1, alY, l_reg, pa0, pa1, pa2, pa3); SBAR();                                                           \
        if ((t) + 1 < NT) { if constexpr (F32) { VMW(); SWRITE_KF(SB); SBAR(); SLOAD_F((const float*)Vh, KBASE((t) + 1)); }  \
                            else { SLOAD_H(Kh, Vh, KBASE((t) + 1), cur.rs); } SBAR(); }                                               \
        pv_tile<VB, SK>(o, vb0, pa0, pa1, pa2, pa3, ACT((t) - 1)); MASKT(PX0, PX1, (t)); partialSM(PX0, PX1, m_reg, mnX, alX);                                        \
        __syncthreads();                                                                                                      \
        if ((t) + 1 < NT) { VMW(); if constexpr (F32) { SWRITE_VF(SB); SBAR(); if ((t) + 2 < NT) SLOAD_F((const float*)Kh, KBASE((t) + 2)); } \
                            else { SWRITE_H(SB); } }                                                                          \
        RESC(alX); __syncthreads(); } while (0)
    for (int t = 1; t + 1 < NT; t += 2) {
        HALF_STEP(pB0, pB1, mnB, alB, pA0, pA1, alA, t, 1, 0, 0);
        HALF_STEP(pA0, pA1, mnA, alA, pB0, pB1, alB, t + 1, 0, 1, 1);
    }
    const bool even = (NT & 1) == 0;
    if (even) { SBAR(); qkt<1, SK>(pB0, pB1, K_lds, r32, hi, S.qr, ACT(NT - 1)); SBAR(); }
#define QROW(e) (nxt.Q + (size_t)(wid * QBLK + r32) * (size_t)nxt.rs + ((e) >> 1) * 16 + hi * 8 + ((e) & 1) * 4)
    if constexpr (F32) { SLOAD_F((const float*)nxt.K, kbn); SBAR();
#pragma unroll
        for (int e = 0; e < 8; ++e) S.tq[e] = *(const f32x4*)QROW(e); }
    else { SLOAD_H(nxt.K, nxt.V, kbn, nxt.rs); SBAR();
#pragma unroll
        for (int d0 = 0; d0 < 8; ++d0) S.qr[d0] = load8<TIn>(nxt.Q + (size_t)(wid * QBLK + r32) * (size_t)nxt.rs + d0 * 16 + hi * 8); }
    SBAR();
    finishSM(pA0, pA1, alA, l_reg, pa0, pa1, pa2, pa3); SBAR();
    if constexpr (F32) {
#pragma unroll
        for (int e = 8; e < 16; ++e) S.tq[e] = *(const f32x4*)QROW(e); SBAR(); }
#undef QROW
    pv_tile<0, SK>(o, vb0, pa0, pa1, pa2, pa3, ACT(even ? NT - 2 : NT - 1));
    if (even) { MASKT(pB0, pB1, NT - 1); partialSM(pB0, pB1, m_reg, mnB, alB); __syncthreads(); RESC(alB);
        finishSM(pB0, pB1, alB, l_reg, pa0, pa1, pa2, pa3); SBAR(); pv_tile<1, SK>(o, vb0, pa0, pa1, pa2, pa3, ACT(NT - 1)); }
    SBAR(); SEAM_K0();
    if (hi == 0) li_l[r32] = l_reg; asm volatile("s_waitcnt lgkmcnt(0)" ::: "memory");
    float rli[16];
#pragma unroll
    for (int r = 0; r < 16; ++r) rli[r] = __builtin_amdgcn_rcpf(li_l[crow(r, hi)]);
    TOut* Ow = cur.O + (size_t)(wid * QBLK) * (size_t)cur.rs;
    if (hi == 0) cur.LSE[(size_t)(wid * QBLK + r32) * (size_t)cur.ls] = m_reg * SCALE + __logf(l_reg);
#pragma unroll
    for (int r = 0; r < 16; ++r) { const int orow = crow(r, hi);
#pragma unroll
        for (int d0 = 0; d0 < 4; ++d0) { const float v = o[d0][r] * rli[r];
            if constexpr (same_t<TOut, float>::v) { Ow[(size_t)orow * (size_t)cur.rs + d0 * 32 + r32] = v; }
            else { const float vn = __shfl_xor(v, 1);
                   if ((r32 & 1) == 0) *(unsigned*)(Ow + (size_t)orow * (size_t)cur.rs + d0 * 32 + r32) = cvtpk(v, vn); } } }
    if constexpr (F32) {
#pragma unroll
        for (int d0 = 0; d0 < 8; ++d0) S.qr[d0] = pack8(S.tq[2 * d0], S.tq[2 * d0 + 1]); }
    __syncthreads();
#undef RESC
#undef KBASE
#undef ACT
#undef MASKT
#undef SEAM_K0
#undef HALF_STEP
}
#undef ROW
#undef VMW
#undef VMWN
#undef SLOAD_H
#undef SWRITE_HK
#undef SWRITE_HV
#undef SWRITE_H
#undef SLOAD_F
#undef SWRITE_KF
#undef SWRITE_VF

#undef SBAR
}
#define GAS __attribute__((address_space(1)))
#define LAS __attribute__((address_space(3)))
typedef unsigned short bf16;
typedef unsigned v4u __attribute__((ext_vector_type(4)));
typedef float f32x4 __attribute__((ext_vector_type(4)));
typedef short bf16x8 __attribute__((ext_vector_type(8)));
typedef GAS unsigned gu32;
typedef GAS unsigned long long gu64;
#define RLX_AGENT __ATOMIC_RELAXED, __HIP_MEMORY_SCOPE_AGENT
#define LDS_WAIT() asm volatile("s_waitcnt lgkmcnt(0)" ::: "memory")
#define VM_WAIT() asm volatile("s_waitcnt vmcnt(0)" ::: "memory")
__device__ __forceinline__ unsigned long long rt() { return __builtin_amdgcn_s_memrealtime(); }
__device__ __forceinline__ unsigned f2bf(float f) { unsigned u = __builtin_bit_cast(unsigned, f); return (u + 0x7fffu + ((u >> 16) & 1u)) >> 16; }
__device__ __forceinline__ unsigned pk2(float lo, float hi) { return f2bf(lo) | (f2bf(hi) << 16); }

#define XB_TMO      128
#define XB_XCNT(j)  (256  + 64 * (j))
#define XB_XSUB(j)  (1280 + 64 * (j))
#define XB_XGEN(j)  (2304 + 64 * (j))
#define XB_TOP      3328
#define XB_TOPGEN   3392
#define XCD_BAR_WORDS 3456
#define XB_SPIN_CAP (1u << 18)

__device__ __forceinline__ unsigned xb_ld(unsigned* p)              { return __hip_atomic_load(p, __ATOMIC_RELAXED, __HIP_MEMORY_SCOPE_AGENT); }
__device__ __forceinline__ unsigned xb_add(unsigned* p, unsigned v) { return __hip_atomic_fetch_add(p, v, __ATOMIC_RELAXED, __HIP_MEMORY_SCOPE_AGENT); }
__device__ __forceinline__ unsigned xb_xcc_id() { return (unsigned)__builtin_amdgcn_s_getreg((3 << 11) | 20) & 0xFu; }
#define XB_SPIN(cond, bar) do { unsigned _sp = 0; while (cond) { __builtin_amdgcn_s_sleep(1); \
    if ((++_sp & 255u) == 0u) { if (xb_ld(&(bar)[XB_TMO])) break; if (_sp > XB_SPIN_CAP) { atomicAdd(&(bar)[XB_TMO], 1u); break; } } } } while (0)

struct XcdBarrier {
    unsigned* bar; unsigned x;
    volatile LAS unsigned* st;
};

__device__ __forceinline__ XcdBarrier xcd_barrier_post(unsigned* bar, volatile LAS unsigned* st) {
    XcdBarrier b; b.bar = bar; b.x = xb_xcc_id(); b.st = st;
    if (threadIdx.x == 0) (void)xb_add(&bar[XB_XCNT(b.x)], 1u);
    return b;
}
__device__ __forceinline__ void xcd_barrier_complete(unsigned* bar, unsigned x, unsigned& nloc, unsigned& nx) {
    const unsigned G = gridDim.x * gridDim.y * gridDim.z;
    unsigned sum, cnt, mine, sp = 0u;
    for (;;) {
        sum = 0u; cnt = 0u; mine = 0u;
#pragma unroll
        for (unsigned j = 0; j < 16; ++j) { const unsigned c = xb_ld(&bar[XB_XCNT(j)]); sum += c; cnt += (c > 0u) ? 1u : 0u; mine = (j == x) ? c : mine; }
        if (sum == G) break;
        __builtin_amdgcn_s_sleep(1);
        if ((++sp & 255u) == 0u) { if (xb_ld(&bar[XB_TMO])) break; if (sp > XB_SPIN_CAP) { atomicAdd(&bar[XB_TMO], 1u); break; } }
    }
    nloc = mine > 0u ? mine : 1u; nx = cnt > 0u ? cnt : 1u;
}

__device__ __forceinline__ void xcd_barrier(const XcdBarrier& b) {
    asm volatile("s_waitcnt vmcnt(0)" ::: "memory");
    __syncthreads();
    if (threadIdx.x == 0) {
        unsigned* bar = b.bar;
        __builtin_amdgcn_s_waitcnt(0);
        unsigned nloc = b.st[0], nx = b.st[1];
        if (nloc == 0u) { xcd_barrier_complete(bar, b.x, nloc, nx); b.st[0] = nloc; b.st[1] = nx; }
        const unsigned old = xb_add(&bar[XB_XSUB(b.x)], 1u);
        const unsigned gen = old / nloc;
        if (old + 1u == (gen + 1u) * nloc) {
            __builtin_amdgcn_fence(__ATOMIC_RELEASE, "agent");
            asm volatile("s_waitcnt vmcnt(0)" ::: "memory");
            const unsigned og = xb_add(&bar[XB_TOP], 1u);
            const unsigned tg = og / nx;
            if (og + 1u == (tg + 1u) * nx) xb_add(&bar[XB_TOPGEN], 1u);
            else XB_SPIN(xb_ld(&bar[XB_TOPGEN]) == tg, bar);
            __builtin_amdgcn_fence(__ATOMIC_ACQUIRE, "agent");
            xb_add(&bar[XB_XGEN(b.x)], 1u);
            asm volatile("s_waitcnt vmcnt(0)" ::: "memory");
        } else {
            XB_SPIN(xb_ld(&bar[XB_XGEN(b.x)]) == gen, bar);
            __builtin_amdgcn_fence(__ATOMIC_ACQUIRE, "agent");
            asm volatile("s_waitcnt vmcnt(0)" ::: "memory");
        }
    }
    __syncthreads();
}

constexpr int NWAVES = 8;

constexpr size_t MiB = 1u << 20, HMiB = 1u << 19;
constexpr size_t WS_CTL = 0, CTL_ZERO_BYTES = 128 * 1024;
constexpr size_t WS_COLMAX = 64 * 1024;
constexpr size_t WS_MOD = 1 * MiB;
constexpr size_t WS_AVEC = WS_MOD + 80 * 1024;
constexpr size_t WS_BIAS_IN = WS_MOD + 96 * 1024;
constexpr size_t WS_BIAS_F2 = WS_MOD + 176 * 1024;
constexpr size_t WS_PS2 = WS_MOD + 256 * 1024, WS_PS3 = WS_MOD + 512 * 1024;
constexpr size_t WS_SW1 = WS_MOD + 768 * 1024, WS_SW2 = WS_MOD + 800 * 1024;
constexpr size_t WS_SA1 = WS_MOD + 832 * 1024, WS_RF3 = WS_MOD + 896 * 1024;
constexpr size_t WS_WGU1 = 2 * MiB;
constexpr size_t WS_WD1 = WS_WGU1 + 11 * MiB;
constexpr size_t WS_WIN = WS_WD1 + 11 * HMiB;
constexpr size_t WS_WA = WS_WIN + 19 * MiB;
constexpr size_t WS_WC = WS_WA + 1 * MiB;
constexpr size_t WS_WO = WS_WC + 2 * MiB;
constexpr size_t WS_WGU2 = WS_WO + 2 * MiB;
constexpr size_t WS_WD2 = WS_WGU2 + 11 * MiB;
constexpr size_t WS_XS = WS_WD2 + 11 * HMiB;
constexpr size_t WS_R = WS_XS + 32 * MiB;
constexpr size_t WS_ACT = WS_R;
constexpr size_t WS_Q = WS_R, WS_K = WS_R + 48 * MiB, WS_V = WS_R + 96 * MiB;
constexpr size_t WS_LSE = WS_R + 144 * MiB;
constexpr size_t WS_O = WS_R + 145 * MiB;
constexpr size_t WS_U = WS_R + 48 * MiB, WS_B = WS_R + 80 * MiB, WS_C = WS_R + 112 * MiB;
constexpr size_t WS_SGA = WS_R, WS_SGC = WS_R + 48 * MiB;
constexpr size_t WS_END = WS_O + 16 * MiB;
static_assert(WS_XS == 59 * MiB && WS_END <= 256 * MiB, "d_ws map");
constexpr size_t WS_XQ1 = WS_XS, WS_XQ3 = WS_O, WS_XQ2 = WS_O;
constexpr size_t WS_RF2 = WS_SA1, WS_SWIN = WS_MOD + 960 * 1024;
constexpr int CW_BAR = 4096;

constexpr int RING_OFF = 0, RING_BYTES = 131072;
constexpr int LDSCTL_OFF = RING_BYTES, MISC_OFF = LDSCTL_OFF + 320, XL_OFF = RING_BYTES + 1024;
constexpr int LDS_BYTES = 151552;


#ifdef NAIVE
#define FFN_I8 0
#else
#define FFN_I8 1
#endif
struct Args { const float* in[20]; float* out; unsigned char* ws; int ph_lo, ph_hi; };
struct Frame {
    LAS unsigned char* lds;
    volatile LAS unsigned* MISC;
    gu32* ctl;
    int tid, lane, wave;
    int vcu, G;
    float* out; unsigned char* ws;
};
enum { I_X = 0, I_C, I_WADA, I_BADA, I_NF1, I_F1G, I_F1U, I_F1D, I_NMIX, I_WIN, I_QN, I_KN, I_CONVW, I_WAB, I_WCB, I_WOUT, I_NF2, I_F2G, I_F2U, I_F2D };
enum { MOD_SH1 = 0, MOD_SC1 = 1024, MOD_GT1 = 2048, MOD_SH2 = 3072, MOD_SC2 = 4096, MOD_GT2 = 5120, MOD_SH3 = 6144, MOD_SC3 = 7168, MOD_GT3 = 8192 };

__device__ __forceinline__ float silu_f(float x) { return x * __builtin_amdgcn_rcpf(1.0f + __builtin_amdgcn_exp2f(-1.4426950408889634f * x)); }
__device__ __forceinline__ float wave_sum(float v) {
#pragma unroll
    for (int o = 1; o < 64; o <<= 1) v += __shfl_xor(v, o);
    return v;
}
__device__ __forceinline__ float blo(unsigned w) { return __uint_as_float(w << 16); }
__device__ __forceinline__ float bhi(unsigned w) { return __uint_as_float(w & 0xffff0000u); }

constexpr int ADA_ITEMS = NMOD / 64;
__device__ __forceinline__ void p0_adaln_item(Frame& F, const Args& args, int item) {
    LAS float* sc = (LAS float*)(F.lds + RING_OFF);
    LAS float* red = sc + 2048;
    const float* c = args.in[I_C]; const float* wada = args.in[I_WADA]; const float* bada = args.in[I_BADA];
    for (int i = F.tid; i < 2 * DM; i += NWAVES * 64) sc[i] = silu_f(c[i]);
    __syncthreads();
    const int j0 = item * 64, cg = F.lane & 15, rs = F.lane >> 4;
    f32x4 a0 = {0.f, 0.f, 0.f, 0.f}, a1 = {0.f, 0.f, 0.f, 0.f};
    const GAS f32x4* wp = (const GAS f32x4*)(wada + (size_t)(F.wave * 128 + rs) * NMOD + j0 + 4 * cg);
#pragma unroll 16
    for (int it = 0; it < 32; ++it) { const int k = F.wave * 128 + 4 * it + rs; const f32x4 w = __builtin_nontemporal_load(&wp[(size_t)it * 4 * (NMOD / 4)]);
        a0 = a0 + w * sc[k]; a1 = a1 + w * sc[DM + k]; }
#pragma unroll
    for (int i = 0; i < 4; ++i) { a0[i] += __shfl_xor(a0[i], 16); a0[i] += __shfl_xor(a0[i], 32); a1[i] += __shfl_xor(a1[i], 16); a1[i] += __shfl_xor(a1[i], 32); }
    if (F.lane < 16) {
#pragma unroll
        for (int i = 0; i < 4; ++i) { red[(F.wave * 2 + 0) * 64 + 4 * cg + i] = a0[i]; red[(F.wave * 2 + 1) * 64 + 4 * cg + i] = a1[i]; } }
    __syncthreads();
    if (F.tid < 128) { const int b = F.tid >> 6, j = F.tid & 63; float s = bada[j0 + j];
#pragma unroll
        for (int w = 0; w < NWAVES; ++w) s += red[(w * 2 + b) * 64 + j];
        ((float*)(F.ws + WS_MOD))[b * NMOD + j0 + j] = s; }
    __syncthreads();
}
__device__ __forceinline__ void p0_transpose_item(const float* W, int K, int N, bf16* WT, int rmode, LAS float* scr, int item, int lane) {
    const int nblk = N / 32, kb = item / nblk, nb = item % nblk, k0 = 64 * kb, n0 = 32 * nb;
    const int r0 = rmode == 0 ? n0 : 256 * (n0 >> 7) + 128 * (rmode - 1) + (n0 & 127);
#pragma unroll 16
    for (int i = 0; i < 32; ++i) { const int kk = 2 * i + (lane >> 5); scr[kk * 33 + (lane & 31)] = __builtin_nontemporal_load(&W[(size_t)(k0 + kk) * N + n0 + (lane & 31)]); }
    LDS_WAIT(); asm volatile("" ::: "memory");
    const int c = lane & 7;
#pragma unroll
    for (int j = 0; j < 4; ++j) { const int n = (lane >> 3) + 8 * j; const LAS float* s = scr + (8 * c) * 33 + n;
        v4u o; o.x = pk2(s[0 * 33], s[1 * 33]); o.y = pk2(s[2 * 33], s[3 * 33]); o.z = pk2(s[4 * 33], s[5 * 33]); o.w = pk2(s[6 * 33], s[7 * 33]);
        *(GAS v4u*)(WT + (size_t)(r0 + n) * K + k0 + 8 * c) = o; }
    LDS_WAIT(); asm volatile("" ::: "memory");
}
__device__ __forceinline__ int q8(float v) { return (int)fminf(fmaxf(rintf(v), -127.f), 127.f); }
__device__ __forceinline__ unsigned pk4q(float a, float b, float c, float d) { return (unsigned)(q8(a) & 255) | ((unsigned)(q8(b) & 255) << 8) | ((unsigned)(q8(c) & 255) << 16) | ((unsigned)(q8(d) & 255) << 24); }
constexpr int ABS_FFN_ITEMS = 4 * 44 * 8, ABS_QKV_ITEMS = (3 * AW / 64) * 8;
__device__ __forceinline__ void wq_absmax(Frame& F, const Args& args, int worker, int nworkers) {
    unsigned* cm = (unsigned*)(F.ws + WS_COLMAX);
    const int cg = F.lane & 15, rs = F.lane >> 4;
    for (int it = worker; it < ABS_FFN_ITEMS + ABS_QKV_ITEMS; it += nworkers) {
        const float* Wb; int pitch, n, kch, slot;
        if (it < ABS_FFN_ITEMS) { const int mat = it / 352, r = it - mat * 352; n = (r >> 3) * 64 + 4 * cg; kch = r & 7; pitch = DFF; slot = mat * DFF + n;
            Wb = (mat == 0 ? args.in[I_F1G] : mat == 1 ? args.in[I_F1U] : mat == 2 ? args.in[I_F2G] : args.in[I_F2U]); }
        else { const int r = it - ABS_FFN_ITEMS; n = (r >> 3) * 64 + 4 * cg; kch = r & 7; pitch = INW; slot = 4 * DFF + n; Wb = args.in[I_WIN]; }
        const GAS f32x4* W = (const GAS f32x4*)(Wb + (size_t)(kch * 128 + rs) * pitch + n);
        f32x4 mx = {0.f, 0.f, 0.f, 0.f};
#pragma unroll 16
        for (int i = 0; i < 32; ++i) { const f32x4 w = __builtin_nontemporal_load(&W[(size_t)i * pitch]); mx = __builtin_elementwise_max(mx, __builtin_elementwise_abs(w)); }
#pragma unroll
        for (int c = 0; c < 4; ++c) { float v = mx[c]; v = fmaxf(v, __shfl_xor(v, 16)); v = fmaxf(v, __shfl_xor(v, 32)); if (rs == 0) atomicMax(cm + slot + c, __float_as_uint(v)); }
    }
}
__device__ __forceinline__ void p0_transpose_item_i8(const float* W, int N, signed char* WQ, int rmode, LAS float* scr, int item, int lane, const float* colmax, float* SW) {
    const int nblk = N / 32, kb = item / nblk, nb = item % nblk, k0 = 64 * kb, n0 = 32 * nb;
    const int r0 = rmode == 0 ? n0 : 256 * (n0 >> 7) + 128 * (rmode - 1) + (n0 & 127);
#pragma unroll 16
    for (int i = 0; i < 32; ++i) { const int kk = 2 * i + (lane >> 5); scr[kk * 33 + (lane & 31)] = __builtin_nontemporal_load(&W[(size_t)(k0 + kk) * N + n0 + (lane & 31)]); }
    LDS_WAIT(); asm volatile("" ::: "memory");
    const int n = lane >> 1, hh = lane & 1; const float cmx = colmax[n0 + n], inv = cmx > 0.f ? 127.0f / cmx : 0.f;
    const LAS float* s = scr + (32 * hh) * 33 + n;
    v4u o0, o1;
    o0.x = pk4q(s[0 * 33] * inv, s[1 * 33] * inv, s[2 * 33] * inv, s[3 * 33] * inv);     o0.y = pk4q(s[4 * 33] * inv, s[5 * 33] * inv, s[6 * 33] * inv, s[7 * 33] * inv);
    o0.z = pk4q(s[8 * 33] * inv, s[9 * 33] * inv, s[10 * 33] * inv, s[11 * 33] * inv);   o0.w = pk4q(s[12 * 33] * inv, s[13 * 33] * inv, s[14 * 33] * inv, s[15 * 33] * inv);
    o1.x = pk4q(s[16 * 33] * inv, s[17 * 33] * inv, s[18 * 33] * inv, s[19 * 33] * inv); o1.y = pk4q(s[20 * 33] * inv, s[21 * 33] * inv, s[22 * 33] * inv, s[23 * 33] * inv);
    o1.z = pk4q(s[24 * 33] * inv, s[25 * 33] * inv, s[26 * 33] * inv, s[27 * 33] * inv); o1.w = pk4q(s[28 * 33] * inv, s[29 * 33] * inv, s[30 * 33] * inv, s[31 * 33] * inv);
    GAS v4u* dst = (GAS v4u*)(WQ + (size_t)(r0 + n) * DM + k0 + 32 * hh); dst[0] = o0; dst[1] = o1;
    if (kb == 0 && hh == 0) SW[r0 + n] = cmx * (1.0f / 127.0f);
    LDS_WAIT(); asm volatile("" ::: "memory");
}
__device__ __forceinline__ void p0_transposes(Frame& F, const Args& args, int set, int gw, int NGW) {
    LAS float* scr = (LAS float*)(F.lds + RING_OFF + F.wave * 16384);
    int base = 0;
#define TR_JOB8(SRC, N_, RMODE, DST, MAT, SWO) do { const int n_it = (DM / 64) * ((N_) / 32); int it = gw - (base % NGW); if (it < 0) it += NGW; \
        const float* W_ = args.in[SRC]; signed char* WQ_ = (signed char*)(F.ws + (DST)); const float* cm_ = (const float*)(F.ws + WS_COLMAX) + (MAT) * DFF; float* sw_ = (float*)(F.ws + (SWO)); \
        for (; it < n_it; it += NGW) p0_transpose_item_i8(W_, (N_), WQ_, (RMODE), scr, it, F.lane, cm_, sw_); base += n_it; } while (0)
#define TR_JOB(SRC, K_, N_, RMODE, DST) do { const int n_it = ((K_) / 64) * ((N_) / 32); int it = gw - (base % NGW); if (it < 0) it += NGW;     \
        const float* W_ = args.in[SRC]; bf16* WT_ = (bf16*)(F.ws + (DST)); \
        for (; it < n_it; it += NGW) p0_transpose_item(W_, (K_), (N_), WT_, (RMODE), scr, it, F.lane); base += n_it; } while (0)
#if FFN_I8
    if (set == 0) { TR_JOB8(I_F1G, DFF, 1, WS_WGU1, 0, WS_SW1); TR_JOB8(I_F1U, DFF, 2, WS_WGU1, 1, WS_SW1); TR_JOB(I_F1D, DFF, DM, 0, WS_WD1); }
#else
    if (set == 0) { TR_JOB(I_F1G, DM, DFF, 1, WS_WGU1); TR_JOB(I_F1U, DM, DFF, 2, WS_WGU1); TR_JOB(I_F1D, DFF, DM, 0, WS_WD1); }
#endif
    else if (set == 1) {
#if FFN_I8
        { const int nblk = INW / 32, n_it = (DM / 64) * nblk; int it = gw - (base % NGW); if (it < 0) it += NGW;
          for (; it < n_it; it += NGW) { if ((it % nblk) * 32 < 3 * AW) p0_transpose_item_i8(args.in[I_WIN], INW, (signed char*)(F.ws + WS_WIN), 0, scr, it, F.lane, (const float*)(F.ws + WS_COLMAX) + 4 * DFF, (float*)(F.ws + WS_SWIN));
                                         else p0_transpose_item(args.in[I_WIN], DM, INW, (bf16*)(F.ws + WS_WIN), 0, scr, it, F.lane); }
          base += n_it; }
#else
        TR_JOB(I_WIN, DM, INW, 0, WS_WIN);
#endif
        TR_JOB(I_WAB, 512, DM, 0, WS_WA); TR_JOB(I_WCB, DM, DM, 0, WS_WC); TR_JOB(I_WOUT, DM, DM, 0, WS_WO); }
#if FFN_I8
    else { TR_JOB8(I_F2G, DFF, 1, WS_WGU2, 2, WS_SW2); TR_JOB8(I_F2U, DFF, 2, WS_WGU2, 3, WS_SW2); TR_JOB(I_F2D, DFF, DM, 0, WS_WD2); }
#else
    else { TR_JOB(I_F2G, DM, DFF, 1, WS_WGU2); TR_JOB(I_F2U, DM, DFF, 2, WS_WGU2); TR_JOB(I_F2D, DFF, DM, 0, WS_WD2); }
#endif
#undef TR_JOB
#undef TR_JOB8
}
__device__ __forceinline__ void norm_pass(Frame& F, const float* X, const float* g, int mod_sh, int mod_sc, bool q8out = false) {
    const int gw = F.vcu * NWAVES + F.wave, NGW = F.G * NWAVES;
    const float* mod = (const float*)(F.ws + WS_MOD); bf16* XS = (bf16*)(F.ws + WS_XS);
    for (int r0 = gw * 8; r0 < M; r0 += NGW * 8) {
        const int b = r0 / SEQ;
        f32x4 a[4], s[4];
#pragma unroll
        for (int j = 0; j < 4; ++j) { const int c = 4 * F.lane + 256 * j;
            a[j] = *(const f32x4*)(g + c) * (*(const f32x4*)(mod + b * NMOD + mod_sc + c) + 1.0f); s[j] = *(const f32x4*)(mod + b * NMOD + mod_sh + c); }
#pragma unroll 4
        for (int r = 0; r < 8; ++r) {
            const GAS f32x4* xr = (const GAS f32x4*)(X + (size_t)(r0 + r) * DM) + F.lane;
            f32x4 v[4]; float ss = 0.f;
#pragma unroll
            for (int j = 0; j < 4; ++j) { v[j] = xr[64 * j]; ss += (v[j].x * v[j].x + v[j].y * v[j].y) + (v[j].z * v[j].z + v[j].w * v[j].w); }
            const float rstd = 1.0f / sqrtf(wave_sum(ss) * (1.f / DM) + EPS);
            if (q8out) {
                f32x4 y[4]; float am = 0.f;
#pragma unroll
                for (int j = 0; j < 4; ++j) { y[j] = v[j] * rstd * a[j] + s[j]; am = fmaxf(am, fmaxf(fmaxf(fabsf(y[j].x), fabsf(y[j].y)), fmaxf(fabsf(y[j].z), fabsf(y[j].w)))); }
#pragma unroll
                for (int o = 1; o < 64; o <<= 1) am = fmaxf(am, __shfl_xor(am, o));
                const float inv = am > 0.f ? 127.0f / am : 0.f;
                GAS unsigned* o4 = (GAS unsigned*)((signed char*)(F.ws + WS_XQ1) + (size_t)(r0 + r) * DM) + F.lane;
#pragma unroll
                for (int j = 0; j < 4; ++j) o4[64 * j] = pk4q(y[j].x * inv, y[j].y * inv, y[j].z * inv, y[j].w * inv);
                if (F.lane == 0) ((float*)(F.ws + WS_SA1))[r0 + r] = am * (1.0f / 127.0f);
            } else {
            GAS unsigned long long* o8 = (GAS unsigned long long*)(XS + (size_t)(r0 + r) * DM) + F.lane;
#pragma unroll
            for (int j = 0; j < 4; ++j) { const f32x4 y = v[j] * rstd * a[j] + s[j];
                o8[64 * j] = (unsigned long long)pk2(y.x, y.y) | ((unsigned long long)pk2(y.z, y.w) << 32); }
            }
        }
    }
}
__device__ __forceinline__ void qknorm_pass(Frame& F, const Args& args) {
    const int gw = F.vcu * NWAVES + F.wave, NGW = F.G * NWAVES;
    const float* gq_ = args.in[I_QN]; const float* gk_ = args.in[I_KN];
    for (int it = gw; it < 2 * M; it += NGW) {
        const int which = it >= M, row = which ? it - M : it;
        bf16* buf = (bf16*)(F.ws + (which ? WS_K : WS_Q)) + (size_t)row * AW; const float* gm = (which ? gk_ : gq_) + 8 * (F.lane & 15);
        const f32x4 g0 = *(const f32x4*)gm, g1 = *(const f32x4*)(gm + 4);
#pragma unroll
        for (int j = 0; j < 3; ++j) { GAS v4u* p = (GAS v4u*)(buf + 512 * j + 8 * F.lane); const v4u w = *p;
            f32x4 v0 = {blo(w.x), bhi(w.x), blo(w.y), bhi(w.y)}, v1 = {blo(w.z), bhi(w.z), blo(w.w), bhi(w.w)};
            float ss = (v0.x * v0.x + v0.y * v0.y) + (v0.z * v0.z + v0.w * v0.w) + (v1.x * v1.x + v1.y * v1.y) + (v1.z * v1.z + v1.w * v1.w);
            ss += __shfl_xor(ss, 1); ss += __shfl_xor(ss, 2); ss += __shfl_xor(ss, 4); ss += __shfl_xor(ss, 8);
            const float r = 1.0f / sqrtf(ss * (1.f / 128.f) + EPS);
            v0 = v0 * r * g0; v1 = v1 * r * g1;
            v4u o; o.x = pk2(v0.x, v0.y); o.y = pk2(v0.z, v0.w); o.z = pk2(v1.x, v1.y); o.w = pk2(v1.z, v1.w); *p = o; }
    }
}
__device__ __forceinline__ void aux_avec(Frame& F, const Args& args) {
    const int gw = F.vcu * NWAVES + F.wave, NGW = F.G * NWAVES;
    const float* mod = (const float*)(F.ws + WS_MOD); float* avec = (float*)(F.ws + WS_AVEC);
    const float* g2 = args.in[I_NMIX]; const float* g3 = args.in[I_NF2];
    for (int idx = gw * 64 + F.lane; idx < 4 * DM; idx += NGW * 64) { const int which = idx >> 11, b = (idx >> 10) & 1, c = idx & (DM - 1);
        avec[idx] = (which ? g3[c] : g2[c]) * (1.0f + mod[b * NMOD + (which ? MOD_SC3 : MOD_SC2) + c]); }
}
__device__ __forceinline__ void aux_bias(Frame& F, int which) {
    const int gw = F.vcu * NWAVES + F.wave, NGW = F.G * NWAVES;
    const float* mod = (const float*)(F.ws + WS_MOD);
    const int nrows = which ? 2 * DFF : INW;
    const float* sh = mod + (which ? MOD_SH3 : MOD_SH2) + 16 * F.lane;
    f32x4 s0[4], s1[4];
#pragma unroll
    for (int q = 0; q < 4; ++q) { s0[q] = *(const f32x4*)(sh + 4 * q); s1[q] = *(const f32x4*)(sh + NMOD + 4 * q); }
    float* bo = (float*)(F.ws + (which ? WS_BIAS_F2 : WS_BIAS_IN));
    for (int n = gw + ((FFN_I8 && !which) ? 3 * AW : 0); n < nrows; n += NGW) {
        const bf16* wrow = (const bf16*)(F.ws + (which ? WS_WGU2 : WS_WIN)) + (size_t)n * DM + 16 * F.lane;
        const v4u w0 = *(const GAS v4u*)wrow, w1 = *(const GAS v4u*)(wrow + 8);
        const float wv[16] = {blo(w0.x), bhi(w0.x), blo(w0.y), bhi(w0.y), blo(w0.z), bhi(w0.z), blo(w0.w), bhi(w0.w), blo(w1.x), bhi(w1.x), blo(w1.y), bhi(w1.y), blo(w1.z), bhi(w1.z), blo(w1.w), bhi(w1.w)};
        float d0 = 0.f, d1 = 0.f;
#pragma unroll
        for (int q = 0; q < 4; ++q)
#pragma unroll
            for (int i = 0; i < 4; ++i) { d0 += s0[q][i] * wv[4 * q + i]; d1 += s1[q][i] * wv[4 * q + i]; }
        d0 = wave_sum(d0); d1 = wave_sum(d1);
        if (F.lane == 0) { bo[n] = d0; bo[nrows + n] = d1; }
    }
}
__device__ __forceinline__ void xs_quant_pass(Frame& F, size_t ps_off, size_t xq_off, size_t rf_off) {
    const int gw = F.vcu * NWAVES + F.wave, NGW = F.G * NWAVES; const bf16* XSb = (const bf16*)(F.ws + WS_XS); const float* PS = (const float*)(F.ws + ps_off);
    for (int r = gw; r < M; r += NGW) { const GAS v4u* p = (const GAS v4u*)(XSb + (size_t)r * DM) + F.lane;
        const v4u w0 = p[0], w1 = p[64]; const f32x4 ps = *(const f32x4*)(PS + (size_t)r * 4);
        const float v[16] = {blo(w0.x), bhi(w0.x), blo(w0.y), bhi(w0.y), blo(w0.z), bhi(w0.z), blo(w0.w), bhi(w0.w), blo(w1.x), bhi(w1.x), blo(w1.y), bhi(w1.y), blo(w1.z), bhi(w1.z), blo(w1.w), bhi(w1.w)};
        float am = 0.f;
#pragma unroll
        for (int i = 0; i < 16; ++i) am = fmaxf(am, fabsf(v[i]));
#pragma unroll
        for (int o = 1; o < 64; o <<= 1) am = fmaxf(am, __shfl_xor(am, o));
        const float inv = am > 0.f ? 127.0f / am : 0.f;
        GAS unsigned long long* q = (GAS unsigned long long*)((signed char*)(F.ws + xq_off) + (size_t)r * DM) + F.lane;
        q[0] = (unsigned long long)pk4q(v[0] * inv, v[1] * inv, v[2] * inv, v[3] * inv) | ((unsigned long long)pk4q(v[4] * inv, v[5] * inv, v[6] * inv, v[7] * inv) << 32);
        q[64] = (unsigned long long)pk4q(v[8] * inv, v[9] * inv, v[10] * inv, v[11] * inv) | ((unsigned long long)pk4q(v[12] * inv, v[13] * inv, v[14] * inv, v[15] * inv) << 32);
        if (F.lane == 0) ((float*)(F.ws + rf_off))[r] = __builtin_amdgcn_rsqf(((ps[0] + ps[1]) + (ps[2] + ps[3])) * (1.0f / 1024.0f) + 1e-6f) * am * (1.0f / 127.0f);
    }
}
__device__ __forceinline__ void aux_bias_i8(Frame& F, int mod_sh, size_t wq_off, size_t sw_off, int nrows, size_t bias_off, int bstride) {
    const int gw = F.vcu * NWAVES + F.wave, NGW = F.G * NWAVES;
    const float* mod = (const float*)(F.ws + WS_MOD); const float* sh = mod + mod_sh + 16 * F.lane; const float* SW = (const float*)(F.ws + sw_off);
    f32x4 s0[4], s1[4];
#pragma unroll
    for (int q = 0; q < 4; ++q) { s0[q] = *(const f32x4*)(sh + 4 * q); s1[q] = *(const f32x4*)(sh + NMOD + 4 * q); }
    float* bo = (float*)(F.ws + bias_off);
    for (int n = gw; n < nrows; n += NGW) {
        const v4u w = *(const GAS v4u*)((const signed char*)(F.ws + wq_off) + (size_t)n * DM + 16 * F.lane);
        const unsigned ww[4] = {w.x, w.y, w.z, w.w}; float d0 = 0.f, d1 = 0.f;
#pragma unroll
        for (int q = 0; q < 4; ++q)
#pragma unroll
            for (int i = 0; i < 4; ++i) { const float wv = (float)(int)(signed char)((ww[q] >> (8 * i)) & 255u); d0 += s0[q][i] * wv; d1 += s1[q][i] * wv; }
        d0 = wave_sum(d0); d1 = wave_sum(d1);
        if (F.lane == 0) { const float sc = SW[n]; bo[n] = d0 * sc; bo[bstride + n] = d1 * sc; }
    }
}
typedef attn::BlockRef<attn::bf16, attn::bf16> ABlock;
__device__ __forceinline__ ABlock attn_ref(Frame& F, int id, int& skv) {
    const int bgh = id >> 5, x = id & 31, b = bgh / 12, gh = bgh - b * 12, g = gh >> 2, d = 1 << (2 * g), nqb = 32 >> (2 * g), r = x / nqb, qb = x - r * nqb;
    ABlock R; const size_t e0 = (size_t)(b * SEQ + r) * AW + gh * 128;
    R.rs = d * AW; R.ls = d * 12; R.P0 = qb * 256; skv = SEQ / d;
    R.K = (const attn::bf16*)(F.ws + WS_K) + e0; R.V = (const attn::bf16*)(F.ws + WS_V) + e0;
    attn::bf16* q = (attn::bf16*)(F.ws + WS_Q) + e0 + (size_t)(qb * 256) * R.rs; R.Q = q; R.O = q;
    R.LSE = (float*)(F.ws + WS_LSE) + (size_t)(b * SEQ + r + qb * 256 * d) * 12 + gh;
    return R;
}
__device__ __forceinline__ void attn_phase(Frame& F, char* lds) {
    constexpr int NITEMS = 768;
    const int per = (NITEMS + F.G - 1) / F.G; int id = F.vcu * per; const int end = (id + per < NITEMS) ? id + per : NITEMS;
    if (id >= end) return;
    int skv, skvn; ABlock cur = attn_ref(F, id, skv);
    attn::Seam<attn::bf16> S;
    attn::causal_swa_prime<attn::bf16, attn::bf16>(cur, attn::WINDOW, lds, S);
    for (;;) {
        const bool last = id + 1 >= end; skvn = skv;
        const ABlock nxt = last ? cur : attn_ref(F, id + 1, skvn);
        attn::causal_swa_block<attn::bf16, attn::bf16>(cur, nxt, skv, attn::WINDOW, lds, S);
        if (last) break;
        cur = nxt; skv = skvn; ++id;
    }
}
__device__ __forceinline__ void merge_conv_pass(Frame& F, const Args& args) {
    const int gw = F.vcu * NWAVES + F.wave, NGW = F.G * NWAVES;
    { const bf16* OG = (const bf16*)(F.ws + WS_Q); const float* LSE = (const float*)(F.ws + WS_LSE); bf16* O = (bf16*)(F.ws + WS_O);
      const int h = F.lane >> 4, e = 8 * (F.lane & 15);
      for (int t = gw; t < M; t += NGW) {
          const float l0 = LSE[(size_t)t * 12 + h], l1 = LSE[(size_t)t * 12 + 4 + h], l2 = LSE[(size_t)t * 12 + 8 + h];
          const float mx = fmaxf(l0, fmaxf(l1, l2)); const float e0 = __expf(l0 - mx), e1 = __expf(l1 - mx), e2 = __expf(l2 - mx); const float inv = 1.0f / (e0 + e1 + e2);
          const float wg[3] = {e0 * inv, e1 * inv, e2 * inv};
          f32x4 a0 = {0.f, 0.f, 0.f, 0.f}, a1 = {0.f, 0.f, 0.f, 0.f};
#pragma unroll
          for (int g = 0; g < 3; ++g) { const v4u w = *(const GAS v4u*)(OG + (size_t)t * AW + (g * 4 + h) * 128 + e);
              a0 = a0 + (f32x4){blo(w.x), bhi(w.x), blo(w.y), bhi(w.y)} * wg[g]; a1 = a1 + (f32x4){blo(w.z), bhi(w.z), blo(w.w), bhi(w.w)} * wg[g]; }
          v4u o; o.x = pk2(a0.x, a0.y); o.y = pk2(a0.z, a0.w); o.z = pk2(a1.x, a1.y); o.w = pk2(a1.z, a1.w);
          *(GAS v4u*)(O + (size_t)t * 512 + 8 * F.lane) = o; } }
    { const bf16* U = (const bf16*)(F.ws + WS_U); bf16* Bv = (bf16*)(F.ws + WS_B); const bf16* Cg = (const bf16*)(F.ws + WS_C); const float* cw = args.in[I_CONVW];
      for (int it = gw; it < 2 * (M / 16); it += NGW) {
          const int ch = it & 1, t0 = (it >> 1) * 16, c0 = 512 * ch + 8 * F.lane;
          float w0[8], w1[8], w2[8], x1[8], x2[8];
#pragma unroll
          for (int i = 0; i < 8; ++i) { w0[i] = cw[c0 + i]; w1[i] = cw[DM + c0 + i]; w2[i] = cw[2 * DM + c0 + i]; x1[i] = 0.f; x2[i] = 0.f; }
          if ((t0 & (SEQ - 1)) != 0) {
#pragma unroll
              for (int p = 2; p >= 1; --p) { const v4u wu = *(const GAS v4u*)(U + (size_t)(t0 - p) * DM + c0), wc = *(const GAS v4u*)(Cg + (size_t)(t0 - p) * DM + c0);
                  const float xu[8] = {blo(wu.x), bhi(wu.x), blo(wu.y), bhi(wu.y), blo(wu.z), bhi(wu.z), blo(wu.w), bhi(wu.w)}, xc[8] = {blo(wc.x), bhi(wc.x), blo(wc.y), bhi(wc.y), blo(wc.z), bhi(wc.z), blo(wc.w), bhi(wc.w)};
#pragma unroll
                  for (int i = 0; i < 8; ++i) { if (p == 2) x2[i] = xu[i] * xc[i]; else x1[i] = xu[i] * xc[i]; } } }
#pragma unroll 4
          for (int r = 0; r < 16; ++r) { const size_t off = (size_t)(t0 + r) * DM + c0;
              const v4u wu = *(const GAS v4u*)(U + off), wc = *(const GAS v4u*)(Cg + off), wb = *(const GAS v4u*)(Bv + off);
              const float xu[8] = {blo(wu.x), bhi(wu.x), blo(wu.y), bhi(wu.y), blo(wu.z), bhi(wu.z), blo(wu.w), bhi(wu.w)}, xc[8] = {blo(wc.x), bhi(wc.x), blo(wc.y), bhi(wc.y), blo(wc.z), bhi(wc.z), blo(wc.w), bhi(wc.w)};
              const float xb[8] = {blo(wb.x), bhi(wb.x), blo(wb.y), bhi(wb.y), blo(wb.z), bhi(wb.z), blo(wb.w), bhi(wb.w)};
              float y[8];
#pragma unroll
              for (int i = 0; i < 8; ++i) { const float x0 = xu[i] * xc[i]; y[i] = xb[i] * (w0[i] * x2[i] + w1[i] * x1[i] + w2[i] * x0); x2[i] = x1[i]; x1[i] = x0; }
              v4u o; o.x = pk2(y[0], y[1]); o.y = pk2(y[2], y[3]); o.z = pk2(y[4], y[5]); o.w = pk2(y[6], y[7]);
              *(GAS v4u*)(Bv + off) = o; } } }
}


#ifdef NAIVE
template <bool DUAL, class St>
__device__ __forceinline__ void naive_gemm(Frame& F, const bf16* A, int lda, const float* W, const float* W2, int ldw, int M_, int N_, int K_, St store) {
    LAS float* As = (LAS float*)(F.lds + RING_OFF);
    LAS float* Ws = As + 64 * 33;
    LAS float* Ws2 = Ws + 32 * 68;
    const int ty = F.tid >> 4, tx = F.tid & 15, ntn = N_ / 64, ntiles = (M_ / 64) * ntn;
    for (int tile = blockIdx.x; tile < ntiles; tile += F.G) {
        const int tm = tile / ntn, tn = tile - tm * ntn;
        float acc[2][4] = {{0.f, 0.f, 0.f, 0.f}, {0.f, 0.f, 0.f, 0.f}}, acc2[2][4] = {{0.f, 0.f, 0.f, 0.f}, {0.f, 0.f, 0.f, 0.f}};
        for (int k0 = 0; k0 < K_; k0 += 32) {
            __syncthreads();
#pragma unroll
            for (int i = 0; i < 4; ++i) { const int e = F.tid + 512 * i, r = e >> 5, c = e & 31; As[r * 33 + c] = __uint_as_float((unsigned)A[(size_t)(tm * 64 + r) * lda + k0 + c] << 16); }
#pragma unroll
            for (int i = 0; i < 4; ++i) { const int e = F.tid + 512 * i, r = e >> 6, c = e & 63; Ws[r * 68 + c] = W[(size_t)(k0 + r) * ldw + tn * 64 + c]; if (DUAL) Ws2[r * 68 + c] = W2[(size_t)(k0 + r) * ldw + tn * 64 + c]; }
            __syncthreads();
#pragma unroll 8
            for (int kk = 0; kk < 32; ++kk) { const float a0 = As[(ty * 2) * 33 + kk], a1 = As[(ty * 2 + 1) * 33 + kk];
#pragma unroll
                for (int j = 0; j < 4; ++j) { const float w = Ws[kk * 68 + tx * 4 + j]; acc[0][j] += a0 * w; acc[1][j] += a1 * w;
                    if (DUAL) { const float w2 = Ws2[kk * 68 + tx * 4 + j]; acc2[0][j] += a0 * w2; acc2[1][j] += a1 * w2; } } }
        }
#pragma unroll
        for (int i = 0; i < 2; ++i)
#pragma unroll
            for (int j = 0; j < 4; ++j) store(tm * 64 + ty * 2 + i, tn * 64 + tx * 4 + j, acc[i][j], acc2[i][j]);
    }
    __syncthreads();
}
__device__ __forceinline__ bf16 f2b(float v) { return (bf16)f2bf(v); }
__device__ __forceinline__ float b2f(bf16 v) { return __uint_as_float((unsigned)v << 16); }
__device__ __forceinline__ void naive_attn(Frame& F) {
    const int gw = F.vcu * NWAVES + F.wave, NGW = F.G * NWAVES;
    bf16* Qb = (bf16*)(F.ws + WS_Q); const bf16* Kb = (const bf16*)(F.ws + WS_K); const bf16* Vb = (const bf16*)(F.ws + WS_V); float* LSE = (float*)(F.ws + WS_LSE);
    for (int it = gw; it < M * 12; it += NGW) {
        const int t = it / 12, gh = it - t * 12, g = gh >> 2, d = 1 << (2 * g), tl = t & (SEQ - 1);
        const float q0 = b2f(Qb[(size_t)t * AW + gh * 128 + 2 * F.lane]), q1 = b2f(Qb[(size_t)t * AW + gh * 128 + 2 * F.lane + 1]);
        float s0 = -INFINITY, s1 = -INFINITY, s2 = -INFINITY;
        for (int j = 0; j <= 128; ++j) { if (tl - j * d < 0) break; const size_t kr = (size_t)(t - j * d) * AW + gh * 128 + 2 * F.lane;
            const float sc = wave_sum(q0 * b2f(Kb[kr]) + q1 * b2f(Kb[kr + 1])) * 0.08838834764831845f;
            if (j < 64) { if (F.lane == j) s0 = sc; } else if (j < 128) { if (F.lane == j - 64) s1 = sc; } else { if (F.lane == 0) s2 = sc; } }
        float mx = fmaxf(s0, fmaxf(s1, s2));
#pragma unroll
        for (int o = 1; o < 64; o <<= 1) mx = fmaxf(mx, __shfl_xor(mx, o));
        const float p0 = __expf(s0 - mx), p1 = __expf(s1 - mx), p2 = __expf(s2 - mx);
        const float l = wave_sum(p0 + p1 + p2);
        float o0 = 0.f, o1 = 0.f;
        for (int j = 0; j <= 128; ++j) { if (tl - j * d < 0) break; const size_t vr = (size_t)(t - j * d) * AW + gh * 128 + 2 * F.lane;
            const float p = (j < 64) ? __shfl(p0, j) : (j < 128) ? __shfl(p1, j - 64) : __shfl(p2, 0);
            o0 += p * b2f(Vb[vr]); o1 += p * b2f(Vb[vr + 1]); }
        const float inv = 1.0f / l;
        Qb[(size_t)t * AW + gh * 128 + 2 * F.lane] = f2b(o0 * inv); Qb[(size_t)t * AW + gh * 128 + 2 * F.lane + 1] = f2b(o1 * inv);
        if (F.lane == 0) LSE[(size_t)t * 12 + gh] = mx + __logf(l);
    }
}
#endif

constexpr int N_PHASES = 17;
__global__ void __launch_bounds__(NWAVES * 64, 2) mega_fwd(Args args) {
    extern __shared__ __attribute__((aligned(16))) unsigned char lds[];
    Frame F;
    F.lds = (LAS unsigned char*)lds;
    F.MISC = (volatile LAS unsigned*)(F.lds + MISC_OFF);
    F.tid = threadIdx.x; F.lane = F.tid & 63; F.wave = __builtin_amdgcn_readfirstlane(F.tid >> 6);
    F.G = gridDim.x; { const int bx = blockIdx.x; F.vcu = (F.G % 8 == 0) ? (bx % 8) * (F.G / 8) + bx / 8 : bx; }
    F.ws = args.ws; F.out = args.out;
    F.ctl = (gu32*)(args.ws + WS_CTL);
    for (int u = F.tid; u < (LDS_BYTES - LDSCTL_OFF) / 4; u += NWAVES * 64) ((LAS unsigned*)(F.lds + LDSCTL_OFF))[u] = 0u;
    __syncthreads();
    XcdBarrier bar = xcd_barrier_post((unsigned*)(F.ctl + CW_BAR), F.MISC + 8);
    const int lo = args.ph_lo, hi = args.ph_hi;
    typedef pg8::bf16_t pb;
#define mod ((const float*)(args.ws + WS_MOD))
#define XS ((const pb*)(args.ws + WS_XS))
    unsigned char* const ws = args.ws;
#define IN(k) (lo <= (k) && (k) < hi)
#define FRESH() do { F.tid = tid_opaque(); F.lane = F.tid & 63; } while (0)
#ifdef PROBE_TA
#define TSTAMP(slot) do { if (F.tid == 0) { const unsigned long long t_ = rt(); F.MISC[16 + 2 * (slot)] = (unsigned)t_; F.MISC[17 + 2 * (slot)] = (unsigned)(t_ >> 32); } } while (0)
#define SEAM(k) do { if (IN(k) && IN((k) + 1)) xcd_barrier(bar); if ((k) == PROBE_TA) TSTAMP(0); if ((k) == PROBE_TB) TSTAMP(1); } while (0)
    if (PROBE_TA == -1) TSTAMP(0);
#else
#define SEAM(k) do { if (IN(k) && IN((k) + 1)) xcd_barrier(bar); } while (0)
#endif
#ifdef NAIVE
#define FUSE_NORM 0
#else
#define FUSE_NORM 1
#endif
#define XL ((PG8_LAS float*)(F.lds + XL_OFF))
#define PS2 ((const float*)(args.ws + WS_PS2))
#define PS3 ((const float*)(args.ws + WS_PS3))
#define bias_in ((const float*)(args.ws + WS_BIAS_IN))
#define bias_f2 ((const float*)(args.ws + WS_BIAS_F2))
#define avec ((const float*)(args.ws + WS_AVEC))
#define GEMM_BX(SCHED_DECL, SCHED_T, A_, K_, BT, N_, MODE, NRM, QKN_, O_, LDC, SPC, SPS, I1, I2, PS_, BIAS_, BSTR) do { pg8::Gemm g{(const pb*)(A_), (const pb*)(BT), M, (N_), (K_)}; SCHED_DECL; \
        typedef pg8::EpiB<MODE, (NRM), (QKN_)> EpiT; EpiT E{(pb*)(O_), (LDC), (SPC), (SPS), (const pb*)(I1), (const pb*)(I2), (PS_), (BIAS_), (BSTR), args.in[I_QN], args.in[I_KN], 2 * AW, XL, 0}; \
        pg8::gemm_phase<EpiT, SCHED_T, true, true>(F.lds + RING_OFF, g, S, E); } while (0)
#define GEMM_B(A_, K_, BT, N_, MODE, NRM, QKN_, O_, LDC, SPC, SPS, I1, I2, PS_, BIAS_, BSTR) \
        GEMM_BX(pg8::StaticOrder S; S.init(M, (N_), F.G, (int)blockIdx.x), pg8::StaticOrder, A_, K_, BT, N_, MODE, NRM, QKN_, O_, LDC, SPC, SPS, I1, I2, PS_, BIAS_, BSTR)
#define GEMM_F(XSO, A_, K_, BT, BASE, COEF, SCALE, AVEC_, PS_) do { pg8::Gemm g{(const pb*)(A_), (const pb*)(BT), M, DM, (K_)}; pg8::StaticOrder S; S.init(M, DM, F.G, (int)blockIdx.x); \
        typedef pg8::EpiF<(XSO)> EpiT; EpiT E{(BASE), F.out, (COEF), (pb*)(ws + WS_XS), (AVEC_), (float*)(PS_), XL, (SCALE)}; pg8::gemm_phase<EpiT, pg8::StaticOrder, true, true>(F.lds + RING_OFF, g, S, E); } while (0)

#define GEMM_I8(XQ_, WQ_, HASB, ROWF_, SW_, BIAS_) do { pg8::Gemm g{(const pb*)(XQ_), (const pb*)(WQ_), M, 2 * DFF, DM / 2}; pg8::StaticOrder S; S.init(M, 2 * DFF, F.G, (int)blockIdx.x);     \
        typedef pg8::EpiI8<(HASB)> EpiT; EpiT E{(pb*)(ws + WS_ACT), DFF, (ROWF_), (SW_), (BIAS_), 2 * DFF, XL, 0}; pg8::gemm_phase<EpiT, pg8::StaticOrder, true, true>(F.lds + RING_OFF, g, S, E); } while (0)
    const bool p0_split = false;
#if FUSE_NORM
    FRESH();
    if (IN(0)) { for (int it = blockIdx.x; it < ADA_ITEMS; it += F.G) p0_adaln_item(F, args, it);
                 if (p0_split && (int)blockIdx.x >= ADA_ITEMS) p0_transposes(F, args, 0, ((int)blockIdx.x - ADA_ITEMS) * NWAVES + F.wave, (256 - ADA_ITEMS) * NWAVES);
#if FFN_I8
                 if (F.G == 256 && (int)blockIdx.x >= ADA_ITEMS) wq_absmax(F, args, ((int)blockIdx.x - ADA_ITEMS) * NWAVES + F.wave, (256 - ADA_ITEMS) * NWAVES);
                 else if (F.G != 256) wq_absmax(F, args, F.vcu * NWAVES + F.wave, F.G * NWAVES);
#endif
    }
#else
    FRESH();
    if (IN(0)) { for (int it = blockIdx.x; it < ADA_ITEMS; it += F.G) p0_adaln_item(F, args, it); for (int st = 0; st < 3; ++st) p0_transposes(F, args, st, F.vcu * NWAVES + F.wave, F.G * NWAVES); }
#endif
    SEAM(0);
    FRESH();
    if (IN(1)) { norm_pass(F, args.in[I_X], args.in[I_NF1], MOD_SH1, MOD_SC1, FFN_I8 != 0); if (FUSE_NORM) { aux_avec(F, args); if (!p0_split) p0_transposes(F, args, 0, F.vcu * NWAVES + F.wave, F.G * NWAVES); } }
    SEAM(1);
#ifdef PROBE_XBAR
    xcd_barrier(bar); xcd_barrier(bar); xcd_barrier(bar); xcd_barrier(bar);
#endif
#if defined(NAIVE) && (NAIVE & 1)
    if (IN(2)) { bf16* ACT = (bf16*)(ws + WS_ACT); naive_gemm<true>(F, (const bf16*)XS, DM, args.in[I_F1G], args.in[I_F1U], DFF, M, DFF, DM, [=](int r, int c, float g, float u) { ACT[(size_t)r * DFF + c] = f2b(silu_f(g) * u); }); }
#else
#if FFN_I8
    if (IN(2)) GEMM_I8(ws + WS_XQ1, ws + WS_WGU1, false, (const float*)(ws + WS_SA1), (const float*)(ws + WS_SW1), nullptr);
#else
    if (IN(2)) GEMM_B(XS, DM, ws + WS_WGU1, 2 * DFF, pg8::EB_SWIGLU, false, false, ws + WS_ACT, DFF, 0, 0, nullptr, nullptr, nullptr, nullptr, 0);
#endif
    FRESH();
    if (FUSE_NORM && IN(2) && F.G == 256 && (int)blockIdx.x >= 128) p0_transposes(F, args, 1, ((int)blockIdx.x - 128) * NWAVES + F.wave, 128 * NWAVES);
    else if (FUSE_NORM && IN(2) && F.G != 256) p0_transposes(F, args, 1, F.vcu * NWAVES + F.wave, F.G * NWAVES);
#endif
    SEAM(2);
#if defined(NAIVE) && (NAIVE & 2)
    if (IN(3)) { const float* xb = args.in[I_X]; float* ob = F.out; naive_gemm<false>(F, (const bf16*)(ws + WS_ACT), DFF, args.in[I_F1D], nullptr, DM, M, DM, DFF, [=](int r, int c, float v, float) { ob[(size_t)r * DM + c] = xb[(size_t)r * DM + c] + 0.5f * mod[(r / SEQ) * NMOD + MOD_GT1 + c] * v; }); }
#else
    FRESH();
    if (FUSE_NORM && IN(3)) { aux_bias(F, 0);
#if FFN_I8
        aux_bias_i8(F, MOD_SH2, WS_WIN, WS_SWIN, 3 * AW, WS_BIAS_IN, INW);
#endif
    }
    if (IN(3)) GEMM_F(FUSE_NORM, ws + WS_ACT, DFF, ws + WS_WD1, args.in[I_X], mod + MOD_GT1, 0.5f, avec, ws + WS_PS2);
#endif
    SEAM(3);
#if FFN_I8
    FRESH();
    if (IN(3) && IN(5)) { xs_quant_pass(F, WS_PS2, WS_XQ2, WS_RF2); xcd_barrier(bar); }
#endif
#if !FUSE_NORM
    if (IN(4)) norm_pass(F, F.out, args.in[I_NMIX], MOD_SH2, MOD_SC2);
    SEAM(4);
#endif
#if defined(NAIVE) && (NAIVE & 4)
    if (IN(5)) { bf16* Qb = (bf16*)(ws + WS_Q); naive_gemm<false>(F, (const bf16*)XS, DM, args.in[I_WIN] + COL_Q, nullptr, INW, M, 3 * AW, DM, [=](int r, int c, float v, float) { const int t = c / AW; Qb[(size_t)t * M * AW + (size_t)r * AW + (c - t * AW)] = f2b(v); }); }
#else
#if FFN_I8
    if (IN(5)) { pg8::Gemm g{(const pb*)(ws + WS_XQ2), (const pb*)(ws + WS_WIN), M, 3 * AW, DM / 2}; pg8::StaticOrder S; S.init(M, 3 * AW, F.G, (int)blockIdx.x);
        typedef pg8::EpiQ8 EpiT; EpiT E{(pb*)(ws + WS_Q), AW, AW, (size_t)(WS_K - WS_Q) / 2, (const float*)(ws + WS_RF2), (const float*)(ws + WS_SWIN), bias_in, INW, args.in[I_QN], args.in[I_KN], 2 * AW, XL, 0};
        pg8::gemm_phase<EpiT, pg8::StaticOrder, true, true>(F.lds + RING_OFF, g, S, E); }
#else
    if (IN(5)) GEMM_B(XS, DM, ws + WS_WIN + (size_t)COL_Q * DM * 2, 3 * AW, pg8::EB_PLAIN, FUSE_NORM, FUSE_NORM, ws + WS_Q, AW, AW, (size_t)(WS_K - WS_Q) / 2, nullptr, nullptr, PS2, bias_in + COL_Q, INW);
#endif
    FRESH();
    if (FUSE_NORM && IN(5) && F.G == 256 && (int)blockIdx.x >= 128) p0_transposes(F, args, 2, ((int)blockIdx.x - 128) * NWAVES + F.wave, 128 * NWAVES);
    else if (FUSE_NORM && IN(5) && F.G != 256) p0_transposes(F, args, 2, F.vcu * NWAVES + F.wave, F.G * NWAVES);
#endif
    SEAM(5);
#if !FUSE_NORM
    if (IN(6)) qknorm_pass(F, args);
    SEAM(6);
#endif
#if defined(NAIVE) && (NAIVE & 8)
    if (IN(7)) naive_attn(F);
#else
    if (IN(7)) attn_phase(F, (char*)lds + RING_OFF);
#endif
    SEAM(7);
#if defined(NAIVE) && (NAIVE & 16)
    if (IN(8)) { bf16* Ub = (bf16*)(ws + WS_U); naive_gemm<false>(F, (const bf16*)XS, DM, args.in[I_WIN] + COL_U, nullptr, INW, M, 3 * DM, DM, [=](int r, int c, float v, float) { const int t = c / DM; Ub[(size_t)t * M * DM + (size_t)r * DM + (c - t * DM)] = f2b(v); }); }
#else
    if (IN(8)) GEMM_B(XS, DM, ws + WS_WIN + (size_t)COL_U * DM * 2, 3 * DM, pg8::EB_PLAIN, FUSE_NORM, false, ws + WS_U, DM, DM, (size_t)(WS_B - WS_U) / 2, nullptr, nullptr, PS2, bias_in + COL_U, INW);
#endif
    SEAM(8);
    FRESH();
    if (IN(9)) { merge_conv_pass(F, args);
#if FFN_I8
        aux_bias_i8(F, MOD_SH3, WS_WGU2, WS_SW2, 2 * DFF, WS_BIAS_F2, 2 * DFF);
#else
        if (FUSE_NORM) aux_bias(F, 1);
#endif
    }
    SEAM(9);
    { bf16* SGA = (bf16*)(ws + WS_SGA); bf16* SGC = (bf16*)(ws + WS_SGC); (void)SGA; (void)SGC;
#if defined(NAIVE) && (NAIVE & 32)
      if (IN(10)) naive_gemm<false>(F, (const bf16*)XS, DM, args.in[I_WIN] + COL_GA, nullptr, INW, M, DM, DM, [=](int r, int c, float v, float) { SGA[(size_t)r * DM + c] = f2b(1.0f / (1.0f + __expf(-v))); });
      if (IN(11)) naive_gemm<false>(F, (const bf16*)XS, DM, args.in[I_WIN] + COL_GC, nullptr, INW, M, DM, DM, [=](int r, int c, float v, float) { SGC[(size_t)r * DM + c] = f2b(1.0f / (1.0f + __expf(-v))); });
#else
    if (IN(10)) GEMM_BX(pg8::TwinOrder S; S.init(M, DM, F.G, (int)blockIdx.x); S.reps = 2, pg8::TwinOrder, XS, DM, ws + WS_WIN + (size_t)COL_GA * DM * 2, 2 * DM, pg8::EB_SIGMOID, FUSE_NORM, false,
                        ws + WS_SGA, DM, DM, (size_t)(WS_SGC - WS_SGA) / 2, nullptr, nullptr, PS2, bias_in + COL_GA, INW);
#endif
#ifdef NAIVE
    if (IN(11) && IN(12)) xcd_barrier(bar);
#endif
#if defined(NAIVE) && (NAIVE & 512)
      if (IN(12)) naive_gemm<false>(F, (const bf16*)(ws + WS_O), 512, args.in[I_WAB], nullptr, DM, M, DM, 512, [=](int r, int c, float v, float) { SGA[(size_t)r * DM + c] = f2b(b2f(SGA[(size_t)r * DM + c]) * v); });
#else
    if (IN(12)) GEMM_B(ws + WS_O, 512, ws + WS_WA, DM, pg8::EB_GATEMUL, false, false, ws + WS_SGA, DM, 0, 0, ws + WS_SGA, nullptr, nullptr, nullptr, 0);
#endif
#ifdef NAIVE
    if (IN(12) && IN(13)) xcd_barrier(bar);
#endif
#if defined(NAIVE) && (NAIVE & 1024)
      if (IN(13)) naive_gemm<false>(F, (const bf16*)(ws + WS_B), DM, args.in[I_WCB], nullptr, DM, M, DM, DM, [=](int r, int c, float v, float) { SGA[(size_t)r * DM + c] = f2b(b2f(SGA[(size_t)r * DM + c]) + b2f(SGC[(size_t)r * DM + c]) * v); });
#else
    if (IN(13)) GEMM_B(ws + WS_B, DM, ws + WS_WC, DM, pg8::EB_MERGE, false, false, ws + WS_SGA, DM, 0, 0, ws + WS_SGA, ws + WS_SGC, nullptr, nullptr, 0);
#endif
    }
    SEAM(13);
#if defined(NAIVE) && (NAIVE & 64)
    if (IN(14)) { float* ob = F.out; naive_gemm<false>(F, (const bf16*)(ws + WS_SGA), DM, args.in[I_WOUT], nullptr, DM, M, DM, DM, [=](int r, int c, float v, float) { ob[(size_t)r * DM + c] += mod[(r / SEQ) * NMOD + MOD_GT2 + c] * v; }); }
#else
    if (IN(14)) GEMM_F(FUSE_NORM, ws + WS_SGA, DM, ws + WS_WO, F.out, mod + MOD_GT2, 1.0f, avec + 2 * DM, ws + WS_PS3);
#endif
    SEAM(14);
#if FFN_I8
    FRESH();
    if (IN(14) && IN(16)) { xs_quant_pass(F, WS_PS3, WS_XQ3, WS_RF3); xcd_barrier(bar); }
#endif
#if !FUSE_NORM
    if (IN(15)) norm_pass(F, F.out, args.in[I_NF2], MOD_SH3, MOD_SC3);
    SEAM(15);
#endif
#if defined(NAIVE) && (NAIVE & 128)
    if (IN(16)) { bf16* ACT = (bf16*)(ws + WS_ACT); naive_gemm<true>(F, (const bf16*)XS, DM, args.in[I_F2G], args.in[I_F2U], DFF, M, DFF, DM, [=](int r, int c, float g, float u) { ACT[(size_t)r * DFF + c] = f2b(silu_f(g) * u); }); }
#else
#if FFN_I8
    if (IN(16)) GEMM_I8(ws + WS_XQ3, ws + WS_WGU2, true, (const float*)(ws + WS_RF3), (const float*)(ws + WS_SW2), bias_f2);
#else
    if (IN(16)) GEMM_B(XS, DM, ws + WS_WGU2, 2 * DFF, pg8::EB_SWIGLU, FUSE_NORM, false, ws + WS_ACT, DFF, 0, 0, nullptr, nullptr, PS3, bias_f2, 2 * DFF);
#endif
#endif
    SEAM(16);
#if defined(NAIVE) && (NAIVE & 256)
    if (IN(17)) { float* ob = F.out; naive_gemm<false>(F, (const bf16*)(ws + WS_ACT), DFF, args.in[I_F2D], nullptr, DM, M, DM, DFF, [=](int r, int c, float v, float) { ob[(size_t)r * DM + c] += 0.5f * mod[(r / SEQ) * NMOD + MOD_GT3 + c] * v; }); }
#else
    if (IN(17)) GEMM_F(false, ws + WS_ACT, DFF, ws + WS_WD2, F.out, mod + MOD_GT3, 0.5f, nullptr, nullptr);
#endif
#ifdef PROBE_TA
    if (PROBE_TB == 17) TSTAMP(1);
    xcd_barrier(bar);
    if (blockIdx.x == 0 && F.tid == 0) { const unsigned long long t0_ = ((unsigned long long)F.MISC[17] << 32) | F.MISC[16], t1_ = ((unsigned long long)F.MISC[19] << 32) | F.MISC[18];
#ifdef PROBE_CONST
        F.out[0] += (float)(PROBE_CONST); (void)t0_; (void)t1_; }
#else
        F.out[0] += (float)(PROBE_SCALE) * 0.01f * (float)(t1_ - t0_); }
#endif
#endif
#undef IN
#undef SEAM
#undef XL
#undef PS2
#undef PS3
#undef bias_in
#undef bias_f2
#undef avec
#undef mod
#undef XS
}

extern "C" void kernel_launch(void* const* d_in, const int* in_sizes, int n_in, void* d_out, int out_size, void* d_ws, size_t ws_size, hipStream_t stream) {
    static int grid = 0;
    if (grid == 0) {
        if (n_in != 20 || in_sizes[0] != M * DM || out_size != M * DM || ws_size < WS_END) { fprintf(stderr, "kernel_launch: shape/workspace mismatch (n_in %d, in0 %d, out %d, ws %zu < %zu)\n", n_in, n_in > 0 ? in_sizes[0] : -1, out_size, ws_size, (size_t)WS_END); grid = -1; return; }
        int dev = 0, cus = 0, per_cu = 0;
        if (hipGetDevice(&dev) != hipSuccess || hipDeviceGetAttribute(&cus, hipDeviceAttributeMultiprocessorCount, dev) != hipSuccess) { grid = -1; return; }
        if (hipFuncSetAttribute((const void*)mega_fwd, hipFuncAttributeMaxDynamicSharedMemorySize, LDS_BYTES) != hipSuccess) { fprintf(stderr, "kernel_launch: hipFuncSetAttribute failed\n"); grid = -1; return; }
        if (hipOccupancyMaxActiveBlocksPerMultiprocessor(&per_cu, (const void*)mega_fwd, NWAVES * 64, LDS_BYTES) != hipSuccess || per_cu < 1) { fprintf(stderr, "kernel_launch: occupancy query reports %d workgroups per CU\n", per_cu); }
        (void)hipGetLastError();
        grid = cus;
    }
    if (grid < 0) return;
    (void)hipMemsetAsync((char*)d_ws + WS_CTL, 0, CTL_ZERO_BYTES, stream);
#ifdef PROBE_MEMSET2
    (void)hipMemsetAsync((char*)d_ws + WS_CTL + CTL_ZERO_BYTES, 0, CTL_ZERO_BYTES, stream);
#endif
    Args a{};
    for (int i = 0; i < 20; ++i) a.in[i] = (const float*)d_in[i];
    a.out = (float*)d_out; a.ws = (unsigned char*)d_ws;
#if defined(PROBE_DUP)
    a.ph_lo = 0; a.ph_hi = PROBE_DUP + 1; hipLaunchKernelGGL(mega_fwd, dim3(grid), dim3(NWAVES * 64), LDS_BYTES, stream, a);
    (void)hipMemsetAsync((char*)d_ws + WS_CTL, 0, CTL_ZERO_BYTES, stream);
    a.ph_lo = PROBE_DUP; a.ph_hi = N_PHASES + 1; hipLaunchKernelGGL(mega_fwd, dim3(grid), dim3(NWAVES * 64), LDS_BYTES, stream, a);
#elif defined(PROBE_RLO)
    a.ph_lo = 0; a.ph_hi = PROBE_RHI + 1; hipLaunchKernelGGL(mega_fwd, dim3(grid), dim3(NWAVES * 64), LDS_BYTES, stream, a);
    (void)hipMemsetAsync((char*)d_ws + WS_CTL, 0, CTL_ZERO_BYTES, stream);
    a.ph_lo = PROBE_RLO; a.ph_hi = N_PHASES + 1; hipLaunchKernelGGL(mega_fwd, dim3(grid), dim3(NWAVES * 64), LDS_BYTES, stream, a);
#elif defined(PROBE_SPLIT)
    a.ph_lo = 0; a.ph_hi = PROBE_SPLIT + 1; hipLaunchKernelGGL(mega_fwd, dim3(grid), dim3(NWAVES * 64), LDS_BYTES, stream, a);
    (void)hipMemsetAsync((char*)d_ws + WS_CTL, 0, CTL_ZERO_BYTES, stream);
    a.ph_lo = PROBE_SPLIT + 1; a.ph_hi = N_PHASES + 1; hipLaunchKernelGGL(mega_fwd, dim3(grid), dim3(NWAVES * 64), LDS_BYTES, stream, a);
#elif !defined(MK_PER_PHASE)
    a.ph_lo = 0; a.ph_hi = N_PHASES + 1;
    hipLaunchKernelGGL(mega_fwd, dim3(grid), dim3(NWAVES * 64), LDS_BYTES, stream, a);
#else
    for (int p = 0; p <= N_PHASES; ++p) { a.ph_lo = p; a.ph_hi = p + 1; hipLaunchKernelGGL(mega_fwd, dim3(grid), dim3(NWAVES * 64), LDS_BYTES, stream, a); }
#endif
}
```

```cpp
#include <hip/hip_runtime.h>
#include <hip/hip_bf16.h>
#include <cstdio>
#include <cstdint>
#include <type_traits>

constexpr int DM = 1024, BATCH = 2, SEQ = 8192, M = BATCH * SEQ;
constexpr int DFF = 2816, NMOD = 9 * DM;
constexpr int AW = 1536;
constexpr int INW = 9728;
constexpr int COL_Q = 0, COL_K = 1536, COL_V = 3072, COL_U = 4608, COL_B = 5632, COL_C = 6656, COL_GA = 7680, COL_GC = 8704;
constexpr float EPS = 1e-6f;

__device__ __forceinline__ int tid_opaque() { int t = (int)threadIdx.x; asm volatile("" : "+v"(t)); return t; }

__device__ __forceinline__ int q8(float v) { return (int)fminf(fmaxf(rintf(v), -127.f), 127.f); }
__device__ __forceinline__ unsigned pk4q(float a, float b, float c, float d) { return (unsigned)(q8(a) & 255) | ((unsigned)(q8(b) & 255) << 8) | ((unsigned)(q8(c) & 255) << 16) | ((unsigned)(q8(d) & 255) << 24); }
namespace pg8 {
#define PG8_LAS __attribute__((address_space(3)))
typedef unsigned short bf16_t;
typedef short bf16x8 __attribute__((ext_vector_type(8)));
typedef float f32x4 __attribute__((ext_vector_type(4)));
typedef unsigned u32x4 __attribute__((ext_vector_type(4)));
typedef unsigned u32x2 __attribute__((ext_vector_type(2)));
typedef int i32x4 __attribute__((ext_vector_type(4)));
template <bool I8> __device__ __forceinline__ auto pg8_mma(bf16x8 b, bf16x8 a, typename std::conditional<I8, i32x4, f32x4>::type c) {
    if constexpr (I8) return __builtin_amdgcn_mfma_i32_16x16x64_i8(__builtin_bit_cast(i32x4, b), __builtin_bit_cast(i32x4, a), c, 0, 0, 0);
    else return __builtin_amdgcn_mfma_f32_16x16x32_bf16(b, a, c, 0, 0, 0);
}
constexpr int BM = 256, BK = 64, HALF = 128, HTB = HALF * BK * 2  , STAGE_BYTES = 8 * HTB, NXCD = 8, WGM = 8;

__host__ __device__ __forceinline__ int lds_byte(int r, int c) { const int st = (r >> 4) * 2 + (c >> 5), rr = r & 15, cc = c & 31, ob = rr * 64 + cc * 2; return st * 1024 + (ob ^ (((ob >> 9) & 1) << 5)); }
__host__ __device__ __forceinline__ void stage_rc(int b, int& R, int& C) { const int st = b / 1024, sb = b % 1024, swz = sb ^ (((sb >> 9) & 1) << 5); R = (st >> 1) * 16 + swz / 64; C = (st & 1) * 32 + (swz % 64) / 2; }
__host__ __device__ __forceinline__ int perm32(int rho) { const int n = rho >> 4, i = rho & 15; return 8 * (i >> 2) + 4 * n + (i & 3); }

struct Unit { int pm, pn; };
struct Gemm { const bf16_t* A; const bf16_t* Bt; int M, N, K; };

struct StaticOrder {
    int nM, nN, nwg, G, c;
    __host__ __device__ void init(int M, int N, int G_, int c_) { nM = M / BM; nN = N / BM; nwg = nM * nN; G = G_; c = c_; }
    __host__ __device__ bool next(int i, Unit& u) const {
        const long L = (long)i * G + c; if (L >= nwg) return false;
        int wgid = (int)L; { const int q = nwg / NXCD, r = nwg % NXCD, xcd = wgid % NXCD, off = wgid / NXCD; wgid = (xcd < r ? xcd * (q + 1) : r * (q + 1) + (xcd - r) * q) + off; }
        const int nig = WGM * nN, gid = wgid / nig, fm = gid * WGM, gsz = (nM - fm) < WGM ? (nM - fm) : WGM;
        u.pm = fm + ((wgid % nig) % gsz); u.pn = (wgid % nig) / gsz; return true;
    }
    __device__ __forceinline__ void a_ready(const Unit&) const {}
    __device__ __forceinline__ void done(const Unit&) const {}
};

typedef float f32x2_t __attribute__((ext_vector_type(2))); typedef __bf16 bf16x2_t __attribute__((ext_vector_type(2)));
__device__ __forceinline__ unsigned cvt_pk_bf16(float lo, float hi) { f32x2_t v = {lo, hi}; bf16x2_t b = __builtin_convertvector(v, bf16x2_t); return __builtin_bit_cast(unsigned, b); }
__device__ __forceinline__ float bf_lo(unsigned w) { return __uint_as_float(w << 16); }
__device__ __forceinline__ float bf_hi(unsigned w) { return __uint_as_float(w & 0xffff0000u); }
__device__ __forceinline__ float sigmoidf_(float x) { return __builtin_amdgcn_rcpf(1.0f + __builtin_amdgcn_exp2f(-1.4426950408889634f * x)); }
__device__ __forceinline__ void unpack8(const u32x4 w, f32x4& a, f32x4& b) { a = (f32x4){bf_lo(w.x), bf_hi(w.x), bf_lo(w.y), bf_hi(w.y)}; b = (f32x4){bf_lo(w.z), bf_hi(w.z), bf_lo(w.w), bf_hi(w.w)}; }
__device__ __forceinline__ u32x4 pack8(const f32x4 a, const f32x4 b) { u32x4 w; w.x = cvt_pk_bf16(a[0], a[1]); w.y = cvt_pk_bf16(a[2], a[3]); w.z = cvt_pk_bf16(b[0], b[1]); w.w = cvt_pk_bf16(b[2], b[3]); return w; }

enum { EB_PLAIN = 0, EB_SWIGLU = 1, EB_SIGMOID = 2, EB_GATEMUL = 3, EB_MERGE = 4, EB_PRODPLAIN = 5 };
__device__ __forceinline__ unsigned pk4u(f32x4 v) { return (unsigned)__builtin_rintf(v[0]) | ((unsigned)__builtin_rintf(v[1]) << 8) | ((unsigned)__builtin_rintf(v[2]) << 16) | ((unsigned)__builtin_rintf(v[3]) << 24); }
__device__ __forceinline__ void unpk8u(u32x2 w, f32x4& a, f32x4& b) { const float k = 1.0f / 255.0f;
    a = (f32x4){(float)(w[0] & 255u), (float)((w[0] >> 8) & 255u), (float)((w[0] >> 16) & 255u), (float)(w[0] >> 24)} * k; b = (f32x4){(float)(w[1] & 255u), (float)((w[1] >> 8) & 255u), (float)((w[1] >> 16) & 255u), (float)(w[1] >> 24)} * k; }
template <int mode, bool NORMED = false, bool QKN = false, bool G8 = false> struct EpiB {
    static constexpr bool PERM = true, AFTER_DRAIN = false, PREFETCH = NORMED, I8 = false; typedef f32x4 acc_t;
    bf16_t* O; int ldc; int split_cols; size_t split_stride; const bf16_t* In1; const bf16_t* In2;
    const float* PS; const float* bias; int bias_bstride; const float* gamma_q; const float* gamma_k; int qk_cols; PG8_LAS float* XL; int par;
    __device__ __forceinline__ void prefetch(const Unit& u, int wid, int buf) const {
        if (NORMED && wid < 4) { const int lane = threadIdx.x & 63; PG8_LAS unsigned char* X2 = (PG8_LAS unsigned char*)(XL + 2048) + buf * 5120;
            __builtin_amdgcn_global_load_lds((const unsigned*)(PS + (size_t)(u.pm * BM + wid * 64 + lane) * 4), (PG8_LAS unsigned*)(X2 + wid * 1024), 16, 0, 0);
            if (wid == 0) __builtin_amdgcn_global_load_lds((const unsigned*)(bias + (size_t)((u.pm * BM) / SEQ) * bias_bstride + u.pn * BM + lane * 4), (PG8_LAS unsigned*)(X2 + 4096), 16, 0, 0); }
    }
    __device__ __forceinline__ void operator()(f32x4 (&acc)[2][2][4][2], const Unit& u, int wr, int wc, int fr, int fq) const {
        const int row0 = u.pm * BM + wr * 64 + fr;
        if (NORMED) {
            const PG8_LAS float* X2 = XL + 2048 + par * 1280;
            f32x4 bv[2][2];
#pragma unroll
            for (int bj = 0; bj < 2; ++bj)
#pragma unroll
                for (int n = 0; n < 2; ++n) bv[bj][n] = *(const PG8_LAS f32x4*)(X2 + 1024 + bj * HALF + wc * 32 + 8 * fq + 4 * n);
#pragma unroll
            for (int ai = 0; ai < 2; ++ai)
#pragma unroll
                for (int m = 0; m < 4; ++m) { const f32x4 p = *(const PG8_LAS f32x4*)(X2 + (ai * HALF + wr * 64 + m * 16 + fr) * 4);
                    const float rstd = __builtin_amdgcn_rsqf(((p[0] + p[1]) + (p[2] + p[3])) * (1.0f / 1024.0f) + 1e-6f);
#pragma unroll
                    for (int bj = 0; bj < 2; ++bj)
#pragma unroll
                        for (int n = 0; n < 2; ++n) acc[ai][bj][m][n] = acc[ai][bj][m][n] * rstd + bv[bj][n]; }
        }
        if (mode == EB_SWIGLU) {
            const int col0 = u.pn * HALF + wc * 32 + 8 * fq;
#pragma unroll
            for (int ai = 0; ai < 2; ++ai)
#pragma unroll
                for (int m = 0; m < 4; ++m) { bf16_t* rowp = O + (size_t)(row0 + ai * HALF + m * 16) * ldc + col0;
                    f32x4 v0, v1;
#pragma unroll
                    for (int i = 0; i < 4; ++i) { const float g0 = acc[ai][0][m][0][i], g1 = acc[ai][0][m][1][i];
                        v0[i] = g0 * sigmoidf_(g0) * acc[ai][1][m][0][i]; v1[i] = g1 * sigmoidf_(g1) * acc[ai][1][m][1][i]; }
                    *(u32x4*)rowp = pack8(v0, v1); }
            return;
        }
        if (mode == EB_PRODPLAIN && u.pn * BM < split_cols) {
            const int col0 = u.pn * HALF + wc * 32 + 8 * fq;
#pragma unroll
            for (int ai = 0; ai < 2; ++ai)
#pragma unroll
                for (int m = 0; m < 4; ++m) { bf16_t* rowp = O + (size_t)(row0 + ai * HALF + m * 16) * ldc + col0;
                    *(u32x4*)rowp = pack8(acc[ai][0][m][0] * acc[ai][1][m][0], acc[ai][0][m][1] * acc[ai][1][m][1]); }
            return;
        }
        int colt = u.pn * BM; size_t boff = 0;
        if (QKN && colt < qk_cols) {
            PG8_LAS float* P = XL;
#pragma unroll
            for (int ai = 0; ai < 2; ++ai)
#pragma unroll
                for (int m = 0; m < 4; ++m)
#pragma unroll
                    for (int bj = 0; bj < 2; ++bj) { const f32x4 a = acc[ai][bj][m][0], b = acc[ai][bj][m][1];
                        float s = ((a[0] * a[0] + a[1] * a[1]) + (a[2] * a[2] + a[3] * a[3])) + ((b[0] * b[0] + b[1] * b[1]) + (b[2] * b[2] + b[3] * b[3]));
                        s += __shfl_xor(s, 16); s += __shfl_xor(s, 32);
                        if (fq == 0) P[((ai * HALF + wr * 64 + m * 16 + fr) * 2 + bj) * 4 + wc] = s; }
            asm volatile("s_waitcnt lgkmcnt(0)" ::: "memory"); __builtin_amdgcn_s_barrier(); asm volatile("" ::: "memory");
            const float* gm = (colt < (qk_cols >> 1) ? gamma_q : gamma_k) + wc * 32 + 8 * fq;
            const f32x4 g0 = *(const f32x4*)gm, g1 = *(const f32x4*)(gm + 4);
#pragma unroll
            for (int ai = 0; ai < 2; ++ai)
#pragma unroll
                for (int m = 0; m < 4; ++m)
#pragma unroll
                    for (int bj = 0; bj < 2; ++bj) { const f32x4 p = *(const PG8_LAS f32x4*)(P + ((ai * HALF + wr * 64 + m * 16 + fr) * 2 + bj) * 4);
                        const float r = __builtin_amdgcn_rsqf(((p[0] + p[1]) + (p[2] + p[3])) * (1.0f / 128.0f) + 1e-6f);
                        acc[ai][bj][m][0] = acc[ai][bj][m][0] * r * g0; acc[ai][bj][m][1] = acc[ai][bj][m][1] * r * g1; }
        }
        if (split_cols) { const int t = colt / split_cols; boff = (size_t)t * split_stride; colt -= t * split_cols; }
        const int col0 = colt + wc * 32 + 8 * fq;
        if (G8 && (mode == EB_GATEMUL || mode == EB_MERGE)) {
#pragma unroll
            for (int ai = 0; ai < 2; ++ai) {
                u32x2 g8[4][2]; u32x4 t16[4][2];
#pragma unroll
                for (int m = 0; m < 4; ++m)
#pragma unroll
                    for (int bj = 0; bj < 2; ++bj) { const size_t off = boff + (size_t)(row0 + ai * HALF + m * 16) * ldc + col0 + bj * HALF;
                        g8[m][bj] = *(const u32x2*)((const unsigned char*)(mode == EB_GATEMUL ? In1 : In2) + off); if (mode == EB_MERGE) t16[m][bj] = *(const u32x4*)(In1 + off); }
#pragma unroll
                for (int m = 0; m < 4; ++m)
#pragma unroll
                    for (int bj = 0; bj < 2; ++bj) { const size_t off = boff + (size_t)(row0 + ai * HALF + m * 16) * ldc + col0 + bj * HALF; f32x4 v0 = acc[ai][bj][m][0], v1 = acc[ai][bj][m][1], g0, g1;
                        unpk8u(g8[m][bj], g0, g1);
                        if (mode == EB_GATEMUL) { v0 = v0 * g0; v1 = v1 * g1; } else { f32x4 a0, a1; unpack8(t16[m][bj], a0, a1); v0 = a0 + g0 * v0; v1 = a1 + g1 * v1; }
                        *(u32x4*)(O + off) = pack8(v0, v1); } }
            return;
        }
#pragma unroll
        for (int ai = 0; ai < 2; ++ai)
#pragma unroll
            for (int m = 0; m < 4; ++m) { const size_t roff = boff + (size_t)(row0 + ai * HALF + m * 16) * ldc + col0;
#pragma unroll
                for (int bj = 0; bj < 2; ++bj) { const size_t off = roff + bj * HALF; f32x4 v0 = acc[ai][bj][m][0], v1 = acc[ai][bj][m][1];
                    if (mode == EB_SIGMOID) {
#pragma unroll
                        for (int i = 0; i < 4; ++i) { v0[i] = sigmoidf_(v0[i]); v1[i] = sigmoidf_(v1[i]); }
                        if (G8) { u32x2 q; q[0] = pk4u(v0 * 255.0f); q[1] = pk4u(v1 * 255.0f); *(u32x2*)((unsigned char*)O + off) = q; continue; }
                    } else if (mode == EB_GATEMUL) { f32x4 a0, a1; if (G8) unpk8u(*(const u32x2*)((const unsigned char*)In1 + off), a0, a1); else unpack8(*(const u32x4*)(In1 + off), a0, a1); v0 = v0 * a0; v1 = v1 * a1; }
                    else if (mode == EB_MERGE) { f32x4 a0, a1, g0, g1; unpack8(*(const u32x4*)(In1 + off), a0, a1); if (G8) unpk8u(*(const u32x2*)((const unsigned char*)In2 + off), g0, g1); else unpack8(*(const u32x4*)(In2 + off), g0, g1); v0 = a0 + g0 * v0; v1 = a1 + g1 * v1; }
                    *(u32x4*)(O + off) = pack8(v0, v1); } }
    }
};
template <bool HASBIAS> struct EpiI8 {
    static constexpr bool PERM = true, AFTER_DRAIN = false, PREFETCH = true, I8 = true; typedef i32x4 acc_t;
    bf16_t* O; int ldc; const float* rowf; const float* sw; const float* bias; int bias_bstride; PG8_LAS float* XL; int par;
    __device__ __forceinline__ void prefetch(const Unit& u, int wid, int buf) const {
        if (wid < 3) { const int lane = threadIdx.x & 63; PG8_LAS unsigned char* X2 = (PG8_LAS unsigned char*)(XL + 2048) + buf * 5120;
            if (wid == 0) __builtin_amdgcn_global_load_lds((const unsigned*)(rowf + (size_t)u.pm * BM + lane * 4), (PG8_LAS unsigned*)(X2), 16, 0, 0);
            else if (wid == 1) __builtin_amdgcn_global_load_lds((const unsigned*)(sw + (size_t)u.pn * BM + lane * 4), (PG8_LAS unsigned*)(X2 + 1024), 16, 0, 0);
            else if (HASBIAS) __builtin_amdgcn_global_load_lds((const unsigned*)(bias + (size_t)((u.pm * BM) / SEQ) * bias_bstride + u.pn * BM + lane * 4), (PG8_LAS unsigned*)(X2 + 2048), 16, 0, 0); }
    }
    __device__ __forceinline__ void operator()(acc_t (&acc)[2][2][4][2], const Unit& u, int wr, int wc, int fr, int fq) const {
        const int row0 = u.pm * BM + wr * 64 + fr, col0 = u.pn * HALF + wc * 32 + 8 * fq;
        const PG8_LAS float* X2 = XL + 2048 + par * 1280;
        f32x4 sv[2][2], bv[2][2];
#pragma unroll
        for (int bj = 0; bj < 2; ++bj)
#pragma unroll
            for (int n = 0; n < 2; ++n) { sv[bj][n] = *(const PG8_LAS f32x4*)(X2 + 256 + bj * HALF + wc * 32 + 8 * fq + 4 * n);
                bv[bj][n] = HASBIAS ? *(const PG8_LAS f32x4*)(X2 + 512 + bj * HALF + wc * 32 + 8 * fq + 4 * n) : (f32x4){0.f, 0.f, 0.f, 0.f}; }
#pragma unroll
        for (int ai = 0; ai < 2; ++ai)
#pragma unroll
            for (int m = 0; m < 4; ++m) { const float rf = X2[ai * HALF + wr * 64 + m * 16 + fr]; bf16_t* rowp = O + (size_t)(row0 + ai * HALF + m * 16) * ldc + col0;
                f32x4 v[2];
#pragma unroll
                for (int n = 0; n < 2; ++n) {
                    const f32x4 rg = sv[0][n] * rf, ru = sv[1][n] * rf;
                    const f32x4 ag = __builtin_convertvector(acc[ai][0][m][n], f32x4), au = __builtin_convertvector(acc[ai][1][m][n], f32x4);
                    const f32x4 g = ag * rg + bv[0][n], uu = au * ru + bv[1][n];
                    const f32x4 t = ag * (rg * -1.4426950408889634f) + bv[0][n] * -1.4426950408889634f;
                    f32x4 e; e[0] = __builtin_amdgcn_exp2f(t[0]); e[1] = __builtin_amdgcn_exp2f(t[1]); e[2] = __builtin_amdgcn_exp2f(t[2]); e[3] = __builtin_amdgcn_exp2f(t[3]);
                    const f32x4 d = e + 1.0f;
                    f32x4 sg; sg[0] = __builtin_amdgcn_rcpf(d[0]); sg[1] = __builtin_amdgcn_rcpf(d[1]); sg[2] = __builtin_amdgcn_rcpf(d[2]); sg[3] = __builtin_amdgcn_rcpf(d[3]);
                    v[n] = g * uu * sg; }
                const f32x4 v0 = v[0], v1 = v[1];
                *(u32x4*)rowp = pack8(v0, v1); }
    }
};
struct EpiG8 {
    static constexpr bool PERM = true, AFTER_DRAIN = false, PREFETCH = true, I8 = true; typedef i32x4 acc_t;
    unsigned char* O; int ldc; int split_cols; size_t split_stride; const float* rowf; const float* sw; const float* bias; int bias_bstride; PG8_LAS float* XL; int par;
    __device__ __forceinline__ void prefetch(const Unit& u, int wid, int buf) const {
        if (wid < 3) { const int lane = threadIdx.x & 63; PG8_LAS unsigned char* X2 = (PG8_LAS unsigned char*)(XL + 2048) + buf * 5120;
            if (wid == 0) __builtin_amdgcn_global_load_lds((const unsigned*)(rowf + (size_t)u.pm * BM + lane * 4), (PG8_LAS unsigned*)(X2), 16, 0, 0);
            else if (wid == 1) __builtin_amdgcn_global_load_lds((const unsigned*)(sw + (size_t)u.pn * BM + lane * 4), (PG8_LAS unsigned*)(X2 + 1024), 16, 0, 0);
            else __builtin_amdgcn_global_load_lds((const unsigned*)(bias + (size_t)((u.pm * BM) / SEQ) * bias_bstride + u.pn * BM + lane * 4), (PG8_LAS unsigned*)(X2 + 2048), 16, 0, 0); }
    }
    __device__ __forceinline__ void operator()(acc_t (&acc)[2][2][4][2], const Unit& u, int wr, int wc, int fr, int fq) const {
        const int row0 = u.pm * BM + wr * 64 + fr;
        const PG8_LAS float* X2 = XL + 2048 + par * 1280;
        f32x4 sv[2][2], bv[2][2];
#pragma unroll
        for (int bj = 0; bj < 2; ++bj)
#pragma unroll
            for (int n = 0; n < 2; ++n) { sv[bj][n] = *(const PG8_LAS f32x4*)(X2 + 256 + bj * HALF + wc * 32 + 8 * fq + 4 * n); bv[bj][n] = *(const PG8_LAS f32x4*)(X2 + 512 + bj * HALF + wc * 32 + 8 * fq + 4 * n); }
        int colt = u.pn * BM; const int t = colt / split_cols; const size_t boff = (size_t)t * split_stride; colt -= t * split_cols;
        const int col0 = colt + wc * 32 + 8 * fq;
#pragma unroll
        for (int ai = 0; ai < 2; ++ai)
#pragma unroll
            for (int m = 0; m < 4; ++m) { const float rf = X2[ai * HALF + wr * 64 + m * 16 + fr]; const size_t roff = boff + (size_t)(row0 + ai * HALF + m * 16) * ldc + col0;
#pragma unroll
                for (int bj = 0; bj < 2; ++bj) { u32x2 q;
#pragma unroll
                    for (int n = 0; n < 2; ++n) {
                        const f32x4 a = __builtin_convertvector(acc[ai][bj][m][n], f32x4);
                        const f32x4 t = a * (sv[bj][n] * (rf * -1.4426950408889634f)) + bv[bj][n] * -1.4426950408889634f;
                        f32x4 e; e[0] = __builtin_amdgcn_exp2f(t[0]); e[1] = __builtin_amdgcn_exp2f(t[1]); e[2] = __builtin_amdgcn_exp2f(t[2]); e[3] = __builtin_amdgcn_exp2f(t[3]);
                        const f32x4 d = e + 1.0f;
                        f32x4 sg; sg[0] = __builtin_amdgcn_rcpf(d[0]); sg[1] = __builtin_amdgcn_rcpf(d[1]); sg[2] = __builtin_amdgcn_rcpf(d[2]); sg[3] = __builtin_amdgcn_rcpf(d[3]);
                        sg = sg * 255.0f;
                        unsigned w = __builtin_amdgcn_cvt_pk_u8_f32(sg[0], 0u, 0u); w = __builtin_amdgcn_cvt_pk_u8_f32(sg[1], 1u, w); w = __builtin_amdgcn_cvt_pk_u8_f32(sg[2], 2u, w); w = __builtin_amdgcn_cvt_pk_u8_f32(sg[3], 3u, w);
                        q[n] = w; }
                    *(u32x2*)(O + roff + bj * HALF) = q; } }
    }
};
struct EpiGM8 {
    static constexpr bool PERM = true, AFTER_DRAIN = false, PREFETCH = false, I8 = true; typedef i32x4 acc_t;
    bf16_t* O; int ldc; const unsigned char* G; const float* rowf; const float* sw;
    __device__ __forceinline__ void operator()(acc_t (&acc)[2][2][4][2], const Unit& u, int wr, int wc, int fr, int fq) const {
        int row0 = u.pm * BM + wr * 64 + fr, col0 = u.pn * BM + wc * 32 + 8 * fq; asm volatile("" : "+v"(row0), "+v"(col0));
#pragma unroll
        for (int ai = 0; ai < 2; ++ai) {
#pragma unroll
            for (int m = 0; m < 4; ++m) { const float rf = rowf[row0 + ai * HALF + m * 16]; const unsigned roff = (unsigned)(row0 + ai * HALF + m * 16) * (unsigned)DM + (unsigned)col0;
#pragma unroll
                for (int bj = 0; bj < 2; ++bj) { f32x4 g0, g1; unpk8u(*(const u32x2*)(G + roff + bj * HALF), g0, g1);
                    const f32x4 s0 = *(const f32x4*)(sw + col0 + bj * HALF), s1 = *(const f32x4*)(sw + col0 + bj * HALF + 4);
                    const f32x4 v0 = __builtin_convertvector(acc[ai][bj][m][0], f32x4) * (s0 * rf) * g0, v1 = __builtin_convertvector(acc[ai][bj][m][1], f32x4) * (s1 * rf) * g1;
                    *(u32x4*)(O + roff + bj * HALF) = pack8(v0, v1); } } }
    }
};
template <int NS = 0> struct EpiQ8 {
    static constexpr bool PERM = true, AFTER_DRAIN = false, PREFETCH = true, I8 = true; typedef i32x4 acc_t;
    bf16_t* O; int ldc; int split_cols; size_t split_stride; const float* rowf; const float* sw; const float* bias; int bias_bstride; const float* gamma_q; const float* gamma_k; int qk_cols; PG8_LAS float* XL; int par;
    __device__ __forceinline__ void prefetch(const Unit& u, int wid, int buf) const {
        if (wid < 3) { const int lane = threadIdx.x & 63; PG8_LAS unsigned char* X2 = (PG8_LAS unsigned char*)(XL + 2048) + buf * 5120;
            if (wid == 0) __builtin_amdgcn_global_load_lds((const unsigned*)(rowf + (size_t)u.pm * BM + lane * 4), (PG8_LAS unsigned*)(X2), 16, 0, 0);
            else if (wid == 1) __builtin_amdgcn_global_load_lds((const unsigned*)(sw + (size_t)u.pn * BM + lane * 4), (PG8_LAS unsigned*)(X2 + 1024), 16, 0, 0);
            else __builtin_amdgcn_global_load_lds((const unsigned*)(bias + (size_t)((u.pm * BM) / SEQ) * bias_bstride + u.pn * BM + lane * 4), (PG8_LAS unsigned*)(X2 + 2048), 16, 0, 0); }
    }
    __device__ __forceinline__ void operator()(acc_t (&acc)[2][2][4][2], const Unit& u, int wr, int wc, int fr, int fq) const {
        if (NS == 2) return;
        const int row0 = u.pm * BM + wr * 64 + fr;
        const PG8_LAS float* X2 = XL + 2048 + par * 1280;
        f32x4 sv[2][2], bv[2][2], v[2][2][4][2];
#pragma unroll
        for (int bj = 0; bj < 2; ++bj)
#pragma unroll
            for (int n = 0; n < 2; ++n) { sv[bj][n] = *(const PG8_LAS f32x4*)(X2 + 256 + bj * HALF + wc * 32 + 8 * fq + 4 * n); bv[bj][n] = *(const PG8_LAS f32x4*)(X2 + 512 + bj * HALF + wc * 32 + 8 * fq + 4 * n); }
#pragma unroll
        for (int ai = 0; ai < 2; ++ai)
#pragma unroll
            for (int m = 0; m < 4; ++m) { const float rf = X2[ai * HALF + wr * 64 + m * 16 + fr];
#pragma unroll
                for (int bj = 0; bj < 2; ++bj)
#pragma unroll
                    for (int n = 0; n < 2; ++n)
#pragma unroll
                        for (int i = 0; i < 4; ++i) v[ai][bj][m][n][i] = (float)acc[ai][bj][m][n][i] * (rf * sv[bj][n][i]) + bv[bj][n][i]; }
        int colt = u.pn * BM; size_t boff = 0;
        if (colt < qk_cols) {
            PG8_LAS float* P = XL;
#pragma unroll
            for (int ai = 0; ai < 2; ++ai)
#pragma unroll
                for (int m = 0; m < 4; ++m)
#pragma unroll
                    for (int bj = 0; bj < 2; ++bj) { const f32x4 a = v[ai][bj][m][0], b = v[ai][bj][m][1];
                        float s = ((a[0] * a[0] + a[1] * a[1]) + (a[2] * a[2] + a[3] * a[3])) + ((b[0] * b[0] + b[1] * b[1]) + (b[2] * b[2] + b[3] * b[3]));
                        s += __shfl_xor(s, 16); s += __shfl_xor(s, 32);
                        if (fq == 0) P[((ai * HALF + wr * 64 + m * 16 + fr) * 2 + bj) * 4 + wc] = s; }
            asm volatile("s_waitcnt lgkmcnt(0)" ::: "memory"); __builtin_amdgcn_s_barrier(); asm volatile("" ::: "memory");
            const float* gm = (colt < (qk_cols >> 1) ? gamma_q : gamma_k) + wc * 32 + 8 * fq;
            const f32x4 g0 = *(const f32x4*)gm, g1 = *(const f32x4*)(gm + 4);
#pragma unroll
            for (int ai = 0; ai < 2; ++ai)
#pragma unroll
                for (int m = 0; m < 4; ++m)
#pragma unroll
                    for (int bj = 0; bj < 2; ++bj) { const f32x4 p = *(const PG8_LAS f32x4*)(P + ((ai * HALF + wr * 64 + m * 16 + fr) * 2 + bj) * 4);
                        const float r = __builtin_amdgcn_rsqf(((p[0] + p[1]) + (p[2] + p[3])) * (1.0f / 128.0f) + 1e-6f);
                        v[ai][bj][m][0] = v[ai][bj][m][0] * r * g0; v[ai][bj][m][1] = v[ai][bj][m][1] * r * g1; }
        }
        if (split_cols) { const int t = colt / split_cols; boff = (size_t)t * split_stride; colt -= t * split_cols; }
        const int col0 = colt + wc * 32 + 8 * fq;
#pragma unroll
        for (int ai = 0; ai < 2; ++ai)
#pragma unroll
            for (int m = 0; m < 4; ++m) { const size_t roff = boff + (size_t)(row0 + ai * HALF + m * 16) * ldc + col0;
#pragma unroll
                for (int bj = 0; bj < 2; ++bj) { const u32x4 pk = pack8(v[ai][bj][m][0], v[ai][bj][m][1]); if (NS == 1) { asm volatile("" :: "v"(pk)); } else *(u32x4*)(O + roff + bj * HALF) = pk; } }
    }
};
#ifndef EPIF_F32_DEPTH
#define EPIF_F32_DEPTH 2
#endif
#ifndef EPIF_B16_DEPTH
#define EPIF_B16_DEPTH 2
#endif
template <bool XSOUT = false, bool BASE16 = false, bool OUT16 = false, int QMODE = 0> struct EpiF {
    static constexpr bool I8 = false; typedef f32x4 acc_t;
    static constexpr bool PERM = true, AFTER_DRAIN = false, PREFETCH = false;
    static constexpr bool AVRELOAD = QMODE != 0 && !BASE16;
    const void* base_; void* out_; const float* coef; bf16_t* XS; const float* avec; float* PS; PG8_LAS float* XL; float scale;
    signed char* XQ; float* RF; unsigned* AM; unsigned* CNT;
    __device__ __forceinline__ void operator()(f32x4 (&acc)[2][2][4][2], const Unit& u, int wr, int wc, int fr, int fq) const {
        const int row0 = u.pm * BM + wr * 64 + fr, col0 = u.pn * BM + wc * 32 + 8 * fq, bt = (u.pm * BM) / SEQ;
        const float* base = (const float*)base_; float* out = (float*)out_; const bf16_t* base16 = (const bf16_t*)base_; bf16_t* out16 = (bf16_t*)out_; (void)base; (void)out; (void)base16; (void)out16;
        const float* cf = coef + (size_t)bt * NMOD + col0;
        f32x4 cv[2][2], av[2][2];
#pragma unroll
        for (int bj = 0; bj < 2; ++bj)
#pragma unroll
            for (int n = 0; n < 2; ++n) { cv[bj][n] = *(const f32x4*)(cf + bj * HALF + n * 4) * scale; if (XSOUT && !AVRELOAD) av[bj][n] = *(const f32x4*)(avec + bt * DM + col0 + bj * HALF + n * 4); }
        const float* avp = avec + bt * DM + col0; (void)avp;
        PG8_LAS float* P = XL;
        constexpr int NSLOT = BASE16 ? EPIF_B16_DEPTH : EPIF_F32_DEPTH;
        f32x4 pre[BASE16 ? 1 : NSLOT][2][2];
        u32x4 pre16[BASE16 ? NSLOT : 1][2];
#define EPIF_LOAD(slot, q) do { const size_t off_ = (size_t)(row0 + ((q) >> 2) * HALF + ((q) & 3) * 16) * DM + col0; \
            if (BASE16) { _Pragma("unroll") for (int bj = 0; bj < 2; ++bj) pre16[slot][bj] = *(const u32x4*)(base16 + off_ + bj * HALF); } \
            else { _Pragma("unroll") for (int bj = 0; bj < 2; ++bj) _Pragma("unroll") for (int n = 0; n < 2; ++n) pre[slot][bj][n] = *(const f32x4*)(base + off_ + bj * HALF + n * 4); } } while (0)
#define EPIF_DO(slot, q) do { const int ai = (q) >> 2, m = (q) & 3; const size_t off = (size_t)(row0 + ai * HALF + m * 16) * DM + col0; float ss = 0.f, amx = 0.f; \
            _Pragma("unroll") for (int bj = 0; bj < 2; ++bj) { f32x4 b0, b1; \
                if (BASE16) { const u32x4 w = pre16[slot][bj]; b0 = (f32x4){__builtin_bit_cast(float, w[0] << 16), __builtin_bit_cast(float, w[0] & 0xffff0000u), __builtin_bit_cast(float, w[1] << 16), __builtin_bit_cast(float, w[1] & 0xffff0000u)}; \
                                                               b1 = (f32x4){__builtin_bit_cast(float, w[2] << 16), __builtin_bit_cast(float, w[2] & 0xffff0000u), __builtin_bit_cast(float, w[3] << 16), __builtin_bit_cast(float, w[3] & 0xffff0000u)}; } \
                else { b0 = pre[slot][bj][0]; b1 = pre[slot][bj][1]; } \
                const f32x4 o0 = b0 + cv[bj][0] * acc[ai][bj][m][0], o1 = b1 + cv[bj][1] * acc[ai][bj][m][1]; \
                if (OUT16) *(u32x4*)(out16 + off + bj * HALF) = pack8(o0, o1); else { *(f32x4*)(out + off + bj * HALF) = o0; *(f32x4*)(out + off + bj * HALF + 4) = o1; } \
                if (XSOUT) { ss += ((o0[0] * o0[0] + o0[1] * o0[1]) + (o0[2] * o0[2] + o0[3] * o0[3])) + ((o1[0] * o1[0] + o1[1] * o1[1]) + (o1[2] * o1[2] + o1[3] * o1[3])); \
                    const f32x4 x0 = o0 * (AVRELOAD ? *(const f32x4*)(avp + bj * HALF) : av[bj][0]), x1 = o1 * (AVRELOAD ? *(const f32x4*)(avp + bj * HALF + 4) : av[bj][1]); \
                    if (QMODE != 2) *(u32x4*)(XS + off + bj * HALF) = pack8(x0, x1); \
                    if (QMODE) { acc[ai][bj][m][0] = x0; acc[ai][bj][m][1] = x1; const f32x4 a0 = __builtin_elementwise_max(__builtin_elementwise_abs(x0), __builtin_elementwise_abs(x1)); \
                        amx = fmaxf(amx, fmaxf(fmaxf(a0[0], a0[1]), fmaxf(a0[2], a0[3]))); } } } \
            if (XSOUT) { ss += __shfl_xor(ss, 16); ss += __shfl_xor(ss, 32); if (QMODE) { amx = fmaxf(amx, __shfl_xor(amx, 16)); amx = fmaxf(amx, __shfl_xor(amx, 32)); } \
                if (fq == 0) { P[(ai * HALF + wr * 64 + m * 16 + fr) * 4 + wc] = ss; if (QMODE) P[1024 + (ai * HALF + wr * 64 + m * 16 + fr) * 4 + wc] = amx; } } } while (0)
        if constexpr (NSLOT == 8) {
            EPIF_LOAD(0, 0); EPIF_LOAD(1, 1); EPIF_LOAD(2, 2); EPIF_LOAD(3, 3); EPIF_LOAD(4, 4); EPIF_LOAD(5, 5); EPIF_LOAD(6, 6); EPIF_LOAD(7, 7);
            EPIF_DO(0, 0); EPIF_DO(1, 1); EPIF_DO(2, 2); EPIF_DO(3, 3); EPIF_DO(4, 4); EPIF_DO(5, 5); EPIF_DO(6, 6); EPIF_DO(7, 7);
        } else if constexpr (NSLOT == 4) {
            EPIF_LOAD(0, 0); EPIF_LOAD(1, 1); EPIF_LOAD(2, 2); EPIF_LOAD(3, 3);
            EPIF_DO(0, 0); EPIF_LOAD(0, 4); EPIF_DO(1, 1); EPIF_LOAD(1, 5); EPIF_DO(2, 2); EPIF_LOAD(2, 6); EPIF_DO(3, 3); EPIF_LOAD(3, 7);
            EPIF_DO(0, 4); EPIF_DO(1, 5); EPIF_DO(2, 6); EPIF_DO(3, 7);
        } else {
        EPIF_LOAD(0, 0); EPIF_LOAD(1, 1);
        EPIF_DO(0, 0); EPIF_LOAD(0, 2); EPIF_DO(1, 1); EPIF_LOAD(1, 3); EPIF_DO(0, 2); EPIF_LOAD(0, 4); EPIF_DO(1, 3); EPIF_LOAD(1, 5);
        EPIF_DO(0, 4); EPIF_LOAD(0, 6); EPIF_DO(1, 5); EPIF_LOAD(1, 7); EPIF_DO(0, 6); EPIF_DO(1, 7);
        }
#undef EPIF_LOAD
#undef EPIF_DO
        if (XSOUT) {
            asm volatile("s_waitcnt lgkmcnt(0)" ::: "memory"); __builtin_amdgcn_s_barrier(); asm volatile("" ::: "memory");
            const int tid = threadIdx.x; const int grow = u.pm * BM + tid;
            if (!QMODE) { if (tid < BM) { const f32x4 p = *(const PG8_LAS f32x4*)(P + tid * 4); PS[(size_t)grow * 4 + u.pn] = (p[0] + p[1]) + (p[2] + p[3]); } }
            else {
                if (tid < BM) { const f32x4 p = *(const PG8_LAS f32x4*)(P + tid * 4), a = *(const PG8_LAS f32x4*)(P + 1024 + tid * 4);
                    const float s = (p[0] + p[1]) + (p[2] + p[3]), am = fmaxf(fmaxf(a[0], a[1]), fmaxf(a[2], a[3]));
                    const unsigned r1 = __hip_atomic_fetch_max(AM + grow, __builtin_bit_cast(unsigned, am), __ATOMIC_RELAXED, __HIP_MEMORY_SCOPE_AGENT);
                    const unsigned r2 = __hip_atomic_exchange((unsigned*)PS + (size_t)grow * 4 + u.pn, __builtin_bit_cast(unsigned, s), __ATOMIC_RELAXED, __HIP_MEMORY_SCOPE_AGENT);
                    asm volatile("" :: "v"(r1), "v"(r2)); }
                asm volatile("s_waitcnt vmcnt(0)" ::: "memory"); __builtin_amdgcn_s_barrier(); asm volatile("" ::: "memory");
                if (tid == 0) { unsigned* c = CNT + 64 * u.pm; (void)__hip_atomic_fetch_add(c, 1u, __ATOMIC_RELAXED, __HIP_MEMORY_SCOPE_AGENT);
                    unsigned sp = 0; while (__hip_atomic_load(c, __ATOMIC_RELAXED, __HIP_MEMORY_SCOPE_AGENT) < 4u && ++sp < (1u << 22)) __builtin_amdgcn_s_sleep(1); }
                __builtin_amdgcn_s_barrier(); asm volatile("" ::: "memory");
                if (tid < BM) { const float am = __builtin_bit_cast(float, __hip_atomic_load(AM + grow, __ATOMIC_RELAXED, __HIP_MEMORY_SCOPE_AGENT));
                    P[tid] = am > 0.f ? 127.0f / am : 0.f;
                    if (u.pn == 0) { float sq[4];
#pragma unroll
                        for (int k = 0; k < 4; ++k) sq[k] = __builtin_bit_cast(float, __hip_atomic_load((unsigned*)PS + (size_t)grow * 4 + k, __ATOMIC_RELAXED, __HIP_MEMORY_SCOPE_AGENT));
                        RF[grow] = __builtin_amdgcn_rsqf(((sq[0] + sq[1]) + (sq[2] + sq[3])) * (1.0f / 1024.0f) + 1e-6f) * am * (1.0f / 127.0f); } }
                asm volatile("s_waitcnt lgkmcnt(0)" ::: "memory"); __builtin_amdgcn_s_barrier(); asm volatile("" ::: "memory");
#pragma unroll
                for (int ai = 0; ai < 2; ++ai)
#pragma unroll
                    for (int m = 0; m < 4; ++m) { const int rl = ai * HALF + wr * 64 + m * 16 + fr; const float inv = P[rl];
#pragma unroll
                        for (int bj = 0; bj < 2; ++bj) { const f32x4 x0 = acc[ai][bj][m][0] * inv, x1 = acc[ai][bj][m][1] * inv; u32x2 qv; qv[0] = pk4q(x0[0], x0[1], x0[2], x0[3]); qv[1] = pk4q(x1[0], x1[1], x1[2], x1[3]);
                            *(u32x2*)(XQ + (size_t)(u.pm * BM + rl) * DM + col0 + bj * HALF) = qv; } }
            }
        }
    }
};

struct TwinOrder : StaticOrder {
    int reps;
    __device__ bool next(int i, Unit& u) const { if (i >= reps) return false; if (!StaticOrder::next(0, u)) return false; u.pn += 4 * i; return true; }
};
template <class Epi, class Sched, bool ALIGN_EPI = false, bool SP2 = false>
__device__ __forceinline__ void gemm_phase(PG8_LAS unsigned char* lds, const Gemm g, const Sched& S, Epi E) {
    const int tid = tid_opaque(), wid = __builtin_amdgcn_readfirstlane(tid >> 6), lane = tid & 63, wr = wid >> 2, wc = wid & 3, fr = lane & 15, fq = lane >> 4;
    const int K = g.K, nt = K / BK;
    unsigned voffA[2], voffB[2];
#pragma unroll
    for (int i = 0; i < 2; ++i) { int R, C; stage_rc(tid * 16 + i * 8192, R, C); const int Rb = Epi::PERM ? ((R & ~31) + perm32(R & 31)) : R;
        voffA[i] = (unsigned)(R * K + C) * 2u; voffB[i] = (unsigned)(Rb * K + C) * 2u; }
    const size_t kstep = (size_t)(BK * 2);
    const size_t hstep = (size_t)HALF * K * 2;
    const size_t tstep = 2 * hstep;
    const unsigned ldsw = (unsigned)wid * 1024u;
    const int aoff = lds_byte(wr * 64 + fr, fq * 8), boff = lds_byte(wc * 32 + fr, fq * 8);
#define PG8_SA(b, h) (((b) * 2 + (h)) * HTB)
#define PG8_SB(b, h) ((4 + (b) * 2 + (h)) * HTB)
#define PG8_STAGE(bufoff, gbase, voff) do { _Pragma("unroll") for (int _i = 0; _i < 2; ++_i) \
        __builtin_amdgcn_global_load_lds((const unsigned*)((const char*)(gbase) + (voff)[_i]), (PG8_LAS unsigned*)(lds + (bufoff) + ldsw + _i * 8192), 16, 0, 0); } while (0)
#define PG8_LDA(dst, b, h) do { _Pragma("unroll") for (int m = 0; m < 4; ++m) _Pragma("unroll") for (int k = 0; k < 2; ++k) dst[m][k] = *(const PG8_LAS bf16x8*)(lds + PG8_SA(b, h) + aoff + m * 2048 + k * 1024); } while (0)
#define PG8_LDB(dst, b, h) do { _Pragma("unroll") for (int n = 0; n < 2; ++n) _Pragma("unroll") for (int k = 0; k < 2; ++k) dst[n][k] = *(const PG8_LAS bf16x8*)(lds + PG8_SB(b, h) + boff + n * 2048 + k * 1024); } while (0)
#define PG8_MMA(ai, bj, At, Bt) do { __builtin_amdgcn_s_setprio(1); _Pragma("unroll") for (int m = 0; m < 4; ++m) _Pragma("unroll") for (int n = 0; n < 2; ++n) _Pragma("unroll") for (int k = 0; k < 2; ++k) \
        acc[ai][bj][m][n] = pg8_mma<Epi::I8>(Bt[n][k], At[m][k], acc[ai][bj][m][n]); __builtin_amdgcn_s_setprio(0); } while (0)
#define PG8_WAIT_V(n) asm volatile("s_waitcnt vmcnt(" #n ")" ::: "memory")
#define PG8_WAIT_L(n) asm volatile("s_waitcnt lgkmcnt(" #n ")" ::: "memory")
#define PG8_BAR __builtin_amdgcn_s_barrier()
#define PG8_SCHED __builtin_amdgcn_sched_barrier(0)
    Unit cur, nxt; int ui = 0;
    if (!S.next(0, cur)) return;
    typedef typename Epi::acc_t acc_t;
    acc_t acc[2][2][4][2];
#pragma unroll
    for (int a = 0; a < 2; ++a)
#pragma unroll
        for (int b = 0; b < 2; ++b)
#pragma unroll
            for (int m = 0; m < 4; ++m)
#pragma unroll
                for (int n = 0; n < 2; ++n) acc[a][b][m][n] = acc_t{};
    bf16x8 At[4][2], B0[2][2], B1[2][2];
    const char* cA = (const char*)g.A + (size_t)cur.pm * tstep; const char* cB = (const char*)g.Bt + (size_t)cur.pn * tstep;
    S.a_ready(cur);
    if constexpr (Epi::PREFETCH) E.prefetch(cur, wid, 0);
    if constexpr (SP2) {
        PG8_STAGE(PG8_SB(0, 0), cB, voffB); PG8_STAGE(PG8_SB(0, 1), cB + hstep, voffB); PG8_STAGE(PG8_SA(0, 0), cA, voffA); PG8_STAGE(PG8_SA(0, 1), cA + hstep, voffA);
        if (wr == 1) PG8_BAR;
        PG8_WAIT_V(2); PG8_BAR;
        PG8_STAGE(PG8_SB(1, 0), cB + kstep, voffB); PG8_STAGE(PG8_SA(1, 0), cA + kstep, voffA); PG8_STAGE(PG8_SB(1, 1), cB + hstep + kstep, voffB);
        PG8_WAIT_V(6); PG8_BAR;
    } else {
        PG8_STAGE(PG8_SB(0, 0), cB, voffB); PG8_STAGE(PG8_SA(0, 0), cA, voffA); PG8_STAGE(PG8_SB(0, 1), cB + hstep, voffB); PG8_STAGE(PG8_SA(0, 1), cA + hstep, voffA);
        if (wr == 1) PG8_BAR;
        PG8_WAIT_V(4); PG8_BAR;
        PG8_STAGE(PG8_SB(1, 0), cB + kstep, voffB); PG8_STAGE(PG8_SA(1, 0), cA + kstep, voffA); PG8_STAGE(PG8_SB(1, 1), cB + hstep + kstep, voffB);
        PG8_WAIT_V(6); PG8_BAR;
    }
    for (;;) {
        const bool has_next = S.next(ui + 1, nxt);
        const char* nA = has_next ? (const char*)g.A + (size_t)nxt.pm * tstep : cA; const char* nB = has_next ? (const char*)g.Bt + (size_t)nxt.pn * tstep : cB;
        for (int t = 0; t < nt; t += 2) {
            const bool last = (t == nt - 2);
            const char* a1 = cA + (size_t)(t + 1) * kstep;
            const char* a2 = last ? nA : cA + (size_t)(t + 2) * kstep; const char* b2 = last ? nB : cB + (size_t)(t + 2) * kstep;
            const char* a3 = a2 + kstep; const char* b3 = b2 + kstep;
            if (last && has_next) S.a_ready(nxt);
            if constexpr (SP2) {
            PG8_LDB(B0, 0, 0); PG8_LDB(B1, 0, 1); PG8_SCHED; PG8_LDA(At, 0, 0); PG8_STAGE(PG8_SA(1, 1), a1 + hstep, voffA);
            PG8_WAIT_V(8); PG8_WAIT_L(0); PG8_BAR; PG8_MMA(0, 0, At, B0); PG8_MMA(0, 1, At, B1); PG8_BAR; PG8_SCHED;
            PG8_LDA(At, 0, 1); PG8_STAGE(PG8_SB(0, 0), b2, voffB); PG8_STAGE(PG8_SB(0, 1), b2 + hstep, voffB); PG8_STAGE(PG8_SA(0, 0), a2, voffA);
            PG8_WAIT_V(8); PG8_WAIT_L(0); PG8_BAR; PG8_MMA(1, 0, At, B0); PG8_MMA(1, 1, At, B1); PG8_BAR; PG8_SCHED;
            PG8_LDB(B0, 1, 0); PG8_LDB(B1, 1, 1); PG8_SCHED; PG8_LDA(At, 1, 0); PG8_STAGE(PG8_SA(0, 1), a2 + hstep, voffA);
            PG8_WAIT_V(8); PG8_WAIT_L(0); PG8_BAR; PG8_MMA(0, 0, At, B0); PG8_MMA(0, 1, At, B1); PG8_BAR; PG8_SCHED;
            PG8_LDA(At, 1, 1); PG8_STAGE(PG8_SB(1, 0), b3, voffB); PG8_STAGE(PG8_SB(1, 1), b3 + hstep, voffB); PG8_STAGE(PG8_SA(1, 0), a3, voffA);
            PG8_WAIT_V(8); PG8_WAIT_L(0); PG8_BAR; PG8_MMA(1, 0, At, B0); PG8_MMA(1, 1, At, B1); PG8_BAR; PG8_SCHED;
            } else {
            PG8_LDB(B0, 0, 0); PG8_SCHED; PG8_LDA(At, 0, 0); PG8_STAGE(PG8_SA(1, 1), a1 + hstep, voffA);
            PG8_WAIT_L(8); PG8_BAR; PG8_WAIT_L(0); PG8_MMA(0, 0, At, B0); PG8_BAR; PG8_SCHED;
            PG8_LDB(B1, 0, 1); PG8_STAGE(PG8_SB(0, 0), b2, voffB);
            PG8_BAR; PG8_WAIT_L(0); PG8_MMA(0, 1, At, B1); PG8_BAR;
            PG8_LDA(At, 0, 1); PG8_STAGE(PG8_SA(0, 0), a2, voffA);
            PG8_BAR; PG8_WAIT_L(0); PG8_MMA(1, 0, At, B0); PG8_BAR; PG8_SCHED;
            PG8_STAGE(PG8_SB(0, 1), b2 + hstep, voffB);
            PG8_WAIT_V(6); PG8_BAR; PG8_MMA(1, 1, At, B1); PG8_BAR;
            PG8_LDB(B0, 1, 0); PG8_SCHED; PG8_LDA(At, 1, 0); PG8_STAGE(PG8_SA(0, 1), a2 + hstep, voffA);
            PG8_WAIT_L(8); PG8_BAR; PG8_WAIT_L(0); PG8_MMA(0, 0, At, B0); PG8_BAR; PG8_SCHED;
            PG8_LDB(B1, 1, 1); PG8_STAGE(PG8_SB(1, 0), b3, voffB);
            PG8_BAR; PG8_WAIT_L(0); PG8_MMA(0, 1, At, B1); PG8_BAR;
            PG8_LDA(At, 1, 1); PG8_STAGE(PG8_SA(1, 0), a3, voffA);
            PG8_BAR; PG8_WAIT_L(0); PG8_MMA(1, 0, At, B0); PG8_BAR; PG8_SCHED;
            PG8_STAGE(PG8_SB(1, 1), b3 + hstep, voffB);
            PG8_WAIT_V(6); PG8_BAR; PG8_MMA(1, 1, At, B1); PG8_BAR;
            }
        }
        if constexpr (ALIGN_EPI) { if (wr == 0) PG8_BAR; }
        if constexpr (!Epi::AFTER_DRAIN) { if constexpr (Epi::PREFETCH) { E.par = ui & 1; } E(acc, cur, wr, wc, fr, fq); S.done(cur); }
        if (!has_next) break;
        if constexpr (Epi::PREFETCH) E.prefetch(nxt, wid, (ui + 1) & 1);
#pragma unroll
        for (int a = 0; a < 2; ++a)
#pragma unroll
            for (int b = 0; b < 2; ++b)
#pragma unroll
                for (int m = 0; m < 4; ++m)
#pragma unroll
                    for (int n = 0; n < 2; ++n) acc[a][b][m][n] = acc_t{};
        cur = nxt; cA = nA; cB = nB; ++ui;
        if constexpr (ALIGN_EPI) { if (wr == 1) PG8_BAR; }
    }
    PG8_WAIT_V(0);
    if constexpr (!ALIGN_EPI) { if (wr == 0) PG8_BAR; }
    PG8_BAR;
    if constexpr (Epi::AFTER_DRAIN) { E.fused(acc, cur, wr, wc, fr, fq, lds, wid, lane); S.done(cur); }
#undef PG8_SA
#undef PG8_SB
#undef PG8_STAGE
#undef PG8_LDA
#undef PG8_LDB
#undef PG8_MMA
#undef PG8_WAIT_V
#undef PG8_WAIT_L
#undef PG8_BAR
#undef PG8_SCHED
}
}

namespace attn {
constexpr int D = 128;
constexpr int WINDOW = 129;
constexpr float THR = 8.f;
constexpr bool WSKIP = true;
constexpr float SCALE = 0.08838834764831845f;
constexpr int NW = 8, QBLK = 32, KVBLK = 64, QB = NW * QBLK;
constexpr int SHM_V = KVBLK * D * 2, SHM_K = KVBLK * D * 2;
constexpr int LDS_BYTES = 2 * SHM_V + 2 * SHM_K + NW * 64 * 4;
using bf16 = __hip_bfloat16;
typedef short bf16x8 __attribute__((ext_vector_type(8)));
typedef short s16x4 __attribute__((ext_vector_type(4)));
typedef float f32x16 __attribute__((ext_vector_type(16)));
typedef float f32x4 __attribute__((ext_vector_type(4)));
typedef unsigned u32x4 __attribute__((ext_vector_type(4)));
template <class A, class Bt> struct same_t { static constexpr bool v = false; };
template <class A> struct same_t<A, A> { static constexpr bool v = true; };

#define KSWZ(row, colB) ((row) * 256 + ((colB) ^ (((row) & 7) << 4)))
#define SBAR() __builtin_amdgcn_sched_barrier(0)
#ifndef ATTN_EARLY_LOAD
#define ATTN_EARLY_LOAD 0
#endif
__device__ __forceinline__ int v_st(int k, int c) { const int kk = (k & ~0xC) | ((k & 4) << 1) | ((k & 8) >> 1); return ((kk >> 3) * 4 + (c >> 5)) * 512 + ((kk & 7) * 32 + (c & 31)) * 2; }
__device__ __forceinline__ int v_rd_base(int lane) { return ((lane & 3) << 3) | (((lane >> 2) & 3) << 6) | (((lane >> 4) & 1) << 5) | (((lane >> 5) & 1) << 8); }
constexpr int v_rd_off(int d0, int ks, int half) { return d0 * 512 + ks * 4096 + half * 2048; }
__device__ __forceinline__ int crow(int r, int hi) { return (r & 3) + 8 * (r >> 2) + 4 * hi; }
__device__ __forceinline__ unsigned cvtpk(float lo, float hi) {
    unsigned r; asm volatile("v_cvt_pk_bf16_f32 %0, %1, %2" : "=v"(r) : "v"(lo), "v"(hi)); return r;
}
__device__ __forceinline__ bf16x8 pack8(f32x4 a, f32x4 b) {
    u32x4 w = {cvtpk(a[0], a[1]), cvtpk(a[2], a[3]), cvtpk(b[0], b[1]), cvtpk(b[2], b[3])};
    return *reinterpret_cast<bf16x8*>(&w);
}
template <class T> __device__ __forceinline__ bf16x8 load8(const T* p) {
    if constexpr (same_t<T, float>::v) { return pack8(*(const f32x4*)p, *(const f32x4*)(p + 4)); }
    else { return *reinterpret_cast<const bf16x8*>(p); }
}
__device__ __forceinline__ void mask_tile(f32x16& p0, f32x16& p1, int dq, unsigned W) {
    const float NEG = -__builtin_inff();
#pragma unroll
    for (int r = 0; r < 16; ++r) {
        const int c = (r & 3) + 8 * (r >> 2);
        if ((unsigned)(dq - c) >= W) p0[r] = NEG;
        if ((unsigned)(dq - c - 32) >= W) p1[r] = NEG;
    }
}
__device__ __forceinline__ void partialSM(f32x16& p0, f32x16& p1, float& m_reg, float& mn, float& alpha) {
    float pmax = p0[0]; for (int r = 1; r < 16; ++r) pmax = fmaxf(pmax, p0[r]); for (int r = 0; r < 16; ++r) pmax = fmaxf(pmax, p1[r]);
    { auto rr = __builtin_amdgcn_permlane32_swap(__float_as_uint(pmax), __float_as_uint(pmax), false, false);
      pmax = fmaxf(__uint_as_float(rr[0]), __uint_as_float(rr[1])); }
    constexpr float C2 = 1.4426950408889634f * SCALE;
    if (__builtin_expect(__all((pmax - m_reg) * SCALE <= THR), 1)) { mn = m_reg; alpha = 1.f; }
    else { mn = fmaxf(m_reg, pmax); alpha = __builtin_amdgcn_exp2f((m_reg - mn) * C2); m_reg = mn; }
    const float mnL = -mn * C2;
    for (int r = 0; r < 16; ++r) p0[r] = fmaf(p0[r], C2, mnL); for (int r = 0; r < 16; ++r) p1[r] = fmaf(p1[r], C2, mnL);
    for (int r = 0; r < 16; ++r) p0[r] = __builtin_amdgcn_exp2f(p0[r]);
}
__device__ __forceinline__ void finishSM(f32x16& p0, f32x16& p1, float alpha, float& l_reg, bf16x8& pa0, bf16x8& pa1, bf16x8& pa2, bf16x8& pa3) {
    for (int r = 0; r < 16; ++r) p1[r] = __builtin_amdgcn_exp2f(p1[r]);
    float ps = 0; for (int r = 0; r < 16; ++r) ps += p0[r]; for (int r = 0; r < 16; ++r) ps += p1[r];
    { auto rr = __builtin_amdgcn_permlane32_swap(__float_as_uint(ps), __float_as_uint(ps), false, false);
      ps = __uint_as_float(rr[0]) + __uint_as_float(rr[1]); }
    l_reg = l_reg * alpha + ps;
#define PK4(P, B_, OUT) do { unsigned a0 = cvtpk(P[B_+0], P[B_+1]), a1 = cvtpk(P[B_+2], P[B_+3]);                          \
        unsigned b0 = cvtpk(P[B_+4], P[B_+5]), b1 = cvtpk(P[B_+6], P[B_+7]);                                             \
        auto r0 = __builtin_amdgcn_permlane32_swap(a0, b0, false, false); auto r1 = __builtin_amdgcn_permlane32_swap(a1, b1, false, false); \
        u32x4 w = {r0[0], r1[0], r0[1], r1[1]}; OUT = *reinterpret_cast<bf16x8*>(&w); } while (0)
    PK4(p0, 0, pa0); PK4(p0, 8, pa1); PK4(p1, 0, pa2); PK4(p1, 8, pa3);
#undef PK4
}
template <int KB, bool SK>
__device__ __forceinline__ void qkt(f32x16& p0, f32x16& p1, const char* K_lds, int r32, int hi, const bf16x8* qr, bool act) {
    if (SK && !act) { const float NEG = -__builtin_inff();
#pragma unroll
        for (int r = 0; r < 16; ++r) { p0[r] = NEG; p1[r] = NEG; } return; }
    p0 = f32x16{}; p1 = f32x16{};
    const char* kb[4];
#pragma unroll
    for (int dd = 0; dd < 4; ++dd) kb[dd] = K_lds + KB * SHM_K + KSWZ(r32, (dd * 16 + hi * 8) * 2);
#pragma unroll
    for (int d0 = 0; d0 < 8; ++d0) { const char* a = kb[d0 & 3] + (d0 >> 2) * 128;
        bf16x8 b0 = *reinterpret_cast<const bf16x8*>(a);
        bf16x8 b1 = *reinterpret_cast<const bf16x8*>(a + 32 * 256);
        p0 = __builtin_amdgcn_mfma_f32_32x32x16_bf16(b0, qr[d0], p0, 0, 0, 0);
        p1 = __builtin_amdgcn_mfma_f32_32x32x16_bf16(b1, qr[d0], p1, 0, 0, 0); }
}
template <int VB, bool SK>
__device__ __forceinline__ void pv_tile(f32x16* o, int vb0, bf16x8 pa0, bf16x8 pa1, bf16x8 pa2, bf16x8 pa3, bool act) {
    if (SK && !act) return;
#define TRRD(dst, off) asm volatile("ds_read_b64_tr_b16 %0, %1 offset:%2" : "=&v"(dst) : "v"(vb0), "i"(off) : "memory")
#define PV_D0(d0) do { s16x4 l0, l1, l2, l3, h0, h1, h2, h3; constexpr int b_ = VB * SHM_V + v_rd_off(d0, 0, 0);     \
        TRRD(l0, b_); TRRD(h0, b_ + 2048); TRRD(l1, b_ + 4096); TRRD(h1, b_ + 6144); TRRD(l2, b_ + 8192); TRRD(h2, b_ + 10240); TRRD(l3, b_ + 12288); TRRD(h3, b_ + 14336); \
        asm volatile("s_waitcnt lgkmcnt(0)" ::: "memory"); SBAR();                 \
        o[d0] = __builtin_amdgcn_mfma_f32_32x32x16_bf16(pa0, (bf16x8){l0[0], l0[1], l0[2], l0[3], h0[0], h0[1], h0[2], h0[3]}, o[d0], 0, 0, 0);   \
        o[d0] = __builtin_amdgcn_mfma_f32_32x32x16_bf16(pa1, (bf16x8){l1[0], l1[1], l1[2], l1[3], h1[0], h1[1], h1[2], h1[3]}, o[d0], 0, 0, 0);   \
        o[d0] = __builtin_amdgcn_mfma_f32_32x32x16_bf16(pa2, (bf16x8){l2[0], l2[1], l2[2], l2[3], h2[0], h2[1], h2[2], h2[3]}, o[d0], 0, 0, 0);   \
        o[d0] = __builtin_amdgcn_mfma_f32_32x32x16_bf16(pa3, (bf16x8){l3[0], l3[1], l3[2], l3[3], h3[0], h3[1], h3[2], h3[3]}, o[d0], 0, 0, 0); } while (0)
    PV_D0(0); PV_D0(1); PV_D0(2); PV_D0(3);
#undef PV_D0
#undef TRRD
}

template <class TIn, class TOut> struct BlockRef { const TIn* Q; const TIn* K; const TIn* V; TOut* O; float* LSE; int P0; int rs; int ls; };
template <class TIn> struct Seam {
    bf16x8 qr[8];
    bf16x8 st_v0, st_v1, st_k0, st_k1; f32x4 sf0, sf1, sf2, sf3;
    f32x4 tq[16];
};
__device__ __forceinline__ int swa_jlo(int P0, int W) { const int lowk = P0 - W + 1; return lowk > 0 ? lowk / KVBLK : 0; }
#define ROW(p, k0, rr, rs_) ((p) + (size_t)((k0) + (rr)) * (size_t)(rs_) + sc)
#define VMW() asm volatile("s_waitcnt vmcnt(0)" ::: "memory")
#define VMWN(n) asm volatile("s_waitcnt vmcnt(%0)" :: "i"(n) : "memory")
#define SLOAD_H(Kp, Vp, k0, rs_) do { S.st_v0 = load8<TIn>(ROW(Vp, k0, sr, rs_)); S.st_v1 = load8<TIn>(ROW(Vp, k0, 32 + sr, rs_));              \
                         S.st_k0 = load8<TIn>(ROW(Kp, k0, sr, rs_)); S.st_k1 = load8<TIn>(ROW(Kp, k0, 32 + sr, rs_)); } while (0)
#define SWRITE_HK(bf) do { *(bf16x8*)(K_lds + (bf) * SHM_K + kws) = S.st_k0; *(bf16x8*)(K_lds + (bf) * SHM_K + kws + 32 * 256) = S.st_k1; } while (0)
#define SWRITE_HV(bf) do { *(bf16x8*)(V_lds + (bf) * SHM_V + vst0) = S.st_v0; *(bf16x8*)(V_lds + (bf) * SHM_V + vst1) = S.st_v1; } while (0)
#define SWRITE_H(bf) do { SWRITE_HV(bf); SWRITE_HK(bf); } while (0)
#define SLOAD_F(p, k0) do { } while (0)
#define SWRITE_KF(bf) do { *(bf16x8*)(K_lds + (bf) * SHM_K + kws) = pack8(S.sf0, S.sf1); *(bf16x8*)(K_lds + (bf) * SHM_K + kws + 32 * 256) = pack8(S.sf2, S.sf3); } while (0)
#define SWRITE_VF(bf) do { *(bf16x8*)(V_lds + (bf) * SHM_V + vst0) = pack8(S.sf0, S.sf1); *(bf16x8*)(V_lds + (bf) * SHM_V + vst1) = pack8(S.sf2, S.sf3); } while (0)
template <class TIn, class TOut>
__device__ __forceinline__ void causal_swa_prime(const BlockRef<TIn, TOut>& cur, int W, char* lds, Seam<TIn>& S) {
    constexpr bool F32 = same_t<TIn, float>::v;
    const int tid = tid_opaque(), wid = __builtin_amdgcn_readfirstlane(tid >> 6), lane = tid & 63, r32 = lane & 31, hi = lane >> 5;
    const int sr = tid >> 4, sc = (tid & 15) * 8, kws = KSWZ(sr, sc * 2); char* K_lds = lds + 2 * SHM_V;
    const int kb0 = swa_jlo(cur.P0, W) * KVBLK;
    for (int d0 = 0; d0 < 8; ++d0) S.qr[d0] = load8<TIn>(cur.Q + (size_t)(wid * QBLK + r32) * (size_t)cur.rs + d0 * 16 + hi * 8);
    if constexpr (F32) { SLOAD_F((const float*)cur.K, kb0); VMW(); SWRITE_KF(0); SBAR(); SLOAD_F((const float*)cur.V, kb0); }
    else { SLOAD_H(cur.K, cur.V, kb0, cur.rs); VMW(); SWRITE_HK(0); }
    __syncthreads();
}
template <class TIn, class TOut>
__device__ __forceinline__ void causal_swa_block(const BlockRef<TIn, TOut>& cur, const BlockRef<TIn, TOut>& nxt, int skv, int W, char* lds, Seam<TIn>& S) {
    constexpr bool F32 = same_t<TIn, float>::v;
    const int tid = tid_opaque(), wid = __builtin_amdgcn_readfirstlane(tid >> 6), lane = tid & 63, r32 = lane & 31, hi = lane >> 5;
    const int j_lo = swa_jlo(cur.P0, W);
    int j_hi = (cur.P0 + QB - 1) / KVBLK + 1; if (j_hi > skv / KVBLK) j_hi = skv / KVBLK;
    const int NT = j_hi - j_lo;
    const int kbn = swa_jlo(nxt.P0, W) * KVBLK;
    const int qlo = cur.P0 + wid * QBLK, qm = qlo + r32 - 4 * hi;
    char* V_lds = lds; char* K_lds = lds + 2 * SHM_V;
    float* ws = (float*)(lds + 2 * SHM_V + 2 * SHM_K) + wid * 64; float* li_l = ws, * al_l = ws + 32;
    float m_reg = -1e30f, l_reg = 0; f32x16 o[4] = {};
    const int sr = tid >> 4, sc = (tid & 15) * 8, vst0 = v_st(sr, sc), vst1 = v_st(32 + sr, sc), kws = KSWZ(sr, sc * 2);
    const int vb0 = (int)(uintptr_t)V_lds + v_rd_base(lane);
    const TIn* Kh = cur.K; const TIn* Vh = cur.V;
#define RESC(a) do { if (__any((a) < 1.f)) { if (hi == 0) al_l[r32] = (a); asm volatile("s_waitcnt lgkmcnt(0)" ::: "memory");              \
                     for (int d_ = 0; d_ < 4; ++d_) for (int r = 0; r < 16; ++r) o[d_][r] *= al_l[crow(r, hi)]; } } while (0)
#define KBASE(t) ((j_lo + (t)) * KVBLK)
#define ACT(t) (KBASE(t) <= qlo + QBLK - 1 && KBASE(t) + KVBLK - 1 >= qlo - W + 1)
#define MASKT(P0_, P1_, t) do { const int kb_ = KBASE(t); if ((!SK || ACT(t)) && (kb_ + KVBLK - 1 > qlo || kb_ <= qlo + QBLK - 1 - W)) mask_tile(P0_, P1_, qm - kb_, (unsigned)W); } while (0)
    constexpr int NQL = F32 ? 16 : 8;
    constexpr bool SK = WSKIP && !F32;
#define SEAM_K0() do { VMWN(NQL); if constexpr (F32) { SWRITE_KF(0); SBAR(); SLOAD_F((const float*)nxt.V, kbn); } else { SWRITE_HK(0); } SBAR(); } while (0)
    f32x16 pA0, pA1, pB0, pB1; float mnA, mnB, alA, alB; bf16x8 pa0, pa1, pa2, pa3;
    if constexpr (F32) { VMW(); SWRITE_VF(0); SBAR(); } else { SWRITE_HV(0); SBAR(); }
    if (NT > 1) { if constexpr (F32) SLOAD_F((const float*)Kh, KBASE(1)); else SLOAD_H(Kh, Vh, KBASE(1), cur.rs); }
    SBAR(); qkt<0, SK>(pA0, pA1, K_lds, r32, hi, S.qr, ACT(0));
    if constexpr (F32) { if (NT > 1) { VMW(); SWRITE_KF(1); SBAR(); SLOAD_F((const float*)Vh, KBASE(1)); } }
    MASKT(pA0, pA1, 0); partialSM(pA0, pA1, m_reg, mnA, alA);
    if (NT > 1) { VMW(); if constexpr (F32) { SWRITE_VF(1); SBAR(); if (NT > 2) SLOAD_F((const float*)Kh, KBASE(2)); } else SWRITE_H(1); }
    __syncthreads();
#define HALF_STEP(PX0, PX1, mnX, alX, PY0, PY1, alY, t, KB, VB, SB) do {                                                      \
        if constexpr (!F32 && ATTN_EARLY_LOAD) { if ((t) + 1 < NT) { SLOAD_H(Kh, Vh, KBASE((t) + 1), cur.rs); } }     \
        SBAR(); qkt<KB, SK>(PX0, PX1, K_lds, r32, hi, S.qr, ACT(t));                                             \
        finishSM(PY0, PY1, alY, l_reg, pa0, pa1, pa2, pa3); SBAR();                                                           \
        if ((t) + 1 < NT) { if constexpr (F32) { VMW(); SWRITE_KF(SB); SBAR(); SLOAD_F((const float*)Vh, KBASE((t) + 1)); }  \
                            else if constexpr (!ATTN_EARLY_LOAD) { SLOAD_H(Kh, Vh, KBASE((t) + 1), cur.rs); } SBAR(); }                                               \
        pv_tile<VB, SK>(o, vb0, pa0, pa1, pa2, pa3, ACT((t) - 1)); MASKT(PX0, PX1, (t)); partialSM(PX0, PX1, m_reg, mnX, alX);                                        \
        __syncthreads();                                                                                                      \
        if ((t) + 1 < NT) { VMW(); if constexpr (F32) { SWRITE_VF(SB); SBAR(); if ((t) + 2 < NT) SLOAD_F((const float*)Kh, KBASE((t) + 2)); } \
                            else { SWRITE_H(SB); } }                                                                          \
        RESC(alX); __syncthreads(); } while (0)
    for (int t = 1; t + 1 < NT; t += 2) {
        HALF_STEP(pB0, pB1, mnB, alB, pA0, pA1, alA, t, 1, 0, 0);
        HALF_STEP(pA0, pA1, mnA, alA, pB0, pB1, alB, t + 1, 0, 1, 1);
    }
    const bool even = (NT & 1) == 0;
    if (even) { SBAR(); qkt<1, SK>(pB0, pB1, K_lds, r32, hi, S.qr, ACT(NT - 1)); SBAR(); }
#define QROW(e) (nxt.Q + (size_t)(wid * QBLK + r32) * (size_t)nxt.rs + ((e) >> 1) * 16 + hi * 8 + ((e) & 1) * 4)
    if constexpr (F32) { SLOAD_F((const float*)nxt.K, kbn); SBAR();
#pragma unroll
        for (int e = 0; e < 8; ++e) S.tq[e] = *(const f32x4*)QROW(e); }
    else { SLOAD_H(nxt.K, nxt.V, kbn, nxt.rs); SBAR();
#pragma unroll
        for (int d0 = 0; d0 < 8; ++d0) S.qr[d0] = load8<TIn>(nxt.Q + (size_t)(wid * QBLK + r32) * (size_t)nxt.rs + d0 * 16 + hi * 8); }
    SBAR();
    finishSM(pA0, pA1, alA, l_reg, pa0, pa1, pa2, pa3); SBAR();
    if constexpr (F32) {
#pragma unroll
        for (int e = 8; e < 16; ++e) S.tq[e] = *(const f32x4*)QROW(e); SBAR(); }
#undef QROW
    pv_tile<0, SK>(o, vb0, pa0, pa1, pa2, pa3, ACT(even ? NT - 2 : NT - 1));
    if (even) { MASKT(pB0, pB1, NT - 1); partialSM(pB0, pB1, m_reg, mnB, alB); __syncthreads(); RESC(alB);
        finishSM(pB0, pB1, alB, l_reg, pa0, pa1, pa2, pa3); SBAR(); pv_tile<1, SK>(o, vb0, pa0, pa1, pa2, pa3, ACT(NT - 1)); }
    SBAR(); SEAM_K0();
    if (hi == 0) li_l[r32] = l_reg; asm volatile("s_waitcnt lgkmcnt(0)" ::: "memory");
    float rli[16];
#pragma unroll
    for (int r = 0; r < 16; ++r) rli[r] = __builtin_amdgcn_rcpf(li_l[crow(r, hi)]);
    TOut* Ow = cur.O + (size_t)(wid * QBLK) * (size_t)cur.rs;
    if (hi == 0) cur.LSE[(size_t)(wid * QBLK + r32) * (size_t)cur.ls] = m_reg * SCALE + __logf(l_reg);
#pragma unroll
    for (int r = 0; r < 16; ++r) { const int orow = crow(r, hi);
#pragma unroll
        for (int d0 = 0; d0 < 4; ++d0) { const float v = o[d0][r] * rli[r];
            if constexpr (same_t<TOut, float>::v) { Ow[(size_t)orow * (size_t)cur.rs + d0 * 32 + r32] = v; }
            else { const float vn = __shfl_xor(v, 1);
                   if ((r32 & 1) == 0) *(unsigned*)(Ow + (size_t)orow * (size_t)cur.rs + d0 * 32 + r32) = cvtpk(v, vn); } } }
    if constexpr (F32) {
#pragma unroll
        for (int d0 = 0; d0 < 8; ++d0) S.qr[d0] = pack8(S.tq[2 * d0], S.tq[2 * d0 + 1]); }
    __syncthreads();
#undef RESC
#undef KBASE
#undef ACT
#undef MASKT
#undef SEAM_K0
#undef HALF_STEP
}
#undef ROW
#undef VMW
#undef VMWN
#undef SLOAD_H
#undef SWRITE_HK
#undef SWRITE_HV
#undef SWRITE_H
#undef SLOAD_F
#undef SWRITE_KF
#undef SWRITE_VF

#undef SBAR
}
#define GAS __attribute__((address_space(1)))
#define LAS __attribute__((address_space(3)))
typedef unsigned short bf16;
typedef unsigned v4u __attribute__((ext_vector_type(4)));
typedef float f32x4 __attribute__((ext_vector_type(4)));
typedef short bf16x8 __attribute__((ext_vector_type(8)));
typedef GAS unsigned gu32;
typedef GAS unsigned long long gu64;
#define RLX_AGENT __ATOMIC_RELAXED, __HIP_MEMORY_SCOPE_AGENT
#define LDS_WAIT() asm volatile("s_waitcnt lgkmcnt(0)" ::: "memory")
#define VM_WAIT() asm volatile("s_waitcnt vmcnt(0)" ::: "memory")
__device__ __forceinline__ unsigned long long rt() { return __builtin_amdgcn_s_memrealtime(); }
__device__ __forceinline__ unsigned f2bf(float f) { unsigned u = __builtin_bit_cast(unsigned, f); return (u + 0x7fffu + ((u >> 16) & 1u)) >> 16; }
__device__ __forceinline__ unsigned pk2(float lo, float hi) { return f2bf(lo) | (f2bf(hi) << 16); }

#define XB_TMO      128
#define XB_XCNT(j)  (256  + 64 * (j))
#define XB_XSUB(j)  (1280 + 64 * (j))
#define XB_XGEN(j)  (2304 + 64 * (j))
#define XB_TOP      3328
#define XB_TOPGEN   3392
#define XCD_BAR_WORDS 3456
#define XB_SPIN_CAP (1u << 18)

__device__ __forceinline__ unsigned xb_ld(unsigned* p)              { return __hip_atomic_load(p, __ATOMIC_RELAXED, __HIP_MEMORY_SCOPE_AGENT); }
__device__ __forceinline__ unsigned xb_add(unsigned* p, unsigned v) { return __hip_atomic_fetch_add(p, v, __ATOMIC_RELAXED, __HIP_MEMORY_SCOPE_AGENT); }
__device__ __forceinline__ unsigned xb_xcc_id() { return (unsigned)__builtin_amdgcn_s_getreg((3 << 11) | 20) & 0xFu; }
#define XB_SPIN(cond, bar) do { unsigned _sp = 0; while (cond) { __builtin_amdgcn_s_sleep(1); \
    if ((++_sp & 255u) == 0u) { if (xb_ld(&(bar)[XB_TMO])) break; if (_sp > XB_SPIN_CAP) { atomicAdd(&(bar)[XB_TMO], 1u); break; } } } } while (0)

struct XcdBarrier {
    unsigned* bar; unsigned x;
    volatile LAS unsigned* st;
};

__device__ __forceinline__ XcdBarrier xcd_barrier_post(unsigned* bar, volatile LAS unsigned* st) {
    XcdBarrier b; b.bar = bar; b.x = xb_xcc_id(); b.st = st;
    if (threadIdx.x == 0) (void)xb_add(&bar[XB_XCNT(b.x)], 1u);
    return b;
}
__device__ __forceinline__ void xcd_barrier_complete(unsigned* bar, unsigned x, unsigned& nloc, unsigned& nx) {
    const unsigned G = gridDim.x * gridDim.y * gridDim.z;
    unsigned sum, cnt, mine, sp = 0u;
    for (;;) {
        sum = 0u; cnt = 0u; mine = 0u;
#pragma unroll
        for (unsigned j = 0; j < 16; ++j) { const unsigned c = xb_ld(&bar[XB_XCNT(j)]); sum += c; cnt += (c > 0u) ? 1u : 0u; mine = (j == x) ? c : mine; }
        if (sum == G) break;
        __builtin_amdgcn_s_sleep(1);
        if ((++sp & 255u) == 0u) { if (xb_ld(&bar[XB_TMO])) break; if (sp > XB_SPIN_CAP) { atomicAdd(&bar[XB_TMO], 1u); break; } }
    }
    nloc = mine > 0u ? mine : 1u; nx = cnt > 0u ? cnt : 1u;
}

__device__ __forceinline__ void xcd_barrier(const XcdBarrier& b) {
    asm volatile("s_waitcnt vmcnt(0)" ::: "memory");
    __syncthreads();
    if (threadIdx.x == 0) {
        unsigned* bar = b.bar;
        __builtin_amdgcn_s_waitcnt(0);
        unsigned nloc = b.st[0], nx = b.st[1];
        if (nloc == 0u) { xcd_barrier_complete(bar, b.x, nloc, nx); b.st[0] = nloc; b.st[1] = nx; }
        const unsigned old = xb_add(&bar[XB_XSUB(b.x)], 1u);
        const unsigned gen = old / nloc;
        if (old + 1u == (gen + 1u) * nloc) {
            __builtin_amdgcn_fence(__ATOMIC_RELEASE, "agent");
            asm volatile("s_waitcnt vmcnt(0)" ::: "memory");
            const unsigned og = xb_add(&bar[XB_TOP], 1u);
            const unsigned tg = og / nx;
            if (og + 1u == (tg + 1u) * nx) xb_add(&bar[XB_TOPGEN], 1u);
            else XB_SPIN(xb_ld(&bar[XB_TOPGEN]) == tg, bar);
            __builtin_amdgcn_fence(__ATOMIC_ACQUIRE, "agent");
            xb_add(&bar[XB_XGEN(b.x)], 1u);
            asm volatile("s_waitcnt vmcnt(0)" ::: "memory");
        } else {
            XB_SPIN(xb_ld(&bar[XB_XGEN(b.x)]) == gen, bar);
            __builtin_amdgcn_fence(__ATOMIC_ACQUIRE, "agent");
            asm volatile("s_waitcnt vmcnt(0)" ::: "memory");
        }
    }
    __syncthreads();
}

constexpr int NWAVES = 8;

constexpr size_t MiB = 1u << 20, HMiB = 1u << 19;
constexpr size_t WS_CTL = 0, CTL_ZERO_BYTES = 320 * 1024;
constexpr size_t WS_COLMAX = 64 * 1024;
constexpr size_t WS_MOD = 1 * MiB;
constexpr size_t WS_AVEC = WS_MOD + 80 * 1024;
constexpr size_t WS_BIAS_IN = WS_MOD + 96 * 1024;
constexpr size_t WS_BIAS_F2 = WS_MOD + 176 * 1024;
constexpr size_t WS_PS2 = WS_MOD + 256 * 1024, WS_PS3 = WS_MOD + 512 * 1024;
constexpr size_t WS_SW1 = WS_MOD + 768 * 1024, WS_SW2 = WS_MOD + 800 * 1024;
constexpr size_t WS_SA1 = WS_MOD + 832 * 1024, WS_RF3 = WS_MOD + 896 * 1024;
constexpr size_t WS_WGU1 = 2 * MiB;
constexpr size_t WS_WD1 = WS_WGU1 + 11 * MiB;
constexpr size_t WS_WIN = WS_WD1 + 11 * HMiB;
constexpr size_t WS_WA = WS_WIN + 19 * MiB;
constexpr size_t WS_WC = WS_WA + 1 * MiB;
constexpr size_t WS_WO = WS_WC + 2 * MiB;
constexpr size_t WS_WGU2 = WS_WO + 2 * MiB;
constexpr size_t WS_WD2 = WS_WGU2 + 11 * MiB;
constexpr size_t WS_XS = WS_WD2 + 11 * HMiB;
constexpr size_t WS_R = WS_XS + 32 * MiB;
constexpr size_t WS_ACT = WS_R;
constexpr size_t WS_Q = WS_R, WS_K = WS_R + 48 * MiB, WS_V = WS_R + 96 * MiB;
constexpr size_t WS_LSE = WS_R + 144 * MiB;
constexpr size_t WS_O = WS_R + 145 * MiB;
constexpr size_t WS_U = WS_R + 48 * MiB, WS_B = WS_R + 80 * MiB, WS_C = WS_R + 112 * MiB;
constexpr size_t WS_SGA = WS_R, WS_SGC = WS_R + 48 * MiB;
constexpr size_t WS_SGA8 = WS_R + 112 * MiB, WS_SGC8 = WS_R + 128 * MiB;
constexpr size_t WS_END = WS_O + 16 * MiB;
static_assert(WS_XS == 59 * MiB && WS_END <= 256 * MiB, "d_ws map");
constexpr size_t WS_XQ1 = WS_XS, WS_XQ3 = WS_O;
constexpr size_t WS_RFO = WS_MOD + 896 * 1024, WS_SWA = WS_MOD + 960 * 1024 + 32 * 1024;
constexpr size_t WS_RF2 = WS_SA1, WS_SWIN = WS_MOD + 960 * 1024;
constexpr int CW_BAR = 4096;
constexpr int CW_CNT2 = 8192, CW_CNT3 = 8192 + 64 * 64;
constexpr size_t WS_AM2 = 192 * 1024, WS_AM3 = 256 * 1024;

constexpr int RING_OFF = 0, RING_BYTES = 131072;
constexpr int LDSCTL_OFF = RING_BYTES, MISC_OFF = LDSCTL_OFF + 320, XL_OFF = RING_BYTES + 1024;
constexpr int LDS_BYTES = 151552;

#ifndef WQ_FUSED
#ifdef NAIVE
#define WQ_FUSED 0
#else
#define WQ_FUSED 1
#endif
#endif
#ifndef WA_I8
#if defined(NAIVE)
#define WA_I8 0
#else
#define WA_I8 0
#endif
#endif
#ifndef GATES_I8
#ifdef NAIVE
#define GATES_I8 0
#else
#define GATES_I8 1
#endif
#endif
constexpr int WIN_I8_ROWS = 3 * 1536 + (GATES_I8 ? 2048 : 0);
#ifndef UCPROD
#ifdef NAIVE
#define UCPROD 0
#else
#define UCPROD 1
#endif
#endif

#ifdef NAIVE
#define FFN_I8 0
#else
#define FFN_I8 1
#endif
struct Args { const float* in[20]; float* out; unsigned char* ws; int ph_lo, ph_hi; };
struct Frame {
    LAS unsigned char* lds;
    volatile LAS unsigned* MISC;
    gu32* ctl;
    int tid, lane, wave;
    int vcu, G;
    float* out; unsigned char* ws;
};
enum { I_X = 0, I_C, I_WADA, I_BADA, I_NF1, I_F1G, I_F1U, I_F1D, I_NMIX, I_WIN, I_QN, I_KN, I_CONVW, I_WAB, I_WCB, I_WOUT, I_NF2, I_F2G, I_F2U, I_F2D };
enum { MOD_SH1 = 0, MOD_SC1 = 1024, MOD_GT1 = 2048, MOD_SH2 = 3072, MOD_SC2 = 4096, MOD_GT2 = 5120, MOD_SH3 = 6144, MOD_SC3 = 7168, MOD_GT3 = 8192 };

__device__ __forceinline__ float silu_f(float x) { return x * __builtin_amdgcn_rcpf(1.0f + __builtin_amdgcn_exp2f(-1.4426950408889634f * x)); }
__device__ __forceinline__ float wave_sum(float v) {
#pragma unroll
    for (int o = 1; o < 64; o <<= 1) v += __shfl_xor(v, o);
    return v;
}
__device__ __forceinline__ float blo(unsigned w) { return __uint_as_float(w << 16); }
__device__ __forceinline__ float bhi(unsigned w) { return __uint_as_float(w & 0xffff0000u); }

constexpr int ADA_ITEMS = NMOD / 64;
__device__ __forceinline__ void p0_adaln_item(Frame& F, const Args& args, int item) {
    LAS float* sc = (LAS float*)(F.lds + RING_OFF);
    LAS float* red = sc + 2048;
    const float* c = args.in[I_C]; const float* wada = args.in[I_WADA]; const float* bada = args.in[I_BADA];
    for (int i = F.tid; i < 2 * DM; i += NWAVES * 64) sc[i] = silu_f(c[i]);
    __syncthreads();
    const int j0 = item * 64, cg = F.lane & 15, rs = F.lane >> 4;
    f32x4 a0 = {0.f, 0.f, 0.f, 0.f}, a1 = {0.f, 0.f, 0.f, 0.f};
    const GAS f32x4* wp = (const GAS f32x4*)(wada + (size_t)(F.wave * 128 + rs) * NMOD + j0 + 4 * cg);
#pragma unroll 16
    for (int it = 0; it < 32; ++it) { const int k = F.wave * 128 + 4 * it + rs; const f32x4 w = __builtin_nontemporal_load(&wp[(size_t)it * 4 * (NMOD / 4)]);
        a0 = a0 + w * sc[k]; a1 = a1 + w * sc[DM + k]; }
#pragma unroll
    for (int i = 0; i < 4; ++i) { a0[i] += __shfl_xor(a0[i], 16); a0[i] += __shfl_xor(a0[i], 32); a1[i] += __shfl_xor(a1[i], 16); a1[i] += __shfl_xor(a1[i], 32); }
    if (F.lane < 16) {
#pragma unroll
        for (int i = 0; i < 4; ++i) { red[(F.wave * 2 + 0) * 64 + 4 * cg + i] = a0[i]; red[(F.wave * 2 + 1) * 64 + 4 * cg + i] = a1[i]; } }
    __syncthreads();
    if (F.tid < 128) { const int b = F.tid >> 6, j = F.tid & 63; float s = bada[j0 + j];
#pragma unroll
        for (int w = 0; w < NWAVES; ++w) s += red[(w * 2 + b) * 64 + j];
        ((float*)(F.ws + WS_MOD))[b * NMOD + j0 + j] = s; }
    __syncthreads();
}
__device__ __forceinline__ void p0_transpose_item(const float* W, int K, int N, bf16* WT, int rmode, LAS float* scr, int item, int lane, int nb0 = 0, int nbn = -1) {
    const int nblk = nbn < 0 ? N / 32 : nbn, kb = item / nblk, nb = item % nblk + nb0, k0 = 64 * kb, n0 = 32 * nb;
    int r0 = rmode == 0 ? n0 : 256 * (n0 >> 7) + 128 * (rmode - 1) + (n0 & 127);
    if (rmode == 3) {
        if (n0 >= COL_U && n0 < COL_B) { const int j = n0 - COL_U; r0 = COL_U + 256 * (j >> 7) + (j & 127); }
        else if (n0 >= COL_B && n0 < COL_C) r0 = n0 + 1024;
        else if (n0 >= COL_C && n0 < COL_GA) { const int j = n0 - COL_C; r0 = COL_U + 256 * (j >> 7) + 128 + (j & 127); }
        else r0 = n0; }
#pragma unroll 16
    for (int i = 0; i < 32; ++i) { const int kk = 2 * i + (lane >> 5); scr[kk * 33 + (lane & 31)] = __builtin_nontemporal_load(&W[(size_t)(k0 + kk) * N + n0 + (lane & 31)]); }
    LDS_WAIT(); asm volatile("" ::: "memory");
    const int c = lane & 7;
#pragma unroll
    for (int j = 0; j < 4; ++j) { const int n = (lane >> 3) + 8 * j; const LAS float* s = scr + (8 * c) * 33 + n;
        v4u o; o.x = pk2(s[0 * 33], s[1 * 33]); o.y = pk2(s[2 * 33], s[3 * 33]); o.z = pk2(s[4 * 33], s[5 * 33]); o.w = pk2(s[6 * 33], s[7 * 33]);
        *(GAS v4u*)(WT + (size_t)(r0 + n) * K + k0 + 8 * c) = o; }
    LDS_WAIT(); asm volatile("" ::: "memory");
}
#ifndef ABS_SPLIT
#define ABS_SPLIT (GATES_I8 ? 1552 : 1376)
#endif
constexpr int ABS_FFN_ITEMS = 4 * 44 * 8, ABS_QKV_ITEMS = (WIN_I8_ROWS / 64) * 8;
__device__ __forceinline__ void wq_absmax(Frame& F, const Args& args, int worker, int nworkers, int first = 0, int last = ABS_FFN_ITEMS + ABS_QKV_ITEMS) {
    unsigned* cm = (unsigned*)(F.ws + WS_COLMAX);
    const int cg = F.lane & 15, rs = F.lane >> 4;
    for (int it = first + worker; it < last; it += nworkers) {
        const float* Wb; int pitch, n, kch, slot;
        if (it < ABS_FFN_ITEMS) { const int mat = it / 352, r = it - mat * 352; n = (r >> 3) * 64 + 4 * cg; kch = r & 7; pitch = DFF; slot = mat * DFF + n;
            Wb = (mat == 0 ? args.in[I_F1G] : mat == 1 ? args.in[I_F1U] : mat == 2 ? args.in[I_F2G] : args.in[I_F2U]); }
        else { const int r = it - ABS_FFN_ITEMS; const int q = (r >> 3) * 64 + 4 * cg; n = q < 3 * AW ? q : q + (COL_GA - 3 * AW); kch = r & 7; pitch = INW; slot = 4 * DFF + q; Wb = args.in[I_WIN]; }
        const GAS f32x4* W = (const GAS f32x4*)(Wb + (size_t)(kch * 128 + rs) * pitch + n);
        f32x4 mx = {0.f, 0.f, 0.f, 0.f};
#pragma unroll 16
        for (int i = 0; i < 32; ++i) { const f32x4 w = __builtin_nontemporal_load(&W[(size_t)i * pitch]); mx = __builtin_elementwise_max(mx, __builtin_elementwise_abs(w)); }
#pragma unroll
        for (int c = 0; c < 4; ++c) { float v = mx[c]; v = fmaxf(v, __shfl_xor(v, 16)); v = fmaxf(v, __shfl_xor(v, 32)); if (rs == 0) atomicMax(cm + slot + c, __float_as_uint(v)); }
    }
}
__device__ __forceinline__ void p0_transpose_item_i8(const float* W, int N, signed char* WQ, int rmode, LAS float* scr, int item, int lane, const float* colmax, float* SW) {
    const int nblk = N / 32, kb = item / nblk, nb = item % nblk, k0 = 64 * kb, n0 = 32 * nb;
    const int r0 = rmode == 0 ? n0 : rmode == 4 ? (n0 < 3 * AW ? n0 : n0 - (COL_GA - 3 * AW)) : 256 * (n0 >> 7) + 128 * (rmode - 1) + (n0 & 127);
#pragma unroll 16
    for (int i = 0; i < 32; ++i) { const int kk = 2 * i + (lane >> 5); scr[kk * 33 + (lane & 31)] = __builtin_nontemporal_load(&W[(size_t)(k0 + kk) * N + n0 + (lane & 31)]); }
    LDS_WAIT(); asm volatile("" ::: "memory");
    const int n = lane >> 1, hh = lane & 1; const float cmx = colmax[(rmode == 4 ? r0 : n0) + n], inv = cmx > 0.f ? 127.0f / cmx : 0.f;
    const LAS float* s = scr + (32 * hh) * 33 + n;
    v4u o0, o1;
    o0.x = pk4q(s[0 * 33] * inv, s[1 * 33] * inv, s[2 * 33] * inv, s[3 * 33] * inv);     o0.y = pk4q(s[4 * 33] * inv, s[5 * 33] * inv, s[6 * 33] * inv, s[7 * 33] * inv);
    o0.z = pk4q(s[8 * 33] * inv, s[9 * 33] * inv, s[10 * 33] * inv, s[11 * 33] * inv);   o0.w = pk4q(s[12 * 33] * inv, s[13 * 33] * inv, s[14 * 33] * inv, s[15 * 33] * inv);
    o1.x = pk4q(s[16 * 33] * inv, s[17 * 33] * inv, s[18 * 33] * inv, s[19 * 33] * inv); o1.y = pk4q(s[20 * 33] * inv, s[21 * 33] * inv, s[22 * 33] * inv, s[23 * 33] * inv);
    o1.z = pk4q(s[24 * 33] * inv, s[25 * 33] * inv, s[26 * 33] * inv, s[27 * 33] * inv); o1.w = pk4q(s[28 * 33] * inv, s[29 * 33] * inv, s[30 * 33] * inv, s[31 * 33] * inv);
    GAS v4u* dst = (GAS v4u*)(WQ + (size_t)(r0 + n) * DM + k0 + 32 * hh); dst[0] = o0; dst[1] = o1;
    if (kb == 0 && hh == 0) SW[r0 + n] = cmx * (1.0f / 127.0f);
    LDS_WAIT(); asm volatile("" ::: "memory");
}
__device__ __forceinline__ void p0_quant_item_wg(const float* W, int N, signed char* WQ, int rmode, LAS float* scr, LAS float* xch, int par, int n0, int wave, int lane, float* SW, int K = DM) {
    const int r0 = rmode == 0 ? n0 : rmode == 4 ? (n0 < 3 * AW ? n0 : n0 - (COL_GA - 3 * AW)) : 256 * (n0 >> 7) + 128 * (rmode - 1) + (n0 & 127);
    const int kw = 128 * wave;
    float v[64]; const bool have = kw < K;
#pragma unroll
    for (int i = 0; i < 64; ++i) v[i] = have ? __builtin_nontemporal_load(&W[(size_t)(kw + 2 * i + (lane >> 5)) * N + n0 + (lane & 31)]) : 0.f;
    float pm = 0.f;
#pragma unroll
    for (int i = 0; i < 64; ++i) pm = fmaxf(pm, fabsf(v[i]));
    pm = fmaxf(pm, __shfl_xor(pm, 32));
    LAS float* xc = xch + par * 256;
    if (lane < 32) xc[wave * 32 + lane] = pm;
    LDS_WAIT(); __syncthreads();
    const int n = lane >> 1, hh = lane & 1;
    float cmx = 0.f;
#pragma unroll
    for (int w = 0; w < NWAVES; ++w) cmx = fmaxf(cmx, xc[w * 32 + n]);
    const float inv = cmx > 0.f ? 127.0f / cmx : 0.f;
    if (have)
#pragma unroll
    for (int sub = 0; sub < 2; ++sub) {
#pragma unroll
        for (int i = 0; i < 32; ++i) scr[(2 * i + (lane >> 5)) * 33 + (lane & 31)] = v[32 * sub + i];
        LDS_WAIT(); asm volatile("" ::: "memory");
        const LAS float* s = scr + (32 * hh) * 33 + n;
        v4u o0, o1;
        o0.x = pk4q(s[0 * 33] * inv, s[1 * 33] * inv, s[2 * 33] * inv, s[3 * 33] * inv);     o0.y = pk4q(s[4 * 33] * inv, s[5 * 33] * inv, s[6 * 33] * inv, s[7 * 33] * inv);
        o0.z = pk4q(s[8 * 33] * inv, s[9 * 33] * inv, s[10 * 33] * inv, s[11 * 33] * inv);   o0.w = pk4q(s[12 * 33] * inv, s[13 * 33] * inv, s[14 * 33] * inv, s[15 * 33] * inv);
        o1.x = pk4q(s[16 * 33] * inv, s[17 * 33] * inv, s[18 * 33] * inv, s[19 * 33] * inv); o1.y = pk4q(s[20 * 33] * inv, s[21 * 33] * inv, s[22 * 33] * inv, s[23 * 33] * inv);
        o1.z = pk4q(s[24 * 33] * inv, s[25 * 33] * inv, s[26 * 33] * inv, s[27 * 33] * inv); o1.w = pk4q(s[28 * 33] * inv, s[29 * 33] * inv, s[30 * 33] * inv, s[31 * 33] * inv);
        GAS v4u* dst = (GAS v4u*)(WQ + (size_t)(r0 + n) * K + kw + 64 * sub + 32 * hh); dst[0] = o0; dst[1] = o1;
        LDS_WAIT(); asm volatile("" ::: "memory");
    }
    if (wave == 0 && hh == 0) SW[r0 + n] = cmx * (1.0f / 127.0f);
}
__device__ __forceinline__ void p0_transposes(Frame& F, const Args& args, int set, int gw, int NGW) {
    LAS float* scr = (LAS float*)(F.lds + RING_OFF + F.wave * 16384);
    int base = 0;
#if WQ_FUSED
    LAS float* xch = (LAS float*)(F.lds + XL_OFF); const int wb = gw / NWAVES, NWB = NGW / NWAVES; int baseq = 0, qpar = 0;
#define TR_JOBQ(SRC, N_, NBLK, NB2N0, RMODE, DST, SWO) do { int it = wb - (baseq % NWB); if (it < 0) it += NWB; \
        for (; it < (NBLK); it += NWB) { const int nb_ = it; p0_quant_item_wg(args.in[SRC], (N_), (signed char*)(F.ws + (DST)), (RMODE), scr, xch, qpar, (NB2N0), F.wave, F.lane, (float*)(F.ws + (SWO))); qpar ^= 1; } baseq += (NBLK); } while (0)
    if (set == 0) { TR_JOBQ(I_F1G, DFF, DFF / 32, 32 * nb_, 1, WS_WGU1, WS_SW1); TR_JOBQ(I_F1U, DFF, DFF / 32, 32 * nb_, 2, WS_WGU1, WS_SW1); __syncthreads(); }
    else if (set == 1 || set == 5) { TR_JOBQ(I_WIN, INW, WIN_I8_ROWS / 32, (32 * nb_ < 3 * AW ? 32 * nb_ : 32 * nb_ + (COL_GA - 3 * AW)), 4, WS_WIN, WS_SWIN); __syncthreads(); }
    else if (set == 2) { TR_JOBQ(I_F2G, DFF, DFF / 32, 32 * nb_, 1, WS_WGU2, WS_SW2); TR_JOBQ(I_F2U, DFF, DFF / 32, 32 * nb_, 2, WS_WGU2, WS_SW2); __syncthreads(); }
    else if (set == 3 && WA_I8) { int it = wb; for (; it < DM / 32; it += NWB) { p0_quant_item_wg(args.in[I_WAB], DM, (signed char*)(F.ws + WS_WA), 0, scr, xch, qpar, 32 * it, F.wave, F.lane, (float*)(F.ws + WS_SWA), 512); qpar ^= 1; } __syncthreads(); }
#undef TR_JOBQ
#endif
#define TR_JOB8(SRC, N_, RMODE, DST, MAT, SWO) do { const int n_it = (DM / 64) * ((N_) / 32); int it = gw - (base % NGW); if (it < 0) it += NGW; \
        const float* W_ = args.in[SRC]; signed char* WQ_ = (signed char*)(F.ws + (DST)); const float* cm_ = (const float*)(F.ws + WS_COLMAX) + (MAT) * DFF; float* sw_ = (float*)(F.ws + (SWO)); \
        for (; it < n_it; it += NGW) p0_transpose_item_i8(W_, (N_), WQ_, (RMODE), scr, it, F.lane, cm_, sw_); base += n_it; } while (0)
#define TR_JOB(SRC, K_, N_, RMODE, DST) do { const int n_it = ((K_) / 64) * ((N_) / 32); int it = gw - (base % NGW); if (it < 0) it += NGW;     \
        const float* W_ = args.in[SRC]; bf16* WT_ = (bf16*)(F.ws + (DST)); \
        for (; it < n_it; it += NGW) p0_transpose_item(W_, (K_), (N_), WT_, (RMODE), scr, it, F.lane); base += n_it; } while (0)
#if WQ_FUSED
    if (set == 0) { }
    else if (set == 3) { TR_JOB(I_F1D, DFF, DM, 0, WS_WD1); if (!WA_I8) TR_JOB(I_WAB, 512, DM, 0, WS_WA); }
    else if (set == 4) { TR_JOB(I_F2D, DFF, DM, 0, WS_WD2); }
#elif FFN_I8
    if (set == 0) { TR_JOB8(I_F1G, DFF, 1, WS_WGU1, 0, WS_SW1); TR_JOB8(I_F1U, DFF, 2, WS_WGU1, 1, WS_SW1); TR_JOB(I_F1D, DFF, DM, 0, WS_WD1); }
#else
    if (set == 0) { TR_JOB(I_F1G, DM, DFF, 1, WS_WGU1); TR_JOB(I_F1U, DM, DFF, 2, WS_WGU1); TR_JOB(I_F1D, DFF, DM, 0, WS_WD1); }
#endif
    else if (set == 1 || (WQ_FUSED && set == 6)) {
#if WQ_FUSED
        if (NGW == 128 * NWAVES) base = 80 * NWAVES;
        { const int nbn = ((GATES_I8 ? COL_GA : INW) - COL_U) / 32, n_it = (DM / 64) * nbn; int it = gw - (base % NGW); if (it < 0) it += NGW;
          for (; it < n_it; it += NGW) p0_transpose_item(args.in[I_WIN], DM, INW, (bf16*)(F.ws + WS_WIN), UCPROD ? 3 : 0, scr, it, F.lane, COL_U / 32, nbn);
          base += n_it; }
#elif FFN_I8
        { const int nblk = INW / 32, n_it = (DM / 64) * nblk; int it = gw - (base % NGW); if (it < 0) it += NGW;
          for (; it < n_it; it += NGW) { if ((it % nblk) * 32 < 3 * AW || (GATES_I8 && (it % nblk) * 32 >= COL_GA)) p0_transpose_item_i8(args.in[I_WIN], INW, (signed char*)(F.ws + WS_WIN), 4, scr, it, F.lane, (const float*)(F.ws + WS_COLMAX) + 4 * DFF, (float*)(F.ws + WS_SWIN));
                                         else p0_transpose_item(args.in[I_WIN], DM, INW, (bf16*)(F.ws + WS_WIN), UCPROD ? 3 : 0, scr, it, F.lane); }
          base += n_it; }
#else
        TR_JOB(I_WIN, DM, INW, 0, WS_WIN);
#endif
        if (!WQ_FUSED) { TR_JOB(I_WAB, 512, DM, 0, WS_WA); TR_JOB(I_WCB, DM, DM, 0, WS_WC); TR_JOB(I_WOUT, DM, DM, 0, WS_WO); } }
#if WQ_FUSED
    else if (set == 2) { if (NGW == 128 * NWAVES) base = 48 * NWAVES; TR_JOB(I_WCB, DM, DM, 0, WS_WC); TR_JOB(I_WOUT, DM, DM, 0, WS_WO); }
#elif FFN_I8
    else { TR_JOB8(I_F2G, DFF, 1, WS_WGU2, 2, WS_SW2); TR_JOB8(I_F2U, DFF, 2, WS_WGU2, 3, WS_SW2); TR_JOB(I_F2D, DFF, DM, 0, WS_WD2); }
#else
    else { TR_JOB(I_F2G, DM, DFF, 1, WS_WGU2); TR_JOB(I_F2U, DM, DFF, 2, WS_WGU2); TR_JOB(I_F2D, DFF, DM, 0, WS_WD2); }
#endif
#undef TR_JOB
#undef TR_JOB8
}
__device__ __forceinline__ void norm_pass(Frame& F, const float* X, const float* g, int mod_sh, int mod_sc, bool q8out = false) {
    const int gw = F.vcu * NWAVES + F.wave, NGW = F.G * NWAVES;
    const float* mod = (const float*)(F.ws + WS_MOD); bf16* XS = (bf16*)(F.ws + WS_XS);
    for (int r0 = gw * 8; r0 < M; r0 += NGW * 8) {
        const int b = r0 / SEQ;
        f32x4 a[4], s[4];
#pragma unroll
        for (int j = 0; j < 4; ++j) { const int c = 4 * F.lane + 256 * j;
            a[j] = *(const f32x4*)(g + c) * (*(const f32x4*)(mod + b * NMOD + mod_sc + c) + 1.0f); s[j] = *(const f32x4*)(mod + b * NMOD + mod_sh + c); }
#pragma unroll
        for (int rq = 0; rq < 8; rq += 4) {
        f32x4 vv[4][4];
#pragma unroll
        for (int rr = 0; rr < 4; ++rr) { const GAS f32x4* xr = (const GAS f32x4*)(X + (size_t)(r0 + rq + rr) * DM) + F.lane;
#pragma unroll
            for (int j = 0; j < 4; ++j) vv[rr][j] = xr[64 * j]; }
#pragma unroll
        for (int rr = 0; rr < 4; ++rr) { const int r = rq + rr;
            f32x4 v[4]; float ss = 0.f;
#pragma unroll
            for (int j = 0; j < 4; ++j) { v[j] = vv[rr][j]; ss += (v[j].x * v[j].x + v[j].y * v[j].y) + (v[j].z * v[j].z + v[j].w * v[j].w); }
            const float rstd = 1.0f / sqrtf(wave_sum(ss) * (1.f / DM) + EPS);
            if (q8out) {
                f32x4 y[4]; float am = 0.f;
#pragma unroll
                for (int j = 0; j < 4; ++j) { y[j] = v[j] * rstd * a[j] + s[j]; am = fmaxf(am, fmaxf(fmaxf(fabsf(y[j].x), fabsf(y[j].y)), fmaxf(fabsf(y[j].z), fabsf(y[j].w)))); }
#pragma unroll
                for (int o = 1; o < 64; o <<= 1) am = fmaxf(am, __shfl_xor(am, o));
                const float inv = am > 0.f ? 127.0f / am : 0.f;
                GAS unsigned* o4 = (GAS unsigned*)((signed char*)(F.ws + WS_XQ1) + (size_t)(r0 + r) * DM) + F.lane;
#pragma unroll
                for (int j = 0; j < 4; ++j) o4[64 * j] = pk4q(y[j].x * inv, y[j].y * inv, y[j].z * inv, y[j].w * inv);
                if (F.lane == 0) ((float*)(F.ws + WS_SA1))[r0 + r] = am * (1.0f / 127.0f);
            } else {
            GAS unsigned long long* o8 = (GAS unsigned long long*)(XS + (size_t)(r0 + r) * DM) + F.lane;
#pragma unroll
            for (int j = 0; j < 4; ++j) { const f32x4 y = v[j] * rstd * a[j] + s[j];
                o8[64 * j] = (unsigned long long)pk2(y.x, y.y) | ((unsigned long long)pk2(y.z, y.w) << 32); }
            }
        }
        }
    }
}
__device__ __forceinline__ void qknorm_pass(Frame& F, const Args& args) {
    const int gw = F.vcu * NWAVES + F.wave, NGW = F.G * NWAVES;
    const float* gq_ = args.in[I_QN]; const float* gk_ = args.in[I_KN];
    for (int it = gw; it < 2 * M; it += NGW) {
        const int which = it >= M, row = which ? it - M : it;
        bf16* buf = (bf16*)(F.ws + (which ? WS_K : WS_Q)) + (size_t)row * AW; const float* gm = (which ? gk_ : gq_) + 8 * (F.lane & 15);
        const f32x4 g0 = *(const f32x4*)gm, g1 = *(const f32x4*)(gm + 4);
#pragma unroll
        for (int j = 0; j < 3; ++j) { GAS v4u* p = (GAS v4u*)(buf + 512 * j + 8 * F.lane); const v4u w = *p;
            f32x4 v0 = {blo(w.x), bhi(w.x), blo(w.y), bhi(w.y)}, v1 = {blo(w.z), bhi(w.z), blo(w.w), bhi(w.w)};
            float ss = (v0.x * v0.x + v0.y * v0.y) + (v0.z * v0.z + v0.w * v0.w) + (v1.x * v1.x + v1.y * v1.y) + (v1.z * v1.z + v1.w * v1.w);
            ss += __shfl_xor(ss, 1); ss += __shfl_xor(ss, 2); ss += __shfl_xor(ss, 4); ss += __shfl_xor(ss, 8);
            const float r = 1.0f / sqrtf(ss * (1.f / 128.f) + EPS);
            v0 = v0 * r * g0; v1 = v1 * r * g1;
            v4u o; o.x = pk2(v0.x, v0.y); o.y = pk2(v0.z, v0.w); o.z = pk2(v1.x, v1.y); o.w = pk2(v1.z, v1.w); *p = o; }
    }
}
__device__ __forceinline__ void aux_avec(Frame& F, const Args& args) {
    const int gw = F.vcu * NWAVES + F.wave, NGW = F.G * NWAVES;
    const float* mod = (const float*)(F.ws + WS_MOD); float* avec = (float*)(F.ws + WS_AVEC);
    const float* g2 = args.in[I_NMIX]; const float* g3 = args.in[I_NF2];
    for (int idx = gw * 64 + F.lane; idx < 4 * DM; idx += NGW * 64) { const int which = idx >> 11, b = (idx >> 10) & 1, c = idx & (DM - 1);
        avec[idx] = (which ? g3[c] : g2[c]) * (1.0f + mod[b * NMOD + (which ? MOD_SC3 : MOD_SC2) + c]); }
}
__device__ __forceinline__ void aux_bias(Frame& F, int which) {
    const int gw = F.vcu * NWAVES + F.wave, NGW = F.G * NWAVES;
    const float* mod = (const float*)(F.ws + WS_MOD);
    const int nrows = which ? 2 * DFF : INW;
    const float* sh = mod + (which ? MOD_SH3 : MOD_SH2) + 16 * F.lane;
    f32x4 s0[4], s1[4];
#pragma unroll
    for (int q = 0; q < 4; ++q) { s0[q] = *(const f32x4*)(sh + 4 * q); s1[q] = *(const f32x4*)(sh + NMOD + 4 * q); }
    float* bo = (float*)(F.ws + (which ? WS_BIAS_F2 : WS_BIAS_IN));
    for (int n = gw + ((FFN_I8 && !which) ? 3 * AW : 0); n < ((GATES_I8 && !which) ? COL_GA : nrows); n += NGW) {
        const bf16* wrow = (const bf16*)(F.ws + (which ? WS_WGU2 : WS_WIN)) + (size_t)n * DM + 16 * F.lane;
        const v4u w0 = *(const GAS v4u*)wrow, w1 = *(const GAS v4u*)(wrow + 8);
        const float wv[16] = {blo(w0.x), bhi(w0.x), blo(w0.y), bhi(w0.y), blo(w0.z), bhi(w0.z), blo(w0.w), bhi(w0.w), blo(w1.x), bhi(w1.x), blo(w1.y), bhi(w1.y), blo(w1.z), bhi(w1.z), blo(w1.w), bhi(w1.w)};
        float d0 = 0.f, d1 = 0.f;
#pragma unroll
        for (int q = 0; q < 4; ++q)
#pragma unroll
            for (int i = 0; i < 4; ++i) { d0 += s0[q][i] * wv[4 * q + i]; d1 += s1[q][i] * wv[4 * q + i]; }
        d0 = wave_sum(d0); d1 = wave_sum(d1);
        if (F.lane == 0) { bo[n] = d0; bo[nrows + n] = d1; }
    }
}
__device__ __forceinline__ void xs_quant_pass(Frame& F, size_t ps_off, signed char* xq, size_t rf_off) {
    const int gw = F.vcu * NWAVES + F.wave, NGW = F.G * NWAVES; const bf16* XSb = (const bf16*)(F.ws + WS_XS); const float* PS = (const float*)(F.ws + ps_off);
    for (int rb = gw; rb < M; rb += 4 * NGW) {
        v4u w0[4], w1[4]; f32x4 ps[4];
#pragma unroll
        for (int j = 0; j < 4; ++j) { const int r = min(rb + j * NGW, M - 1); const GAS v4u* p = (const GAS v4u*)(XSb + (size_t)r * DM) + F.lane;
            w0[j] = p[0]; w1[j] = p[64]; ps[j] = *(const f32x4*)(PS + (size_t)r * 4); }
#pragma unroll
        for (int j = 0; j < 4; ++j) { const int r = rb + j * NGW; if (r < M) {
            const float v[16] = {blo(w0[j].x), bhi(w0[j].x), blo(w0[j].y), bhi(w0[j].y), blo(w0[j].z), bhi(w0[j].z), blo(w0[j].w), bhi(w0[j].w), blo(w1[j].x), bhi(w1[j].x), blo(w1[j].y), bhi(w1[j].y), blo(w1[j].z), bhi(w1[j].z), blo(w1[j].w), bhi(w1[j].w)};
            float am = 0.f;
#pragma unroll
            for (int i = 0; i < 16; ++i) am = fmaxf(am, fabsf(v[i]));
#pragma unroll
            for (int o = 1; o < 64; o <<= 1) am = fmaxf(am, __shfl_xor(am, o));
            const float inv = am > 0.f ? 127.0f / am : 0.f;
            GAS unsigned long long* q = (GAS unsigned long long*)(xq + (size_t)r * DM) + F.lane;
            q[0] = (unsigned long long)pk4q(v[0] * inv, v[1] * inv, v[2] * inv, v[3] * inv) | ((unsigned long long)pk4q(v[4] * inv, v[5] * inv, v[6] * inv, v[7] * inv) << 32);
            q[64] = (unsigned long long)pk4q(v[8] * inv, v[9] * inv, v[10] * inv, v[11] * inv) | ((unsigned long long)pk4q(v[12] * inv, v[13] * inv, v[14] * inv, v[15] * inv) << 32);
            if (F.lane == 0) ((float*)(F.ws + rf_off))[r] = __builtin_amdgcn_rsqf(((ps[j][0] + ps[j][1]) + (ps[j][2] + ps[j][3])) * (1.0f / 1024.0f) + 1e-6f) * am * (1.0f / 127.0f); } }
    }
}
__device__ __forceinline__ void aux_bias_i8(Frame& F, int mod_sh, size_t wq_off, size_t sw_off, int nrows, size_t bias_off, int bstride) {
    const int gw = F.vcu * NWAVES + F.wave, NGW = F.G * NWAVES;
    const float* mod = (const float*)(F.ws + WS_MOD); const float* sh = mod + mod_sh + 16 * F.lane; const float* SW = (const float*)(F.ws + sw_off);
    f32x4 s0[4], s1[4];
#pragma unroll
    for (int q = 0; q < 4; ++q) { s0[q] = *(const f32x4*)(sh + 4 * q); s1[q] = *(const f32x4*)(sh + NMOD + 4 * q); }
    float* bo = (float*)(F.ws + bias_off);
    for (int n = gw; n < nrows; n += NGW) {
        const v4u w = *(const GAS v4u*)((const signed char*)(F.ws + wq_off) + (size_t)n * DM + 16 * F.lane);
        const unsigned ww[4] = {w.x, w.y, w.z, w.w}; float d0 = 0.f, d1 = 0.f;
#pragma unroll
        for (int q = 0; q < 4; ++q)
#pragma unroll
            for (int i = 0; i < 4; ++i) { const float wv = (float)(int)(signed char)((ww[q] >> (8 * i)) & 255u); d0 += s0[q][i] * wv; d1 += s1[q][i] * wv; }
        d0 = wave_sum(d0); d1 = wave_sum(d1);
        if (F.lane == 0) { const float sc = SW[n]; bo[n] = d0 * sc; bo[bstride + n] = d1 * sc; }
    }
}
typedef attn::BlockRef<attn::bf16, attn::bf16> ABlock;
__device__ __forceinline__ ABlock attn_ref(Frame& F, int id, int& skv) {
    const int bgh = id >> 5, x = id & 31, b = bgh / 12, gh = bgh - b * 12, g = gh >> 2, d = 1 << (2 * g), nqb = 32 >> (2 * g), r = x / nqb, qb = x - r * nqb;
    ABlock R; const size_t e0 = (size_t)(b * SEQ + r) * AW + gh * 128;
    R.rs = d * AW; R.ls = d * 12; R.P0 = qb * 256; skv = SEQ / d;
    R.K = (const attn::bf16*)(F.ws + WS_K) + e0; R.V = (const attn::bf16*)(F.ws + WS_V) + e0;
    attn::bf16* q = (attn::bf16*)(F.ws + WS_Q) + e0 + (size_t)(qb * 256) * R.rs; R.Q = q; R.O = q;
    R.LSE = (float*)(F.ws + WS_LSE) + (size_t)(b * SEQ + r + qb * 256 * d) * 12 + gh;
    return R;
}
__device__ __forceinline__ void attn_phase(Frame& F, char* lds) {
    constexpr int NITEMS = 768;
    const int per = (NITEMS + F.G - 1) / F.G; int id = F.vcu * per; const int end = (id + per < NITEMS) ? id + per : NITEMS;
    if (id >= end) return;
    int skv, skvn; ABlock cur = attn_ref(F, id, skv);
    attn::Seam<attn::bf16> S;
    attn::causal_swa_prime<attn::bf16, attn::bf16>(cur, attn::WINDOW, lds, S);
    for (;;) {
        const bool last = id + 1 >= end; skvn = skv;
        const ABlock nxt = last ? cur : attn_ref(F, id + 1, skvn);
        attn::causal_swa_block<attn::bf16, attn::bf16>(cur, nxt, skv, attn::WINDOW, lds, S);
        if (last) break;
        cur = nxt; skv = skvn; ++id;
    }
}
__device__ __forceinline__ void merge_conv_pass(Frame& F, const Args& args) {
    const int gw = F.vcu * NWAVES + F.wave, NGW = F.G * NWAVES;
    { const bf16* OG = (const bf16*)(F.ws + WS_Q); const float* LSE = (const float*)(F.ws + WS_LSE); bf16* O = (bf16*)(F.ws + WS_O);
      const int h = F.lane >> 4, e = 8 * (F.lane & 15);
      for (int t = gw; t < M; t += NGW) {
          const float l0 = LSE[(size_t)t * 12 + h], l1 = LSE[(size_t)t * 12 + 4 + h], l2 = LSE[(size_t)t * 12 + 8 + h];
          const float mx = fmaxf(l0, fmaxf(l1, l2)); const float e0 = __expf(l0 - mx), e1 = __expf(l1 - mx), e2 = __expf(l2 - mx); const float inv = 1.0f / (e0 + e1 + e2);
          const float wg[3] = {e0 * inv, e1 * inv, e2 * inv};
          f32x4 a0 = {0.f, 0.f, 0.f, 0.f}, a1 = {0.f, 0.f, 0.f, 0.f};
#pragma unroll
          for (int g = 0; g < 3; ++g) { const v4u w = *(const GAS v4u*)(OG + (size_t)t * AW + (g * 4 + h) * 128 + e);
              a0 = a0 + (f32x4){blo(w.x), bhi(w.x), blo(w.y), bhi(w.y)} * wg[g]; a1 = a1 + (f32x4){blo(w.z), bhi(w.z), blo(w.w), bhi(w.w)} * wg[g]; }
#if WA_I8
          float am = fmaxf(fmaxf(fmaxf(fabsf(a0.x), fabsf(a0.y)), fmaxf(fabsf(a0.z), fabsf(a0.w))), fmaxf(fmaxf(fabsf(a1.x), fabsf(a1.y)), fmaxf(fabsf(a1.z), fabsf(a1.w))));
#pragma unroll
          for (int o_ = 1; o_ < 64; o_ <<= 1) am = fmaxf(am, __shfl_xor(am, o_));
          const float qi = am > 0.f ? 127.0f / am : 0.f;
          *(GAS unsigned long long*)((signed char*)O + (size_t)t * 512 + 8 * F.lane) = (unsigned long long)pk4q(a0.x * qi, a0.y * qi, a0.z * qi, a0.w * qi) | ((unsigned long long)pk4q(a1.x * qi, a1.y * qi, a1.z * qi, a1.w * qi) << 32);
          if (F.lane == 0) ((float*)(F.ws + WS_RFO))[t] = am * (1.0f / 127.0f); } }
#else
          v4u o; o.x = pk2(a0.x, a0.y); o.y = pk2(a0.z, a0.w); o.z = pk2(a1.x, a1.y); o.w = pk2(a1.z, a1.w);
          *(GAS v4u*)(O + (size_t)t * 512 + 8 * F.lane) = o; } }
#endif
#if UCPROD
    { const bf16* Z = (const bf16*)(F.ws + WS_U); bf16* Bv = (bf16*)(F.ws + WS_B); const float* cw = args.in[I_CONVW];
      for (int it = gw; it < 2 * (M / 16); it += NGW) {
          const int ch = it & 1, t0 = (it >> 1) * 16, c0 = 512 * ch + 8 * F.lane;
          float w0[8], w1[8], w2[8], x1[8], x2[8];
#pragma unroll
          for (int i = 0; i < 8; ++i) { w0[i] = cw[c0 + i]; w1[i] = cw[DM + c0 + i]; w2[i] = cw[2 * DM + c0 + i]; x1[i] = 0.f; x2[i] = 0.f; }
          if ((t0 & (SEQ - 1)) != 0) {
#pragma unroll
              for (int p = 2; p >= 1; --p) { const v4u wz = *(const GAS v4u*)(Z + (size_t)(t0 - p) * DM + c0);
                  const float xz[8] = {blo(wz.x), bhi(wz.x), blo(wz.y), bhi(wz.y), blo(wz.z), bhi(wz.z), blo(wz.w), bhi(wz.w)};
#pragma unroll
                  for (int i = 0; i < 8; ++i) { if (p == 2) x2[i] = xz[i]; else x1[i] = xz[i]; } } }
#pragma unroll 4
          for (int r = 0; r < 16; ++r) { const size_t off = (size_t)(t0 + r) * DM + c0;
              const v4u wz = *(const GAS v4u*)(Z + off), wb = *(const GAS v4u*)(Bv + off);
              const float xz[8] = {blo(wz.x), bhi(wz.x), blo(wz.y), bhi(wz.y), blo(wz.z), bhi(wz.z), blo(wz.w), bhi(wz.w)};
              const float xb[8] = {blo(wb.x), bhi(wb.x), blo(wb.y), bhi(wb.y), blo(wb.z), bhi(wb.z), blo(wb.w), bhi(wb.w)};
              float y[8];
#pragma unroll
              for (int i = 0; i < 8; ++i) { const float x0 = xz[i]; y[i] = xb[i] * (w0[i] * x2[i] + w1[i] * x1[i] + w2[i] * x0); x2[i] = x1[i]; x1[i] = x0; }
              v4u o; o.x = pk2(y[0], y[1]); o.y = pk2(y[2], y[3]); o.z = pk2(y[4], y[5]); o.w = pk2(y[6], y[7]);
              *(GAS v4u*)(Bv + off) = o; } } }
#else
    { const bf16* U = (const bf16*)(F.ws + WS_U); bf16* Bv = (bf16*)(F.ws + WS_B); const bf16* Cg = (const bf16*)(F.ws + WS_C); const float* cw = args.in[I_CONVW];
      for (int it = gw; it < 2 * (M / 16); it += NGW) {
          const int ch = it & 1, t0 = (it >> 1) * 16, c0 = 512 * ch + 8 * F.lane;
          float w0[8], w1[8], w2[8], x1[8], x2[8];
#pragma unroll
          for (int i = 0; i < 8; ++i) { w0[i] = cw[c0 + i]; w1[i] = cw[DM + c0 + i]; w2[i] = cw[2 * DM + c0 + i]; x1[i] = 0.f; x2[i] = 0.f; }
          if ((t0 & (SEQ - 1)) != 0) {
#pragma unroll
              for (int p = 2; p >= 1; --p) { const v4u wu = *(const GAS v4u*)(U + (size_t)(t0 - p) * DM + c0), wc = *(const GAS v4u*)(Cg + (size_t)(t0 - p) * DM + c0);
                  const float xu[8] = {blo(wu.x), bhi(wu.x), blo(wu.y), bhi(wu.y), blo(wu.z), bhi(wu.z), blo(wu.w), bhi(wu.w)}, xc[8] = {blo(wc.x), bhi(wc.x), blo(wc.y), bhi(wc.y), blo(wc.z), bhi(wc.z), blo(wc.w), bhi(wc.w)};
#pragma unroll
                  for (int i = 0; i < 8; ++i) { if (p == 2) x2[i] = xu[i] * xc[i]; else x1[i] = xu[i] * xc[i]; } } }
#pragma unroll 4
          for (int r = 0; r < 16; ++r) { const size_t off = (size_t)(t0 + r) * DM + c0;
              const v4u wu = *(const GAS v4u*)(U + off), wc = *(const GAS v4u*)(Cg + off), wb = *(const GAS v4u*)(Bv + off);
              const float xu[8] = {blo(wu.x), bhi(wu.x), blo(wu.y), bhi(wu.y), blo(wu.z), bhi(wu.z), blo(wu.w), bhi(wu.w)}, xc[8] = {blo(wc.x), bhi(wc.x), blo(wc.y), bhi(wc.y), blo(wc.z), bhi(wc.z), blo(wc.w), bhi(wc.w)};
              const float xb[8] = {blo(wb.x), bhi(wb.x), blo(wb.y), bhi(wb.y), blo(wb.z), bhi(wb.z), blo(wb.w), bhi(wb.w)};
              float y[8];
#pragma unroll
              for (int i = 0; i < 8; ++i) { const float x0 = xu[i] * xc[i]; y[i] = xb[i] * (w0[i] * x2[i] + w1[i] * x1[i] + w2[i] * x0); x2[i] = x1[i]; x1[i] = x0; }
              v4u o; o.x = pk2(y[0], y[1]); o.y = pk2(y[2], y[3]); o.z = pk2(y[4], y[5]); o.w = pk2(y[6], y[7]);
              *(GAS v4u*)(Bv + off) = o; } } }
#endif
}


#ifdef NAIVE
template <bool DUAL, class St>
__device__ __forceinline__ void naive_gemm(Frame& F, const bf16* A, int lda, const float* W, const float* W2, int ldw, int M_, int N_, int K_, St store) {
    LAS float* As = (LAS float*)(F.lds + RING_OFF);
    LAS float* Ws = As + 64 * 33;
    LAS float* Ws2 = Ws + 32 * 68;
    const int ty = F.tid >> 4, tx = F.tid & 15, ntn = N_ / 64, ntiles = (M_ / 64) * ntn;
    for (int tile = blockIdx.x; tile < ntiles; tile += F.G) {
        const int tm = tile / ntn, tn = tile - tm * ntn;
        float acc[2][4] = {{0.f, 0.f, 0.f, 0.f}, {0.f, 0.f, 0.f, 0.f}}, acc2[2][4] = {{0.f, 0.f, 0.f, 0.f}, {0.f, 0.f, 0.f, 0.f}};
        for (int k0 = 0; k0 < K_; k0 += 32) {
            __syncthreads();
#pragma unroll
            for (int i = 0; i < 4; ++i) { const int e = F.tid + 512 * i, r = e >> 5, c = e & 31; As[r * 33 + c] = __uint_as_float((unsigned)A[(size_t)(tm * 64 + r) * lda + k0 + c] << 16); }
#pragma unroll
            for (int i = 0; i < 4; ++i) { const int e = F.tid + 512 * i, r = e >> 6, c = e & 63; Ws[r * 68 + c] = W[(size_t)(k0 + r) * ldw + tn * 64 + c]; if (DUAL) Ws2[r * 68 + c] = W2[(size_t)(k0 + r) * ldw + tn * 64 + c]; }
            __syncthreads();
#pragma unroll 8
            for (int kk = 0; kk < 32; ++kk) { const float a0 = As[(ty * 2) * 33 + kk], a1 = As[(ty * 2 + 1) * 33 + kk];
#pragma unroll
                for (int j = 0; j < 4; ++j) { const float w = Ws[kk * 68 + tx * 4 + j]; acc[0][j] += a0 * w; acc[1][j] += a1 * w;
                    if (DUAL) { const float w2 = Ws2[kk * 68 + tx * 4 + j]; acc2[0][j] += a0 * w2; acc2[1][j] += a1 * w2; } } }
        }
#pragma unroll
        for (int i = 0; i < 2; ++i)
#pragma unroll
            for (int j = 0; j < 4; ++j) store(tm * 64 + ty * 2 + i, tn * 64 + tx * 4 + j, acc[i][j], acc2[i][j]);
    }
    __syncthreads();
}
__device__ __forceinline__ bf16 f2b(float v) { return (bf16)f2bf(v); }
__device__ __forceinline__ float b2f(bf16 v) { return __uint_as_float((unsigned)v << 16); }
__device__ __forceinline__ void naive_attn(Frame& F) {
    const int gw = F.vcu * NWAVES + F.wave, NGW = F.G * NWAVES;
    bf16* Qb = (bf16*)(F.ws + WS_Q); const bf16* Kb = (const bf16*)(F.ws + WS_K); const bf16* Vb = (const bf16*)(F.ws + WS_V); float* LSE = (float*)(F.ws + WS_LSE);
    for (int it = gw; it < M * 12; it += NGW) {
        const int t = it / 12, gh = it - t * 12, g = gh >> 2, d = 1 << (2 * g), tl = t & (SEQ - 1);
        const float q0 = b2f(Qb[(size_t)t * AW + gh * 128 + 2 * F.lane]), q1 = b2f(Qb[(size_t)t * AW + gh * 128 + 2 * F.lane + 1]);
        float s0 = -INFINITY, s1 = -INFINITY, s2 = -INFINITY;
        for (int j = 0; j <= 128; ++j) { if (tl - j * d < 0) break; const size_t kr = (size_t)(t - j * d) * AW + gh * 128 + 2 * F.lane;
            const float sc = wave_sum(q0 * b2f(Kb[kr]) + q1 * b2f(Kb[kr + 1])) * 0.08838834764831845f;
            if (j < 64) { if (F.lane == j) s0 = sc; } else if (j < 128) { if (F.lane == j - 64) s1 = sc; } else { if (F.lane == 0) s2 = sc; } }
        float mx = fmaxf(s0, fmaxf(s1, s2));
#pragma unroll
        for (int o = 1; o < 64; o <<= 1) mx = fmaxf(mx, __shfl_xor(mx, o));
        const float p0 = __expf(s0 - mx), p1 = __expf(s1 - mx), p2 = __expf(s2 - mx);
        const float l = wave_sum(p0 + p1 + p2);
        float o0 = 0.f, o1 = 0.f;
        for (int j = 0; j <= 128; ++j) { if (tl - j * d < 0) break; const size_t vr = (size_t)(t - j * d) * AW + gh * 128 + 2 * F.lane;
            const float p = (j < 64) ? __shfl(p0, j) : (j < 128) ? __shfl(p1, j - 64) : __shfl(p2, 0);
            o0 += p * b2f(Vb[vr]); o1 += p * b2f(Vb[vr + 1]); }
        const float inv = 1.0f / l;
        Qb[(size_t)t * AW + gh * 128 + 2 * F.lane] = f2b(o0 * inv); Qb[(size_t)t * AW + gh * 128 + 2 * F.lane + 1] = f2b(o1 * inv);
        if (F.lane == 0) LSE[(size_t)t * 12 + gh] = mx + __logf(l);
    }
}
#endif

constexpr int N_PHASES = 17;
__global__ void __launch_bounds__(NWAVES * 64, 2) mega_fwd(Args args) {
    extern __shared__ __attribute__((aligned(16))) unsigned char lds[];
    Frame F;
    F.lds = (LAS unsigned char*)lds;
    F.MISC = (volatile LAS unsigned*)(F.lds + MISC_OFF);
    F.tid = threadIdx.x; F.lane = F.tid & 63; F.wave = __builtin_amdgcn_readfirstlane(F.tid >> 6);
    F.G = gridDim.x; { const int bx = blockIdx.x; F.vcu = (F.G % 8 == 0) ? (bx % 8) * (F.G / 8) + bx / 8 : bx; }
    F.ws = args.ws; F.out = args.out;
    F.ctl = (gu32*)(args.ws + WS_CTL);
    for (int u = F.tid; u < (LDS_BYTES - LDSCTL_OFF) / 4; u += NWAVES * 64) ((LAS unsigned*)(F.lds + LDSCTL_OFF))[u] = 0u;
    __syncthreads();
    XcdBarrier bar = xcd_barrier_post((unsigned*)(F.ctl + CW_BAR), F.MISC + 8);
    const int lo = args.ph_lo, hi = args.ph_hi;
    typedef pg8::bf16_t pb;
#define mod ((const float*)(args.ws + WS_MOD))
#define XS ((const pb*)(args.ws + WS_XS))
    unsigned char* const ws = args.ws;
#define IN(k) (lo <= (k) && (k) < hi)
#ifndef SET2_EARLY
#define SET2_EARLY 0
#endif
#ifndef SET2_FIRST
#define SET2_FIRST 1
#endif
#ifdef NAIVE
#define RES16 0
#define X1B ((void*)F.out)
#define X2B ((void*)F.out)
#else
#define RES16 1
#define X1B ((void*)F.out)
#define X2B ((void*)(ws + WS_C))
#endif
#if defined(NAIVE) || !FFN_I8
#define QRDV 0
#else
#define QRDV 1
#endif
#ifndef GATES8
#ifdef NAIVE
#define GATES8 0
#else
#define GATES8 1
#endif
#endif
#define XQ2P ((unsigned char*)F.out + (size_t)32 * MiB)
#ifndef GATES_EARLY
#define GATES_EARLY 1
#endif
#ifndef SET1_FIRST
#define SET1_FIRST 1
#endif
#ifndef SET1_SPLIT
#define SET1_SPLIT 0
#endif
#ifndef STAG16
#define STAG16 800
#endif
#define FRESH() do { F.tid = tid_opaque(); F.lane = F.tid & 63; } while (0)
#ifdef PROBE_TA
#define TSTAMP(slot) do { if (F.tid == 0) { const unsigned long long t_ = rt(); F.MISC[16 + 2 * (slot)] = (unsigned)t_; F.MISC[17 + 2 * (slot)] = (unsigned)(t_ >> 32); } } while (0)
#define SEAM(k) do { if (IN(k) && IN((k) + 1)) xcd_barrier(bar); if ((k) == PROBE_TA) TSTAMP(0); if ((k) == PROBE_TB) TSTAMP(1); } while (0)
    if (PROBE_TA == -1) TSTAMP(0);
#else
#define SEAM(k) do { if (IN(k) && IN((k) + 1)) xcd_barrier(bar); } while (0)
#endif
#ifdef NAIVE
#define FUSE_NORM 0
#else
#define FUSE_NORM 1
#endif
#define XL ((PG8_LAS float*)(F.lds + XL_OFF))
#define PS2 ((const float*)(args.ws + WS_PS2))
#define PS3 ((const float*)(args.ws + WS_PS3))
#define bias_in ((const float*)(args.ws + WS_BIAS_IN))
#define bias_f2 ((const float*)(args.ws + WS_BIAS_F2))
#define avec ((const float*)(args.ws + WS_AVEC))
#define GEMM_BX(SCHED_DECL, SCHED_T, A_, K_, BT, N_, MODE, NRM, QKN_, O_, LDC, SPC, SPS, I1, I2, PS_, BIAS_, BSTR) GEMM_BXG(false, SCHED_DECL, SCHED_T, A_, K_, BT, N_, MODE, NRM, QKN_, O_, LDC, SPC, SPS, I1, I2, PS_, BIAS_, BSTR)
#define GEMM_BXG(G8_, SCHED_DECL, SCHED_T, A_, K_, BT, N_, MODE, NRM, QKN_, O_, LDC, SPC, SPS, I1, I2, PS_, BIAS_, BSTR) do { pg8::Gemm g{(const pb*)(A_), (const pb*)(BT), M, (N_), (K_)}; SCHED_DECL; \
        typedef pg8::EpiB<MODE, (NRM), (QKN_), (G8_)> EpiT; EpiT E{(pb*)(O_), (LDC), (SPC), (SPS), (const pb*)(I1), (const pb*)(I2), (PS_), (BIAS_), (BSTR), args.in[I_QN], args.in[I_KN], 2 * AW, XL, 0}; \
        pg8::gemm_phase<EpiT, SCHED_T, true, true>(F.lds + RING_OFF, g, S, E); } while (0)
#define GEMM_B(A_, K_, BT, N_, MODE, NRM, QKN_, O_, LDC, SPC, SPS, I1, I2, PS_, BIAS_, BSTR) \
        GEMM_BX(pg8::StaticOrder S; S.init(M, (N_), F.G, (int)blockIdx.x), pg8::StaticOrder, A_, K_, BT, N_, MODE, NRM, QKN_, O_, LDC, SPC, SPS, I1, I2, PS_, BIAS_, BSTR)
#define GEMM_F(XSO, B16, O16, QM, A_, K_, BT, BASE, OUT_, COEF, SCALE, AVEC_, PS_, XQ_, RF_, AM_, CNT_) do { pg8::Gemm g{(const pb*)(A_), (const pb*)(BT), M, DM, (K_)}; pg8::StaticOrder S; S.init(M, DM, F.G, (int)blockIdx.x); \
        typedef pg8::EpiF<(XSO), (B16), (O16), (QM)> EpiT; EpiT E{(BASE), (OUT_), (COEF), (pb*)(ws + WS_XS), (AVEC_), (float*)(PS_), XL, (SCALE), (signed char*)(XQ_), (float*)(RF_), (unsigned*)(AM_), (unsigned*)(CNT_)}; pg8::gemm_phase<EpiT, pg8::StaticOrder, true, true>(F.lds + RING_OFF, g, S, E); } while (0)

#define GEMM_I8(XQ_, WQ_, HASB, ROWF_, SW_, BIAS_) do { pg8::Gemm g{(const pb*)(XQ_), (const pb*)(WQ_), M, 2 * DFF, DM / 2}; pg8::StaticOrder S; S.init(M, 2 * DFF, F.G, (int)blockIdx.x);     \
        typedef pg8::EpiI8<(HASB)> EpiT; EpiT E{(pb*)(ws + WS_ACT), DFF, (ROWF_), (SW_), (BIAS_), 2 * DFF, XL, 0}; pg8::gemm_phase<EpiT, pg8::StaticOrder, true, true>(F.lds + RING_OFF, g, S, E); } while (0)
    const bool p0_split = false;
#if FUSE_NORM
    FRESH();
    if (IN(0)) { for (int it = blockIdx.x; it < ADA_ITEMS; it += F.G) p0_adaln_item(F, args, it);
                 if (p0_split && (int)blockIdx.x >= ADA_ITEMS) p0_transposes(F, args, 0, ((int)blockIdx.x - ADA_ITEMS) * NWAVES + F.wave, (256 - ADA_ITEMS) * NWAVES);
                 if (WQ_FUSED && F.G == 256 && (int)blockIdx.x >= ADA_ITEMS) p0_transposes(F, args, 3, ((int)blockIdx.x - ADA_ITEMS) * NWAVES + F.wave, (256 - ADA_ITEMS) * NWAVES);
#if FFN_I8 && !WQ_FUSED
                 if (F.G == 256 && (int)blockIdx.x >= ADA_ITEMS) wq_absmax(F, args, ((int)blockIdx.x - ADA_ITEMS) * NWAVES + F.wave, (256 - ADA_ITEMS) * NWAVES, 0, ABS_SPLIT);
                 else if (F.G == 256) wq_absmax(F, args, (int)blockIdx.x + ADA_ITEMS * F.wave, ADA_ITEMS * NWAVES, ABS_SPLIT, ABS_FFN_ITEMS + ABS_QKV_ITEMS);
                 else if (F.G != 256) wq_absmax(F, args, F.vcu * NWAVES + F.wave, F.G * NWAVES);
#endif
    }
#else
    FRESH();
    if (IN(0)) { for (int it = blockIdx.x; it < ADA_ITEMS; it += F.G) p0_adaln_item(F, args, it); for (int st = 0; st < 3; ++st) p0_transposes(F, args, st, F.vcu * NWAVES + F.wave, F.G * NWAVES); }
#endif
    SEAM(0);
    FRESH();
    if (IN(1)) { norm_pass(F, args.in[I_X], args.in[I_NF1], MOD_SH1, MOD_SC1, FFN_I8 != 0); if (FUSE_NORM) { aux_avec(F, args); if (!p0_split) p0_transposes(F, args, 0, F.vcu * NWAVES + F.wave, F.G * NWAVES); if (WQ_FUSED && F.G != 256) { p0_transposes(F, args, 3, F.vcu * NWAVES + F.wave, F.G * NWAVES); p0_transposes(F, args, 4, F.vcu * NWAVES + F.wave, F.G * NWAVES); } if (SET2_EARLY) p0_transposes(F, args, 2, F.vcu * NWAVES + F.wave, F.G * NWAVES); } }
    SEAM(1);
#ifdef PROBE_XBAR
    xcd_barrier(bar); xcd_barrier(bar); xcd_barrier(bar); xcd_barrier(bar);
#endif
#if defined(NAIVE) && (NAIVE & 1)
    if (IN(2)) { bf16* ACT = (bf16*)(ws + WS_ACT); naive_gemm<true>(F, (const bf16*)XS, DM, args.in[I_F1G], args.in[I_F1U], DFF, M, DFF, DM, [=](int r, int c, float g, float u) { ACT[(size_t)r * DFF + c] = f2b(silu_f(g) * u); }); }
#else
#if FFN_I8
    if (SET1_FIRST && FUSE_NORM && IN(2) && F.G == 256 && (int)blockIdx.x >= 128) { p0_transposes(F, args, SET1_FIRST == 2 ? 6 : 1, ((int)blockIdx.x - 128) * NWAVES + F.wave, 128 * NWAVES); __syncthreads(); FRESH(); }
    if (SET1_SPLIT && FUSE_NORM && IN(2) && F.G == 256 && (int)blockIdx.x >= 128) { p0_transposes(F, args, 1, ((int)blockIdx.x - 128) * NWAVES + F.wave, 256 * NWAVES); __syncthreads(); FRESH(); }
    if (IN(2)) GEMM_I8(ws + WS_XQ1, ws + WS_WGU1, false, (const float*)(ws + WS_SA1), (const float*)(ws + WS_SW1), nullptr);
#else
    if (IN(2)) GEMM_B(XS, DM, ws + WS_WGU1, 2 * DFF, pg8::EB_SWIGLU, false, false, ws + WS_ACT, DFF, 0, 0, nullptr, nullptr, nullptr, nullptr, 0);
#endif
    FRESH();
    if (SET1_SPLIT && FUSE_NORM && IN(2) && F.G == 256 && (int)blockIdx.x >= 128) p0_transposes(F, args, 1, ((int)blockIdx.x - 128 + 128) * NWAVES + F.wave, 256 * NWAVES);
    else if (SET1_FIRST == 2 && FUSE_NORM && IN(2) && F.G == 256 && (int)blockIdx.x >= 128) p0_transposes(F, args, 5, ((int)blockIdx.x - 128) * NWAVES + F.wave, 128 * NWAVES);
    else if (SET1_FIRST && F.G == 256) { }
    else if (FUSE_NORM && IN(2) && F.G == 256 && (int)blockIdx.x >= 128) p0_transposes(F, args, 1, ((int)blockIdx.x - 128) * NWAVES + F.wave, 128 * NWAVES);
    else if (FUSE_NORM && IN(2) && F.G != 256) p0_transposes(F, args, 1, F.vcu * NWAVES + F.wave, F.G * NWAVES);
#endif
    SEAM(2);
#if defined(NAIVE) && (NAIVE & 2)
    if (IN(3)) { const float* xb = args.in[I_X]; float* ob = F.out; naive_gemm<false>(F, (const bf16*)(ws + WS_ACT), DFF, args.in[I_F1D], nullptr, DM, M, DM, DFF, [=](int r, int c, float v, float) { ob[(size_t)r * DM + c] = xb[(size_t)r * DM + c] + 0.5f * mod[(r / SEQ) * NMOD + MOD_GT1 + c] * v; }); }
#else
    FRESH();
    if (FUSE_NORM && IN(3)) { aux_bias(F, 0);
#if FFN_I8
        aux_bias_i8(F, MOD_SH2, WS_WIN, WS_SWIN, 3 * AW, WS_BIAS_IN, INW);
        if (GATES_I8) aux_bias_i8(F, MOD_SH2, WS_WIN + (size_t)3 * AW * DM, WS_SWIN + 3 * AW * 4, 2 * DM, WS_BIAS_IN + COL_GA * 4, INW);
#endif
    }
    const bool rdv = QRDV && F.G == M / 256 * (DM / 256) && IN(3) && IN(5) && IN(14) && IN(16);
    if (IN(3)) { if (rdv) GEMM_F(FUSE_NORM, false, RES16, (QRDV ? 1 : 0), ws + WS_ACT, DFF, ws + WS_WD1, args.in[I_X], X1B, mod + MOD_GT1, 0.5f, avec, ws + WS_PS2, XQ2P, ws + WS_RF2, ws + WS_AM2, F.ctl + CW_CNT2);
                 else GEMM_F(FUSE_NORM, false, RES16, 0, ws + WS_ACT, DFF, ws + WS_WD1, args.in[I_X], X1B, mod + MOD_GT1, 0.5f, avec, ws + WS_PS2, nullptr, nullptr, nullptr, nullptr); }
#endif
    SEAM(3);
#if FFN_I8
    FRESH();
    if (IN(3) && IN(5) && !rdv) { xs_quant_pass(F, WS_PS2, (signed char*)XQ2P, WS_RF2); xcd_barrier(bar); }
#ifdef PROBE_TA
    if (PROBE_TA == 4) TSTAMP(0);
    if (PROBE_TB == 4) TSTAMP(1);
#endif
#endif
#if !FUSE_NORM
    if (IN(4)) norm_pass(F, F.out, args.in[I_NMIX], MOD_SH2, MOD_SC2);
    SEAM(4);
#endif
#if defined(NAIVE) && (NAIVE & 4)
    if (IN(5)) { bf16* Qb = (bf16*)(ws + WS_Q); naive_gemm<false>(F, (const bf16*)XS, DM, args.in[I_WIN] + COL_Q, nullptr, INW, M, 3 * AW, DM, [=](int r, int c, float v, float) { const int t = c / AW; Qb[(size_t)t * M * AW + (size_t)r * AW + (c - t * AW)] = f2b(v); }); }
#else
#if FFN_I8
    if (SET2_FIRST && FUSE_NORM && IN(5) && F.G == 256 && (int)blockIdx.x >= 128) { p0_transposes(F, args, 2, ((int)blockIdx.x - 128) * NWAVES + F.wave, 128 * NWAVES); __syncthreads(); FRESH(); }
    if (IN(5)) { pg8::Gemm g{(const pb*)(XQ2P), (const pb*)(ws + WS_WIN), M, 3 * AW, DM / 2}; pg8::StaticOrder S; S.init(M, 3 * AW, F.G, (int)blockIdx.x);
        typedef pg8::EpiQ8<0> EpiT; EpiT E{(pb*)(ws + WS_Q), AW, AW, (size_t)(WS_K - WS_Q) / 2, (const float*)(ws + WS_RF2), (const float*)(ws + WS_SWIN), bias_in, INW, args.in[I_QN], args.in[I_KN], 2 * AW, XL, 0};
        pg8::gemm_phase<EpiT, pg8::StaticOrder, true, true>(F.lds + RING_OFF, g, S, E); }
#ifdef PROBE_P5X
    if (IN(5)) { xcd_barrier(bar); TSTAMP(0);
#ifdef PROBE_STAGGER
        if (F.vcu & 1) { const unsigned long long t0s = rt(); while (rt() - t0s < (unsigned long long)(PROBE_STAGGER)) __builtin_amdgcn_s_sleep(8); }
#endif
        pg8::Gemm g{(const pb*)(XQ2P), (const pb*)(ws + WS_WIN), M, 3 * AW, DM / 2}; pg8::StaticOrder S; S.init(M, 3 * AW, F.G, (int)blockIdx.x);
        typedef pg8::EpiQ8<PROBE_P5X> EpiT; EpiT E{(pb*)(ws + WS_Q), AW, AW, (size_t)(WS_K - WS_Q) / 2, (const float*)(ws + WS_RF2), (const float*)(ws + WS_SWIN), bias_in, INW, args.in[I_QN], args.in[I_KN], 2 * AW, XL, 0};
        pg8::gemm_phase<EpiT, pg8::StaticOrder, true, true>(F.lds + RING_OFF, g, S, E); xcd_barrier(bar); TSTAMP(1); }
#endif
#else
    if (IN(5)) GEMM_B(XS, DM, ws + WS_WIN + (size_t)COL_Q * DM * 2, 3 * AW, pg8::EB_PLAIN, FUSE_NORM, FUSE_NORM, ws + WS_Q, AW, AW, (size_t)(WS_K - WS_Q) / 2, nullptr, nullptr, PS2, bias_in + COL_Q, INW);
#endif
    FRESH();
    if (SET2_EARLY || (SET2_FIRST && F.G == 256)) {} else
    if (FUSE_NORM && IN(5) && F.G == 256 && (int)blockIdx.x >= 128) p0_transposes(F, args, 2, ((int)blockIdx.x - 128) * NWAVES + F.wave, 128 * NWAVES);
    else if (FUSE_NORM && IN(5) && F.G != 256) p0_transposes(F, args, 2, F.vcu * NWAVES + F.wave, F.G * NWAVES);
#endif
    SEAM(5);
#if !FUSE_NORM
    if (IN(6)) qknorm_pass(F, args);
    SEAM(6);
#endif
#if defined(NAIVE) && (NAIVE & 8)
    if (IN(7)) naive_attn(F);
#else
    if (IN(7)) attn_phase(F, (char*)lds + RING_OFF);
#endif
    SEAM(7);
#if defined(NAIVE) && (NAIVE & 16)
    if (IN(8)) { bf16* Ub = (bf16*)(ws + WS_U); naive_gemm<false>(F, (const bf16*)XS, DM, args.in[I_WIN] + COL_U, nullptr, INW, M, 3 * DM, DM, [=](int r, int c, float v, float) { const int t = c / DM; Ub[(size_t)t * M * DM + (size_t)r * DM + (c - t * DM)] = f2b(v); }); }
#else
#define GATE_GEMM_I8() do { pg8::Gemm g{(const pb*)(XQ2P), (const pb*)(ws + WS_WIN + (size_t)3 * AW * DM), M, 2 * DM, DM / 2}; pg8::TwinOrder S; S.init(M, DM, F.G, (int)blockIdx.x); S.reps = 2; \
        typedef pg8::EpiG8 EpiT; EpiT E{(unsigned char*)(ws + WS_SGA8), DM, DM, (size_t)(WS_SGC8 - WS_SGA8), (const float*)(ws + WS_RF2), (const float*)(ws + WS_SWIN) + 3 * AW, bias_in + COL_GA, INW, XL, 0}; \
        pg8::gemm_phase<EpiT, pg8::TwinOrder, true, true>(F.lds + RING_OFF, g, S, E); } while (0)
#if GATES_I8 && GATES_EARLY
    const bool gfirst = F.G == 256 && (((int)blockIdx.x >> 3) & 1);
    if (IN(8) && gfirst) { GATE_GEMM_I8(); FRESH(); }
#endif
#if UCPROD
    if (IN(8)) GEMM_B(XS, DM, ws + WS_WIN + (size_t)COL_U * DM * 2, 3 * DM, pg8::EB_PRODPLAIN, FUSE_NORM, false, ws + WS_U, DM, 2 * DM, (size_t)(WS_B - WS_U) / 2, nullptr, nullptr, PS2, bias_in + COL_U, INW);
#else
    if (IN(8)) GEMM_B(XS, DM, ws + WS_WIN + (size_t)COL_U * DM * 2, 3 * DM, pg8::EB_PLAIN, FUSE_NORM, false, ws + WS_U, DM, DM, (size_t)(WS_B - WS_U) / 2, nullptr, nullptr, PS2, bias_in + COL_U, INW);
#endif
#endif
#if GATES_I8 && GATES_EARLY
    if (IN(8) && !gfirst) { FRESH(); GATE_GEMM_I8(); }
#endif
    SEAM(8);
    FRESH();
    if (IN(9)) { merge_conv_pass(F, args);
#if FFN_I8
        aux_bias_i8(F, MOD_SH3, WS_WGU2, WS_SW2, 2 * DFF, WS_BIAS_F2, 2 * DFF);
#else
        if (FUSE_NORM) aux_bias(F, 1);
#endif
    }
    SEAM(9);
    { bf16* SGA = (bf16*)(ws + WS_SGA); bf16* SGC = (bf16*)(ws + WS_SGC); (void)SGA; (void)SGC;
#if defined(NAIVE) && (NAIVE & 32)
      if (IN(10)) naive_gemm<false>(F, (const bf16*)XS, DM, args.in[I_WIN] + COL_GA, nullptr, INW, M, DM, DM, [=](int r, int c, float v, float) { SGA[(size_t)r * DM + c] = f2b(1.0f / (1.0f + __expf(-v))); });
      if (IN(11)) naive_gemm<false>(F, (const bf16*)XS, DM, args.in[I_WIN] + COL_GC, nullptr, INW, M, DM, DM, [=](int r, int c, float v, float) { SGC[(size_t)r * DM + c] = f2b(1.0f / (1.0f + __expf(-v))); });
#else
#if GATES_I8 && GATES_EARLY
#elif GATES_I8
    if (IN(10)) GATE_GEMM_I8();
#elif GATES8
    if (IN(10)) GEMM_BXG(true, pg8::TwinOrder S; S.init(M, DM, F.G, (int)blockIdx.x); S.reps = 2, pg8::TwinOrder, XS, DM, ws + WS_WIN + (size_t)COL_GA * DM * 2, 2 * DM, pg8::EB_SIGMOID, FUSE_NORM, false,
                        ws + WS_SGA8, DM, DM, (size_t)(WS_SGC8 - WS_SGA8), nullptr, nullptr, PS2, bias_in + COL_GA, INW);
#else
    if (IN(10)) GEMM_BX(pg8::TwinOrder S; S.init(M, DM, F.G, (int)blockIdx.x); S.reps = 2, pg8::TwinOrder, XS, DM, ws + WS_WIN + (size_t)COL_GA * DM * 2, 2 * DM, pg8::EB_SIGMOID, FUSE_NORM, false,
                        ws + WS_SGA, DM, DM, (size_t)(WS_SGC - WS_SGA) / 2, nullptr, nullptr, PS2, bias_in + COL_GA, INW);
#endif
#endif
#ifdef NAIVE
    if (IN(11) && IN(12)) xcd_barrier(bar);
#endif
#if defined(NAIVE) && (NAIVE & 512)
      if (IN(12)) naive_gemm<false>(F, (const bf16*)(ws + WS_O), 512, args.in[I_WAB], nullptr, DM, M, DM, 512, [=](int r, int c, float v, float) { SGA[(size_t)r * DM + c] = f2b(b2f(SGA[(size_t)r * DM + c]) * v); });
#else
#if WA_I8
    if (IN(12)) { pg8::Gemm g{(const pb*)(ws + WS_O), (const pb*)(ws + WS_WA), M, DM, 512 / 2}; pg8::StaticOrder S; S.init(M, DM, F.G, (int)blockIdx.x);
        typedef pg8::EpiGM8 EpiT; EpiT E{(pb*)(ws + WS_SGA), DM, (const unsigned char*)(ws + WS_SGA8), (const float*)(ws + WS_RFO), (const float*)(ws + WS_SWA)};
        pg8::gemm_phase<EpiT, pg8::StaticOrder, false, true>(F.lds + RING_OFF, g, S, E); }
#elif GATES8
    if (IN(12)) GEMM_BXG(true, pg8::StaticOrder S; S.init(M, DM, F.G, (int)blockIdx.x), pg8::StaticOrder, ws + WS_O, 512, ws + WS_WA, DM, pg8::EB_GATEMUL, false, false, ws + WS_SGA, DM, 0, 0, ws + WS_SGA8, nullptr, nullptr, nullptr, 0);
#else
    if (IN(12)) GEMM_B(ws + WS_O, 512, ws + WS_WA, DM, pg8::EB_GATEMUL, false, false, ws + WS_SGA, DM, 0, 0, ws + WS_SGA, nullptr, nullptr, nullptr, 0);
#endif
#endif
#ifdef NAIVE
    if (IN(12) && IN(13)) xcd_barrier(bar);
#endif
#if defined(NAIVE) && (NAIVE & 1024)
      if (IN(13)) naive_gemm<false>(F, (const bf16*)(ws + WS_B), DM, args.in[I_WCB], nullptr, DM, M, DM, DM, [=](int r, int c, float v, float) { SGA[(size_t)r * DM + c] = f2b(b2f(SGA[(size_t)r * DM + c]) + b2f(SGC[(size_t)r * DM + c]) * v); });
#else
#if GATES8
    if (IN(13)) GEMM_BXG(true, pg8::StaticOrder S; S.init(M, DM, F.G, (int)blockIdx.x), pg8::StaticOrder, ws + WS_B, DM, ws + WS_WC, DM, pg8::EB_MERGE, false, false, ws + WS_SGA, DM, 0, 0, ws + WS_SGA, ws + WS_SGC8, nullptr, nullptr, 0);
#else
    if (IN(13)) GEMM_B(ws + WS_B, DM, ws + WS_WC, DM, pg8::EB_MERGE, false, false, ws + WS_SGA, DM, 0, 0, ws + WS_SGA, ws + WS_SGC, nullptr, nullptr, 0);
#endif
#endif
    }
    SEAM(13);
#if defined(NAIVE) && (NAIVE & 64)
    if (IN(14)) { float* ob = F.out; naive_gemm<false>(F, (const bf16*)(ws + WS_SGA), DM, args.in[I_WOUT], nullptr, DM, M, DM, DM, [=](int r, int c, float v, float) { ob[(size_t)r * DM + c] += mod[(r / SEQ) * NMOD + MOD_GT2 + c] * v; }); }
#else
    if (IN(14)) { if (rdv) GEMM_F(FUSE_NORM, RES16, RES16, (QRDV ? 2 : 0), ws + WS_SGA, DM, ws + WS_WO, X1B, X2B, mod + MOD_GT2, 1.0f, avec + 2 * DM, ws + WS_PS3, ws + WS_XQ3, ws + WS_RF3, ws + WS_AM3, F.ctl + CW_CNT3);
                  else GEMM_F(FUSE_NORM, RES16, RES16, 0, ws + WS_SGA, DM, ws + WS_WO, X1B, X2B, mod + MOD_GT2, 1.0f, avec + 2 * DM, ws + WS_PS3, nullptr, nullptr, nullptr, nullptr); }
#endif
    SEAM(14);
#if FFN_I8
    FRESH();
    if (IN(14) && IN(16) && !rdv) { xs_quant_pass(F, WS_PS3, (signed char*)(ws + WS_XQ3), WS_RF3); xcd_barrier(bar); }
#ifdef PROBE_TA
    if (PROBE_TA == 15) TSTAMP(0);
    if (PROBE_TB == 15) TSTAMP(1);
#endif
#endif
#if !FUSE_NORM
    if (IN(15)) norm_pass(F, F.out, args.in[I_NF2], MOD_SH3, MOD_SC3);
    SEAM(15);
#endif
#if defined(NAIVE) && (NAIVE & 128)
    if (IN(16)) { bf16* ACT = (bf16*)(ws + WS_ACT); naive_gemm<true>(F, (const bf16*)XS, DM, args.in[I_F2G], args.in[I_F2U], DFF, M, DFF, DM, [=](int r, int c, float g, float u) { ACT[(size_t)r * DFF + c] = f2b(silu_f(g) * u); }); }
#else
#if FFN_I8
    if (WQ_FUSED && IN(16) && F.G == 256 && (int)blockIdx.x >= 128) { p0_transposes(F, args, 4, ((int)blockIdx.x - 128) * NWAVES + F.wave, 128 * NWAVES); __syncthreads(); FRESH(); }
    else if (STAG16 && !WQ_FUSED && IN(16) && F.G == 256 && (int)blockIdx.x >= 128) { const unsigned long long t0s = rt(); while (rt() - t0s < (unsigned long long)(STAG16)) __builtin_amdgcn_s_sleep(8); }
    if (IN(16)) GEMM_I8(ws + WS_XQ3, ws + WS_WGU2, true, (const float*)(ws + WS_RF3), (const float*)(ws + WS_SW2), bias_f2);
#else
    if (IN(16)) GEMM_B(XS, DM, ws + WS_WGU2, 2 * DFF, pg8::EB_SWIGLU, FUSE_NORM, false, ws + WS_ACT, DFF, 0, 0, nullptr, nullptr, PS3, bias_f2, 2 * DFF);
#endif
#endif
    SEAM(16);
#if defined(NAIVE) && (NAIVE & 256)
    if (IN(17)) { float* ob = F.out; naive_gemm<false>(F, (const bf16*)(ws + WS_ACT), DFF, args.in[I_F2D], nullptr, DM, M, DM, DFF, [=](int r, int c, float v, float) { ob[(size_t)r * DM + c] += 0.5f * mod[(r / SEQ) * NMOD + MOD_GT3 + c] * v; }); }
#else
    if (IN(17)) GEMM_F(false, RES16, false, 0, ws + WS_ACT, DFF, ws + WS_WD2, X2B, F.out, mod + MOD_GT3, 0.5f, nullptr, nullptr, nullptr, nullptr, nullptr, nullptr);
#endif
#ifdef PROBE_TA
    if (PROBE_TB == 17) TSTAMP(1);
    xcd_barrier(bar);
    if (blockIdx.x == 0 && F.tid == 0) { const unsigned long long t0_ = ((unsigned long long)F.MISC[17] << 32) | F.MISC[16], t1_ = ((unsigned long long)F.MISC[19] << 32) | F.MISC[18];
#ifdef PROBE_CONST
        F.out[0] += (float)(PROBE_CONST); (void)t0_; (void)t1_; }
#else
        F.out[0] += (float)(PROBE_SCALE) * 0.01f * (float)(t1_ - t0_); }
#endif
#endif
#undef IN
#undef SEAM
#undef XL
#undef PS2
#undef PS3
#undef bias_in
#undef bias_f2
#undef avec
#undef mod
#undef XS
}

extern "C" void kernel_launch(void* const* d_in, const int* in_sizes, int n_in, void* d_out, int out_size, void* d_ws, size_t ws_size, hipStream_t stream) {
    static int grid = 0;
    if (grid == 0) {
        if (n_in != 20 || in_sizes[0] != M * DM || out_size != M * DM || ws_size < WS_END) { fprintf(stderr, "kernel_launch: shape/workspace mismatch (n_in %d, in0 %d, out %d, ws %zu < %zu)\n", n_in, n_in > 0 ? in_sizes[0] : -1, out_size, ws_size, (size_t)WS_END); grid = -1; return; }
        int dev = 0, cus = 0, per_cu = 0;
        if (hipGetDevice(&dev) != hipSuccess || hipDeviceGetAttribute(&cus, hipDeviceAttributeMultiprocessorCount, dev) != hipSuccess) { grid = -1; return; }
        if (hipFuncSetAttribute((const void*)mega_fwd, hipFuncAttributeMaxDynamicSharedMemorySize, LDS_BYTES) != hipSuccess) { fprintf(stderr, "kernel_launch: hipFuncSetAttribute failed\n"); grid = -1; return; }
        if (hipOccupancyMaxActiveBlocksPerMultiprocessor(&per_cu, (const void*)mega_fwd, NWAVES * 64, LDS_BYTES) != hipSuccess || per_cu < 1) { fprintf(stderr, "kernel_launch: occupancy query reports %d workgroups per CU\n", per_cu); }
        (void)hipGetLastError();
        grid = cus;
    }
    if (grid < 0) return;
    (void)hipMemsetAsync((char*)d_ws + WS_CTL, 0, CTL_ZERO_BYTES, stream);
#ifdef PROBE_MEMSET2
    (void)hipMemsetAsync((char*)d_ws + WS_CTL + CTL_ZERO_BYTES, 0, CTL_ZERO_BYTES, stream);
#endif
    Args a{};
    for (int i = 0; i < 20; ++i) a.in[i] = (const float*)d_in[i];
    a.out = (float*)d_out; a.ws = (unsigned char*)d_ws;
#if defined(PROBE_DUP)
    a.ph_lo = 0; a.ph_hi = PROBE_DUP + 1; hipLaunchKernelGGL(mega_fwd, dim3(grid), dim3(NWAVES * 64), LDS_BYTES, stream, a);
    (void)hipMemsetAsync((char*)d_ws + WS_CTL, 0, CTL_ZERO_BYTES, stream);
    a.ph_lo = PROBE_DUP; a.ph_hi = N_PHASES + 1; hipLaunchKernelGGL(mega_fwd, dim3(grid), dim3(NWAVES * 64), LDS_BYTES, stream, a);
#elif defined(PROBE_RLO)
    a.ph_lo = 0; a.ph_hi = PROBE_RHI + 1; hipLaunchKernelGGL(mega_fwd, dim3(grid), dim3(NWAVES * 64), LDS_BYTES, stream, a);
    (void)hipMemsetAsync((char*)d_ws + WS_CTL, 0, CTL_ZERO_BYTES, stream);
    a.ph_lo = PROBE_RLO; a.ph_hi = N_PHASES + 1; hipLaunchKernelGGL(mega_fwd, dim3(grid), dim3(NWAVES * 64), LDS_BYTES, stream, a);
#elif defined(PROBE_SPLIT)
    a.ph_lo = 0; a.ph_hi = PROBE_SPLIT + 1; hipLaunchKernelGGL(mega_fwd, dim3(grid), dim3(NWAVES * 64), LDS_BYTES, stream, a);
    (void)hipMemsetAsync((char*)d_ws + WS_CTL, 0, CTL_ZERO_BYTES, stream);
    a.ph_lo = PROBE_SPLIT + 1; a.ph_hi = N_PHASES + 1; hipLaunchKernelGGL(mega_fwd, dim3(grid), dim3(NWAVES * 64), LDS_BYTES, stream, a);
#elif !defined(MK_PER_PHASE)
    a.ph_lo = 0; a.ph_hi = N_PHASES + 1;
    hipLaunchKernelGGL(mega_fwd, dim3(grid), dim3(NWAVES * 64), LDS_BYTES, stream, a);
#else
    for (int p = 0; p <= N_PHASES; ++p) { a.ph_lo = p; a.ph_hi = p + 1; hipLaunchKernelGGL(mega_fwd, dim3(grid), dim3(NWAVES * 64), LDS_BYTES, stream, a); }
#endif
}
```
